# Optimizing an MI355X kernel written in HIP

```python
import math
import jax
import jax.numpy as jnp
from jax import lax

D_MODEL = 1024
BATCH = 1
SEQ = 16384
DEPTH = 2

CHUNK = 64
Q_BLOCK = 128
HEAD_DIM = D_MODEL // 16
NEG_INF = -1e30
H_A = 4
H_IDX = 4
D_IDX = HEAD_DIM // 2
TOPK_MAX = 256
H_B = 4
CONV_K = 4
H_C = 4
N_PREV_CHUNKS = 8
MAX_REL_PAST = 128
N_REL = CHUNK + MAX_REL_PAST
H_D = 4
DQ_D = HEAD_DIM // 2
W_A = H_A * HEAD_DIM
W_B = H_B * HEAD_DIM
W_C = H_C * HEAD_DIM
W_D = H_D * 2 * DQ_D
W_BRANCH = W_A
N_BRANCH = 4
COL_SIZES = (W_A, W_A, W_A, H_IDX * D_IDX, D_IDX, H_IDX,
             W_B, W_B, W_B, H_B, H_B, W_B,
             W_C, W_C, W_C,
             W_D, W_D, W_D)
C_IN = sum(COL_SIZES)
N_GROUPS = 4
EXPERTS_PER_GROUP = 8
N_EXPERTS = N_GROUPS * EXPERTS_PER_GROUP
TOP_K_INNER = 2
F_EXPERT = D_MODEL // 2
MOE_BLOCK = 128

kernel_name = 'hybrid_gated_dsa_mlstm_band_diffattn_hmoe'


def rmsnorm(x, g, eps=1e-6):
    xf = x.astype(jnp.float32)
    y = xf * lax.rsqrt(jnp.mean(xf * xf, axis=-1, keepdims=True) + eps)
    return (y * g.astype(jnp.float32)).astype(x.dtype)


def head_rmsnorm(x, g):
    h, d = x.shape[-2:]
    return rmsnorm(x, g.reshape(h, d))


def chunk_visible(t_pos, s_pos):
    return (s_pos // CHUNK) <= (t_pos // CHUNK)


def causal_dwconv(x, w, b):
    k, c = w.shape
    y = lax.conv_general_dilated(x, w[:, None, :].astype(x.dtype), window_strides=(1,),
                                 padding=[(k - 1, 0)], dimension_numbers=('NWC', 'WIO', 'NWC'),
                                 feature_group_count=c)
    return y + b.astype(x.dtype)


def split_columns(proj):
    parts = []
    off = 0
    for sz in COL_SIZES:
        parts.append(proj[..., off:off + sz])
        off += sz
    return parts


def dsa_mixer(q, k, v, q_idx, k_idx, w_idx):
    b, s, h, dh = q.shape
    topk = min(TOPK_MAX, s // 4)
    nqb = s // Q_BLOCK
    s_pos = jnp.arange(s)
    k_idx32 = k_idx.astype(jnp.float32)

    def to_blocks(a):
        return jnp.moveaxis(a.reshape(b, nqb, Q_BLOCK, *a.shape[2:]), 1, 0)

    def gather_rows(a, idx):
        return jax.vmap(lambda ab, ib: ab[ib])(a, idx)

    def block(args):
        qb, qib, wib, blk = args
        t_pos = blk * Q_BLOCK + jnp.arange(Q_BLOCK)
        visible = chunk_visible(t_pos[:, None], s_pos[None, :])
        rel = jnp.maximum(jnp.einsum('bqhd,bsd->bqhs', qib.astype(jnp.float32), k_idx32), 0.0)
        score = jnp.einsum('bqhs,bqh->bqs', rel, wib.astype(jnp.float32))
        score = jnp.where(visible[None], score, NEG_INF)
        _, sel = lax.top_k(score, topk)
        sel_ok = chunk_visible(t_pos[None, :, None], sel)
        k_sel = gather_rows(k, sel)
        v_sel = gather_rows(v, sel)
        logits = jnp.einsum('bqhd,bqkhd->bhqk', qb, k_sel).astype(jnp.float32) * (dh ** -0.5)
        logits = jnp.where(sel_ok[:, None], logits, NEG_INF)
        p = jax.nn.softmax(logits, axis=-1).astype(v.dtype)
        return jnp.einsum('bhqk,bqkhd->bqhd', p, v_sel)

    out = lax.map(block, (to_blocks(q), to_blocks(q_idx), to_blocks(w_idx), jnp.arange(nqb)))
    return jnp.moveaxis(out, 0, 1).reshape(b, s, h, dh)


def mlstm_mixer(q, k, v, i_pre, f_pre, o_pre, norm_g):
    b, s, h, d = q.shape
    n_chunks = s // CHUNK

    def to_chunks(a):
        a = a.reshape(b, n_chunks, CHUNK, h, *a.shape[3:])
        return jnp.moveaxis(jnp.moveaxis(a, 1, 0), 3, 2)

    qc = to_chunks(q.astype(jnp.float32))
    kc = to_chunks(k.astype(jnp.float32) * (d ** -0.5))
    vc = to_chunks(v.astype(jnp.float32))
    ic = to_chunks(i_pre.astype(jnp.float32))
    lfc = to_chunks(jax.nn.log_sigmoid(f_pre.astype(jnp.float32)))
    causal = jnp.tril(jnp.ones((CHUNK, CHUNK), dtype=bool))

    def step(carry, xs):
        c_mat, n_vec, m = carry
        qt, kt, vt, it, lft = xs
        cum = jnp.cumsum(lft, axis=-1)
        dmat = cum[..., :, None] - cum[..., None, :] + it[..., None, :]
        dmat = jnp.where(causal, dmat, NEG_INF)
        m_inter = cum + m[..., None]
        m_t = jnp.maximum(m_inter, jnp.max(dmat, axis=-1))
        w = jnp.exp(dmat - m_t[..., None]) * jnp.einsum('bhtd,bhsd->bhts', qt, kt)
        inter = jnp.exp(m_inter - m_t)
        num = inter[..., None] * jnp.einsum('bhtk,bhvk->bhtv', qt, c_mat) + jnp.einsum('bhts,bhsv->bhtv', w, vt)
        den = inter * jnp.einsum('bhtk,bhk->bht', qt, n_vec) + jnp.sum(w, axis=-1)
        h_t = num / jnp.maximum(jnp.abs(den), jnp.exp(-m_t))[..., None]
        cum_end = cum[..., -1]
        g = cum_end[..., None] - cum + it
        m_new = jnp.maximum(cum_end + m, jnp.max(g, axis=-1))
        carry_scale = jnp.exp(cum_end + m - m_new)
        src = jnp.exp(g - m_new[..., None])
        c_new = carry_scale[..., None, None] * c_mat + jnp.einsum('bhs,bhsv,bhsk->bhvk', src, vt, kt)
        n_new = carry_scale[..., None] * n_vec + jnp.einsum('bhs,bhsk->bhk', src, kt)
        return (c_new, n_new, m_new), h_t

    init = (jnp.zeros((b, h, d, d), jnp.float32), jnp.zeros((b, h, d), jnp.float32),
            jnp.zeros((b, h), jnp.float32))
    _, hc = lax.scan(step, init, (qc, kc, vc, ic, lfc))
    hs = jnp.moveaxis(jnp.moveaxis(hc, 2, 3), 0, 1).reshape(b, s, h, d).astype(q.dtype)
    return jax.nn.sigmoid(o_pre) * head_rmsnorm(hs, norm_g)


def chunk_band_attention(q, k, v, rel_bias):
    b, s, h, d = q.shape
    n_chunks = s // CHUNK
    n_band = N_PREV_CHUNKS + 1
    qc = q.reshape(b, n_chunks, CHUNK, h, d)
    pad = ((0, 0), (N_PREV_CHUNKS, 0), (0, 0), (0, 0), (0, 0))
    kp = jnp.pad(k.reshape(b, n_chunks, CHUNK, h, d), pad)
    vp = jnp.pad(v.reshape(b, n_chunks, CHUNK, h, d), pad)
    band_idx = jnp.arange(n_chunks)[:, None] + jnp.arange(n_band)[None, :]
    kb = kp[:, band_idx].reshape(b, n_chunks, n_band * CHUNK, h, d)
    vb = vp[:, band_idx].reshape(b, n_chunks, n_band * CHUNK, h, d)
    band_ok = (jnp.arange(n_chunks)[:, None] - N_PREV_CHUNKS + jnp.arange(n_band)[None, :]) >= 0
    key_ok = jnp.repeat(band_ok, CHUNK, axis=1)
    dist = N_PREV_CHUNKS * CHUNK + jnp.arange(CHUNK)[:, None] - jnp.arange(n_band * CHUNK)[None, :]
    rel_id = jnp.clip(dist, -(CHUNK - 1), MAX_REL_PAST) + (CHUNK - 1)
    bias = rel_bias[:, rel_id].astype(jnp.float32)
    logits = jnp.einsum('bcihd,bcphd->bhcip', qc, kb).astype(jnp.float32) * (d ** -0.5) + bias[:, None]
    logits = jnp.where(key_ok[None, None, :, None, :], logits, NEG_INF)
    p = jax.nn.softmax(logits, axis=-1).astype(v.dtype)
    return jnp.einsum('bhcip,bcphd->bcihd', p, vb).reshape(b, s, h, d)


def diff_attention(q, k, v, lam_params, norm_g, lam_init):
    b, s, h, _, dq = q.shape
    lp = lam_params.astype(jnp.float32)
    lam = jnp.exp(jnp.sum(lp[0] * lp[1])) - jnp.exp(jnp.sum(lp[2] * lp[3])) + lam_init
    nqb = s // Q_BLOCK
    s_pos = jnp.arange(s)
    q_blocks = jnp.moveaxis(q.reshape(b, nqb, Q_BLOCK, h, 2, dq), 1, 0)

    def block(args):
        qb, blk = args
        t_pos = blk * Q_BLOCK + jnp.arange(Q_BLOCK)
        visible = chunk_visible(t_pos[:, None], s_pos[None, :])
        logits = jnp.einsum('bqhrd,bshrd->bhrqs', qb, k).astype(jnp.float32) * (dq ** -0.5)
        p = jax.nn.softmax(jnp.where(visible, logits, NEG_INF), axis=-1)
        a = (p[:, :, 0] - lam * p[:, :, 1]).astype(v.dtype)
        return jnp.einsum('bhqs,bshd->bqhd', a, v)

    out = lax.map(block, (q_blocks, jnp.arange(nqb)))
    out = jnp.moveaxis(out, 0, 1).reshape(b, s, h, v.shape[-1])
    return head_rmsnorm(out, norm_g) * (1.0 - lam_init)


def hier_moe(h, gw, gb, ew, eb, w1, w3, w2):
    b, s, d = h.shape
    t = b * s
    xt = h.reshape(t, d)
    g_logits = jnp.einsum('td,dg->tg', xt, gw).astype(jnp.float32) + gb.astype(jnp.float32)
    g_sel = jnp.argmax(g_logits, axis=-1)
    g_gate = jnp.take_along_axis(jax.nn.softmax(g_logits, axis=-1), g_sel[:, None], axis=1)
    e_logits = (jnp.einsum('td,de->te', xt, ew).astype(jnp.float32) + eb.astype(jnp.float32))
    e_logits = e_logits.reshape(t, N_GROUPS, EXPERTS_PER_GROUP)
    e_in_group = jnp.take_along_axis(e_logits, g_sel[:, None, None], axis=1)[:, 0]
    top_v, top_i = lax.top_k(e_in_group, TOP_K_INNER)
    gate = jax.nn.softmax(top_v, axis=-1) * g_gate
    n_assign = t * TOP_K_INNER
    eid = (g_sel[:, None] * EXPERTS_PER_GROUP + top_i).reshape(n_assign).astype(jnp.int32)
    tok = jnp.repeat(jnp.arange(t, dtype=jnp.int32), TOP_K_INNER)
    wt = gate.reshape(n_assign)
    order = jnp.argsort(eid)
    se = eid[order]
    counts = jnp.bincount(eid, length=N_EXPERTS)
    padded = (counts + MOE_BLOCK - 1) // MOE_BLOCK * MOE_BLOCK
    ends_pad = jnp.cumsum(padded)
    starts_pad = ends_pad - padded
    starts = jnp.cumsum(counts) - counts
    dest = starts_pad[se] + (jnp.arange(n_assign) - starts[se])
    n_rows = -(-(n_assign + N_EXPERTS * (MOE_BLOCK - 1)) // MOE_BLOCK) * MOE_BLOCK
    n_blocks = n_rows // MOE_BLOCK
    row_tok = jnp.zeros((n_rows,), jnp.int32).at[dest].set(tok[order])
    row_w = jnp.zeros((n_rows,), jnp.float32).at[dest].set(wt[order])
    block_e = jnp.minimum(jnp.searchsorted(ends_pad, jnp.arange(n_blocks) * MOE_BLOCK, side='right'),
                          N_EXPERTS - 1)
    xs = xt[row_tok].reshape(n_blocks, MOE_BLOCK, d)

    def expert_block(args):
        xb, e = args
        return (jax.nn.silu(xb @ w1[e]) * (xb @ w3[e])) @ w2[e]

    ys = lax.map(expert_block, (xs, block_e)).reshape(n_rows, d)
    out = jnp.zeros((t, d), h.dtype).at[row_tok].add((ys * row_w[:, None]).astype(h.dtype))
    return out.reshape(b, s, d)


def hybrid_layer(x, layer_idx, norm_mix_g, w_in, conv_w, conv_b, i_bias, f_bias, mnorm_g,
                 rel_bias, lam_p, dnorm_g, w_branch, w_gate, w_out, norm_ffn_g,
                 rgw, rgb, rew, reb, w1, w3, w2):
    b, s, d = x.shape
    h = rmsnorm(x, norm_mix_g)
    proj = jnp.einsum('bsd,dc->bsc', h, w_in)
    (qa, ka, va, qi, ki, wi, qb, kb, vb, ib, fb, ob, qc, kc, vc, qd, kd, vd) = split_columns(proj)

    y_a = dsa_mixer(qa.reshape(b, s, H_A, HEAD_DIM), ka.reshape(b, s, H_A, HEAD_DIM),
                    va.reshape(b, s, H_A, HEAD_DIM), qi.reshape(b, s, H_IDX, D_IDX), ki, wi)

    qk_b = jax.nn.silu(causal_dwconv(jnp.concatenate([qb, kb], axis=-1), conv_w, conv_b))
    y_b = mlstm_mixer(qk_b[..., :W_B].reshape(b, s, H_B, HEAD_DIM),
                      qk_b[..., W_B:].reshape(b, s, H_B, HEAD_DIM),
                      vb.reshape(b, s, H_B, HEAD_DIM), ib + i_bias, fb + f_bias,
                      ob.reshape(b, s, H_B, HEAD_DIM), mnorm_g)

    y_c = chunk_band_attention(qc.reshape(b, s, H_C, HEAD_DIM), kc.reshape(b, s, H_C, HEAD_DIM),
                               vc.reshape(b, s, H_C, HEAD_DIM), rel_bias)

    lam_init = 0.8 - 0.6 * math.exp(-0.3 * layer_idx)
    y_d = diff_attention(qd.reshape(b, s, H_D, 2, DQ_D), kd.reshape(b, s, H_D, 2, DQ_D),
                         vd.reshape(b, s, H_D, 2 * DQ_D), lam_p, dnorm_g, lam_init)

    branches = jnp.stack([y_a.reshape(b, s, W_BRANCH), y_b.reshape(b, s, W_BRANCH),
                          y_c.reshape(b, s, W_BRANCH), y_d.reshape(b, s, W_BRANCH)], axis=2)
    up = jnp.einsum('bsnw,nwd->bsnd', branches, w_branch)
    gates = jax.nn.sigmoid(jnp.einsum('bsd,de->bse', h, w_gate)).reshape(b, s, N_BRANCH, d)
    mixed = jnp.sum(gates * up, axis=2)
    x = x + jnp.einsum('bsd,de->bse', mixed, w_out)

    h2 = rmsnorm(x, norm_ffn_g)
    return x + hier_moe(h2, rgw, rgb, rew, reb, w1, w3, w2)


def setup_inputs(seed: int = 0) -> dict:
    key = jax.random.key(seed)
    ks = jax.random.split(key, 24)
    f32 = jnp.float32
    nl = DEPTH

    def nrm(k, shape, scale):
        return jax.random.normal(k, shape, f32) * scale

    return {
        'x': nrm(ks[0], (BATCH, SEQ, D_MODEL), 1.0),
        'norm_mix_g': 1.0 + nrm(ks[1], (nl, D_MODEL), 0.01),
        'w_in': nrm(ks[2], (nl, D_MODEL, C_IN), D_MODEL ** -0.5),
        'conv_w': nrm(ks[3], (nl, CONV_K, 2 * W_B), CONV_K ** -0.5),
        'conv_b': nrm(ks[4], (nl, 2 * W_B), 0.01),
        'mlstm_i_bias': nrm(ks[5], (nl, H_B), 0.1),
        'mlstm_f_bias': jnp.linspace(3.0, 6.0, H_B, dtype=f32)[None, :] + nrm(ks[6], (nl, H_B), 0.1),
        'mlstm_norm_g': 1.0 + nrm(ks[7], (nl, W_B), 0.01),
        'relpos_bias': nrm(ks[8], (nl, H_C, N_REL), 0.1),
        'diff_lambda': nrm(ks[9], (nl, 4, DQ_D), 0.1),
        'diff_norm_g': 1.0 + nrm(ks[10], (nl, W_D), 0.01),
        'w_branch': nrm(ks[11], (nl, N_BRANCH, W_BRANCH, D_MODEL), W_BRANCH ** -0.5),
        'w_gate': nrm(ks[12], (nl, D_MODEL, N_BRANCH * D_MODEL), D_MODEL ** -0.5),
        'w_out': nrm(ks[13], (nl, D_MODEL, D_MODEL), (N_BRANCH * D_MODEL) ** -0.5),
        'norm_ffn_g': 1.0 + nrm(ks[14], (nl, D_MODEL), 0.01),
        'router_group_w': nrm(ks[15], (nl, D_MODEL, N_GROUPS), D_MODEL ** -0.5),
        'router_group_b': nrm(ks[16], (nl, N_GROUPS), 0.01),
        'router_expert_w': nrm(ks[17], (nl, D_MODEL, N_EXPERTS), D_MODEL ** -0.5),
        'router_expert_b': nrm(ks[18], (nl, N_EXPERTS), 0.01),
        'expert_w1': nrm(ks[19], (nl, N_EXPERTS, D_MODEL, F_EXPERT), D_MODEL ** -0.5),
        'expert_w3': nrm(ks[20], (nl, N_EXPERTS, D_MODEL, F_EXPERT), D_MODEL ** -0.5),
        'expert_w2': nrm(ks[21], (nl, N_EXPERTS, F_EXPERT, D_MODEL), F_EXPERT ** -0.5),
        'final_norm_g': 1.0 + nrm(ks[22], (D_MODEL,), 0.01),
    }


def reference(x, norm_mix_g, w_in, conv_w, conv_b, mlstm_i_bias, mlstm_f_bias, mlstm_norm_g,
              relpos_bias, diff_lambda, diff_norm_g, w_branch, w_gate, w_out, norm_ffn_g,
              router_group_w, router_group_b, router_expert_w, router_expert_b,
              expert_w1, expert_w3, expert_w2, final_norm_g):
    for l in range(DEPTH):
        x = hybrid_layer(x, l, norm_mix_g[l], w_in[l], conv_w[l], conv_b[l], mlstm_i_bias[l],
                         mlstm_f_bias[l], mlstm_norm_g[l], relpos_bias[l], diff_lambda[l],
                         diff_norm_g[l], w_branch[l], w_gate[l], w_out[l], norm_ffn_g[l],
                         router_group_w[l], router_group_b[l], router_expert_w[l],
                         router_expert_b[l], expert_w1[l], expert_w3[l], expert_w2[l])
    return rmsnorm(x, final_norm_g)
```

```cpp
#include <hip/hip_runtime.h>
#include <cstdio>
#include <cstdint>

#define GAS __attribute__((address_space(1)))
#define LAS __attribute__((address_space(3)))
typedef unsigned short bf16;
typedef short bf16x8 __attribute__((ext_vector_type(8)));
typedef short s16x4 __attribute__((ext_vector_type(4)));
typedef float f32x2 __attribute__((ext_vector_type(2)));
typedef float f32x4 __attribute__((ext_vector_type(4)));
typedef float f32x16 __attribute__((ext_vector_type(16)));
typedef unsigned u32x2 __attribute__((ext_vector_type(2)));
typedef unsigned u32x4 __attribute__((ext_vector_type(4)));

#ifndef MK_MULTI
#define MK_MULTI 0
#endif

constexpr int S = 16384, D = 1024, NL = 2, NCH = 256;
constexpr int PW = 3584;
constexpr int C_QA = 0, C_KA = 256, C_VA = 512, C_QI = 768, C_KI = 896, C_WI = 928, C_IB = 932, C_FB = 936, C_QB = 960, C_KB = 1216,
              C_VB = 1472, C_OB = 1728, C_QC = 1984, C_KC = 2240, C_VC = 2496, C_QD = 2752, C_KD = 3008, C_VD = 3264;
constexpr int CIN = 3500;
constexpr int NE = 32, FE = 512, NRMAX = 40960, NBMAX = 160;
constexpr float RMS_EPS = 1e-6f;

constexpr size_t MiB = 1u << 20;
constexpr size_t WS_CTL = 0, CTL_ZERO_BYTES = 1 * MiB;
constexpr size_t WS_WIN = 1 * MiB;
constexpr size_t WS_WBR = WS_WIN + 7 * MiB;
constexpr size_t WS_WGATE = WS_WBR + 2 * MiB;
constexpr size_t WS_WOUT = WS_WGATE + 8 * MiB;
constexpr size_t WS_W13 = WS_WOUT + 2 * MiB;
constexpr size_t WS_W2 = WS_W13 + 64 * MiB;
constexpr size_t WS_H = WS_W2 + 32 * MiB;
constexpr size_t WS_PU = WS_H + 32 * MiB;
constexpr size_t WS_XS = WS_PU;
constexpr size_t WS_ACT = WS_PU + 80 * MiB;
constexpr size_t WS_Y = WS_PU + 128 * MiB;
constexpr size_t WS_MIXED = WS_Y + 32 * MiB;
constexpr size_t WS_CAND = WS_MIXED + 32 * MiB;
constexpr size_t WS_YE = WS_Y;
constexpr size_t WS_MLC = WS_CAND + 128 * MiB;
constexpr size_t WS_MLN = WS_MLC + 16 * MiB;
constexpr size_t WS_MLS = WS_MLN + 256 * 1024;
constexpr size_t WS_RT = WS_MLS + 64 * 1024;
constexpr size_t WS_SEL = WS_RT + 1 * MiB;
constexpr size_t WS_NSEL = WS_SEL + 8 * MiB;
constexpr size_t WS_END = WS_NSEL + 1 * MiB;
static_assert(WS_YE + (size_t)NRMAX * 1024 * 2 <= WS_MLC, "ye overlay");
static_assert(WS_ACT + (size_t)NRMAX * 512 * 2 <= WS_Y, "act overlay");
constexpr int CW_BAR = 4096;
constexpr int CW_CNT = 16384;
constexpr int CW_FILL = 16384 + 64;

constexpr int RING_BYTES = 131072;
constexpr int LDS_BYTES = 163840;
constexpr int LDSCTL_OFF = LDS_BYTES - 2048;
constexpr int MISC_OFF = LDSCTL_OFF + 1024;

__device__ __forceinline__ unsigned f2bf(float f) { unsigned u = __builtin_bit_cast(unsigned, f); return (u + 0x7fffu + ((u >> 16) & 1u)) >> 16; }
__device__ __forceinline__ unsigned pk2(float lo, float hi) { return f2bf(lo) | (f2bf(hi) << 16); }
__device__ __forceinline__ float bflo(unsigned w) { return __builtin_bit_cast(float, w << 16); }
__device__ __forceinline__ float bfhi(unsigned w) { return __builtin_bit_cast(float, w & 0xffff0000u); }
__device__ __forceinline__ float bf2f(bf16 b) { return __builtin_bit_cast(float, (unsigned)b << 16); }
#define LDS_WAIT() asm volatile("s_waitcnt lgkmcnt(0)" ::: "memory")
#define VM_WAIT() asm volatile("s_waitcnt vmcnt(0)" ::: "memory")
__device__ __forceinline__ float wave_sum(float v) {
#pragma unroll
    for (int o = 1; o < 64; o <<= 1) v += __shfl_xor(v, o);
    return v;
}
__device__ __forceinline__ float wave_max(float v) {
#pragma unroll
    for (int o = 1; o < 64; o <<= 1) v = fmaxf(v, __shfl_xor(v, o));
    return v;
}

namespace pg8 {
#define PG8_LAS __attribute__((address_space(3)))
typedef unsigned short bf16_t;
constexpr int BM = 256, BK = 64, HALF = 128, HTB = HALF * BK * 2, STAGE_BYTES = 8 * HTB, NXCD = 8, WGM = 8;
__host__ __device__ __forceinline__ int lds_byte(int r, int c) { const int st = (r >> 4) * 2 + (c >> 5), rr = r & 15, cc = c & 31, ob = rr * 64 + cc * 2; return st * 1024 + (ob ^ (((ob >> 9) & 1) << 5)); }
__host__ __device__ __forceinline__ void stage_rc(int b, int& R, int& C) { const int st = b / 1024, sb = b % 1024, swz = sb ^ (((sb >> 9) & 1) << 5); R = (st >> 1) * 16 + swz / 64; C = (st & 1) * 32 + (swz % 64) / 2; }
__host__ __device__ __forceinline__ int perm32(int rho) { const int n = rho >> 4, i = rho & 15; return 8 * (i >> 2) + 4 * n + (i & 3); }
struct Unit { int pm, pn; };
struct Gemm { const bf16_t* A; const bf16_t* Bt; int M, N, K; };
struct StaticOrder {
    int nM, nN, nwg, G, c;
    __host__ __device__ void init(int M, int N, int G_, int c_) { nM = M / BM; nN = N / BM; nwg = nM * nN; G = G_; c = c_; }
    __host__ __device__ bool next(int i, Unit& u) const {
        const long L = (long)i * G + c; if (L >= nwg) return false;
        int wgid = (int)L; { const int q = nwg / NXCD, r = nwg % NXCD, xcd = wgid % NXCD, off = wgid / NXCD; wgid = (xcd < r ? xcd * (q + 1) : r * (q + 1) + (xcd - r) * q) + off; }
        const int nig = WGM * nN, gid = wgid / nig, fm = gid * WGM, gsz = (nM - fm) < WGM ? (nM - fm) : WGM;
        u.pm = fm + ((wgid % nig) % gsz); u.pn = (wgid % nig) / gsz; return true;
    }
    __device__ __forceinline__ void a_ready(const Unit&) const {}
    __device__ __forceinline__ void done(const Unit&) const {}
};
__device__ __forceinline__ unsigned cvt_pk_bf16(float lo, float hi) { unsigned r; asm volatile("v_cvt_pk_bf16_f32 %0, %1, %2" : "=v"(r) : "v"(lo), "v"(hi)); return r; }

template <class Epi, class Sched, bool ALIGN_EPI = false, bool SP2 = false>
__device__ __forceinline__ void gemm_phase(PG8_LAS unsigned char* lds, const Gemm g, const Sched& S, const Epi& E, const int tid) {
    const int wid = __builtin_amdgcn_readfirstlane(tid >> 6), lane = tid & 63, wr = wid >> 2, wc = wid & 3, fr = lane & 15, fq = lane >> 4;
    int Kl_ = g.K; asm volatile("" : "+s"(Kl_));
    const int K = Kl_, nt = K / BK;
    unsigned voffA[2], voffB[2];
#pragma unroll
    for (int i = 0; i < 2; ++i) { int R, C; stage_rc(tid * 16 + i * 8192, R, C); const int Rb = Epi::PERM ? ((R & ~31) + perm32(R & 31)) : R;
        voffA[i] = (unsigned)(R * K + C) * 2u; voffB[i] = (unsigned)(Rb * K + C) * 2u; }
    const size_t kstep = (size_t)(BK * 2);
    const size_t hstep = (size_t)HALF * K * 2;
    const size_t tstep = 2 * hstep;
    const unsigned ldsw = (unsigned)wid * 1024u;
    const int aoff = lds_byte(wr * 64 + fr, fq * 8), boff = lds_byte(wc * 32 + fr, fq * 8);
#define PG8_SA(b, h) (((b) * 2 + (h)) * HTB)
#define PG8_SB(b, h) ((4 + (b) * 2 + (h)) * HTB)
#define PG8_STAGE(bufoff, gbase, voff) do { _Pragma("unroll") for (int _i = 0; _i < 2; ++_i) \
        __builtin_amdgcn_global_load_lds((const unsigned*)((const char*)(gbase) + (voff)[_i]), (PG8_LAS unsigned*)(lds + (bufoff) + ldsw + _i * 8192), 16, 0, 0); } while (0)
#define PG8_LDA(dst, b, h) do { _Pragma("unroll") for (int m = 0; m < 4; ++m) _Pragma("unroll") for (int k = 0; k < 2; ++k) dst[m][k] = *(const PG8_LAS bf16x8*)(lds + PG8_SA(b, h) + aoff + m * 2048 + k * 1024); } while (0)
#define PG8_LDB(dst, b, h) do { _Pragma("unroll") for (int n = 0; n < 2; ++n) _Pragma("unroll") for (int k = 0; k < 2; ++k) dst[n][k] = *(const PG8_LAS bf16x8*)(lds + PG8_SB(b, h) + boff + n * 2048 + k * 1024); } while (0)
#define PG8_MMA(ai, bj, At, Bt) do { __builtin_amdgcn_s_setprio(1); _Pragma("unroll") for (int m = 0; m < 4; ++m) _Pragma("unroll") for (int n = 0; n < 2; ++n) _Pragma("unroll") for (int k = 0; k < 2; ++k) \
        acc[ai][bj][m][n] = __builtin_amdgcn_mfma_f32_16x16x32_bf16(Bt[n][k], At[m][k], acc[ai][bj][m][n], 0, 0, 0); __builtin_amdgcn_s_setprio(0); } while (0)
#define PG8_WAIT_V(n) asm volatile("s_waitcnt vmcnt(" #n ")" ::: "memory")
#define PG8_WAIT_L(n) asm volatile("s_waitcnt lgkmcnt(" #n ")" ::: "memory")
#define PG8_BAR __builtin_amdgcn_s_barrier()
#define PG8_SCHED __builtin_amdgcn_sched_barrier(0)
    Unit cur, nxt; int ui = 0;
    if (!S.next(0, cur)) return;
    f32x4 acc[2][2][4][2];
#pragma unroll
    for (int a = 0; a < 2; ++a)
#pragma unroll
        for (int b = 0; b < 2; ++b)
#pragma unroll
            for (int m = 0; m < 4; ++m)
#pragma unroll
                for (int n = 0; n < 2; ++n) acc[a][b][m][n] = (f32x4){0.f, 0.f, 0.f, 0.f};
    bf16x8 At[4][2], B0[2][2], B1[2][2];
    const char* cA = (const char*)g.A + (size_t)cur.pm * tstep; const char* cB = (const char*)g.Bt + (size_t)cur.pn * tstep;
    S.a_ready(cur);
    if constexpr (SP2) {
        PG8_STAGE(PG8_SB(0, 0), cB, voffB); PG8_STAGE(PG8_SB(0, 1), cB + hstep, voffB); PG8_STAGE(PG8_SA(0, 0), cA, voffA); PG8_STAGE(PG8_SA(0, 1), cA + hstep, voffA);
        if (wr == 1) PG8_BAR;
        PG8_WAIT_V(2); PG8_BAR;
        PG8_STAGE(PG8_SB(1, 0), cB + kstep, voffB); PG8_STAGE(PG8_SA(1, 0), cA + kstep, voffA); PG8_STAGE(PG8_SB(1, 1), cB + hstep + kstep, voffB);
        PG8_WAIT_V(6); PG8_BAR;
    } else {
        PG8_STAGE(PG8_SB(0, 0), cB, voffB); PG8_STAGE(PG8_SA(0, 0), cA, voffA); PG8_STAGE(PG8_SB(0, 1), cB + hstep, voffB); PG8_STAGE(PG8_SA(0, 1), cA + hstep, voffA);
        if (wr == 1) PG8_BAR;
        PG8_WAIT_V(4); PG8_BAR;
        PG8_STAGE(PG8_SB(1, 0), cB + kstep, voffB); PG8_STAGE(PG8_SA(1, 0), cA + kstep, voffA); PG8_STAGE(PG8_SB(1, 1), cB + hstep + kstep, voffB);
        PG8_WAIT_V(6); PG8_BAR;
    }
    for (;;) {
        const bool has_next = S.next(ui + 1, nxt);
        const char* nA = has_next ? (const char*)g.A + (size_t)nxt.pm * tstep : cA; const char* nB = has_next ? (const char*)g.Bt + (size_t)nxt.pn * tstep : cB;
        for (int t = 0; t < nt; t += 2) {
            const bool last = (t == nt - 2);
            const char* a1 = cA + (size_t)(t + 1) * kstep;
            const char* a2 = last ? nA : cA + (size_t)(t + 2) * kstep; const char* b2 = last ? nB : cB + (size_t)(t + 2) * kstep;
            const char* a3 = a2 + kstep; const char* b3 = b2 + kstep;
            if (last && has_next) S.a_ready(nxt);
            if constexpr (SP2) {
            PG8_LDB(B0, 0, 0); PG8_LDB(B1, 0, 1); PG8_SCHED; PG8_LDA(At, 0, 0); PG8_STAGE(PG8_SA(1, 1), a1 + hstep, voffA);
            PG8_WAIT_V(8); PG8_WAIT_L(0); PG8_BAR; PG8_MMA(0, 0, At, B0); PG8_MMA(0, 1, At, B1); PG8_BAR; PG8_SCHED;
            PG8_LDA(At, 0, 1); PG8_STAGE(PG8_SB(0, 0), b2, voffB); PG8_STAGE(PG8_SB(0, 1), b2 + hstep, voffB); PG8_STAGE(PG8_SA(0, 0), a2, voffA);
            PG8_WAIT_V(8); PG8_WAIT_L(0); PG8_BAR; PG8_MMA(1, 0, At, B0); PG8_MMA(1, 1, At, B1); PG8_BAR; PG8_SCHED;
            PG8_LDB(B0, 1, 0); PG8_LDB(B1, 1, 1); PG8_SCHED; PG8_LDA(At, 1, 0); PG8_STAGE(PG8_SA(0, 1), a2 + hstep, voffA);
            PG8_WAIT_V(8); PG8_WAIT_L(0); PG8_BAR; PG8_MMA(0, 0, At, B0); PG8_MMA(0, 1, At, B1); PG8_BAR; PG8_SCHED;
            PG8_LDA(At, 1, 1); PG8_STAGE(PG8_SB(1, 0), b3, voffB); PG8_STAGE(PG8_SB(1, 1), b3 + hstep, voffB); PG8_STAGE(PG8_SA(1, 0), a3, voffA);
            PG8_WAIT_V(8); PG8_WAIT_L(0); PG8_BAR; PG8_MMA(1, 0, At, B0); PG8_MMA(1, 1, At, B1); PG8_BAR; PG8_SCHED;
            } else {
            PG8_LDB(B0, 0, 0); PG8_SCHED; PG8_LDA(At, 0, 0); PG8_STAGE(PG8_SA(1, 1), a1 + hstep, voffA);
            PG8_WAIT_L(8); PG8_BAR; PG8_WAIT_L(0); PG8_MMA(0, 0, At, B0); PG8_BAR; PG8_SCHED;
            PG8_LDB(B1, 0, 1); PG8_STAGE(PG8_SB(0, 0), b2, voffB);
            PG8_BAR; PG8_WAIT_L(0); PG8_MMA(0, 1, At, B1); PG8_BAR;
            PG8_LDA(At, 0, 1); PG8_STAGE(PG8_SA(0, 0), a2, voffA);
            PG8_BAR; PG8_WAIT_L(0); PG8_MMA(1, 0, At, B0); PG8_BAR; PG8_SCHED;
            PG8_STAGE(PG8_SB(0, 1), b2 + hstep, voffB);
            PG8_WAIT_V(6); PG8_BAR; PG8_MMA(1, 1, At, B1); PG8_BAR;
            PG8_LDB(B0, 1, 0); PG8_SCHED; PG8_LDA(At, 1, 0); PG8_STAGE(PG8_SA(0, 1), a2 + hstep, voffA);
            PG8_WAIT_L(8); PG8_BAR; PG8_WAIT_L(0); PG8_MMA(0, 0, At, B0); PG8_BAR; PG8_SCHED;
            PG8_LDB(B1, 1, 1); PG8_STAGE(PG8_SB(1, 0), b3, voffB);
            PG8_BAR; PG8_WAIT_L(0); PG8_MMA(0, 1, At, B1); PG8_BAR;
            PG8_LDA(At, 1, 1); PG8_STAGE(PG8_SA(1, 0), a3, voffA);
            PG8_BAR; PG8_WAIT_L(0); PG8_MMA(1, 0, At, B0); PG8_BAR; PG8_SCHED;
            PG8_STAGE(PG8_SB(1, 1), b3 + hstep, voffB);
            PG8_WAIT_V(6); PG8_BAR; PG8_MMA(1, 1, At, B1); PG8_BAR;
            }
        }
        if constexpr (ALIGN_EPI) { if (wr == 0) PG8_BAR; }
        E(acc, cur, wr, wc, fr, fq); S.done(cur);
        if (!has_next) break;
#pragma unroll
        for (int a = 0; a < 2; ++a)
#pragma unroll
            for (int b = 0; b < 2; ++b)
#pragma unroll
                for (int m = 0; m < 4; ++m)
#pragma unroll
                    for (int n = 0; n < 2; ++n) acc[a][b][m][n] = (f32x4){0.f, 0.f, 0.f, 0.f};
        cur = nxt; cA = nA; cB = nB; ++ui;
        if constexpr (ALIGN_EPI) { if (wr == 1) PG8_BAR; }
    }
    PG8_WAIT_V(0);
    if constexpr (!ALIGN_EPI) { if (wr == 0) PG8_BAR; }
    PG8_BAR;
#undef PG8_SA
#undef PG8_SB
#undef PG8_STAGE
#undef PG8_LDA
#undef PG8_LDB
#undef PG8_MMA
#undef PG8_WAIT_V
#undef PG8_WAIT_L
#undef PG8_BAR
#undef PG8_SCHED
}

struct EpiStore {
    static constexpr bool PERM = true;
    bf16_t* O; int ldc; int rowmask;
    __device__ __forceinline__ void operator()(const f32x4 (&acc)[2][2][4][2], const Unit& u, int wr, int wc, int fr, int fq) const {
        const int row0 = (u.pm & rowmask) * BM + wr * 64 + fr, col0 = u.pn * BM + wc * 32 + 8 * fq;
#pragma unroll
        for (int ai = 0; ai < 2; ++ai)
#pragma unroll
            for (int m = 0; m < 4; ++m) { int row = row0 + ai * HALF + m * 16; asm volatile("" : "+v"(row)); bf16_t* rowp = O + (size_t)row * ldc + col0;
#pragma unroll
                for (int bj = 0; bj < 2; ++bj) { const f32x4 v0 = acc[ai][bj][m][0], v1 = acc[ai][bj][m][1];
                    u32x4 w; w.x = cvt_pk_bf16(v0[0], v0[1]); w.y = cvt_pk_bf16(v0[2], v0[3]); w.z = cvt_pk_bf16(v1[0], v1[1]); w.w = cvt_pk_bf16(v1[2], v1[3]);
                    *(u32x4*)(rowp + bj * HALF) = w; } }
    }
};
__device__ __forceinline__ float sigmoidf_(float x) { return 1.f / (1.f + __expf(-x)); }
struct EpiGateMix {
    static constexpr bool PERM = true;
    const bf16_t* U; bf16_t* MX;
    __device__ __forceinline__ void operator()(const f32x4 (&acc)[2][2][4][2], const Unit& u, int wr, int wc, int fr, int fq) const {
        const int row0 = u.pm * BM + wr * 64 + fr, dcol = u.pn * 64 + wc * 16 + fq * 4;
#pragma unroll
        for (int ai = 0; ai < 2; ++ai)
#pragma unroll
            for (int m = 0; m < 4; ++m) { int row = row0 + ai * HALF + m * 16; asm volatile("" : "+v"(row)); const bf16_t* up = U + (size_t)row * 4096 + dcol;
                float o0 = 0.f, o1 = 0.f, o2 = 0.f, o3 = 0.f;
#pragma unroll
                for (int bj = 0; bj < 2; ++bj)
#pragma unroll
                    for (int n = 0; n < 2; ++n) { const u32x2 uu = *(const u32x2*)(up + (2 * bj + n) * 1024); const f32x4 a = acc[ai][bj][m][n];
                        o0 += sigmoidf_(a[0]) * bflo(uu.x); o1 += sigmoidf_(a[1]) * bfhi(uu.x); o2 += sigmoidf_(a[2]) * bflo(uu.y); o3 += sigmoidf_(a[3]) * bfhi(uu.y); }
                u32x2 w; w.x = cvt_pk_bf16(o0, o1); w.y = cvt_pk_bf16(o2, o3);
                *(u32x2*)(MX + (size_t)row * 1024 + dcol) = w; }
    }
};
struct EpiResid {
    static constexpr bool PERM = true;
    const float* xin; float* xout;
    __device__ __forceinline__ void operator()(const f32x4 (&acc)[2][2][4][2], const Unit& u, int wr, int wc, int fr, int fq) const {
        const int row0 = u.pm * BM + wr * 64 + fr, col0 = u.pn * BM + wc * 32 + 8 * fq;
#pragma unroll
        for (int ai = 0; ai < 2; ++ai)
#pragma unroll
            for (int m = 0; m < 4; ++m) { int row = row0 + ai * HALF + m * 16; asm volatile("" : "+v"(row)); const size_t ro = (size_t)row * 1024 + col0;
#pragma unroll
                for (int bj = 0; bj < 2; ++bj)
#pragma unroll
                    for (int n = 0; n < 2; ++n) { const size_t o = ro + bj * HALF + 4 * n; const f32x4 xv = *(const f32x4*)(xin + o); *(f32x4*)(xout + o) = xv + acc[ai][bj][m][n]; } }
    }
};
struct EpiSwiglu {
    static constexpr bool PERM = true;
    bf16_t* ACT;
    __device__ __forceinline__ void operator()(const f32x4 (&acc)[2][2][4][2], const Unit& u, int wr, int wc, int fr, int fq) const {
        const int row0 = u.pm * BM + wr * 64 + fr, col0 = (u.pn & 3) * 128 + wc * 32 + 8 * fq;
#pragma unroll
        for (int ai = 0; ai < 2; ++ai)
#pragma unroll
            for (int m = 0; m < 4; ++m) { int row = row0 + ai * HALF + m * 16; asm volatile("" : "+v"(row)); float v[8];
#pragma unroll
                for (int n = 0; n < 2; ++n)
#pragma unroll
                    for (int i = 0; i < 4; ++i) { const float a = acc[ai][0][m][n][i], b = acc[ai][1][m][n][i]; v[4 * n + i] = a * sigmoidf_(a) * b; }
                u32x4 w; w.x = cvt_pk_bf16(v[0], v[1]); w.y = cvt_pk_bf16(v[2], v[3]); w.z = cvt_pk_bf16(v[4], v[5]); w.w = cvt_pk_bf16(v[6], v[7]);
                *(u32x4*)(ACT + (size_t)row * 512 + col0) = w; }
    }
};
struct EpiDown {
    static constexpr bool PERM = true;
    bf16_t* YE; const float* roww;
    __device__ __forceinline__ void operator()(const f32x4 (&acc)[2][2][4][2], const Unit& u, int wr, int wc, int fr, int fq) const {
        const int row0 = u.pm * BM + wr * 64 + fr, col0 = (u.pn & 3) * BM + wc * 32 + 8 * fq;
#pragma unroll
        for (int ai = 0; ai < 2; ++ai)
#pragma unroll
            for (int m = 0; m < 4; ++m) { int row = row0 + ai * HALF + m * 16; asm volatile("" : "+v"(row)); const float s = roww[row]; bf16_t* rowp = YE + (size_t)row * 1024 + col0;
#pragma unroll
                for (int bj = 0; bj < 2; ++bj) { const f32x4 v0 = acc[ai][bj][m][0] * s, v1 = acc[ai][bj][m][1] * s;
                    u32x4 w; w.x = cvt_pk_bf16(v0[0], v0[1]); w.y = cvt_pk_bf16(v0[2], v0[3]); w.z = cvt_pk_bf16(v1[0], v1[1]); w.w = cvt_pk_bf16(v1[2], v1[3]);
                    *(u32x4*)(rowp + bj * HALF) = w; } }
    }
};
struct SchedUp {
    int G, c;
    __device__ __forceinline__ bool next(int i, Unit& u) const { const int L = i * G + c; if (L >= 1024) return false; const int n = L >> 8, pm = (L >> 2) & 63, pn = L & 3; u.pm = n * 64 + pm; u.pn = n * 4 + pn; return true; }
    __device__ __forceinline__ void a_ready(const Unit&) const {}
    __device__ __forceinline__ void done(const Unit&) const {}
};
struct SchedMoe {
    int G, c, nunits; const PG8_LAS int* tab;
    __device__ __forceinline__ bool next(int i, Unit& u) const { const int L = i * G + c; if (L >= nunits) return false; const int b = L >> 2, t = L & 3; const int e = __builtin_amdgcn_readfirstlane(tab[b]); u.pm = b; u.pn = e * 4 + t; return true; }
    __device__ __forceinline__ void a_ready(const Unit&) const {}
    __device__ __forceinline__ void done(const Unit&) const {}
};
}

#define XB_TMO      128
#define XB_XCNT(j)  (256  + 64 * (j))
#define XB_XSUB(j)  (1280 + 64 * (j))
#define XB_XGEN(j)  (2304 + 64 * (j))
#define XB_TOP      3328
#define XB_TOPGEN   3392
#define XCD_BAR_WORDS 3456
#define XB_SPIN_CAP (1u << 18)
__device__ __forceinline__ unsigned xb_ld(unsigned* p)              { return __hip_atomic_load(p, __ATOMIC_RELAXED, __HIP_MEMORY_SCOPE_AGENT); }
__device__ __forceinline__ unsigned xb_add(unsigned* p, unsigned v) { return __hip_atomic_fetch_add(p, v, __ATOMIC_RELAXED, __HIP_MEMORY_SCOPE_AGENT); }
__device__ __forceinline__ unsigned xb_xcc_id() { return (unsigned)__builtin_amdgcn_s_getreg((3 << 11) | 20) & 0xFu; }
#define XB_SPIN(cond, bar) do { unsigned _sp = 0; while (cond) { __builtin_amdgcn_s_sleep(1); \
    if ((++_sp & 255u) == 0u) { if (xb_ld(&(bar)[XB_TMO])) break; if (_sp > XB_SPIN_CAP) { atomicAdd(&(bar)[XB_TMO], 1u); break; } } } } while (0)
struct XcdBarrier { unsigned* bar; unsigned x; volatile LAS unsigned* st; };
__device__ __forceinline__ XcdBarrier xcd_barrier_post(unsigned* bar, volatile LAS unsigned* st) {
    XcdBarrier b; b.bar = bar; b.x = xb_xcc_id(); b.st = st;
    if (threadIdx.x == 0) (void)xb_add(&bar[XB_XCNT(b.x)], 1u);
    return b;
}
__device__ __forceinline__ void xcd_barrier_complete(unsigned* bar, unsigned x, unsigned& nloc, unsigned& nx) {
    const unsigned G = gridDim.x * gridDim.y * gridDim.z;
    unsigned sum, cnt, mine, sp = 0u;
    for (;;) {
        sum = 0u; cnt = 0u; mine = 0u;
#pragma unroll
        for (unsigned j = 0; j < 16; ++j) { const unsigned c = xb_ld(&bar[XB_XCNT(j)]); sum += c; cnt += (c > 0u) ? 1u : 0u; mine = (j == x) ? c : mine; }
        if (sum == G) break;
        __builtin_amdgcn_s_sleep(1);
        if ((++sp & 255u) == 0u) { if (xb_ld(&bar[XB_TMO])) break; if (sp > XB_SPIN_CAP) { atomicAdd(&bar[XB_TMO], 1u); break; } }
    }
    nloc = mine > 0u ? mine : 1u; nx = cnt > 0u ? cnt : 1u;
}
__device__ __forceinline__ void xcd_barrier(const XcdBarrier& b) {
    asm volatile("s_waitcnt vmcnt(0)" ::: "memory");
    __syncthreads();
    if (threadIdx.x == 0) {
        unsigned* bar = b.bar;
        __builtin_amdgcn_s_waitcnt(0);
        unsigned nloc = b.st[0], nx = b.st[1];
        if (nloc == 0u) { xcd_barrier_complete(bar, b.x, nloc, nx); b.st[0] = nloc; b.st[1] = nx; }
        const unsigned old = xb_add(&bar[XB_XSUB(b.x)], 1u);
        const unsigned gen = old / nloc;
        if (old + 1u == (gen + 1u) * nloc) {
            __builtin_amdgcn_fence(__ATOMIC_RELEASE, "agent");
            asm volatile("s_waitcnt vmcnt(0)" ::: "memory");
            const unsigned og = xb_add(&bar[XB_TOP], 1u);
            const unsigned tg = og / nx;
            if (og + 1u == (tg + 1u) * nx) xb_add(&bar[XB_TOPGEN], 1u);
            else XB_SPIN(xb_ld(&bar[XB_TOPGEN]) == tg, bar);
            __builtin_amdgcn_fence(__ATOMIC_ACQUIRE, "agent");
            xb_add(&bar[XB_XGEN(b.x)], 1u);
            asm volatile("s_waitcnt vmcnt(0)" ::: "memory");
        } else {
            XB_SPIN(xb_ld(&bar[XB_XGEN(b.x)]) == gen, bar);
            __builtin_amdgcn_fence(__ATOMIC_ACQUIRE, "agent");
            asm volatile("s_waitcnt vmcnt(0)" ::: "memory");
        }
    }
    __syncthreads();
}

struct Args {
    const float* in[23]; float* out; unsigned char* ws; int seg_lo, seg_hi;
};
typedef const __attribute__((address_space(4))) Args* ArgsP;
__device__ __forceinline__ ArgsP kargs() { unsigned long long v = (unsigned long long)__builtin_amdgcn_kernarg_segment_ptr(); asm volatile("" : "+s"(v)); return (ArgsP)v; }
struct Frame {
    LAS unsigned char* lds; unsigned char* ws; unsigned* ctl;
    int tid, lane, wave, G, bid;
};

template <class SC>
__device__ __forceinline__ void cvt_item(const float* W, int ldw, int K, bf16* WT, int k0, int n0, SC sc, LAS float* scr, int lane) {
    const int nl = lane & 31; const int scol = sc(n0 + nl);
#pragma unroll 8
    for (int i = 0; i < 32; ++i) { const int kk = 2 * i + (lane >> 5); scr[kk * 33 + nl] = scol >= 0 ? W[(size_t)(k0 + kk) * ldw + scol] : 0.f; }
    LDS_WAIT(); asm volatile("" ::: "memory");
    const int c = lane & 7;
#pragma unroll
    for (int j = 0; j < 4; ++j) { const int n = (lane >> 3) + 8 * j; const LAS float* s = scr + (8 * c) * 33 + n;
        u32x4 o; o.x = pk2(s[0 * 33], s[1 * 33]); o.y = pk2(s[2 * 33], s[3 * 33]); o.z = pk2(s[4 * 33], s[5 * 33]); o.w = pk2(s[6 * 33], s[7 * 33]);
        *(u32x4*)(WT + (size_t)(n0 + n) * K + k0 + 8 * c) = o; }
    LDS_WAIT(); asm volatile("" ::: "memory");
}
__device__ __forceinline__ int src_col_win(int dc) {
    if (dc < 932) return dc;
    if (dc < 936) return 1700 + (dc - 932);
    if (dc < 940) return 1704 + (dc - 936);
    if (dc < 960) return -1;
    if (dc < 1728) return 932 + (dc - 960);
    if (dc < 1984) return 1708 + (dc - 1728);
    if (dc < 3520) return 1964 + (dc - 1984);
    return -1;
}
__device__ __forceinline__ void phase_convert(Frame& F, int l) {
    ArgsP a = kargs();
    LAS float* scr = (LAS float*)(F.lds + F.wave * 16384);
    const int gw = F.bid * 8 + F.wave, NGW = F.G * 8;
    constexpr int I_WIN = 16 * 112, I_WBR = 4 * 4 * 32, I_WG = 16 * 128, I_WO = 16 * 32, I_W13 = 32 * 16 * 32, I_W2 = 32 * 8 * 32;
    constexpr int NIT = I_WIN + I_WBR + I_WG + I_WO + I_W13 + I_W2;
    const float* w_in = a->in[2] + (size_t)l * 1024 * CIN;
    const float* w_br = a->in[11] + (size_t)l * 4 * 256 * 1024;
    const float* w_gate = a->in[12] + (size_t)l * 1024 * 4096;
    const float* w_out = a->in[13] + (size_t)l * 1024 * 1024;
    const float* w1 = a->in[19] + (size_t)l * NE * 1024 * FE;
    const float* w3 = a->in[20] + (size_t)l * NE * 1024 * FE;
    const float* w2 = a->in[21] + (size_t)l * NE * FE * 1024;
    for (int it = gw; it < NIT; it += NGW) {
        int r = it;
        if (r < I_WIN) { const int kb = r / 112, nb = r % 112; cvt_item(w_in, CIN, 1024, (bf16*)(F.ws + WS_WIN), kb * 64, nb * 32, [](int n) { return src_col_win(n); }, scr, F.lane); continue; } r -= I_WIN;
        if (r < I_WBR) { const int n = r / 128, q = r % 128, kb = q / 32, nb = q % 32; cvt_item(w_br + (size_t)n * 256 * 1024, 1024, 256, (bf16*)(F.ws + WS_WBR) + (size_t)n * 1024 * 256, kb * 64, nb * 32, [](int c) { return c; }, scr, F.lane); continue; } r -= I_WBR;
        if (r < I_WG) { const int kb = r / 128, nb = r % 128;
            cvt_item(w_gate, 4096, 1024, (bf16*)(F.ws + WS_WGATE), kb * 64, nb * 32, [](int np) { const int pn = np >> 8, L = np & 255, bj = L >> 7, wc = (L >> 5) & 3, fq = (L >> 3) & 3, n = (L >> 2) & 1, i = L & 3;
                return (2 * bj + n) * 1024 + pn * 64 + wc * 16 + fq * 4 + i; }, scr, F.lane); continue; } r -= I_WG;
        if (r < I_WO) { const int kb = r / 32, nb = r % 32; cvt_item(w_out, 1024, 1024, (bf16*)(F.ws + WS_WOUT), kb * 64, nb * 32, [](int c) { return c; }, scr, F.lane); continue; } r -= I_WO;
        if (r < I_W13) { const int e = r / 512, q = r % 512, kb = q / 32, nb = q % 32;
            const int t = (nb * 32) >> 8, L0 = (nb * 32) & 255; const float* src = (L0 < 128 ? w1 : w3) + (size_t)e * 1024 * FE; const int cbase = t * 128 + (L0 & 127) - nb * 32;
            cvt_item(src, FE, 1024, (bf16*)(F.ws + WS_W13) + (size_t)e * 1024 * 1024, kb * 64, nb * 32, [cbase](int np) { return np + cbase; }, scr, F.lane); continue; } r -= I_W13;
        { const int e = r / 256, q = r % 256, kb = q / 32, nb = q % 32; cvt_item(w2 + (size_t)e * FE * 1024, 1024, FE, (bf16*)(F.ws + WS_W2) + (size_t)e * 1024 * FE, kb * 64, nb * 32, [](int c) { return c; }, scr, F.lane); }
    }
}
__device__ __forceinline__ void rms_row_to_bf16(const float* xrow, const float* g, bf16* orow, int lane) {
    const f32x4* xr = (const f32x4*)xrow + lane; const f32x4* gr = (const f32x4*)g + lane;
    f32x4 v[4]; float s = 0.f;
#pragma unroll
    for (int j = 0; j < 4; ++j) { v[j] = xr[64 * j]; s += (v[j].x * v[j].x + v[j].y * v[j].y) + (v[j].z * v[j].z + v[j].w * v[j].w); }
    const float rstd = rsqrtf(wave_sum(s) * (1.f / D) + RMS_EPS);
    unsigned long long* o8 = (unsigned long long*)orow + lane;
#pragma unroll
    for (int j = 0; j < 4; ++j) { const f32x4 gg = gr[64 * j]; o8[64 * j] = (unsigned long long)pk2(v[j].x * rstd * gg.x, v[j].y * rstd * gg.y) | ((unsigned long long)pk2(v[j].z * rstd * gg.z, v[j].w * rstd * gg.w) << 32); }
}

#ifndef MFMA_F32
#define MFMA_F32(av, bv, cv) __builtin_amdgcn_mfma_f32_16x16x4f32((av), (bv), (cv), 0, 0, 0)
#endif
__device__ __forceinline__ void phase_router(Frame& F, int l, const float* xcur) {
    ArgsP a = kargs();
    LAS float* xs = (LAS float*)F.lds;
    LAS float* wsm = xs + 64 * 65;
    LAS float* lg = wsm + 64 * 48;
    LAS float* rs = lg + 64 * 37;
    const float* g = a->in[14] + (size_t)l * D;
    const float* rgw = a->in[15] + (size_t)l * D * 4; const float* rgb = a->in[16] + (size_t)l * 4;
    const float* rew = a->in[17] + (size_t)l * D * 32; const float* reb = a->in[18] + (size_t)l * 32;
    bf16* h2 = (bf16*)(F.ws + WS_H);
    int* tok_e = (int*)(F.ws + WS_RT); float* tok_w = (float*)(F.ws + WS_RT + 131072);
    unsigned* cnt = F.ctl + CW_CNT + l * 32;
    const int r = F.tid & 63;
    const int li = F.lane & 15, kq = F.lane >> 4, rb = F.wave & 3, cset = F.wave >> 2;
    for (int blk = F.bid; blk < S / 64; blk += F.G) {
        const int row0 = blk * 64;
        f32x4 acc0 = {0.f, 0.f, 0.f, 0.f}, acc1 = {0.f, 0.f, 0.f, 0.f}; float ss = 0.f;
        for (int kc = 0; kc < 16; ++kc) {
            __syncthreads();
            { const int rr = F.tid >> 3, kk = (F.tid & 7) * 8; const float* xp = xcur + (size_t)(row0 + rr) * D + kc * 64 + kk; const float* gp = g + kc * 64 + kk;
              const f32x4 x0 = *(const f32x4*)xp, x1 = *(const f32x4*)(xp + 4), g0 = *(const f32x4*)gp, g1 = *(const f32x4*)(gp + 4);
              LAS float* d = xs + rr * 65 + kk; d[0] = x0.x * g0.x; d[1] = x0.y * g0.y; d[2] = x0.z * g0.z; d[3] = x0.w * g0.w; d[4] = x1.x * g1.x; d[5] = x1.y * g1.y; d[6] = x1.z * g1.z; d[7] = x1.w * g1.w;
              ss += (x0.x * x0.x + x0.y * x0.y) + (x0.z * x0.z + x0.w * x0.w) + (x1.x * x1.x + x1.y * x1.y) + (x1.z * x1.z + x1.w * x1.w); }
            { const int kk = F.tid >> 3, c0 = (F.tid & 7) * 6; const size_t kg = (size_t)(kc * 64 + kk);
#pragma unroll
              for (int i = 0; i < 6; ++i) { const int c = c0 + i; wsm[kk * 48 + c] = c < 4 ? rgw[kg * 4 + c] : (c < 36 ? rew[kg * 32 + (c - 4)] : 0.f); } }
            __syncthreads();
            if (cset == 0) {
#pragma unroll 4
                for (int k0 = 0; k0 < 64; k0 += 4) { const float av = xs[(rb * 16 + li) * 65 + k0 + kq];
                    acc0 = MFMA_F32(av, wsm[(k0 + kq) * 48 + li], acc0); acc1 = MFMA_F32(av, wsm[(k0 + kq) * 48 + 16 + li], acc1); }
            } else {
#pragma unroll 4
                for (int k0 = 0; k0 < 64; k0 += 4) { const float av = xs[(rb * 16 + li) * 65 + k0 + kq]; acc0 = MFMA_F32(av, wsm[(k0 + kq) * 48 + 32 + li], acc0); }
            }
        }
        ss += __shfl_xor(ss, 1); ss += __shfl_xor(ss, 2); ss += __shfl_xor(ss, 4);
        __syncthreads();
        if ((F.tid & 7) == 0) rs[F.tid >> 3] = rsqrtf(ss * (1.f / D) + RMS_EPS);
        __syncthreads();
#pragma unroll
        for (int i = 0; i < 4; ++i) { const int rw = rb * 16 + kq * 4 + i; const float rstd = rs[rw];
            if (cset == 0) { lg[rw * 37 + li] = acc0[i] * rstd; lg[rw * 37 + 16 + li] = acc1[i] * rstd; } else if (li < 4) lg[rw * 37 + 32 + li] = acc0[i] * rstd; }
        __syncthreads();
        if (F.tid < 64) {
            const LAS float* L = lg + F.tid * 37; const int tok = row0 + F.tid;
            float gl[4]; int gs = 0; float gm = -3.0e38f;
#pragma unroll
            for (int i = 0; i < 4; ++i) { gl[i] = L[i] + rgb[i]; if (gl[i] > gm) { gm = gl[i]; gs = i; } }
            float gsum = 0.f;
#pragma unroll
            for (int i = 0; i < 4; ++i) gsum += __expf(gl[i] - gm);
            const float ggate = 1.f / gsum;
            float v0 = -3.0e38f, v1 = -3.0e38f; int i0 = 0, i1 = 0;
            for (int i = 0; i < 8; ++i) { const float v = L[4 + gs * 8 + i] + reb[gs * 8 + i]; if (v > v0) { v1 = v0; i1 = i0; v0 = v; i0 = i; } else if (v > v1) { v1 = v; i1 = i; } }
            const float e1 = __expf(v1 - v0), den = 1.f / (1.f + e1);
            const int ea = gs * 8 + i0, eb = gs * 8 + i1;
            tok_e[tok * 2] = ea; tok_e[tok * 2 + 1] = eb; tok_w[tok * 2] = den * ggate; tok_w[tok * 2 + 1] = e1 * den * ggate;
            atomicAdd(&cnt[ea], 1u); atomicAdd(&cnt[eb], 1u);
        }
        for (int i = 0; i < 8; ++i) { const int rr = F.wave * 8 + i; const float rstd = rs[rr];
            const f32x4* xr = (const f32x4*)(xcur + (size_t)(row0 + rr) * D) + F.lane; const f32x4* gr = (const f32x4*)g + F.lane; unsigned long long* o8 = (unsigned long long*)(h2 + (size_t)(row0 + rr) * D) + F.lane;
#pragma unroll
            for (int j = 0; j < 4; ++j) { const f32x4 v = xr[64 * j], gg = gr[64 * j]; o8[64 * j] = (unsigned long long)pk2(v.x * rstd * gg.x, v.y * rstd * gg.y) | ((unsigned long long)pk2(v.z * rstd * gg.z, v.w * rstd * gg.w) << 32); } }
    }
    __syncthreads();
}
__device__ __forceinline__ void moe_table(Frame& F, int l) {
    LAS int* tab = (LAS int*)(F.lds + LDSCTL_OFF);
    if (F.tid == 0) { int bo = 0;
#pragma unroll 1
        for (int e = 0; e < NE; ++e) { const int c = (int)__hip_atomic_load(F.ctl + CW_CNT + l * 32 + e, __ATOMIC_RELAXED, __HIP_MEMORY_SCOPE_AGENT); const int nb = (c + 255) >> 8; tab[192 + e] = bo * 256; for (int b = 0; b < nb; ++b) tab[bo + b] = e; bo += nb; } tab[224] = bo; }
    __syncthreads();
}
__device__ __forceinline__ void phase_scatter(Frame& F, int l) {
    moe_table(F, l);
    LAS int* tab = (LAS int*)(F.lds + LDSCTL_OFF);
    const bf16* h2 = (const bf16*)(F.ws + WS_H); bf16* xs = (bf16*)(F.ws + WS_XS);
    const int* tok_e = (const int*)(F.ws + WS_RT); const float* tok_w = (const float*)(F.ws + WS_RT + 131072);
    int* slot_row = (int*)(F.ws + WS_RT + 262144); float* row_w = (float*)(F.ws + WS_RT + 393216);
    unsigned* fill = F.ctl + CW_FILL + l * 32;
    const int gw = F.bid * 8 + F.wave, NGW = F.G * 8;
    for (int sl = gw; sl < S * 2; sl += NGW) {
        const int e = tok_e[sl]; int row = 0;
        if (F.lane == 0) { const unsigned p = atomicAdd(&fill[e], 1u); row = tab[192 + e] + (int)p; slot_row[sl] = row; row_w[row] = tok_w[sl]; }
        row = __shfl(row, 0);
        const u32x4* src = (const u32x4*)(h2 + (size_t)(sl >> 1) * D) + F.lane; u32x4* dst = (u32x4*)(xs + (size_t)row * D) + F.lane;
        dst[0] = src[0]; dst[64] = src[64];
    }
}
__device__ __forceinline__ void phase_combine(Frame& F, int l, float* xcur) {
    ArgsP a = kargs();
    const bf16* ye = (const bf16*)(F.ws + WS_YE); const int* slot_row = (const int*)(F.ws + WS_RT + 262144);
    const bool last = (l == NL - 1);
    const float* g = last ? a->in[22] : a->in[1] + (size_t)(l + 1) * D;
    bf16* h = (bf16*)(F.ws + WS_H);
    const int gw = F.bid * 8 + F.wave, NGW = F.G * 8;
    for (int m = gw; m < S; m += NGW) {
        const int r0 = slot_row[2 * m], r1 = slot_row[2 * m + 1];
        f32x4* xr = (f32x4*)(xcur + (size_t)m * D) + F.lane; const f32x4* gr = (const f32x4*)g + F.lane;
        const u32x2* y0 = (const u32x2*)(ye + (size_t)r0 * D) + F.lane; const u32x2* y1 = (const u32x2*)(ye + (size_t)r1 * D) + F.lane;
        f32x4 v[4]; float s = 0.f;
#pragma unroll
        for (int j = 0; j < 4; ++j) { const u32x2 p0 = y0[64 * j], p1 = y1[64 * j]; f32x4 x = xr[64 * j];
            x.x = (x.x + bflo(p0.x)) + bflo(p1.x); x.y = (x.y + bfhi(p0.x)) + bfhi(p1.x); x.z = (x.z + bflo(p0.y)) + bflo(p1.y); x.w = (x.w + bfhi(p0.y)) + bfhi(p1.y);
            v[j] = x; s += (x.x * x.x + x.y * x.y) + (x.z * x.z + x.w * x.w); }
        const float rstd = rsqrtf(wave_sum(s) * (1.f / D) + RMS_EPS);
        if (last) {
#pragma unroll
            for (int j = 0; j < 4; ++j) { const f32x4 gg = gr[64 * j]; xr[64 * j] = (f32x4){v[j].x * rstd * gg.x, v[j].y * rstd * gg.y, v[j].z * rstd * gg.z, v[j].w * rstd * gg.w}; }
        } else {
            unsigned long long* o8 = (unsigned long long*)(h + (size_t)m * D) + F.lane;
#pragma unroll
            for (int j = 0; j < 4; ++j) { const f32x4 gg = gr[64 * j]; xr[64 * j] = v[j];
                o8[64 * j] = (unsigned long long)pk2(v[j].x * rstd * gg.x, v[j].y * rstd * gg.y) | ((unsigned long long)pk2(v[j].z * rstd * gg.z, v[j].w * rstd * gg.w) << 32); }
        }
    }
}


typedef short v4i16_t __attribute__((ext_vector_type(4)));
__device__ __forceinline__ s16x4 ds_tr16(const LAS unsigned char* p) { return __builtin_bit_cast(s16x4, __builtin_amdgcn_ds_read_tr16_b64_v4i16((LAS v4i16_t*)p)); }
template <int MODE>
__device__ __forceinline__ void attn_phase(Frame& F, int l) {
    ArgsP a = kargs();
    constexpr int NS = MODE ? 2 : 1;
    const bf16* P = (const bf16*)(F.ws + WS_PU);
    bf16* Y = (bf16*)(F.ws + WS_Y) + (size_t)(MODE ? 3 : 2) * S * 256;
    const int colQ = MODE ? C_QD : C_QC, colK = MODE ? C_KD : C_KC, colV = MODE ? C_VD : C_VC;
    const float sc2 = (MODE ? 0.17677669529663687f : 0.125f) * 1.4426950408889634f;
    LAS unsigned char* Kb = F.lds; LAS unsigned char* Vb = F.lds + 16384; LAS float* btab = (LAS float*)(F.lds + 32768);
    const int lane = F.lane, w = F.wave, r = lane & 31, hh = lane >> 5;
    for (int u = F.bid; u < 256; u += F.G) {
        const int head = u & 3, ug = u >> 2;
        int qrow, cw, lo_w, T0, T1;
        if (MODE) { qrow = ug * 256 + w * 32; cw = ug * 4 + (w >> 1); lo_w = 0; T0 = 0; T1 = ug * 4 + 3; }
        else { cw = ug * 4 + (w >> 1); qrow = cw * 64 + (w & 1) * 32; lo_w = cw - 8 < 0 ? 0 : cw - 8; T0 = ug * 4 - 8 < 0 ? 0 : ug * 4 - 8; T1 = ug * 4 + 3; }
        if (!MODE) { __syncthreads(); if (F.tid < 192) btab[F.tid] = a->in[8][(size_t)(l * 4 + head) * 192 + F.tid] * 1.4426950408889634f; }
        bf16x8 Qf[4];
#pragma unroll
        for (int kk = 0; kk < 4; ++kk) Qf[kk] = *(const bf16x8*)(P + (size_t)(qrow + r) * PW + colQ + head * 64 + kk * 16 + 8 * hh);
        f32x16 O[NS][2]; float m[NS], lsum[NS];
#pragma unroll
        for (int s = 0; s < NS; ++s) { m[s] = -1e30f; lsum[s] = 0.f;
#pragma unroll
            for (int d = 0; d < 2; ++d)
#pragma unroll
                for (int i = 0; i < 16; ++i) O[s][d][i] = 0.f; }
        const int srow = F.tid >> 3, sch = F.tid & 7;
        const bf16* gK = P + (size_t)srow * PW + colK + head * 64 + sch * 8; const bf16* gV = P + (size_t)srow * PW + colV + head * 64 + sch * 8;
        const int kwoff = srow * 128 + ((sch ^ (srow & 7)) << 4), vwoff = srow * 128 + sch * 16;
        u32x4 kreg = *(const u32x4*)(gK + (size_t)T0 * 64 * PW), vreg = *(const u32x4*)(gV + (size_t)T0 * 64 * PW);
        __syncthreads();
        *(LAS u32x4*)(Kb + kwoff) = kreg; *(LAS u32x4*)(Vb + vwoff) = vreg;
        __syncthreads();
        for (int j = T0; j <= T1; ++j) {
            const int buf = (j - T0) & 1;
            if (j < T1) { kreg = *(const u32x4*)(gK + (size_t)(j + 1) * 64 * PW); vreg = *(const u32x4*)(gV + (size_t)(j + 1) * 64 * PW); }
            if (j >= lo_w && j <= cw) {
                const LAS unsigned char* Kt = Kb + buf * 8192; const LAS unsigned char* Vt = Vb + buf * 8192;
                bf16x8 pf[NS][4];
#pragma unroll
                for (int s = 0; s < NS; ++s) {
                    f32x16 Sq[2];
#pragma unroll
                    for (int kb = 0; kb < 2; ++kb) {
#pragma unroll
                        for (int i = 0; i < 16; ++i) Sq[kb][i] = 0.f;
#pragma unroll
                        for (int k2 = 0; k2 < (MODE ? 2 : 4); ++k2) { const int kk = MODE ? 2 * s + k2 : k2; const int row = kb * 32 + r;
                            const bf16x8 kf = *(const LAS bf16x8*)(Kt + row * 128 + (((kk * 2 + hh) ^ (row & 7)) << 4));
                            Sq[kb] = __builtin_amdgcn_mfma_f32_32x32x16_bf16(kf, Qf[kk], Sq[kb], 0, 0, 0); }
                    }
                    float mx = -1e30f;
                    if (!MODE) {
                        const int dj = cw - j;
                        if (dj >= 3) { const float bc = btab[191];
#pragma unroll
                            for (int kb = 0; kb < 2; ++kb)
#pragma unroll
                                for (int i = 0; i < 16; ++i) { const float t = Sq[kb][i] * sc2 + bc; Sq[kb][i] = t; mx = fmaxf(mx, t); } }
                        else { const int base = dj * 64 + (w & 1) * 32 + r - 4 * hh + 63;
#pragma unroll
                            for (int kb = 0; kb < 2; ++kb)
#pragma unroll
                                for (int i = 0; i < 16; ++i) { int rid = base - (kb * 32 + (i & 3) + 8 * (i >> 2)); rid = rid < 0 ? 0 : (rid > 191 ? 191 : rid);
                                    const float t = Sq[kb][i] * sc2 + btab[rid]; Sq[kb][i] = t; mx = fmaxf(mx, t); } }
                    } else {
#pragma unroll
                        for (int kb = 0; kb < 2; ++kb)
#pragma unroll
                            for (int i = 0; i < 16; ++i) { const float t = Sq[kb][i] * sc2; Sq[kb][i] = t; mx = fmaxf(mx, t); }
                    }
                    mx = fmaxf(mx, __shfl_xor(mx, 32));
                    const float mn = fmaxf(m[s], mx), alpha = __builtin_amdgcn_exp2f(m[s] - mn); m[s] = mn;
                    float rs = 0.f;
#pragma unroll
                    for (int kb = 0; kb < 2; ++kb)
#pragma unroll
                        for (int i = 0; i < 16; ++i) { const float p = __builtin_amdgcn_exp2f(Sq[kb][i] - mn); Sq[kb][i] = p; rs += p; }
                    lsum[s] = lsum[s] * alpha + rs;
#pragma unroll
                    for (int d = 0; d < 2; ++d)
#pragma unroll
                        for (int i = 0; i < 16; ++i) O[s][d][i] *= alpha;
#pragma unroll
                    for (int kb = 0; kb < 2; ++kb)
#pragma unroll
                        for (int ss = 0; ss < 2; ++ss) { u32x4 pw;
                            pw.x = pg8::cvt_pk_bf16(Sq[kb][8 * ss + 0], Sq[kb][8 * ss + 1]); pw.y = pg8::cvt_pk_bf16(Sq[kb][8 * ss + 2], Sq[kb][8 * ss + 3]);
                            pw.z = pg8::cvt_pk_bf16(Sq[kb][8 * ss + 4], Sq[kb][8 * ss + 5]); pw.w = pg8::cvt_pk_bf16(Sq[kb][8 * ss + 6], Sq[kb][8 * ss + 7]);
                            pf[s][kb * 2 + ss] = __builtin_bit_cast(bf16x8, pw); }
                    __builtin_amdgcn_sched_barrier(0);
                }
                const int li = lane & 15, lg = lane >> 4;
                const LAS unsigned char* vbase = Vt + (4 * (lg >> 1) + (li >> 2)) * 128 + (16 * (lg & 1) + 4 * (li & 3)) * 2;
#pragma unroll
                for (int d = 0; d < 2; ++d)
#pragma unroll
                    for (int st = 0; st < 4; ++st) {
                        const s16x4 v0 = ds_tr16(vbase + (st * 16) * 128 + d * 64), v1 = ds_tr16(vbase + (st * 16 + 8) * 128 + d * 64);
                        const bf16x8 vf = (bf16x8){v0[0], v0[1], v0[2], v0[3], v1[0], v1[1], v1[2], v1[3]};
#pragma unroll
                        for (int s = 0; s < NS; ++s) O[s][d] = __builtin_amdgcn_mfma_f32_32x32x16_bf16(vf, pf[s][st], O[s][d], 0, 0, 0);
                        if (st & 1) __builtin_amdgcn_sched_barrier(0);
                    }
            }
            if (j < T1) { *(LAS u32x4*)(Kb + (buf ^ 1) * 8192 + kwoff) = kreg; *(LAS u32x4*)(Vb + (buf ^ 1) * 8192 + vwoff) = vreg; }
            __syncthreads();
        }
        float inv[NS];
#pragma unroll
        for (int s = 0; s < NS; ++s) { const float lt = lsum[s] + __shfl_xor(lsum[s], 32); inv[s] = 1.f / lt; }
        bf16* yrow = Y + (size_t)(qrow + r) * 256 + head * 64 + 4 * hh;
        if (MODE) {
            const float* lp = a->in[9] + (size_t)l * 128 + (lane & 31); float s1 = (lane < 32) ? lp[0] * lp[32] : 0.f, s2 = (lane < 32) ? lp[64] * lp[96] : 0.f;
            s1 = wave_sum(s1); s2 = wave_sum(s2);
            const float lam_init = 0.8f - 0.6f * __expf(-0.3f * (float)l), lam = __expf(s1) - __expf(s2) + lam_init;
            const float* gn = a->in[10] + (size_t)l * 256 + head * 64 + 4 * hh;
            float ss = 0.f;
#pragma unroll
            for (int d = 0; d < 2; ++d)
#pragma unroll
                for (int i = 0; i < 16; ++i) { const float o = O[0][d][i] * inv[0] - lam * (O[NS - 1][d][i] * inv[NS - 1]); O[0][d][i] = o; ss += o * o; }
            ss += __shfl_xor(ss, 32);
            const float rstd = rsqrtf(ss * (1.f / 64.f) + RMS_EPS) * (1.f - lam_init);
#pragma unroll
            for (int d = 0; d < 2; ++d)
#pragma unroll
                for (int g = 0; g < 4; ++g) { const f32x4 gg = *(const f32x4*)(gn + d * 32 + 8 * g); u32x2 o2;
                    o2.x = pk2(O[0][d][4 * g + 0] * rstd * gg.x, O[0][d][4 * g + 1] * rstd * gg.y); o2.y = pk2(O[0][d][4 * g + 2] * rstd * gg.z, O[0][d][4 * g + 3] * rstd * gg.w);
                    *(u32x2*)(yrow + d * 32 + 8 * g) = o2; }
        } else {
#pragma unroll
            for (int d = 0; d < 2; ++d)
#pragma unroll
                for (int g = 0; g < 4; ++g) { u32x2 o2;
                    o2.x = pk2(O[0][d][4 * g + 0] * inv[0], O[0][d][4 * g + 1] * inv[0]); o2.y = pk2(O[0][d][4 * g + 2] * inv[0], O[0][d][4 * g + 3] * inv[0]);
                    *(u32x2*)(yrow + d * 32 + 8 * g) = o2; }
        }
    }
    __syncthreads();
}


__device__ __forceinline__ float vmax3_(float a, float b, float c) { float r; asm("v_max3_f32 %0, %1, %2, %3" : "=v"(r) : "v"(a), "v"(b), "v"(c)); return r; }
__device__ __forceinline__ void attnD_phase(Frame& F, int l) {
    ArgsP a = kargs();
    const bf16* P = (const bf16*)(F.ws + WS_PU);
    bf16* Y = (bf16*)(F.ws + WS_Y) + (size_t)3 * S * 256;
    const float sc2 = 0.17677669529663687f * 1.4426950408889634f;
    const int lane = F.lane, w = F.wave, r = lane & 31, hh = lane >> 5, rw = w & 3, ksel = w >> 2;
    const int srow = F.tid >> 3, sch = F.tid & 7;
    const int kwoff = srow * 128 + ((sch ^ (srow & 7)) << 4), vwoff = srow * 128 + sch * 16;
#pragma unroll 1
    for (int pr = F.bid; pr < 256; pr += F.G) {
        const int head = pr & 3, bp = pr >> 2;
#pragma unroll 1
        for (int rep = 0; rep < 2; ++rep) {
            const int b = rep ? 127 - bp : bp;
            const int qrow = b * 128 + rw * 32, cw = 2 * b + (rw >> 1);
            bf16x8 Qf[4];
#pragma unroll
            for (int kk = 0; kk < 4; ++kk) Qf[kk] = *(const bf16x8*)(P + (size_t)(qrow + r) * PW + C_QD + head * 64 + kk * 16 + 8 * hh);
            f32x16 O[2][2]; float m[2], lsum[2];
#pragma unroll
            for (int s2 = 0; s2 < 2; ++s2) { m[s2] = -1e30f; lsum[s2] = 0.f;
#pragma unroll
                for (int d = 0; d < 2; ++d)
#pragma unroll
                    for (int i = 0; i < 16; ++i) O[s2][d][i] = 0.f; }
            const bf16* gK = P + (size_t)srow * PW + C_KD + head * 64 + sch * 8; const bf16* gV = P + (size_t)srow * PW + C_VD + head * 64 + sch * 8;
            u32x4 kr0 = *(const u32x4*)gK, kr1 = *(const u32x4*)(gK + (size_t)64 * PW), vr0 = *(const u32x4*)gV, vr1 = *(const u32x4*)(gV + (size_t)64 * PW);
            __syncthreads();
            *(LAS u32x4*)(F.lds + kwoff) = kr0; *(LAS u32x4*)(F.lds + 8192 + kwoff) = kr1; *(LAS u32x4*)(F.lds + 16384 + vwoff) = vr0; *(LAS u32x4*)(F.lds + 24576 + vwoff) = vr1;
            __syncthreads();
#pragma unroll 1
            for (int i = 0; i <= b; ++i) {
                const int buf = i & 1, j = 2 * i + ksel;
                if (i < b) { const size_t go = (size_t)(2 * i + 2) * 64 * PW; kr0 = *(const u32x4*)(gK + go); kr1 = *(const u32x4*)(gK + go + (size_t)64 * PW); vr0 = *(const u32x4*)(gV + go); vr1 = *(const u32x4*)(gV + go + (size_t)64 * PW); }
                if (j <= cw) {
                    const LAS unsigned char* Kt = F.lds + buf * 32768 + ksel * 8192; const LAS unsigned char* Vt = F.lds + buf * 32768 + 16384 + ksel * 8192;
                    bf16x8 pf[2][4];
#pragma unroll
                    for (int s2 = 0; s2 < 2; ++s2) {
                        f32x16 Sq[2];
#pragma unroll
                        for (int kb = 0; kb < 2; ++kb) {
#pragma unroll
                            for (int ii = 0; ii < 16; ++ii) Sq[kb][ii] = 0.f;
#pragma unroll
                            for (int k2 = 0; k2 < 2; ++k2) { const int kk = 2 * s2 + k2; const int row = kb * 32 + r;
                                const bf16x8 kf = *(const LAS bf16x8*)(Kt + row * 128 + (((kk * 2 + hh) ^ (row & 7)) << 4));
                                Sq[kb] = __builtin_amdgcn_mfma_f32_32x32x16_bf16(kf, Qf[kk], Sq[kb], 0, 0, 0); }
                        }
                        __builtin_amdgcn_sched_barrier(0);
                        asm volatile("s_nop 15\n\ts_nop 3" ::: "memory");
                        __builtin_amdgcn_sched_barrier(0);
                        float mx = vmax3_(Sq[0][0], Sq[0][1], Sq[0][2]);
#pragma unroll
                        for (int ii = 3; ii < 15; ii += 2) mx = vmax3_(mx, Sq[0][ii], Sq[0][ii + 1]);
                        mx = vmax3_(mx, Sq[0][15], Sq[1][0]);
#pragma unroll
                        for (int ii = 1; ii < 15; ii += 2) mx = vmax3_(mx, Sq[1][ii], Sq[1][ii + 1]);
                        mx = fmaxf(mx, Sq[1][15]);
                        mx = fmaxf(mx, __shfl_xor(mx, 32)) * sc2;
                        if (__any(mx > m[s2] + 8.f)) { const float mn = fmaxf(m[s2], mx), al = __builtin_amdgcn_exp2f(m[s2] - mn); m[s2] = mn; lsum[s2] *= al;
#pragma unroll
                            for (int d = 0; d < 2; ++d)
#pragma unroll
                                for (int ii = 0; ii < 16; ++ii) O[s2][d][ii] *= al; }
                        const float negm = -m[s2]; float rs = 0.f;
#pragma unroll
                        for (int kb = 0; kb < 2; ++kb)
#pragma unroll
                            for (int ii = 0; ii < 16; ++ii) { const float p = __builtin_amdgcn_exp2f(fmaf(Sq[kb][ii], sc2, negm)); Sq[kb][ii] = p; rs += p; }
                        lsum[s2] += rs;
#pragma unroll
                        for (int kb = 0; kb < 2; ++kb)
#pragma unroll
                            for (int ss = 0; ss < 2; ++ss) { u32x4 pw;
                                pw.x = pg8::cvt_pk_bf16(Sq[kb][8 * ss + 0], Sq[kb][8 * ss + 1]); pw.y = pg8::cvt_pk_bf16(Sq[kb][8 * ss + 2], Sq[kb][8 * ss + 3]);
                                pw.z = pg8::cvt_pk_bf16(Sq[kb][8 * ss + 4], Sq[kb][8 * ss + 5]); pw.w = pg8::cvt_pk_bf16(Sq[kb][8 * ss + 6], Sq[kb][8 * ss + 7]);
                                pf[s2][kb * 2 + ss] = __builtin_bit_cast(bf16x8, pw); }
                        __builtin_amdgcn_sched_barrier(0);
                    }
                    const int li = lane & 15, lg = lane >> 4;
                    const LAS unsigned char* vbase = Vt + (4 * (lg >> 1) + (li >> 2)) * 128 + (16 * (lg & 1) + 4 * (li & 3)) * 2;
#pragma unroll
                    for (int d = 0; d < 2; ++d)
#pragma unroll
                        for (int st = 0; st < 4; ++st) {
                            const s16x4 v0 = ds_tr16(vbase + (st * 16) * 128 + d * 64), v1 = ds_tr16(vbase + (st * 16 + 8) * 128 + d * 64);
                            const bf16x8 vf = (bf16x8){v0[0], v0[1], v0[2], v0[3], v1[0], v1[1], v1[2], v1[3]};
                            O[0][d] = __builtin_amdgcn_mfma_f32_32x32x16_bf16(vf, pf[0][st], O[0][d], 0, 0, 0);
                            O[1][d] = __builtin_amdgcn_mfma_f32_32x32x16_bf16(vf, pf[1][st], O[1][d], 0, 0, 0);
                            if (st & 1) __builtin_amdgcn_sched_barrier(0);
                        }
                }
                if (i < b) { LAS unsigned char* nb = F.lds + (buf ^ 1) * 32768; *(LAS u32x4*)(nb + kwoff) = kr0; *(LAS u32x4*)(nb + 8192 + kwoff) = kr1; *(LAS u32x4*)(nb + 16384 + vwoff) = vr0; *(LAS u32x4*)(nb + 24576 + vwoff) = vr1; }
                __syncthreads();
            }
            LAS float* xo = (LAS float*)F.lds + rw * 4096; LAS float* xm = (LAS float*)(F.lds + 65536) + rw * 256;
            if (ksel) {
#pragma unroll
                for (int s2 = 0; s2 < 2; ++s2) { xm[s2 * 64 + lane] = m[s2]; xm[128 + s2 * 64 + lane] = lsum[s2];
#pragma unroll
                    for (int d = 0; d < 2; ++d)
#pragma unroll
                        for (int ii = 0; ii < 16; ++ii) xo[((s2 * 2 + d) * 16 + ii) * 64 + lane] = O[s2][d][ii]; }
            }
            __syncthreads();
            if (!ksel) {
                float inv[2];
#pragma unroll
                for (int s2 = 0; s2 < 2; ++s2) { const float mb = xm[s2 * 64 + lane], lb = xm[128 + s2 * 64 + lane]; const float mn = fmaxf(m[s2], mb), aa = __builtin_amdgcn_exp2f(m[s2] - mn), ab = __builtin_amdgcn_exp2f(mb - mn);
                    float lt = lsum[s2] * aa + lb * ab; lt += __shfl_xor(lt, 32); inv[s2] = 1.f / lt;
#pragma unroll
                    for (int d = 0; d < 2; ++d)
#pragma unroll
                        for (int ii = 0; ii < 16; ++ii) O[s2][d][ii] = (O[s2][d][ii] * aa + xo[((s2 * 2 + d) * 16 + ii) * 64 + lane] * ab) * inv[s2]; }
                const float* lp = a->in[9] + (size_t)l * 128 + (lane & 31); float s1 = (lane < 32) ? lp[0] * lp[32] : 0.f, s3 = (lane < 32) ? lp[64] * lp[96] : 0.f;
                s1 = wave_sum(s1); s3 = wave_sum(s3);
                const float lam_init = 0.8f - 0.6f * __expf(-0.3f * (float)l), lam = __expf(s1) - __expf(s3) + lam_init;
                const float* gn = a->in[10] + (size_t)l * 256 + head * 64 + 4 * hh;
                float ss = 0.f;
#pragma unroll
                for (int d = 0; d < 2; ++d)
#pragma unroll
                    for (int ii = 0; ii < 16; ++ii) { const float o = O[0][d][ii] - lam * O[1][d][ii]; O[0][d][ii] = o; ss += o * o; }
                ss += __shfl_xor(ss, 32);
                const float rstd = rsqrtf(ss * (1.f / 64.f) + RMS_EPS) * (1.f - lam_init);
                bf16* yrow = Y + (size_t)(qrow + r) * 256 + head * 64 + 4 * hh;
#pragma unroll
                for (int d = 0; d < 2; ++d)
#pragma unroll
                    for (int g = 0; g < 4; ++g) { const f32x4 gg = *(const f32x4*)(gn + d * 32 + 8 * g); u32x2 o2;
                        o2.x = pk2(O[0][d][4 * g + 0] * rstd * gg.x, O[0][d][4 * g + 1] * rstd * gg.y); o2.y = pk2(O[0][d][4 * g + 2] * rstd * gg.z, O[0][d][4 * g + 3] * rstd * gg.w);
                        *(u32x2*)(yrow + d * 32 + 8 * g) = o2; }
            }
        }
    }
    __syncthreads();
}

using pg8::sigmoidf_;
constexpr int ML_CE = 0, ML_G = 1024, ML_SC = 2048;
__device__ __forceinline__ float logsigmoidf_(float f) { return f >= 0.f ? -log1pf(__expf(-f)) : f - log1pf(__expf(f)); }
__device__ __forceinline__ void ml_gates(const bf16* P, const float* ib, const float* fb, int c, int h, int lane, float& a_t, float& i_t) {
    const bf16* pr = P + (size_t)(c * 64 + lane) * PW;
    i_t = bf2f(pr[C_IB + h]) + ib[h]; a_t = logsigmoidf_(bf2f(pr[C_FB + h]) + fb[h]);
}
__device__ __forceinline__ float wave_scan_add(float v, int lane) {
#pragma unroll
    for (int o = 1; o < 64; o <<= 1) { const float u = __shfl_up(v, o); if (lane >= o) v += u; }
    return v;
}
__device__ __forceinline__ float wave_scan_max(float v, int lane) {
#pragma unroll
    for (int o = 1; o < 64; o <<= 1) { const float u = __shfl_up(v, o); if (lane >= o) v = fmaxf(v, u); }
    return v;
}
__device__ __forceinline__ void ml_phase1(Frame& F, int l) {
    ArgsP a = kargs(); const bf16* P = (const bf16*)(F.ws + WS_PU); float* mls = (float*)(F.ws + WS_MLS);
    const float* ib = a->in[5] + l * 4; const float* fb = a->in[6] + l * 4;
    for (int u = F.bid * 8 + F.wave; u < NCH * 4; u += F.G * 8) {
        const int c = u >> 2, h = u & 3; float at, it; ml_gates(P, ib, fb, c, h, F.lane, at, it);
        const float cum = wave_scan_add(at, F.lane), ce = __shfl(cum, 63), g = ce - cum + it, G = wave_max(g);
        if (F.lane == 0) { mls[ML_CE + u] = ce; mls[ML_G + u] = G; }
    }
}
__device__ __forceinline__ void ml_mscan(Frame& F, LAS float* mt, LAS float* tmp) {
    const float* mls = (const float*)(F.ws + WS_MLS);
    __syncthreads();
    for (int i = F.tid; i < 1024; i += 512) { tmp[i] = mls[ML_CE + i]; tmp[1024 + i] = mls[ML_G + i]; }
    __syncthreads();
    if (F.tid < 4) { float m = 0.f;
#pragma unroll 1
        for (int c = 0; c < NCH; ++c) { mt[F.tid * 257 + c] = m; m = fmaxf(tmp[c * 4 + F.tid] + m, tmp[1024 + c * 4 + F.tid]); }
        mt[F.tid * 257 + 256] = m; }
    __syncthreads();
}
__device__ __forceinline__ void ml_stage_conv(const bf16* P, int col0, const float* cw, const float* cb, int row0, float sc, LAS float* dst, int tid) {
    const int t = tid >> 3, d0 = (tid & 7) * 8;
    float acc[8];
#pragma unroll
    for (int i = 0; i < 8; ++i) acc[i] = cb[d0 + i];
#pragma unroll
    for (int j = 0; j < 4; ++j) { const int r = row0 + t - 3 + j;
        if (r >= 0) { const u32x4 x = *(const u32x4*)(P + (size_t)r * PW + col0 + d0); const float* w = cw + j * 512 + d0;
            acc[0] += w[0] * bflo(x.x); acc[1] += w[1] * bfhi(x.x); acc[2] += w[2] * bflo(x.y); acc[3] += w[3] * bfhi(x.y);
            acc[4] += w[4] * bflo(x.z); acc[5] += w[5] * bfhi(x.z); acc[6] += w[6] * bflo(x.w); acc[7] += w[7] * bfhi(x.w); } }
#pragma unroll
    for (int i = 0; i < 8; ++i) dst[t * 65 + d0 + i] = acc[i] * sigmoidf_(acc[i]) * sc;
}
__device__ __forceinline__ void ml_stage_plain(const bf16* P, int col0, int row0, const LAS float* rs, LAS float* dst, int tid) {
    const int t = tid >> 3, d0 = (tid & 7) * 8; const float sc = rs ? rs[t] : 1.f;
    const u32x4 x = *(const u32x4*)(P + (size_t)(row0 + t) * PW + col0 + d0); LAS float* d = dst + t * 65 + d0;
    d[0] = bflo(x.x) * sc; d[1] = bfhi(x.x) * sc; d[2] = bflo(x.y) * sc; d[3] = bfhi(x.y) * sc; d[4] = bflo(x.z) * sc; d[5] = bfhi(x.z) * sc; d[6] = bflo(x.w) * sc; d[7] = bfhi(x.w) * sc;
}
__device__ __forceinline__ void ml_phase3(Frame& F, int l) {
    ArgsP a = kargs(); const bf16* P = (const bf16*)(F.ws + WS_PU); float* mls = (float*)(F.ws + WS_MLS);
    float* dC = (float*)(F.ws + WS_MLC); float* dn = (float*)(F.ws + WS_MLN);
    const float* ib = a->in[5] + l * 4; const float* fb = a->in[6] + l * 4; const float* cw = a->in[3] + (size_t)l * 2048; const float* cb = a->in[4] + (size_t)l * 512;
    LAS float* Kl = (LAS float*)F.lds; LAS float* Vl = Kl + 64 * 65; LAS float* srcL = Vl + 64 * 65; LAS float* mt = srcL + 64; LAS float* tmp = mt + 4 * 257 + 4;
    ml_mscan(F, mt, tmp);
    const int lane = F.lane, w = F.wave, li = lane & 15, kq = lane >> 4, bi = w >> 1, bj0 = (w & 1) * 2;
    for (int u = F.bid; u < NCH * 4; u += F.G) {
        const int c = u >> 2, h = u & 3; const float m0 = mt[h * 257 + c], m1 = mt[h * 257 + c + 1];
        __syncthreads();
        if (w == 0) { float at, it; ml_gates(P, ib, fb, c, h, lane, at, it); const float cum = wave_scan_add(at, lane), ce = __shfl(cum, 63);
            srcL[lane] = __expf(ce - cum + it - m1); if (lane == 0) mls[ML_SC + u] = __expf(ce + m0 - m1); }
        ml_stage_conv(P, C_KB + h * 64, cw + 256 + h * 64, cb + 256 + h * 64, c * 64, 0.125f, Kl, F.tid);
        __syncthreads();
        ml_stage_plain(P, C_VB + h * 64, c * 64, srcL, Vl, F.tid);
        __syncthreads();
        f32x4 acc0 = {0.f, 0.f, 0.f, 0.f}, acc1 = {0.f, 0.f, 0.f, 0.f};
#pragma unroll 4
        for (int k0 = 0; k0 < 64; k0 += 4) { const float av = Vl[(k0 + kq) * 65 + bi * 16 + li];
            acc0 = MFMA_F32(av, Kl[(k0 + kq) * 65 + bj0 * 16 + li], acc0); acc1 = MFMA_F32(av, Kl[(k0 + kq) * 65 + (bj0 + 1) * 16 + li], acc1); }
        float* o = dC + (size_t)u * 4096 + (bi * 16 + kq * 4) * 64 + li;
#pragma unroll
        for (int r = 0; r < 4; ++r) { o[r * 64 + bj0 * 16] = acc0[r]; o[r * 64 + (bj0 + 1) * 16] = acc1[r]; }
        if (F.tid < 64) { float sacc = 0.f; for (int s2 = 0; s2 < 64; ++s2) sacc += srcL[s2] * Kl[s2 * 65 + F.tid]; dn[(size_t)u * 64 + F.tid] = sacc; }
    }
    __syncthreads();
}
__device__ __forceinline__ void ml_phase4(Frame& F) {
    float* dC = (float*)(F.ws + WS_MLC); float* dn = (float*)(F.ws + WS_MLN); const float* sc = (const float*)(F.ws + WS_MLS) + ML_SC;
    float* base; size_t stride; int h;
    if (F.wave == 0) { const int e = F.bid * 64 + F.lane; if (e >= 16384) return; h = e >> 12; base = dC + (size_t)h * 4096 + (e & 4095); stride = 4 * 4096; }
    else if (F.wave == 1 && F.bid < 4) { h = F.bid; base = dn + (size_t)h * 64 + F.lane; stride = 4 * 64; }
    else return;
    float st = 0.f;
    for (int c0 = 0; c0 < NCH; c0 += 8) {
        float v[8], g[8];
#pragma unroll
        for (int i = 0; i < 8; ++i) { v[i] = base[(size_t)(c0 + i) * stride]; g[i] = sc[(c0 + i) * 4 + h]; }
#pragma unroll
        for (int i = 0; i < 8; ++i) { base[(size_t)(c0 + i) * stride] = st; st = g[i] * st + v[i]; }
    }
}
__device__ __forceinline__ void ml_phase5(Frame& F, int l) {
    ArgsP a = kargs(); const bf16* P = (const bf16*)(F.ws + WS_PU);
    const float* Cst = (const float*)(F.ws + WS_MLC); const float* nst = (const float*)(F.ws + WS_MLN);
    const float* ib = a->in[5] + l * 4; const float* fb = a->in[6] + l * 4; const float* cw = a->in[3] + (size_t)l * 2048; const float* cb = a->in[4] + (size_t)l * 512;
    const float* gn = a->in[7] + (size_t)l * 256;
    bf16* Y = (bf16*)(F.ws + WS_Y) + (size_t)1 * S * 256;
    LAS float* Ql = (LAS float*)F.lds; LAS float* Kl = Ql + 64 * 65; LAS float* Vl = Kl + 64 * 65; LAS float* Cl = Vl + 64 * 65; LAS float* Wl = Cl + 64 * 65;
    LAS float* cumL = Wl + 64 * 65; LAS float* bL = cumL + 64; LAS float* mtL = bL + 64; LAS float* inL = mtL + 64; LAS float* nL = inL + 64; LAS float* denL = nL + 64;
    LAS float* mt = denL + 64; LAS float* tmp = mt + 4 * 257 + 4;
    ml_mscan(F, mt, tmp);
    const int lane = F.lane, w = F.wave, li = lane & 15, kq = lane >> 4, bi = w >> 1, bj0 = (w & 1) * 2;
    for (int u = F.bid; u < NCH * 4; u += F.G) {
        const int c = u >> 2, h = u & 3; const float m0 = mt[h * 257 + c];
        __syncthreads();
        if (w == 0) { float at, it; ml_gates(P, ib, fb, c, h, lane, at, it); const float cum = wave_scan_add(at, lane);
            const float bb = it - cum, pm = wave_scan_max(bb, lane), mtt = fmaxf(cum + m0, cum + pm);
            cumL[lane] = cum; bL[lane] = bb; mtL[lane] = mtt; inL[lane] = __expf(cum + m0 - mtt); nL[lane] = nst[(size_t)u * 64 + lane]; }
        ml_stage_conv(P, C_QB + h * 64, cw + h * 64, cb + h * 64, c * 64, 1.f, Ql, F.tid);
        ml_stage_conv(P, C_KB + h * 64, cw + 256 + h * 64, cb + 256 + h * 64, c * 64, 0.125f, Kl, F.tid);
        ml_stage_plain(P, C_VB + h * 64, c * 64, nullptr, Vl, F.tid);
        { const int t = F.tid >> 3, d0 = (F.tid & 7) * 8; const f32x4 c0 = *(const f32x4*)(Cst + (size_t)u * 4096 + t * 64 + d0), c1 = *(const f32x4*)(Cst + (size_t)u * 4096 + t * 64 + d0 + 4);
          LAS float* d = Cl + t * 65 + d0; d[0] = c0.x; d[1] = c0.y; d[2] = c0.z; d[3] = c0.w; d[4] = c1.x; d[5] = c1.y; d[6] = c1.z; d[7] = c1.w; }
        __syncthreads();
        {
            f32x4 acc0 = {0.f, 0.f, 0.f, 0.f}, acc1 = {0.f, 0.f, 0.f, 0.f};
#pragma unroll 4
            for (int k0 = 0; k0 < 64; k0 += 4) { const float av = Ql[(bi * 16 + li) * 65 + k0 + kq];
                acc0 = MFMA_F32(av, Kl[(bj0 * 16 + li) * 65 + k0 + kq], acc0); acc1 = MFMA_F32(av, Kl[((bj0 + 1) * 16 + li) * 65 + k0 + kq], acc1); }
#pragma unroll
            for (int r = 0; r < 4; ++r) { const int t = bi * 16 + kq * 4 + r; const float ct = cumL[t] - mtL[t];
                { const int s2 = bj0 * 16 + li; Wl[t * 65 + s2] = (s2 <= t) ? __expf(ct + bL[s2]) * acc0[r] : 0.f; }
                { const int s2 = (bj0 + 1) * 16 + li; Wl[t * 65 + s2] = (s2 <= t) ? __expf(ct + bL[s2]) * acc1[r] : 0.f; } }
        }
        __syncthreads();
        if (F.tid < 64) { const int t = F.tid; float qn = 0.f, sw = 0.f;
            for (int k = 0; k < 64; ++k) { qn += Ql[t * 65 + k] * nL[k]; sw += Wl[t * 65 + k]; }
            const float den = inL[t] * qn + sw; denL[t] = 1.f / fmaxf(fabsf(den), __expf(-mtL[t])); }
        f32x4 acc0 = {0.f, 0.f, 0.f, 0.f}, acc1 = {0.f, 0.f, 0.f, 0.f};
#pragma unroll 4
        for (int k0 = 0; k0 < 64; k0 += 4) { const float av = Ql[(bi * 16 + li) * 65 + k0 + kq];
            acc0 = MFMA_F32(av, Cl[(bj0 * 16 + li) * 65 + k0 + kq], acc0); acc1 = MFMA_F32(av, Cl[((bj0 + 1) * 16 + li) * 65 + k0 + kq], acc1); }
#pragma unroll
        for (int r = 0; r < 4; ++r) { const float it = inL[bi * 16 + kq * 4 + r]; acc0[r] *= it; acc1[r] *= it; }
#pragma unroll 4
        for (int k0 = 0; k0 < 64; k0 += 4) { const float av = Wl[(bi * 16 + li) * 65 + k0 + kq];
            acc0 = MFMA_F32(av, Vl[(k0 + kq) * 65 + bj0 * 16 + li], acc0); acc1 = MFMA_F32(av, Vl[(k0 + kq) * 65 + (bj0 + 1) * 16 + li], acc1); }
        __syncthreads();
#pragma unroll
        for (int r = 0; r < 4; ++r) { const int t = bi * 16 + kq * 4 + r; const float dv = denL[t]; Wl[t * 65 + bj0 * 16 + li] = acc0[r] * dv; Wl[t * 65 + (bj0 + 1) * 16 + li] = acc1[r] * dv; }
        __syncthreads();
        { const int t = F.tid >> 3, d0 = (F.tid & 7) * 8; float hv[8], ss = 0.f;
#pragma unroll
          for (int i = 0; i < 8; ++i) { hv[i] = Wl[t * 65 + d0 + i]; ss += hv[i] * hv[i]; }
          ss += __shfl_xor(ss, 1); ss += __shfl_xor(ss, 2); ss += __shfl_xor(ss, 4);
          const float rstd = rsqrtf(ss * (1.f / 64.f) + RMS_EPS);
          const u32x4 ov = *(const u32x4*)(P + (size_t)(c * 64 + t) * PW + C_OB + h * 64 + d0); const float* g = gn + h * 64 + d0;
          const float o0 = sigmoidf_(bflo(ov.x)), o1 = sigmoidf_(bfhi(ov.x)), o2 = sigmoidf_(bflo(ov.y)), o3 = sigmoidf_(bfhi(ov.y)), o4 = sigmoidf_(bflo(ov.z)), o5 = sigmoidf_(bfhi(ov.z)), o6 = sigmoidf_(bflo(ov.w)), o7 = sigmoidf_(bfhi(ov.w));
          u32x4 y; y.x = pk2(o0 * hv[0] * rstd * g[0], o1 * hv[1] * rstd * g[1]); y.y = pk2(o2 * hv[2] * rstd * g[2], o3 * hv[3] * rstd * g[3]);
          y.z = pk2(o4 * hv[4] * rstd * g[4], o5 * hv[5] * rstd * g[5]); y.w = pk2(o6 * hv[6] * rstd * g[6], o7 * hv[7] * rstd * g[7]);
          *(u32x4*)(Y + (size_t)(c * 64 + t) * 256 + h * 64 + d0) = y; }
    }
    __syncthreads();
}


constexpr int DSA_CAP = 2048, DSA_TRIG = 1024, QHP = 260;
__device__ __forceinline__ u32x2 ld_list(const u32x2* p) { const unsigned long long v = __hip_atomic_load((const unsigned long long*)p, __ATOMIC_RELAXED, __HIP_MEMORY_SCOPE_AGENT); return (u32x2){(unsigned)v, (unsigned)(v >> 32)}; }

__device__ __forceinline__ unsigned wave_prefix_incl(unsigned v) {
    v += (unsigned)__builtin_amdgcn_update_dpp(0, (int)v, 0x111, 0xf, 0xf, false);
    v += (unsigned)__builtin_amdgcn_update_dpp(0, (int)v, 0x112, 0xf, 0xf, false);
    v += (unsigned)__builtin_amdgcn_update_dpp(0, (int)v, 0x114, 0xf, 0xf, false);
    v += (unsigned)__builtin_amdgcn_update_dpp(0, (int)v, 0x118, 0xf, 0xf, false);
    v += (unsigned)__builtin_amdgcn_update_dpp(0, (int)v, 0x142, 0xa, 0xf, false);
    v += (unsigned)__builtin_amdgcn_update_dpp(0, (int)v, 0x143, 0xc, 0xf, false);
    return v;
}
__device__ __forceinline__ unsigned sortable(float v) { const unsigned b = __builtin_bit_cast(unsigned, v); return (b & 0x80000000u) ? ~b : (b | 0x80000000u); }
__device__ __forceinline__ unsigned lanes_below(unsigned long long m) { return __builtin_amdgcn_mbcnt_hi((unsigned)(m >> 32), __builtin_amdgcn_mbcnt_lo((unsigned)m, 0u)); }

__device__ __forceinline__ unsigned dsa_bin(unsigned sv) {
    const bool pos = (sv >> 31) != 0u; const unsigned mag = (pos ? sv : ~sv) & 0x7fffffffu; int t = (int)(mag >> 19) - 1904; t = t < 0 ? 0 : (t > 255 ? 255 : t);
    return pos ? 256u + (unsigned)t : 255u - (unsigned)t;
}
__device__ __forceinline__ unsigned dsa_bin_T(unsigned B) {
    if (B >= 257u) return (0x80000000u | ((1904u + (B - 256u)) << 19)) - 1u;
    if (B == 256u) return 0x7fffffffu;
    if (B == 0u) return 0u;
    const unsigned t = 255u - B, mag = ((1905u + t) << 19) - 1u; return (0x7fffffffu - mag) - 1u;
}
__device__ __forceinline__ unsigned dsa_hist_T(const LAS unsigned* qh, int lane) {
    const int grp = 63 - lane;
    const u32x4 h = *(const LAS u32x4*)(qh + 4 * grp);
    const unsigned c[8] = {h.x & 0xffffu, h.x >> 16, h.y & 0xffffu, h.y >> 16, h.z & 0xffffu, h.z >> 16, h.w & 0xffffu, h.w >> 16};
    unsigned tl = 0u;
#pragma unroll
    for (int i = 0; i < 8; ++i) tl += c[i];
    const unsigned suf = wave_prefix_incl(tl);
    const unsigned above = suf - tl; const bool mine = (above < 256u) && (256u <= suf);
    unsigned B = 0u;
    if (mine) { unsigned cc = above; B = 8u * grp;
#pragma unroll
        for (int i = 7; i >= 0; --i) { cc += c[i]; if (cc >= 256u) { B = 8u * grp + i; break; } } }
    const unsigned long long mm = __ballot(mine); if (!mm) return 0u;
    B = (unsigned)__builtin_amdgcn_readlane((int)B, (int)__builtin_ctzll(mm));
    return dsa_bin_T(B);
}
template <int NPASS, class KF, class PF>
__device__ __forceinline__ unsigned radix_kth(int n, KF key, PF pred, unsigned& want, LAS unsigned* hist, int lane) {
    unsigned prefix = 0u, himask = 0u;
#pragma unroll 1
    for (int p = 0; p < NPASS; ++p) {
        const int shift = 8 * (NPASS - 1 - p);
        *(LAS u32x4*)(hist + 4 * lane) = (u32x4){0u, 0u, 0u, 0u};
        asm volatile("s_waitcnt lgkmcnt(0)" ::: "memory");
#pragma unroll 4
        for (int i = lane; i < n; i += 64) { const unsigned k = key(i); if (pred(i) && ((k ^ prefix) & himask) == 0u) (void)__hip_atomic_fetch_add(hist + ((k >> shift) & 255u), 1u, __ATOMIC_RELAXED, __HIP_MEMORY_SCOPE_WORKGROUP); }
        asm volatile("s_waitcnt lgkmcnt(0)" ::: "memory");
        const int grp = 63 - lane;
        const u32x4 h = *(LAS u32x4*)(hist + 4 * grp);
        const unsigned tl = h.x + h.y + h.z + h.w; const unsigned suf = wave_prefix_incl(tl);
        const unsigned above = suf - tl;
        const bool mine = (above < want) && (want <= suf);
        unsigned D = 0u, nw = 0u;
        if (mine) { unsigned c = above;
            if (c + h.w >= want) { D = 4 * grp + 3; nw = want - c; } else { c += h.w;
            if (c + h.z >= want) { D = 4 * grp + 2; nw = want - c; } else { c += h.z;
            if (c + h.y >= want) { D = 4 * grp + 1; nw = want - c; } else { c += h.y; D = 4 * grp; nw = want - c; } } } }
        const unsigned long long mm = __ballot(mine); const int src = mm ? (int)__builtin_ctzll(mm) : 0;
        D = (unsigned)__builtin_amdgcn_readlane((int)D, src); nw = (unsigned)__builtin_amdgcn_readlane((int)nw, src);
        prefix |= D << shift; himask |= 0xffu << shift; want = nw;
    }
    return prefix;
}
__device__ __forceinline__ void dsa_prune(u32x2* list, LAS unsigned* nq, LAS unsigned* Tq, int q, LAS u32x2* st, LAS unsigned* hist, int lane, bool exact, unsigned tmin) {
    const int n0 = (int)nq[q]; int n = 0;
#pragma unroll 1
    for (int i0 = 0; i0 < n0; i0 += 256) {
        u32x2 t8[4];
#pragma unroll
        for (int u = 0; u < 4; ++u) { const int i = i0 + u * 64 + lane; t8[u] = (i < n0) ? ld_list(list + i) : (u32x2){0u, 0u}; }
#pragma unroll
        for (int u = 0; u < 4; ++u) { const int i = i0 + u * 64 + lane; const bool k = (i < n0) && t8[u].x > tmin;
            const unsigned long long m = __ballot(k); if (k) st[n + (int)lanes_below(m)] = t8[u]; n += (int)__popcll(m); } }
    asm volatile("s_waitcnt vmcnt(0) lgkmcnt(0)" ::: "memory");
    if (n <= 256) {
#pragma unroll 1
        for (int i = lane; i < n; i += 64) list[i] = st[i];
        if (lane == 0) { nq[q] = (unsigned)n; if (tmin > Tq[q]) Tq[q] = tmin; }
        asm volatile("s_waitcnt vmcnt(0)" ::: "memory");
        return;
    }
    if (!exact) {
        unsigned want = 256u;
        const unsigned Th = radix_kth<2>(n, [st](int i) { return st[i].x >> 16; }, [](int) { return true; }, want, hist, lane);
        unsigned cnt_ge = 0u;
#pragma unroll 1
        for (int i0 = 0; i0 < n; i0 += 64) { const int i = i0 + lane; cnt_ge += (unsigned)__popcll(__ballot(i < n && (st[i].x >> 16) >= Th)); }
        if (cnt_ge <= 512u && Th > 0u) {
            unsigned base = 0u;
#pragma unroll 1
            for (int i0 = 0; i0 < n; i0 += 64) { const int i = i0 + lane; const u32x2 t = (i < n) ? st[i] : (u32x2){0u, 0u};
                const bool keep = (i < n) && (t.x >> 16) >= Th;
                const unsigned long long m = __ballot(keep); if (keep) list[base + lanes_below(m)] = t; base += (unsigned)__popcll(m); }
            if (lane == 0) { nq[q] = base; const unsigned tn = (Th << 16) - 1u; Tq[q] = tn > tmin ? tn : tmin; }
            asm volatile("s_waitcnt vmcnt(0)" ::: "memory");
            return;
        }
    }
    unsigned want = 256u;
    const unsigned Ts = radix_kth<4>(n, [st](int i) { return st[i].x; }, [](int) { return true; }, want, hist, lane);
    unsigned cnt_eq = 0u;
#pragma unroll 1
    for (int i0 = 0; i0 < n; i0 += 64) { const int i = i0 + lane; cnt_eq += (unsigned)__popcll(__ballot(i < n && st[i].x == Ts)); }
    unsigned Tk = 0u;
    if (cnt_eq > want) Tk = radix_kth<2>(n, [st](int i) { return 0x3fffu - st[i].y; }, [st, Ts](int i) { return st[i].x == Ts; }, want, hist, lane);
    unsigned base = 0u;
#pragma unroll 1
    for (int i0 = 0; i0 < n; i0 += 64) { const int i = i0 + lane; const u32x2 t = (i < n) ? st[i] : (u32x2){0u, 0u};
        const bool keep = (i < n) && (t.x > Ts || (t.x == Ts && (0x3fffu - t.y) >= Tk));
        const unsigned long long m = __ballot(keep); if (keep) list[base + lanes_below(m)] = t; base += (unsigned)__popcll(m); }
    if (lane == 0) { nq[q] = base; Tq[q] = Ts > 0u ? Ts - 1u : 0u; }
    asm volatile("s_waitcnt vmcnt(0)" ::: "memory");
}
__device__ __forceinline__ int dsa_final(const u32x2* list, int n0, unsigned tmin, LAS u32x2* st, LAS unsigned* hist, LAS unsigned* bmp, int lane) {
    int n = 0;
#pragma unroll 1
    for (int i0 = 0; i0 < n0; i0 += 512) {
        u32x4 t4[4];
#pragma unroll
        for (int u = 0; u < 4; ++u) { const int i = i0 + u * 128 + 2 * lane; t4[u] = (i < n0) ? *(const u32x4*)(list + i) : (u32x4){0u, 0u, 0u, 0u}; }
#pragma unroll
        for (int u = 0; u < 4; ++u) { const int i = i0 + u * 128 + 2 * lane;
            { const bool k = (i < n0) && t4[u].x > tmin; const unsigned long long m = __ballot(k); if (k) st[n + (int)lanes_below(m)] = (u32x2){t4[u].x, t4[u].y}; n += (int)__popcll(m); }
            { const bool k = (i + 1 < n0) && t4[u].z > tmin; const unsigned long long m = __ballot(k); if (k) st[n + (int)lanes_below(m)] = (u32x2){t4[u].z, t4[u].w}; n += (int)__popcll(m); } }
    }
    asm volatile("s_waitcnt lgkmcnt(0)" ::: "memory");
    unsigned Ts = 0u, Tk = 0u;
    if (n > 256) {
        unsigned want = 256u;
        Ts = radix_kth<4>(n, [st](int i) { return st[i].x; }, [](int) { return true; }, want, hist, lane);
        unsigned cnt_eq = 0u;
#pragma unroll 1
        for (int i0 = 0; i0 < n; i0 += 64) { const int i = i0 + lane; cnt_eq += (unsigned)__popcll(__ballot(i < n && st[i].x == Ts)); }
        if (cnt_eq > want) Tk = radix_kth<2>(n, [st](int i) { return 0x3fffu - st[i].y; }, [st, Ts](int i) { return st[i].x == Ts; }, want, hist, lane);
    }
    int cnt = 0;
#pragma unroll 1
    for (int i0 = 0; i0 < n; i0 += 64) { const int i = i0 + lane; const u32x2 t = (i < n) ? st[i] : (u32x2){0u, 0u};
        const bool keep = (i < n) && (n <= 256 || t.x > Ts || (t.x == Ts && (0x3fffu - t.y) >= Tk));
        if (keep) (void)__hip_atomic_fetch_or(bmp + (t.y >> 5), 1u << (t.y & 31u), __ATOMIC_RELAXED, __HIP_MEMORY_SCOPE_WORKGROUP);
        cnt += (int)__popcll(__ballot(keep)); }
    asm volatile("s_waitcnt lgkmcnt(0)" ::: "memory");
    return cnt;
}
__device__ __forceinline__ void dsa_unit(Frame& F, int G32) {
    const bf16* P = (const bf16*)(F.ws + WS_PU);
    bf16* Y = (bf16*)(F.ws + WS_Y);
    u32x2* cand = (u32x2*)(F.ws + WS_CAND) + (size_t)F.bid * 32 * DSA_CAP;
    const int lane = F.lane, w = F.wave, r = lane & 31, hh = lane >> 5;
    LAS unsigned char* wscr = F.lds + w * 12288;
    LAS unsigned* Tq = (LAS unsigned*)(F.lds + 98304); LAS unsigned* nq = Tq + 32;
    LAS unsigned* hist = (LAS unsigned*)(F.lds + 98816 + w * 1024);
    LAS unsigned* qhist = (LAS unsigned*)(F.lds + 107008);
    const int q0 = G32 * 32, c = G32 >> 1, nt = c + 1, nrounds = (nt + 7) >> 3;
    __syncthreads();
    if (F.tid < 32) { Tq[F.tid] = 0u; nq[F.tid] = 0u; nq[32 + F.tid] = 0u; nq[64 + F.tid] = 0u; }
#pragma unroll
    for (int k = 0; k < 4; ++k) *(LAS u32x4*)(qhist + F.tid * 4 + k * 2048) = (u32x4){0u, 0u, 0u, 0u};
    if (F.tid < 32) *(LAS u32x4*)(qhist + 8192 + F.tid * 4) = (u32x4){0u, 0u, 0u, 0u};
    bf16x8 Qf[4][2]; float wh[4];
    { const bf16* qp = P + (size_t)(q0 + r) * PW;
#pragma unroll
      for (int h = 0; h < 4; ++h) { wh[h] = bf2f(qp[C_WI + h]);
#pragma unroll
          for (int kk = 0; kk < 2; ++kk) Qf[h][kk] = *(const bf16x8*)(qp + C_QI + h * 32 + kk * 16 + 8 * hh); } }
    bf16x8 Kf[2][2];
    { const int j0 = w < nt ? w : 0;
#pragma unroll
      for (int kb = 0; kb < 2; ++kb)
#pragma unroll
          for (int kk = 0; kk < 2; ++kk) Kf[kb][kk] = *(const bf16x8*)(P + (size_t)(j0 * 64 + kb * 32 + r) * PW + C_KI + kk * 16 + 8 * hh); }
    __syncthreads();
    LAS unsigned* nlast = nq + 32;
    const int R0 = nrounds < 4 ? nrounds : 4, nvr = nrounds + R0;
    for (int vr = 0; vr < nvr; ++vr) {
        const int mode = vr < R0 ? 0 : (vr < nrounds ? 1 : 2);
        const int rd = mode == 2 ? vr - nrounds : vr;
        const int j = rd * 8 + w;
        int rr = r; asm volatile("" : "+v"(rr));
        u32x2* myl = cand + (size_t)rr * DSA_CAP;
        if (j < nt) {
            f32x16 acc[2];
#pragma unroll
            for (int h = 0; h < 4; ++h)
#pragma unroll
                for (int kb = 0; kb < 2; ++kb) { f32x16 sv;
#pragma unroll
                    for (int i = 0; i < 16; ++i) sv[i] = 0.f;
                    sv = __builtin_amdgcn_mfma_f32_32x32x16_bf16(Kf[kb][0], Qf[h][0], sv, 0, 0, 0); sv = __builtin_amdgcn_mfma_f32_32x32x16_bf16(Kf[kb][1], Qf[h][1], sv, 0, 0, 0);
#pragma unroll
                    for (int i = 0; i < 16; ++i) { const float rl = __builtin_amdgcn_fmed3f(sv[i], 0.f, __builtin_inff()); acc[kb][i] = (h == 0) ? (wh[0] * rl + 0.f) : fmaf(wh[h], rl, acc[kb][i]); } }
            const unsigned T = mode ? Tq[rr] : 0xffffffffu;
            LAS unsigned* myv = (LAS unsigned*)wscr + lane * 36;
            unsigned pm = 0u;
#pragma unroll
            for (int kb = 0; kb < 2; ++kb)
#pragma unroll
                for (int g = 0; g < 4; ++g) { u32x4 v4;
                    v4.x = sortable(acc[kb][4 * g]); v4.y = sortable(acc[kb][4 * g + 1]); v4.z = sortable(acc[kb][4 * g + 2]); v4.w = sortable(acc[kb][4 * g + 3]);
                    pm |= (v4.x > T ? 1u : 0u) << (kb * 16 + 4 * g) | (v4.y > T ? 2u : 0u) << (kb * 16 + 4 * g) | (v4.z > T ? 4u : 0u) << (kb * 16 + 4 * g) | (v4.w > T ? 8u : 0u) << (kb * 16 + 4 * g);
                    *(LAS u32x4*)(myv + kb * 16 + 4 * g) = v4;
                    if (mode == 0) { const unsigned b0 = dsa_bin(v4.x), b1 = dsa_bin(v4.y), b2 = dsa_bin(v4.z), b3 = dsa_bin(v4.w); LAS unsigned* qh = qhist + rr * QHP;
                        (void)__hip_atomic_fetch_add(qh + (b0 >> 1), 1u << (16u * (b0 & 1u)), __ATOMIC_RELAXED, __HIP_MEMORY_SCOPE_WORKGROUP); (void)__hip_atomic_fetch_add(qh + (b1 >> 1), 1u << (16u * (b1 & 1u)), __ATOMIC_RELAXED, __HIP_MEMORY_SCOPE_WORKGROUP);
                        (void)__hip_atomic_fetch_add(qh + (b2 >> 1), 1u << (16u * (b2 & 1u)), __ATOMIC_RELAXED, __HIP_MEMORY_SCOPE_WORKGROUP); (void)__hip_atomic_fetch_add(qh + (b3 >> 1), 1u << (16u * (b3 & 1u)), __ATOMIC_RELAXED, __HIP_MEMORY_SCOPE_WORKGROUP); } }
            asm volatile("s_waitcnt lgkmcnt(0)" ::: "memory");
            while (__any(pm != 0u)) {
                if (pm) { const int e = __builtin_ctz(pm); pm &= pm - 1u; const unsigned sv1 = myv[e];
                    const unsigned pos1 = __hip_atomic_fetch_add(nq + rr, 1u, __ATOMIC_RELAXED, __HIP_MEMORY_SCOPE_WORKGROUP);
                    if (mode == 1) { const unsigned bn = dsa_bin(sv1); (void)__hip_atomic_fetch_add(qhist + rr * QHP + (bn >> 1), 1u << (16u * (bn & 1u)), __ATOMIC_RELAXED, __HIP_MEMORY_SCOPE_WORKGROUP); }
                    myl[pos1] = (u32x2){sv1, (unsigned)(j * 64 + (e >> 4) * 32 + (e & 3) + 8 * ((e & 15) >> 2) + 4 * hh)}; }
            }
        }
        { const int nv = vr + 1, nrd = nv < nrounds ? nv : nv - nrounds; int jn = nrd * 8 + w; if (jn >= nt || nv >= nvr) jn = (j < nt ? j : 0);
#pragma unroll
          for (int kb = 0; kb < 2; ++kb)
#pragma unroll
              for (int kk = 0; kk < 2; ++kk) Kf[kb][kk] = *(const bf16x8*)(P + (size_t)(jn * 64 + kb * 32 + r) * PW + C_KI + kk * 16 + 8 * hh); }
        LAS unsigned* oflag = nq + 64;
#pragma unroll 1
        for (int qq = 0; qq < 4; ++qq) { const int q = w * 4 + qq; const unsigned n = nq[q];
            if (n > (unsigned)DSA_TRIG) { if (lane == 0) oflag[0] = 1u; continue; }
            if (mode == 1 && n < nlast[q] + 48u) continue;
            if (lane == 0) nlast[q] = n;
            const unsigned Th = dsa_hist_T(qhist + q * QHP, lane);
            if (lane == 0 && Th > Tq[q]) Tq[q] = Th; }
        __syncthreads();
        if (oflag[0]) {
            asm volatile("s_waitcnt vmcnt(0)" ::: "memory");
            __syncthreads();
#pragma unroll 1
            for (int qq = 0; qq < 4; ++qq) { const int q = w * 4 + qq; const unsigned n = nq[q];
                if (n > (unsigned)DSA_TRIG) {
                    const unsigned Th = dsa_hist_T(qhist + q * QHP, lane);
                    dsa_prune(cand + (size_t)q * DSA_CAP, nq, Tq, q, (LAS u32x2*)wscr, hist, lane, false, Th > Tq[q] ? Th : Tq[q]);
                    const int n2 = (int)nq[q]; LAS unsigned* qh = qhist + q * QHP;
                    *(LAS u32x4*)(qh + 4 * lane) = (u32x4){0u, 0u, 0u, 0u};
                    asm volatile("s_waitcnt lgkmcnt(0)" ::: "memory");
#pragma unroll 1
                    for (int i = lane; i < n2; i += 64) { const unsigned bn = dsa_bin(ld_list(cand + (size_t)q * DSA_CAP + i).x); (void)__hip_atomic_fetch_add(qh + (bn >> 1), 1u << (16u * (bn & 1u)), __ATOMIC_RELAXED, __HIP_MEMORY_SCOPE_WORKGROUP); }
                    __builtin_amdgcn_fence(__ATOMIC_ACQUIRE, "agent");
                    asm volatile("s_waitcnt vmcnt(0) lgkmcnt(0)" ::: "memory");
                    if (lane == 0) nlast[q] = (unsigned)n2;
                } }
            __syncthreads();
            if (F.tid == 0) oflag[0] = 0u;
            __syncthreads();
        }
    }
    asm volatile("s_waitcnt vmcnt(0)" ::: "memory");
    __syncthreads();
#pragma unroll 1
    for (int qq = 0; qq < 4; ++qq) { const int q = w * 4 + qq; const unsigned Th = dsa_hist_T(qhist + q * QHP, lane); if (lane == 0 && Th > Tq[q]) Tq[q] = Th; }
    __syncthreads();
#pragma unroll 1
    for (int qq = 0; qq < 4; ++qq) {
        const int q = w * 4 + qq, qrow = q0 + q; const int n0 = (int)nq[q];
        LAS unsigned* bmp = (LAS unsigned*)(F.lds + 107008 + w * 2048);
        *(LAS u32x4*)(bmp + 8 * lane) = (u32x4){0u, 0u, 0u, 0u}; *(LAS u32x4*)(bmp + 8 * lane + 4) = (u32x4){0u, 0u, 0u, 0u};
        asm volatile("s_waitcnt lgkmcnt(0)" ::: "memory");
        const int n = dsa_final(cand + (size_t)q * DSA_CAP, n0, n0 > 256 ? Tq[q] : 0u, (LAS u32x2*)wscr, hist, bmp, lane);
        unsigned short* srow = (unsigned short*)(F.ws + WS_SEL) + (size_t)qrow * 256;
        { const u32x4 b0 = *(LAS u32x4*)(bmp + 8 * lane), b1 = *(LAS u32x4*)(bmp + 8 * lane + 4); const unsigned wd[8] = {b0.x, b0.y, b0.z, b0.w, b1.x, b1.y, b1.z, b1.w};
          unsigned cnt = 0u;
#pragma unroll
          for (int i = 0; i < 8; ++i) cnt += (unsigned)__popc(wd[i]);
          unsigned pos = wave_prefix_incl(cnt) - cnt;
#pragma unroll
          for (int i = 0; i < 8; ++i) { unsigned wv = wd[i]; while (wv) { const int bpos = __builtin_ctz(wv); srow[pos++] = (unsigned short)(lane * 256 + i * 32 + bpos); wv &= wv - 1u; } } }
        if (lane == 0) ((int*)(F.ws + WS_NSEL))[qrow] = n;
    }
    asm volatile("s_waitcnt vmcnt(0)" ::: "memory");
}
__device__ __forceinline__ void dsa_sparse_unit(Frame& F, int G32) {
    const bf16* P = (const bf16*)(F.ws + WS_PU); bf16* Y = (bf16*)(F.ws + WS_Y);
    const int lane = F.lane, w = F.wave, q0 = G32 * 32;
#pragma unroll 1
    for (int qq = 0; qq < 4; ++qq) {
        int l2 = lane; asm volatile("" : "+v"(l2)); const int ks = l2 >> 4, dg = l2 & 15;
        const int q = w * 4 + qq, qrow = q0 + q; const int n = ((const int*)(F.ws + WS_NSEL))[qrow];
        LAS unsigned short* srt = (LAS unsigned short*)(F.lds + w * 1024 + (qq & 1) * 512);
        { const unsigned long long* g8 = (const unsigned long long*)((const unsigned short*)(F.ws + WS_SEL) + (size_t)qrow * 256); ((LAS unsigned long long*)srt)[lane] = g8[lane]; }
        asm volatile("s_waitcnt vmcnt(0) lgkmcnt(0)" ::: "memory");
        float qv[16];
        { const u32x4 a0 = *(const u32x4*)(P + (size_t)qrow * PW + C_QA + dg * 16), a1 = *(const u32x4*)(P + (size_t)qrow * PW + C_QA + dg * 16 + 8); const float sc = 0.125f * 1.4426950408889634f;
          qv[0] = bflo(a0.x) * sc; qv[1] = bfhi(a0.x) * sc; qv[2] = bflo(a0.y) * sc; qv[3] = bfhi(a0.y) * sc; qv[4] = bflo(a0.z) * sc; qv[5] = bfhi(a0.z) * sc; qv[6] = bflo(a0.w) * sc; qv[7] = bfhi(a0.w) * sc;
          qv[8] = bflo(a1.x) * sc; qv[9] = bfhi(a1.x) * sc; qv[10] = bflo(a1.y) * sc; qv[11] = bfhi(a1.y) * sc; qv[12] = bflo(a1.z) * sc; qv[13] = bfhi(a1.z) * sc; qv[14] = bflo(a1.w) * sc; qv[15] = bfhi(a1.w) * sc; }
        float mrun = -1e30f, lrun = 0.f, o[16];
#pragma unroll
        for (int i = 0; i < 16; ++i) o[i] = 0.f;
        const int nb = (n + 15) >> 4;
#pragma unroll 1
        for (int bt = 0; bt < nb; ++bt) {
            u32x4 kk[4][2], vv[4][2]; bool val[4];
#pragma unroll
            for (int t = 0; t < 4; ++t) { const int jn = bt * 16 + t * 4 + ks; val[t] = jn < n; const unsigned idx = val[t] ? (unsigned)srt[jn] : 0u;
                const bf16* kp = P + (size_t)idx * PW + C_KA + dg * 16; kk[t][0] = *(const u32x4*)kp; kk[t][1] = *(const u32x4*)(kp + 8); vv[t][0] = *(const u32x4*)(kp + 256); vv[t][1] = *(const u32x4*)(kp + 264); }
#pragma unroll
            for (int t = 0; t < 4; ++t) {
                const u32x4 k0 = kk[t][0], k1 = kk[t][1];
                float d = qv[0] * bflo(k0.x); d = fmaf(qv[1], bfhi(k0.x), d); d = fmaf(qv[2], bflo(k0.y), d); d = fmaf(qv[3], bfhi(k0.y), d); d = fmaf(qv[4], bflo(k0.z), d); d = fmaf(qv[5], bfhi(k0.z), d);
                d = fmaf(qv[6], bflo(k0.w), d); d = fmaf(qv[7], bfhi(k0.w), d); d = fmaf(qv[8], bflo(k1.x), d); d = fmaf(qv[9], bfhi(k1.x), d); d = fmaf(qv[10], bflo(k1.y), d); d = fmaf(qv[11], bfhi(k1.y), d);
                d = fmaf(qv[12], bflo(k1.z), d); d = fmaf(qv[13], bfhi(k1.z), d); d = fmaf(qv[14], bflo(k1.w), d); d = fmaf(qv[15], bfhi(k1.w), d);
                d += __builtin_bit_cast(float, __builtin_amdgcn_update_dpp(0, __builtin_bit_cast(int, d), 0xB1, 0xf, 0xf, false));
                d += __builtin_bit_cast(float, __builtin_amdgcn_update_dpp(0, __builtin_bit_cast(int, d), 0x4E, 0xf, 0xf, false));
                if (!val[t]) d = -1e30f;
                if (__any(d > mrun + 8.f)) { const float mn = fmaxf(mrun, d), al = __builtin_amdgcn_exp2f(mrun - mn); mrun = mn; lrun *= al;
#pragma unroll
                    for (int i = 0; i < 16; ++i) o[i] *= al; }
                const float p = val[t] ? __builtin_amdgcn_exp2f(d - mrun) : 0.f; lrun += p;
                const u32x4 v0 = vv[t][0], v1 = vv[t][1];
                o[0] = fmaf(p, bflo(v0.x), o[0]); o[1] = fmaf(p, bfhi(v0.x), o[1]); o[2] = fmaf(p, bflo(v0.y), o[2]); o[3] = fmaf(p, bfhi(v0.y), o[3]); o[4] = fmaf(p, bflo(v0.z), o[4]); o[5] = fmaf(p, bfhi(v0.z), o[5]);
                o[6] = fmaf(p, bflo(v0.w), o[6]); o[7] = fmaf(p, bfhi(v0.w), o[7]); o[8] = fmaf(p, bflo(v1.x), o[8]); o[9] = fmaf(p, bfhi(v1.x), o[9]); o[10] = fmaf(p, bflo(v1.y), o[10]); o[11] = fmaf(p, bfhi(v1.y), o[11]);
                o[12] = fmaf(p, bflo(v1.z), o[12]); o[13] = fmaf(p, bfhi(v1.z), o[13]); o[14] = fmaf(p, bflo(v1.w), o[14]); o[15] = fmaf(p, bfhi(v1.w), o[15]);
            }
        }
        { float ma = fmaxf(mrun, __shfl_xor(mrun, 16)); ma = fmaxf(ma, __shfl_xor(ma, 32)); const float al = __builtin_amdgcn_exp2f(mrun - ma);
          lrun *= al; lrun += __shfl_xor(lrun, 16); lrun += __shfl_xor(lrun, 32); const float iv = 1.f / lrun;
#pragma unroll
          for (int i = 0; i < 16; ++i) { float t = o[i] * al; t += __shfl_xor(t, 16); t += __shfl_xor(t, 32); o[i] = t * iv; } }
        if (ks == 0) { u32x4 y0, y1; y0.x = pk2(o[0], o[1]); y0.y = pk2(o[2], o[3]); y0.z = pk2(o[4], o[5]); y0.w = pk2(o[6], o[7]); y1.x = pk2(o[8], o[9]); y1.y = pk2(o[10], o[11]); y1.z = pk2(o[12], o[13]); y1.w = pk2(o[14], o[15]);
            *(u32x4*)(Y + (size_t)qrow * 256 + dg * 16) = y0; *(u32x4*)(Y + (size_t)qrow * 256 + dg * 16 + 8) = y1; }
    }
}
__device__ __forceinline__ void dsa_phase(Frame& F) {
#pragma unroll 1
    for (int i2 = F.bid * 2; i2 < 512; i2 += F.G * 2)
#pragma unroll 1
        for (int rep = 0; rep < 2; ++rep) dsa_unit(F, rep ? 511 - (i2 >> 1) : (i2 >> 1));
    __syncthreads();
}
__device__ __forceinline__ void dsa_sparse_phase(Frame& F) {
#pragma unroll 1
    for (int i2 = F.bid * 2; i2 < 512; i2 += F.G * 2)
#pragma unroll 1
        for (int rep = 0; rep < 2; ++rep) dsa_sparse_unit(F, rep ? 511 - (i2 >> 1) : (i2 >> 1));
}

__device__ __forceinline__ void phase_mixers_stub(Frame& F) {
    u32x4* y = (u32x4*)(F.ws + WS_Y); const size_t n = (size_t)1 * S * 256 * 2 / 16;
    for (size_t i = (size_t)F.bid * 512 + F.tid; i < n; i += (size_t)F.G * 512) y[i] = (u32x4){0u, 0u, 0u, 0u};
}

__device__ __forceinline__ Frame mkframe() {
    Frame F; int t = threadIdx.x; asm volatile("" : "+v"(t));
    extern __shared__ __attribute__((aligned(16))) unsigned char lds_raw[];
    F.lds = (LAS unsigned char*)lds_raw; F.ws = kargs()->ws; F.ctl = (unsigned*)(F.ws + WS_CTL);
    F.tid = t; F.lane = t & 63; F.wave = __builtin_amdgcn_readfirstlane(t >> 6); F.G = gridDim.x; F.bid = blockIdx.x;
    return F;
}
__device__ __forceinline__ void grid_barrier() {
    extern __shared__ __attribute__((aligned(16))) unsigned char lds_raw[];
    XcdBarrier b; b.bar = (unsigned*)(kargs()->ws + WS_CTL) + CW_BAR; b.x = xb_xcc_id(); b.st = (volatile LAS unsigned*)((LAS unsigned char*)lds_raw + MISC_OFF) + 8;
    xcd_barrier(b);
}
constexpr int NSEG = 14;
#ifndef SEGMASK
#define SEGMASK 0xffff
#endif
template <int l> __device__ __forceinline__ void layer_body() {
#if MK_MULTI
#define RUN(k) (((SEGMASK >> (k)) & 1) && (l * NSEG + (k)) >= kargs()->seg_lo && (l * NSEG + (k)) < kargs()->seg_hi)
#define SEAM(k) do { } while (0)
#else
#define RUN(k) ((SEGMASK >> (k)) & 1)
#define SEAM(k) grid_barrier()
#endif
    {
        if (RUN(0) && l == 0) {
            Frame F = mkframe();
            phase_convert(F, l);
            if (l == 0) { const int gw = F.bid * 8 + F.wave, NGW = F.G * 8; const float* x0 = kargs()->in[0]; const float* g0 = kargs()->in[1];
                for (int m = gw; m < S; m += NGW) rms_row_to_bf16(x0 + (size_t)m * D, g0, (bf16*)(F.ws + WS_H) + (size_t)m * D, F.lane); }
        }
        if (l == 0) SEAM(0);
        if (RUN(1)) {
            Frame F = mkframe();
            pg8::Gemm g{(const bf16*)(F.ws + WS_H), (const bf16*)(F.ws + WS_WIN), S, PW, 1024}; pg8::StaticOrder So; So.init(S, PW, F.G, F.bid);
            pg8::EpiStore E{(bf16*)(F.ws + WS_PU), PW, 0x7fffffff};
            pg8::gemm_phase<pg8::EpiStore, pg8::StaticOrder, true, true>(F.lds, g, So, E, F.tid);
        }
        SEAM(1);
        if (RUN(2)) { Frame F = mkframe(); ml_phase1(F, l); }
        if (RUN(2)) { Frame F = mkframe(); attn_phase<0>(F, l); }
        SEAM(2);
        if (RUN(3)) { Frame F = mkframe(); ml_phase3(F, l); }
        if (RUN(3)) { Frame F = mkframe(); attnD_phase(F, l); }
        SEAM(3);
        if (RUN(4)) { Frame F = mkframe(); ml_phase4(F); }
        if (RUN(4)) { Frame F = mkframe(); dsa_phase(F); }
        if (RUN(4)) { Frame F = mkframe(); dsa_sparse_phase(F); }
        SEAM(4);
        if (RUN(5)) { Frame F = mkframe(); ml_phase5(F, l); }
        SEAM(5);
        if (RUN(6)) {
            Frame F = mkframe();
            pg8::Gemm g{(const bf16*)(F.ws + WS_Y), (const bf16*)(F.ws + WS_WBR), 4 * S, 4096, 256}; pg8::SchedUp Su{F.G, F.bid};
            pg8::EpiStore E{(bf16*)(F.ws + WS_PU), 4096, 63};
            pg8::gemm_phase<pg8::EpiStore, pg8::SchedUp, true, true>(F.lds, g, Su, E, F.tid);
        }
        SEAM(6);
        if (RUN(7)) {
            Frame F = mkframe();
            pg8::Gemm g{(const bf16*)(F.ws + WS_H), (const bf16*)(F.ws + WS_WGATE), S, 4096, 1024}; pg8::StaticOrder So; So.init(S, 4096, F.G, F.bid);
            pg8::EpiGateMix E{(const bf16*)(F.ws + WS_PU), (bf16*)(F.ws + WS_MIXED)};
            pg8::gemm_phase<pg8::EpiGateMix, pg8::StaticOrder, true, true>(F.lds, g, So, E, F.tid);
        }
        SEAM(7);
        if (RUN(8)) {
            Frame F = mkframe();
            pg8::Gemm g{(const bf16*)(F.ws + WS_MIXED), (const bf16*)(F.ws + WS_WOUT), S, 1024, 1024}; pg8::StaticOrder So; So.init(S, 1024, F.G, F.bid);
            float* xo = kargs()->out;
            pg8::EpiResid E{(l == 0) ? kargs()->in[0] : (const float*)xo, xo};
            pg8::gemm_phase<pg8::EpiResid, pg8::StaticOrder, true, true>(F.lds, g, So, E, F.tid);
        }
        SEAM(8);
        if (RUN(9)) { Frame F = mkframe(); phase_router(F, l, kargs()->out); }
        SEAM(9);
        if (RUN(10)) { Frame F = mkframe(); phase_scatter(F, l); }
        SEAM(10);
        if (RUN(11)) {
            Frame F = mkframe();
            moe_table(F, l); const LAS int* tab = (const LAS int*)(F.lds + LDSCTL_OFF);
            pg8::Gemm g{(const bf16*)(F.ws + WS_XS), (const bf16*)(F.ws + WS_W13), NRMAX, NE * 1024, 1024}; pg8::SchedMoe Sm{F.G, F.bid, __builtin_amdgcn_readfirstlane(tab[224]) * 4, tab};
            pg8::EpiSwiglu E{(bf16*)(F.ws + WS_ACT)};
            pg8::gemm_phase<pg8::EpiSwiglu, pg8::SchedMoe, true, true>(F.lds, g, Sm, E, F.tid);
        }
        SEAM(11);
        if (RUN(12)) {
            Frame F = mkframe();
            moe_table(F, l); const LAS int* tab = (const LAS int*)(F.lds + LDSCTL_OFF);
            pg8::Gemm g{(const bf16*)(F.ws + WS_ACT), (const bf16*)(F.ws + WS_W2), NRMAX, NE * 1024, FE}; pg8::SchedMoe Sm{F.G, F.bid, __builtin_amdgcn_readfirstlane(tab[224]) * 4, tab};
            pg8::EpiDown E{(bf16*)(F.ws + WS_YE), (const float*)(F.ws + WS_RT + 393216)};
            pg8::gemm_phase<pg8::EpiDown, pg8::SchedMoe, true, true>(F.lds, g, Sm, E, F.tid);
        }
        SEAM(12);
        if (RUN(13)) { Frame F = mkframe(); phase_combine(F, l, kargs()->out); }
        if (RUN(13) && l + 1 < NL) { Frame F = mkframe(); phase_convert(F, l + 1); }
        if (l + 1 < NL) SEAM(13);
    }
#undef RUN
#undef SEAM
}
__global__ void __launch_bounds__(512, 2) fwd_kernel(Args args) {
    extern __shared__ __attribute__((aligned(16))) unsigned char lds_raw[];
    {
        LAS unsigned char* lds = (LAS unsigned char*)lds_raw;
        for (int u = threadIdx.x; u < (LDS_BYTES - LDSCTL_OFF) / 4; u += 512) ((LAS unsigned*)(lds + LDSCTL_OFF))[u] = 0u;
        __syncthreads();
        if (!MK_MULTI) (void)xcd_barrier_post((unsigned*)(kargs()->ws + WS_CTL) + CW_BAR, (volatile LAS unsigned*)(lds + MISC_OFF) + 8);
    }
    layer_body<0>();
    layer_body<1>();
}

extern "C" void kernel_launch(void* const* d_in, const int* in_sizes, int n_in, void* d_out, int out_size, void* d_ws, size_t ws_size, hipStream_t stream) {
    static int grid = 0;
    if (grid == 0) {
        if (n_in != 23 || out_size != S * D || ws_size < WS_END) { fprintf(stderr, "kernel_launch: unexpected shapes (n_in %d out %d ws %zu need %zu)\n", n_in, out_size, ws_size, (size_t)WS_END); grid = -1; return; }
        int dev = 0, cus = 0, per_cu = 0;
        if (hipGetDevice(&dev) != hipSuccess || hipDeviceGetAttribute(&cus, hipDeviceAttributeMultiprocessorCount, dev) != hipSuccess) { grid = -1; return; }
        if (hipFuncSetAttribute((const void*)fwd_kernel, hipFuncAttributeMaxDynamicSharedMemorySize, LDS_BYTES) != hipSuccess) { fprintf(stderr, "kernel_launch: hipFuncSetAttribute failed\n"); grid = -1; return; }
        if (hipOccupancyMaxActiveBlocksPerMultiprocessor(&per_cu, (const void*)fwd_kernel, 512, LDS_BYTES) != hipSuccess || per_cu < 1) fprintf(stderr, "kernel_launch: occupancy query says %d\n", per_cu);
        (void)hipGetLastError();
        grid = cus;
    }
    if (grid < 0) return;
    if (hipMemsetAsync((char*)d_ws + WS_CTL, 0, CTL_ZERO_BYTES, stream) != hipSuccess) return;
    Args a{};
    for (int i = 0; i < 23; ++i) a.in[i] = (const float*)d_in[i];
    a.out = (float*)d_out; a.ws = (unsigned char*)d_ws;
#if MK_MULTI
    for (int s = 0; s < NL * NSEG; ++s) { a.seg_lo = s; a.seg_hi = s + 1; hipLaunchKernelGGL(fwd_kernel, dim3(grid), dim3(512), LDS_BYTES, stream, a); }
#else
    a.seg_lo = 0; a.seg_hi = NL * NSEG;
    hipLaunchKernelGGL(fwd_kernel, dim3(grid), dim3(512), LDS_BYTES, stream, a);
#endif
}
```

```cpp
#include <hip/hip_runtime.h>
#include <cstdio>
#include <cstdint>

#define GAS __attribute__((address_space(1)))
#define LAS __attribute__((address_space(3)))
typedef unsigned short bf16;
typedef short bf16x8 __attribute__((ext_vector_type(8)));
typedef short s16x4 __attribute__((ext_vector_type(4)));
typedef float f32x2 __attribute__((ext_vector_type(2)));
typedef float f32x4 __attribute__((ext_vector_type(4)));
typedef float f32x16 __attribute__((ext_vector_type(16)));
typedef unsigned u32x2 __attribute__((ext_vector_type(2)));
typedef unsigned u32x4 __attribute__((ext_vector_type(4)));

#ifndef MK_MULTI
#define MK_MULTI 0
#endif

constexpr int S = 16384, D = 1024, NL = 2, NCH = 256;
constexpr int PW = 3584;
constexpr int C_QA = 0, C_KA = 256, C_VA = 512, C_QI = 768, C_KI = 896, C_WI = 928, C_IB = 932, C_FB = 936, C_QB = 960, C_KB = 1216,
              C_VB = 1472, C_OB = 1728, C_QC = 1984, C_KC = 2240, C_VC = 2496, C_QD = 2752, C_KD = 3008, C_VD = 3264;
constexpr int CIN = 3500;
constexpr int NE = 32, FE = 512, NRMAX = 40960, NBMAX = 160;
constexpr float RMS_EPS = 1e-6f;

constexpr size_t MiB = 1u << 20;
constexpr size_t WS_CTL = 0, CTL_ZERO_BYTES = 1 * MiB;
constexpr size_t WS_WIN = 1 * MiB;
constexpr size_t WS_WBR = WS_WIN + 7 * MiB;
constexpr size_t WS_WGATE = WS_WBR + 2 * MiB;
constexpr size_t WS_WOUT = WS_WGATE + 8 * MiB;
constexpr size_t WS_W13 = WS_WOUT + 2 * MiB;
constexpr size_t WS_W2 = WS_W13 + 64 * MiB;
constexpr size_t WS_H = WS_W2 + 32 * MiB;
constexpr size_t WS_PU = WS_H + 32 * MiB;
constexpr size_t WS_XS = WS_PU;
constexpr size_t WS_ACT = WS_PU + 80 * MiB;
constexpr size_t WS_Y = WS_PU + 128 * MiB;
constexpr size_t WS_MIXED = WS_Y + 32 * MiB;
constexpr size_t WS_CAND = WS_MIXED + 32 * MiB;
constexpr size_t WS_YE = WS_Y;
constexpr size_t WS_MLC = WS_CAND + 128 * MiB;
constexpr size_t WS_MLN = WS_MLC + 16 * MiB;
constexpr size_t WS_MLS = WS_MLN + 256 * 1024;
constexpr size_t WS_RT = WS_MLS + 64 * 1024;
constexpr size_t WS_SEL = WS_RT + 1 * MiB;
constexpr size_t WS_NSEL = WS_SEL + 8 * MiB;
constexpr size_t WS_KV8 = WS_NSEL + 1 * MiB;
constexpr size_t WS_END = WS_KV8 + 8 * MiB;
static_assert(WS_YE + (size_t)NRMAX * 1024 * 2 <= WS_MLC, "ye overlay");
static_assert(WS_ACT + (size_t)NRMAX * 512 * 2 <= WS_Y, "act overlay");
constexpr int CW_BAR = 4096;
constexpr int CW_CNT = 16384;
constexpr int CW_FILL = 16384 + 64;

constexpr int RING_BYTES = 131072;
constexpr int LDS_BYTES = 163840;
constexpr int LDSCTL_OFF = LDS_BYTES - 2048;
constexpr int MISC_OFF = LDSCTL_OFF + 1024;

__device__ __forceinline__ unsigned f2bf(float f) { unsigned u = __builtin_bit_cast(unsigned, f); return (u + 0x7fffu + ((u >> 16) & 1u)) >> 16; }
__device__ __forceinline__ unsigned pk2(float lo, float hi) { return f2bf(lo) | (f2bf(hi) << 16); }
__device__ __forceinline__ float bflo(unsigned w) { return __builtin_bit_cast(float, w << 16); }
__device__ __forceinline__ float bfhi(unsigned w) { return __builtin_bit_cast(float, w & 0xffff0000u); }
__device__ __forceinline__ float bf2f(bf16 b) { return __builtin_bit_cast(float, (unsigned)b << 16); }
#define LDS_WAIT() asm volatile("s_waitcnt lgkmcnt(0)" ::: "memory")
#define VM_WAIT() asm volatile("s_waitcnt vmcnt(0)" ::: "memory")
__device__ __forceinline__ float wave_sum(float v) {
#pragma unroll
    for (int o = 1; o < 64; o <<= 1) v += __shfl_xor(v, o);
    return v;
}
__device__ __forceinline__ float wave_max(float v) {
#pragma unroll
    for (int o = 1; o < 64; o <<= 1) v = fmaxf(v, __shfl_xor(v, o));
    return v;
}

namespace pg8 {
#define PG8_LAS __attribute__((address_space(3)))
typedef unsigned short bf16_t;
constexpr int BM = 256, BK = 64, HALF = 128, HTB = HALF * BK * 2, STAGE_BYTES = 8 * HTB, NXCD = 8, WGM = 8;
__host__ __device__ __forceinline__ int lds_byte(int r, int c) { const int st = (r >> 4) * 2 + (c >> 5), rr = r & 15, cc = c & 31, ob = rr * 64 + cc * 2; return st * 1024 + (ob ^ (((ob >> 9) & 1) << 5)); }
__host__ __device__ __forceinline__ void stage_rc(int b, int& R, int& C) { const int st = b / 1024, sb = b % 1024, swz = sb ^ (((sb >> 9) & 1) << 5); R = (st >> 1) * 16 + swz / 64; C = (st & 1) * 32 + (swz % 64) / 2; }
__host__ __device__ __forceinline__ int perm32(int rho) { const int n = rho >> 4, i = rho & 15; return 8 * (i >> 2) + 4 * n + (i & 3); }
struct Unit { int pm, pn; };
struct Gemm { const bf16_t* A; const bf16_t* Bt; int M, N, K; };
struct StaticOrder {
    int nM, nN, nwg, G, c;
    __host__ __device__ void init(int M, int N, int G_, int c_) { nM = M / BM; nN = N / BM; nwg = nM * nN; G = G_; c = c_; }
    __host__ __device__ bool next(int i, Unit& u) const {
        const long L = (long)i * G + c; if (L >= nwg) return false;
        int wgid = (int)L; { const int q = nwg / NXCD, r = nwg % NXCD, xcd = wgid % NXCD, off = wgid / NXCD; wgid = (xcd < r ? xcd * (q + 1) : r * (q + 1) + (xcd - r) * q) + off; }
        const int nig = WGM * nN, gid = wgid / nig, fm = gid * WGM, gsz = (nM - fm) < WGM ? (nM - fm) : WGM;
        u.pm = fm + ((wgid % nig) % gsz); u.pn = (wgid % nig) / gsz; return true;
    }
    __device__ __forceinline__ void a_ready(const Unit&) const {}
    __device__ __forceinline__ void done(const Unit&) const {}
};
__device__ __forceinline__ unsigned cvt_pk_bf16(float lo, float hi) { unsigned r; asm volatile("v_cvt_pk_bf16_f32 %0, %1, %2" : "=v"(r) : "v"(lo), "v"(hi)); return r; }

template <class Epi, class Sched, bool ALIGN_EPI = false, bool SP2 = false>
__device__ __forceinline__ void gemm_phase(PG8_LAS unsigned char* lds, const Gemm g, const Sched& S, const Epi& E, const int tid) {
    const int wid = __builtin_amdgcn_readfirstlane(tid >> 6), lane = tid & 63, wr = wid >> 2, wc = wid & 3, fr = lane & 15, fq = lane >> 4;
    int Kl_ = g.K; asm volatile("" : "+s"(Kl_));
    const int K = Kl_, nt = K / BK;
    unsigned voffA[2], voffB[2];
#pragma unroll
    for (int i = 0; i < 2; ++i) { int R, C; stage_rc(tid * 16 + i * 8192, R, C); const int Rb = Epi::PERM ? ((R & ~31) + perm32(R & 31)) : R;
        voffA[i] = (unsigned)(R * K + C) * 2u; voffB[i] = (unsigned)(Rb * K + C) * 2u; }
    const size_t kstep = (size_t)(BK * 2);
    const size_t hstep = (size_t)HALF * K * 2;
    const size_t tstep = 2 * hstep;
    const unsigned ldsw = (unsigned)wid * 1024u;
    const int aoff = lds_byte(wr * 64 + fr, fq * 8), boff = lds_byte(wc * 32 + fr, fq * 8);
#define PG8_SA(b, h) (((b) * 2 + (h)) * HTB)
#define PG8_SB(b, h) ((4 + (b) * 2 + (h)) * HTB)
#define PG8_STAGE(bufoff, gbase, voff) do { _Pragma("unroll") for (int _i = 0; _i < 2; ++_i) \
        __builtin_amdgcn_global_load_lds((const unsigned*)((const char*)(gbase) + (voff)[_i]), (PG8_LAS unsigned*)(lds + (bufoff) + ldsw + _i * 8192), 16, 0, 0); } while (0)
#define PG8_LDA(dst, b, h) do { _Pragma("unroll") for (int m = 0; m < 4; ++m) _Pragma("unroll") for (int k = 0; k < 2; ++k) dst[m][k] = *(const PG8_LAS bf16x8*)(lds + PG8_SA(b, h) + aoff + m * 2048 + k * 1024); } while (0)
#define PG8_LDB(dst, b, h) do { _Pragma("unroll") for (int n = 0; n < 2; ++n) _Pragma("unroll") for (int k = 0; k < 2; ++k) dst[n][k] = *(const PG8_LAS bf16x8*)(lds + PG8_SB(b, h) + boff + n * 2048 + k * 1024); } while (0)
#define PG8_MMA(ai, bj, At, Bt) do { __builtin_amdgcn_s_setprio(1); _Pragma("unroll") for (int m = 0; m < 4; ++m) _Pragma("unroll") for (int n = 0; n < 2; ++n) _Pragma("unroll") for (int k = 0; k < 2; ++k) \
        acc[ai][bj][m][n] = __builtin_amdgcn_mfma_f32_16x16x32_bf16(Bt[n][k], At[m][k], acc[ai][bj][m][n], 0, 0, 0); __builtin_amdgcn_s_setprio(0); } while (0)
#define PG8_WAIT_V(n) asm volatile("s_waitcnt vmcnt(" #n ")" ::: "memory")
#define PG8_WAIT_L(n) asm volatile("s_waitcnt lgkmcnt(" #n ")" ::: "memory")
#define PG8_BAR __builtin_amdgcn_s_barrier()
#define PG8_SCHED __builtin_amdgcn_sched_barrier(0)
    Unit cur, nxt; int ui = 0;
    if (!S.next(0, cur)) return;
    f32x4 acc[2][2][4][2];
#pragma unroll
    for (int a = 0; a < 2; ++a)
#pragma unroll
        for (int b = 0; b < 2; ++b)
#pragma unroll
            for (int m = 0; m < 4; ++m)
#pragma unroll
                for (int n = 0; n < 2; ++n) acc[a][b][m][n] = (f32x4){0.f, 0.f, 0.f, 0.f};
    bf16x8 At[4][2], B0[2][2], B1[2][2];
    const char* cA = (const char*)g.A + (size_t)cur.pm * tstep; const char* cB = (const char*)g.Bt + (size_t)cur.pn * tstep;
    S.a_ready(cur);
    if constexpr (SP2) {
        PG8_STAGE(PG8_SB(0, 0), cB, voffB); PG8_STAGE(PG8_SB(0, 1), cB + hstep, voffB); PG8_STAGE(PG8_SA(0, 0), cA, voffA); PG8_STAGE(PG8_SA(0, 1), cA + hstep, voffA);
        if (wr == 1) PG8_BAR;
        PG8_WAIT_V(2); PG8_BAR;
        PG8_STAGE(PG8_SB(1, 0), cB + kstep, voffB); PG8_STAGE(PG8_SA(1, 0), cA + kstep, voffA); PG8_STAGE(PG8_SB(1, 1), cB + hstep + kstep, voffB);
        PG8_WAIT_V(6); PG8_BAR;
    } else {
        PG8_STAGE(PG8_SB(0, 0), cB, voffB); PG8_STAGE(PG8_SA(0, 0), cA, voffA); PG8_STAGE(PG8_SB(0, 1), cB + hstep, voffB); PG8_STAGE(PG8_SA(0, 1), cA + hstep, voffA);
        if (wr == 1) PG8_BAR;
        PG8_WAIT_V(4); PG8_BAR;
        PG8_STAGE(PG8_SB(1, 0), cB + kstep, voffB); PG8_STAGE(PG8_SA(1, 0), cA + kstep, voffA); PG8_STAGE(PG8_SB(1, 1), cB + hstep + kstep, voffB);
        PG8_WAIT_V(6); PG8_BAR;
    }
    for (;;) {
        const bool has_next = S.next(ui + 1, nxt);
        const char* nA = has_next ? (const char*)g.A + (size_t)nxt.pm * tstep : cA; const char* nB = has_next ? (const char*)g.Bt + (size_t)nxt.pn * tstep : cB;
        for (int t = 0; t < nt; t += 2) {
            const bool last = (t == nt - 2);
            const char* a1 = cA + (size_t)(t + 1) * kstep;
            const char* a2 = last ? nA : cA + (size_t)(t + 2) * kstep; const char* b2 = last ? nB : cB + (size_t)(t + 2) * kstep;
            const char* a3 = a2 + kstep; const char* b3 = b2 + kstep;
            if (last && has_next) S.a_ready(nxt);
            if constexpr (SP2) {
            PG8_LDB(B0, 0, 0); PG8_LDB(B1, 0, 1); PG8_SCHED; PG8_LDA(At, 0, 0); PG8_STAGE(PG8_SA(1, 1), a1 + hstep, voffA);
            PG8_WAIT_V(8); PG8_WAIT_L(0); PG8_BAR; PG8_MMA(0, 0, At, B0); PG8_MMA(0, 1, At, B1); PG8_BAR; PG8_SCHED;
            PG8_LDA(At, 0, 1); PG8_STAGE(PG8_SB(0, 0), b2, voffB); PG8_STAGE(PG8_SB(0, 1), b2 + hstep, voffB); PG8_STAGE(PG8_SA(0, 0), a2, voffA);
            PG8_WAIT_V(8); PG8_WAIT_L(0); PG8_BAR; PG8_MMA(1, 0, At, B0); PG8_MMA(1, 1, At, B1); PG8_BAR; PG8_SCHED;
            PG8_LDB(B0, 1, 0); PG8_LDB(B1, 1, 1); PG8_SCHED; PG8_LDA(At, 1, 0); PG8_STAGE(PG8_SA(0, 1), a2 + hstep, voffA);
            PG8_WAIT_V(8); PG8_WAIT_L(0); PG8_BAR; PG8_MMA(0, 0, At, B0); PG8_MMA(0, 1, At, B1); PG8_BAR; PG8_SCHED;
            PG8_LDA(At, 1, 1); PG8_STAGE(PG8_SB(1, 0), b3, voffB); PG8_STAGE(PG8_SB(1, 1), b3 + hstep, voffB); PG8_STAGE(PG8_SA(1, 0), a3, voffA);
            PG8_WAIT_V(8); PG8_WAIT_L(0); PG8_BAR; PG8_MMA(1, 0, At, B0); PG8_MMA(1, 1, At, B1); PG8_BAR; PG8_SCHED;
            } else {
            PG8_LDB(B0, 0, 0); PG8_SCHED; PG8_LDA(At, 0, 0); PG8_STAGE(PG8_SA(1, 1), a1 + hstep, voffA);
            PG8_WAIT_L(8); PG8_BAR; PG8_WAIT_L(0); PG8_MMA(0, 0, At, B0); PG8_BAR; PG8_SCHED;
            PG8_LDB(B1, 0, 1); PG8_STAGE(PG8_SB(0, 0), b2, voffB);
            PG8_BAR; PG8_WAIT_L(0); PG8_MMA(0, 1, At, B1); PG8_BAR;
            PG8_LDA(At, 0, 1); PG8_STAGE(PG8_SA(0, 0), a2, voffA);
            PG8_BAR; PG8_WAIT_L(0); PG8_MMA(1, 0, At, B0); PG8_BAR; PG8_SCHED;
            PG8_STAGE(PG8_SB(0, 1), b2 + hstep, voffB);
            PG8_WAIT_V(6); PG8_BAR; PG8_MMA(1, 1, At, B1); PG8_BAR;
            PG8_LDB(B0, 1, 0); PG8_SCHED; PG8_LDA(At, 1, 0); PG8_STAGE(PG8_SA(0, 1), a2 + hstep, voffA);
            PG8_WAIT_L(8); PG8_BAR; PG8_WAIT_L(0); PG8_MMA(0, 0, At, B0); PG8_BAR; PG8_SCHED;
            PG8_LDB(B1, 1, 1); PG8_STAGE(PG8_SB(1, 0), b3, voffB);
            PG8_BAR; PG8_WAIT_L(0); PG8_MMA(0, 1, At, B1); PG8_BAR;
            PG8_LDA(At, 1, 1); PG8_STAGE(PG8_SA(1, 0), a3, voffA);
            PG8_BAR; PG8_WAIT_L(0); PG8_MMA(1, 0, At, B0); PG8_BAR; PG8_SCHED;
            PG8_STAGE(PG8_SB(1, 1), b3 + hstep, voffB);
            PG8_WAIT_V(6); PG8_BAR; PG8_MMA(1, 1, At, B1); PG8_BAR;
            }
        }
        if constexpr (ALIGN_EPI) { if (wr == 0) PG8_BAR; }
        E(acc, cur, wr, wc, fr, fq); S.done(cur);
        if (!has_next) break;
#pragma unroll
        for (int a = 0; a < 2; ++a)
#pragma unroll
            for (int b = 0; b < 2; ++b)
#pragma unroll
                for (int m = 0; m < 4; ++m)
#pragma unroll
                    for (int n = 0; n < 2; ++n) acc[a][b][m][n] = (f32x4){0.f, 0.f, 0.f, 0.f};
        cur = nxt; cA = nA; cB = nB; ++ui;
        if constexpr (ALIGN_EPI) { if (wr == 1) PG8_BAR; }
    }
    PG8_WAIT_V(0);
    if constexpr (!ALIGN_EPI) { if (wr == 0) PG8_BAR; }
    PG8_BAR;
#undef PG8_SA
#undef PG8_SB
#undef PG8_STAGE
#undef PG8_LDA
#undef PG8_LDB
#undef PG8_MMA
#undef PG8_WAIT_V
#undef PG8_WAIT_L
#undef PG8_BAR
#undef PG8_SCHED
}

struct EpiStore {
    static constexpr bool PERM = true;
    bf16_t* O; int ldc; int rowmask; unsigned char* T8;
    __device__ __forceinline__ void operator()(const f32x4 (&acc)[2][2][4][2], const Unit& u, int wr, int wc, int fr, int fq) const {
        const int row0 = (u.pm & rowmask) * BM + wr * 64 + fr, col0 = u.pn * BM + wc * 32 + 8 * fq;
        const bool side = T8 != nullptr && (u.pn == 1 || u.pn == 2);
#pragma unroll
        for (int ai = 0; ai < 2; ++ai)
#pragma unroll
            for (int m = 0; m < 4; ++m) { int row = row0 + ai * HALF + m * 16; asm volatile("" : "+v"(row)); bf16_t* rowp = O + (size_t)row * ldc + col0;
#pragma unroll
                for (int bj = 0; bj < 2; ++bj) { const f32x4 v0 = acc[ai][bj][m][0], v1 = acc[ai][bj][m][1];
                    u32x4 w; w.x = cvt_pk_bf16(v0[0], v0[1]); w.y = cvt_pk_bf16(v0[2], v0[3]); w.z = cvt_pk_bf16(v1[0], v1[1]); w.w = cvt_pk_bf16(v1[2], v1[3]);
                    *(u32x4*)(rowp + bj * HALF) = w;
                    if (side) { int q0 = __builtin_amdgcn_cvt_pk_fp8_f32(v0[0], v0[1], 0, false); q0 = __builtin_amdgcn_cvt_pk_fp8_f32(v0[2], v0[3], q0, true);
                        int q1 = __builtin_amdgcn_cvt_pk_fp8_f32(v1[0], v1[1], 0, false); q1 = __builtin_amdgcn_cvt_pk_fp8_f32(v1[2], v1[3], q1, true);
                        *(u32x2*)(T8 + (size_t)row * 512 + (col0 + bj * HALF - 256)) = (u32x2){(unsigned)q0, (unsigned)q1}; } } }
    }
};
__device__ __forceinline__ float sigmoidf_(float x) { return 1.f / (1.f + __expf(-x)); }
struct EpiGateMix {
    static constexpr bool PERM = true;
    const bf16_t* U; bf16_t* MX;
    __device__ __forceinline__ void operator()(const f32x4 (&acc)[2][2][4][2], const Unit& u, int wr, int wc, int fr, int fq) const {
        const int row0 = u.pm * BM + wr * 64 + fr, dcol = u.pn * 64 + wc * 16 + fq * 4;
#pragma unroll
        for (int ai = 0; ai < 2; ++ai)
#pragma unroll
            for (int m = 0; m < 4; ++m) { int row = row0 + ai * HALF + m * 16; asm volatile("" : "+v"(row)); const bf16_t* up = U + (size_t)row * 4096 + dcol;
                float o0 = 0.f, o1 = 0.f, o2 = 0.f, o3 = 0.f;
#pragma unroll
                for (int bj = 0; bj < 2; ++bj)
#pragma unroll
                    for (int n = 0; n < 2; ++n) { const u32x2 uu = *(const u32x2*)(up + (2 * bj + n) * 1024); const f32x4 a = acc[ai][bj][m][n];
                        o0 += sigmoidf_(a[0]) * bflo(uu.x); o1 += sigmoidf_(a[1]) * bfhi(uu.x); o2 += sigmoidf_(a[2]) * bflo(uu.y); o3 += sigmoidf_(a[3]) * bfhi(uu.y); }
                u32x2 w; w.x = cvt_pk_bf16(o0, o1); w.y = cvt_pk_bf16(o2, o3);
                *(u32x2*)(MX + (size_t)row * 1024 + dcol) = w; }
    }
};
struct EpiResid {
    static constexpr bool PERM = true;
    const float* xin; float* xout;
    __device__ __forceinline__ void operator()(const f32x4 (&acc)[2][2][4][2], const Unit& u, int wr, int wc, int fr, int fq) const {
        const int row0 = u.pm * BM + wr * 64 + fr, col0 = u.pn * BM + wc * 32 + 8 * fq;
#pragma unroll
        for (int ai = 0; ai < 2; ++ai)
#pragma unroll
            for (int m = 0; m < 4; ++m) { int row = row0 + ai * HALF + m * 16; asm volatile("" : "+v"(row)); const size_t ro = (size_t)row * 1024 + col0;
#pragma unroll
                for (int bj = 0; bj < 2; ++bj)
#pragma unroll
                    for (int n = 0; n < 2; ++n) { const size_t o = ro + bj * HALF + 4 * n; const f32x4 xv = *(const f32x4*)(xin + o); *(f32x4*)(xout + o) = xv + acc[ai][bj][m][n]; } }
    }
};
struct EpiSwiglu {
    static constexpr bool PERM = true;
    bf16_t* ACT;
    __device__ __forceinline__ void operator()(const f32x4 (&acc)[2][2][4][2], const Unit& u, int wr, int wc, int fr, int fq) const {
        const int row0 = u.pm * BM + wr * 64 + fr, col0 = (u.pn & 3) * 128 + wc * 32 + 8 * fq;
#pragma unroll
        for (int ai = 0; ai < 2; ++ai)
#pragma unroll
            for (int m = 0; m < 4; ++m) { int row = row0 + ai * HALF + m * 16; asm volatile("" : "+v"(row)); float v[8];
#pragma unroll
                for (int n = 0; n < 2; ++n)
#pragma unroll
                    for (int i = 0; i < 4; ++i) { const float a = acc[ai][0][m][n][i], b = acc[ai][1][m][n][i]; v[4 * n + i] = a * sigmoidf_(a) * b; }
                u32x4 w; w.x = cvt_pk_bf16(v[0], v[1]); w.y = cvt_pk_bf16(v[2], v[3]); w.z = cvt_pk_bf16(v[4], v[5]); w.w = cvt_pk_bf16(v[6], v[7]);
                *(u32x4*)(ACT + (size_t)row * 512 + col0) = w; }
    }
};
struct EpiDown {
    static constexpr bool PERM = true;
    bf16_t* YE; const float* roww;
    __device__ __forceinline__ void operator()(const f32x4 (&acc)[2][2][4][2], const Unit& u, int wr, int wc, int fr, int fq) const {
        const int row0 = u.pm * BM + wr * 64 + fr, col0 = (u.pn & 3) * BM + wc * 32 + 8 * fq;
#pragma unroll
        for (int ai = 0; ai < 2; ++ai)
#pragma unroll
            for (int m = 0; m < 4; ++m) { int row = row0 + ai * HALF + m * 16; asm volatile("" : "+v"(row)); const float s = roww[row]; bf16_t* rowp = YE + (size_t)row * 1024 + col0;
#pragma unroll
                for (int bj = 0; bj < 2; ++bj) { const f32x4 v0 = acc[ai][bj][m][0] * s, v1 = acc[ai][bj][m][1] * s;
                    u32x4 w; w.x = cvt_pk_bf16(v0[0], v0[1]); w.y = cvt_pk_bf16(v0[2], v0[3]); w.z = cvt_pk_bf16(v1[0], v1[1]); w.w = cvt_pk_bf16(v1[2], v1[3]);
                    *(u32x4*)(rowp + bj * HALF) = w; } }
    }
};
struct SchedUp {
    int G, c;
    __device__ __forceinline__ bool next(int i, Unit& u) const { const int L = i * G + c; if (L >= 1024) return false; const int n = L >> 8, pm = (L >> 2) & 63, pn = L & 3; u.pm = n * 64 + pm; u.pn = n * 4 + pn; return true; }
    __device__ __forceinline__ void a_ready(const Unit&) const {}
    __device__ __forceinline__ void done(const Unit&) const {}
};
struct SchedMoe {
    int G, c, nunits; const PG8_LAS int* tab;
    __device__ __forceinline__ bool next(int i, Unit& u) const { const int L = i * G + c; if (L >= nunits) return false; const int b = L >> 2, t = L & 3; const int e = __builtin_amdgcn_readfirstlane(tab[b]); u.pm = b; u.pn = e * 4 + t; return true; }
    __device__ __forceinline__ void a_ready(const Unit&) const {}
    __device__ __forceinline__ void done(const Unit&) const {}
};
}

#define XB_TMO      128
#define XB_XCNT(j)  (256  + 64 * (j))
#define XB_XSUB(j)  (1280 + 64 * (j))
#define XB_XGEN(j)  (2304 + 64 * (j))
#define XB_TOP      3328
#define XB_TOPGEN   3392
#define XCD_BAR_WORDS 3456
#define XB_SPIN_CAP (1u << 18)
__device__ __forceinline__ unsigned xb_ld(unsigned* p)              { return __hip_atomic_load(p, __ATOMIC_RELAXED, __HIP_MEMORY_SCOPE_AGENT); }
__device__ __forceinline__ unsigned xb_add(unsigned* p, unsigned v) { return __hip_atomic_fetch_add(p, v, __ATOMIC_RELAXED, __HIP_MEMORY_SCOPE_AGENT); }
__device__ __forceinline__ unsigned xb_xcc_id() { return (unsigned)__builtin_amdgcn_s_getreg((3 << 11) | 20) & 0xFu; }
#define XB_SPIN(cond, bar) do { unsigned _sp = 0; while (cond) { __builtin_amdgcn_s_sleep(1); \
    if ((++_sp & 255u) == 0u) { if (xb_ld(&(bar)[XB_TMO])) break; if (_sp > XB_SPIN_CAP) { atomicAdd(&(bar)[XB_TMO], 1u); break; } } } } while (0)
struct XcdBarrier { unsigned* bar; unsigned x; volatile LAS unsigned* st; };
__device__ __forceinline__ XcdBarrier xcd_barrier_post(unsigned* bar, volatile LAS unsigned* st) {
    XcdBarrier b; b.bar = bar; b.x = xb_xcc_id(); b.st = st;
    if (threadIdx.x == 0) (void)xb_add(&bar[XB_XCNT(b.x)], 1u);
    return b;
}
__device__ __forceinline__ void xcd_barrier_complete(unsigned* bar, unsigned x, unsigned& nloc, unsigned& nx) {
    const unsigned G = gridDim.x * gridDim.y * gridDim.z;
    unsigned sum, cnt, mine, sp = 0u;
    for (;;) {
        sum = 0u; cnt = 0u; mine = 0u;
#pragma unroll
        for (unsigned j = 0; j < 16; ++j) { const unsigned c = xb_ld(&bar[XB_XCNT(j)]); sum += c; cnt += (c > 0u) ? 1u : 0u; mine = (j == x) ? c : mine; }
        if (sum == G) break;
        __builtin_amdgcn_s_sleep(1);
        if ((++sp & 255u) == 0u) { if (xb_ld(&bar[XB_TMO])) break; if (sp > XB_SPIN_CAP) { atomicAdd(&bar[XB_TMO], 1u); break; } }
    }
    nloc = mine > 0u ? mine : 1u; nx = cnt > 0u ? cnt : 1u;
}
__device__ __forceinline__ void xcd_barrier(const XcdBarrier& b) {
    asm volatile("s_waitcnt vmcnt(0)" ::: "memory");
    __syncthreads();
    if (threadIdx.x == 0) {
        unsigned* bar = b.bar;
        __builtin_amdgcn_s_waitcnt(0);
        unsigned nloc = b.st[0], nx = b.st[1];
        if (nloc == 0u) { xcd_barrier_complete(bar, b.x, nloc, nx); b.st[0] = nloc; b.st[1] = nx; }
        const unsigned old = xb_add(&bar[XB_XSUB(b.x)], 1u);
        const unsigned gen = old / nloc;
        if (old + 1u == (gen + 1u) * nloc) {
            __builtin_amdgcn_fence(__ATOMIC_RELEASE, "agent");
            asm volatile("s_waitcnt vmcnt(0)" ::: "memory");
            const unsigned og = xb_add(&bar[XB_TOP], 1u);
            const unsigned tg = og / nx;
            if (og + 1u == (tg + 1u) * nx) xb_add(&bar[XB_TOPGEN], 1u);
            else XB_SPIN(xb_ld(&bar[XB_TOPGEN]) == tg, bar);
            __builtin_amdgcn_fence(__ATOMIC_ACQUIRE, "agent");
            xb_add(&bar[XB_XGEN(b.x)], 1u);
            asm volatile("s_waitcnt vmcnt(0)" ::: "memory");
        } else {
            XB_SPIN(xb_ld(&bar[XB_XGEN(b.x)]) == gen, bar);
            __builtin_amdgcn_fence(__ATOMIC_ACQUIRE, "agent");
            asm volatile("s_waitcnt vmcnt(0)" ::: "memory");
        }
    }
    __syncthreads();
}

struct Args {
    const float* in[23]; float* out; unsigned char* ws; int seg_lo, seg_hi;
};
typedef const __attribute__((address_space(4))) Args* ArgsP;
__device__ __forceinline__ ArgsP kargs() { unsigned long long v = (unsigned long long)__builtin_amdgcn_kernarg_segment_ptr(); asm volatile("" : "+s"(v)); return (ArgsP)v; }
struct Frame {
    LAS unsigned char* lds; unsigned char* ws; unsigned* ctl;
    int tid, lane, wave, G, bid;
};

template <class SC>
__device__ __forceinline__ void cvt_item(const float* W, int ldw, int K, bf16* WT, int k0, int n0, SC sc, LAS float* scr, int lane) {
    const int nl = lane & 31; const int scol = sc(n0 + nl);
#pragma unroll 8
    for (int i = 0; i < 32; ++i) { const int kk = 2 * i + (lane >> 5); scr[kk * 33 + nl] = scol >= 0 ? W[(size_t)(k0 + kk) * ldw + scol] : 0.f; }
    LDS_WAIT(); asm volatile("" ::: "memory");
    const int c = lane & 7;
#pragma unroll
    for (int j = 0; j < 4; ++j) { const int n = (lane >> 3) + 8 * j; const LAS float* s = scr + (8 * c) * 33 + n;
        u32x4 o; o.x = pk2(s[0 * 33], s[1 * 33]); o.y = pk2(s[2 * 33], s[3 * 33]); o.z = pk2(s[4 * 33], s[5 * 33]); o.w = pk2(s[6 * 33], s[7 * 33]);
        *(u32x4*)(WT + (size_t)(n0 + n) * K + k0 + 8 * c) = o; }
    LDS_WAIT(); asm volatile("" ::: "memory");
}
__device__ __forceinline__ int src_col_win(int dc) {
    if (dc < 932) return dc;
    if (dc < 936) return 1700 + (dc - 932);
    if (dc < 940) return 1704 + (dc - 936);
    if (dc < 960) return -1;
    if (dc < 1728) return 932 + (dc - 960);
    if (dc < 1984) return 1708 + (dc - 1728);
    if (dc < 3520) return 1964 + (dc - 1984);
    return -1;
}
__device__ __forceinline__ void phase_convert(Frame& F, int l) {
    ArgsP a = kargs();
    LAS float* scr = (LAS float*)(F.lds + F.wave * 16384);
    const int gw = F.bid * 8 + F.wave, NGW = F.G * 8;
    constexpr int I_WIN = 16 * 112, I_WBR = 4 * 4 * 32, I_WG = 16 * 128, I_WO = 16 * 32, I_W13 = 32 * 16 * 32, I_W2 = 32 * 8 * 32;
    constexpr int NIT = I_WIN + I_WBR + I_WG + I_WO + I_W13 + I_W2;
    const float* w_in = a->in[2] + (size_t)l * 1024 * CIN;
    const float* w_br = a->in[11] + (size_t)l * 4 * 256 * 1024;
    const float* w_gate = a->in[12] + (size_t)l * 1024 * 4096;
    const float* w_out = a->in[13] + (size_t)l * 1024 * 1024;
    const float* w1 = a->in[19] + (size_t)l * NE * 1024 * FE;
    const float* w3 = a->in[20] + (size_t)l * NE * 1024 * FE;
    const float* w2 = a->in[21] + (size_t)l * NE * FE * 1024;
    for (int it = gw; it < NIT; it += NGW) {
        int r = it;
        if (r < I_WIN) { const int kb = r / 112, nb = r % 112; cvt_item(w_in, CIN, 1024, (bf16*)(F.ws + WS_WIN), kb * 64, nb * 32, [](int n) { return src_col_win(n); }, scr, F.lane); continue; } r -= I_WIN;
        if (r < I_WBR) { const int n = r / 128, q = r % 128, kb = q / 32, nb = q % 32; cvt_item(w_br + (size_t)n * 256 * 1024, 1024, 256, (bf16*)(F.ws + WS_WBR) + (size_t)n * 1024 * 256, kb * 64, nb * 32, [](int c) { return c; }, scr, F.lane); continue; } r -= I_WBR;
        if (r < I_WG) { const int kb = r / 128, nb = r % 128;
            cvt_item(w_gate, 4096, 1024, (bf16*)(F.ws + WS_WGATE), kb * 64, nb * 32, [](int np) { const int pn = np >> 8, L = np & 255, bj = L >> 7, wc = (L >> 5) & 3, fq = (L >> 3) & 3, n = (L >> 2) & 1, i = L & 3;
                return (2 * bj + n) * 1024 + pn * 64 + wc * 16 + fq * 4 + i; }, scr, F.lane); continue; } r -= I_WG;
        if (r < I_WO) { const int kb = r / 32, nb = r % 32; cvt_item(w_out, 1024, 1024, (bf16*)(F.ws + WS_WOUT), kb * 64, nb * 32, [](int c) { return c; }, scr, F.lane); continue; } r -= I_WO;
        if (r < I_W13) { const int e = r / 512, q = r % 512, kb = q / 32, nb = q % 32;
            const int t = (nb * 32) >> 8, L0 = (nb * 32) & 255; const float* src = (L0 < 128 ? w1 : w3) + (size_t)e * 1024 * FE; const int cbase = t * 128 + (L0 & 127) - nb * 32;
            cvt_item(src, FE, 1024, (bf16*)(F.ws + WS_W13) + (size_t)e * 1024 * 1024, kb * 64, nb * 32, [cbase](int np) { return np + cbase; }, scr, F.lane); continue; } r -= I_W13;
        { const int e = r / 256, q = r % 256, kb = q / 32, nb = q % 32; cvt_item(w2 + (size_t)e * FE * 1024, 1024, FE, (bf16*)(F.ws + WS_W2) + (size_t)e * 1024 * FE, kb * 64, nb * 32, [](int c) { return c; }, scr, F.lane); }
    }
}
__device__ __forceinline__ void rms_row_to_bf16(const float* xrow, const float* g, bf16* orow, int lane) {
    const f32x4* xr = (const f32x4*)xrow + lane; const f32x4* gr = (const f32x4*)g + lane;
    f32x4 v[4]; float s = 0.f;
#pragma unroll
    for (int j = 0; j < 4; ++j) { v[j] = xr[64 * j]; s += (v[j].x * v[j].x + v[j].y * v[j].y) + (v[j].z * v[j].z + v[j].w * v[j].w); }
    const float rstd = rsqrtf(wave_sum(s) * (1.f / D) + RMS_EPS);
    unsigned long long* o8 = (unsigned long long*)orow + lane;
#pragma unroll
    for (int j = 0; j < 4; ++j) { const f32x4 gg = gr[64 * j]; o8[64 * j] = (unsigned long long)pk2(v[j].x * rstd * gg.x, v[j].y * rstd * gg.y) | ((unsigned long long)pk2(v[j].z * rstd * gg.z, v[j].w * rstd * gg.w) << 32); }
}

#ifndef MFMA_F32
#define MFMA_F32(av, bv, cv) __builtin_amdgcn_mfma_f32_16x16x4f32((av), (bv), (cv), 0, 0, 0)
#endif
__device__ __forceinline__ void phase_router(Frame& F, int l, const float* xcur) {
    ArgsP a = kargs();
    LAS float* xs = (LAS float*)F.lds;
    LAS float* wsm = xs + 64 * 65;
    LAS float* lg = wsm + 64 * 48;
    LAS float* rs = lg + 64 * 37;
    const float* g = a->in[14] + (size_t)l * D;
    const float* rgw = a->in[15] + (size_t)l * D * 4; const float* rgb = a->in[16] + (size_t)l * 4;
    const float* rew = a->in[17] + (size_t)l * D * 32; const float* reb = a->in[18] + (size_t)l * 32;
    bf16* h2 = (bf16*)(F.ws + WS_H);
    int* tok_e = (int*)(F.ws + WS_RT); float* tok_w = (float*)(F.ws + WS_RT + 131072);
    unsigned* cnt = F.ctl + CW_CNT + l * 32;
    const int r = F.tid & 63;
    const int li = F.lane & 15, kq = F.lane >> 4, rb = F.wave & 3, cset = F.wave >> 2;
    for (int blk = F.bid; blk < S / 64; blk += F.G) {
        const int row0 = blk * 64;
        f32x4 acc0 = {0.f, 0.f, 0.f, 0.f}, acc1 = {0.f, 0.f, 0.f, 0.f}; float ss = 0.f;
        for (int kc = 0; kc < 16; ++kc) {
            __syncthreads();
            { const int rr = F.tid >> 3, kk = (F.tid & 7) * 8; const float* xp = xcur + (size_t)(row0 + rr) * D + kc * 64 + kk; const float* gp = g + kc * 64 + kk;
              const f32x4 x0 = *(const f32x4*)xp, x1 = *(const f32x4*)(xp + 4), g0 = *(const f32x4*)gp, g1 = *(const f32x4*)(gp + 4);
              LAS float* d = xs + rr * 65 + kk; d[0] = x0.x * g0.x; d[1] = x0.y * g0.y; d[2] = x0.z * g0.z; d[3] = x0.w * g0.w; d[4] = x1.x * g1.x; d[5] = x1.y * g1.y; d[6] = x1.z * g1.z; d[7] = x1.w * g1.w;
              ss += (x0.x * x0.x + x0.y * x0.y) + (x0.z * x0.z + x0.w * x0.w) + (x1.x * x1.x + x1.y * x1.y) + (x1.z * x1.z + x1.w * x1.w); }
            { const int kk = F.tid >> 3, c0 = (F.tid & 7) * 6; const size_t kg = (size_t)(kc * 64 + kk);
#pragma unroll
              for (int i = 0; i < 6; ++i) { const int c = c0 + i; wsm[kk * 48 + c] = c < 4 ? rgw[kg * 4 + c] : (c < 36 ? rew[kg * 32 + (c - 4)] : 0.f); } }
            __syncthreads();
            if (cset == 0) {
#pragma unroll 4
                for (int k0 = 0; k0 < 64; k0 += 4) { const float av = xs[(rb * 16 + li) * 65 + k0 + kq];
                    acc0 = MFMA_F32(av, wsm[(k0 + kq) * 48 + li], acc0); acc1 = MFMA_F32(av, wsm[(k0 + kq) * 48 + 16 + li], acc1); }
            } else {
#pragma unroll 4
                for (int k0 = 0; k0 < 64; k0 += 4) { const float av = xs[(rb * 16 + li) * 65 + k0 + kq]; acc0 = MFMA_F32(av, wsm[(k0 + kq) * 48 + 32 + li], acc0); }
            }
        }
        ss += __shfl_xor(ss, 1); ss += __shfl_xor(ss, 2); ss += __shfl_xor(ss, 4);
        __syncthreads();
        if ((F.tid & 7) == 0) rs[F.tid >> 3] = rsqrtf(ss * (1.f / D) + RMS_EPS);
        __syncthreads();
#pragma unroll
        for (int i = 0; i < 4; ++i) { const int rw = rb * 16 + kq * 4 + i; const float rstd = rs[rw];
            if (cset == 0) { lg[rw * 37 + li] = acc0[i] * rstd; lg[rw * 37 + 16 + li] = acc1[i] * rstd; } else if (li < 4) lg[rw * 37 + 32 + li] = acc0[i] * rstd; }
        __syncthreads();
        if (F.tid < 64) {
            const LAS float* L = lg + F.tid * 37; const int tok = row0 + F.tid;
            float gl[4]; int gs = 0; float gm = -3.0e38f;
#pragma unroll
            for (int i = 0; i < 4; ++i) { gl[i] = L[i] + rgb[i]; if (gl[i] > gm) { gm = gl[i]; gs = i; } }
            float gsum = 0.f;
#pragma unroll
            for (int i = 0; i < 4; ++i) gsum += __expf(gl[i] - gm);
            const float ggate = 1.f / gsum;
            float v0 = -3.0e38f, v1 = -3.0e38f; int i0 = 0, i1 = 0;
            for (int i = 0; i < 8; ++i) { const float v = L[4 + gs * 8 + i] + reb[gs * 8 + i]; if (v > v0) { v1 = v0; i1 = i0; v0 = v; i0 = i; } else if (v > v1) { v1 = v; i1 = i; } }
            const float e1 = __expf(v1 - v0), den = 1.f / (1.f + e1);
            const int ea = gs * 8 + i0, eb = gs * 8 + i1;
            tok_e[tok * 2] = ea; tok_e[tok * 2 + 1] = eb; tok_w[tok * 2] = den * ggate; tok_w[tok * 2 + 1] = e1 * den * ggate;
            atomicAdd(&cnt[ea], 1u); atomicAdd(&cnt[eb], 1u);
        }
        for (int i = 0; i < 8; ++i) { const int rr = F.wave * 8 + i; const float rstd = rs[rr];
            const f32x4* xr = (const f32x4*)(xcur + (size_t)(row0 + rr) * D) + F.lane; const f32x4* gr = (const f32x4*)g + F.lane; unsigned long long* o8 = (unsigned long long*)(h2 + (size_t)(row0 + rr) * D) + F.lane;
#pragma unroll
            for (int j = 0; j < 4; ++j) { const f32x4 v = xr[64 * j], gg = gr[64 * j]; o8[64 * j] = (unsigned long long)pk2(v.x * rstd * gg.x, v.y * rstd * gg.y) | ((unsigned long long)pk2(v.z * rstd * gg.z, v.w * rstd * gg.w) << 32); } }
    }
    __syncthreads();
}
__device__ __forceinline__ void moe_table(Frame& F, int l) {
    LAS int* tab = (LAS int*)(F.lds + LDSCTL_OFF);
    if (F.tid == 0) { int bo = 0;
#pragma unroll 1
        for (int e = 0; e < NE; ++e) { const int c = (int)__hip_atomic_load(F.ctl + CW_CNT + l * 32 + e, __ATOMIC_RELAXED, __HIP_MEMORY_SCOPE_AGENT); const int nb = (c + 255) >> 8; tab[192 + e] = bo * 256; for (int b = 0; b < nb; ++b) tab[bo + b] = e; bo += nb; } tab[224] = bo; }
    __syncthreads();
}
__device__ __forceinline__ void phase_scatter(Frame& F, int l) {
    moe_table(F, l);
    LAS int* tab = (LAS int*)(F.lds + LDSCTL_OFF);
    const bf16* h2 = (const bf16*)(F.ws + WS_H); bf16* xs = (bf16*)(F.ws + WS_XS);
    const int* tok_e = (const int*)(F.ws + WS_RT); const float* tok_w = (const float*)(F.ws + WS_RT + 131072);
    int* slot_row = (int*)(F.ws + WS_RT + 262144); float* row_w = (float*)(F.ws + WS_RT + 393216);
    unsigned* fill = F.ctl + CW_FILL + l * 32;
    const int gw = F.bid * 8 + F.wave, NGW = F.G * 8;
    for (int b0 = gw * 16; b0 < S * 2; b0 += NGW * 16) {
        int row = 0;
        if (F.lane < 16) { const int sl = b0 + F.lane; const int e = tok_e[sl]; const unsigned p = atomicAdd(&fill[e], 1u); row = tab[192 + e] + (int)p; slot_row[sl] = row; row_w[row] = tok_w[sl]; }
#pragma unroll 4
        for (int k = 0; k < 16; ++k) { const int rk = __builtin_amdgcn_readlane(row, k); const int sl = b0 + k;
            const u32x4* src = (const u32x4*)(h2 + (size_t)(sl >> 1) * D) + F.lane; u32x4* dst = (u32x4*)(xs + (size_t)rk * D) + F.lane;
            dst[0] = src[0]; dst[64] = src[64]; }
    }
}
__device__ __forceinline__ void phase_combine(Frame& F, int l, float* xcur) {
    ArgsP a = kargs();
    const bf16* ye = (const bf16*)(F.ws + WS_YE); const int* slot_row = (const int*)(F.ws + WS_RT + 262144);
    const bool last = (l == NL - 1);
    const float* g = last ? a->in[22] : a->in[1] + (size_t)(l + 1) * D;
    bf16* h = (bf16*)(F.ws + WS_H);
    const int gw = F.bid * 8 + F.wave, NGW = F.G * 8;
    int srl = 0; { const int k = F.lane >> 1, m = gw + k * NGW; if (F.lane < 16 && m < S) srl = slot_row[2 * m + (F.lane & 1)]; }
    int kk_ = 0;
    for (int m = gw; m < S; m += NGW, ++kk_) {
        const int r0 = __shfl(srl, 2 * kk_), r1 = __shfl(srl, 2 * kk_ + 1);
        f32x4* xr = (f32x4*)(xcur + (size_t)m * D) + F.lane; const f32x4* gr = (const f32x4*)g + F.lane;
        const u32x2* y0 = (const u32x2*)(ye + (size_t)r0 * D) + F.lane; const u32x2* y1 = (const u32x2*)(ye + (size_t)r1 * D) + F.lane;
        f32x4 v[4]; float s = 0.f;
#pragma unroll
        for (int j = 0; j < 4; ++j) { const u32x2 p0 = y0[64 * j], p1 = y1[64 * j]; f32x4 x = xr[64 * j];
            x.x = (x.x + bflo(p0.x)) + bflo(p1.x); x.y = (x.y + bfhi(p0.x)) + bfhi(p1.x); x.z = (x.z + bflo(p0.y)) + bflo(p1.y); x.w = (x.w + bfhi(p0.y)) + bfhi(p1.y);
            v[j] = x; s += (x.x * x.x + x.y * x.y) + (x.z * x.z + x.w * x.w); }
        const float rstd = rsqrtf(wave_sum(s) * (1.f / D) + RMS_EPS);
        if (last) {
#pragma unroll
            for (int j = 0; j < 4; ++j) { const f32x4 gg = gr[64 * j]; xr[64 * j] = (f32x4){v[j].x * rstd * gg.x, v[j].y * rstd * gg.y, v[j].z * rstd * gg.z, v[j].w * rstd * gg.w}; }
        } else {
            unsigned long long* o8 = (unsigned long long*)(h + (size_t)m * D) + F.lane;
#pragma unroll
            for (int j = 0; j < 4; ++j) { const f32x4 gg = gr[64 * j]; xr[64 * j] = v[j];
                o8[64 * j] = (unsigned long long)pk2(v[j].x * rstd * gg.x, v[j].y * rstd * gg.y) | ((unsigned long long)pk2(v[j].z * rstd * gg.z, v[j].w * rstd * gg.w) << 32); }
        }
    }
}


typedef short v4i16_t __attribute__((ext_vector_type(4)));
__device__ __forceinline__ s16x4 ds_tr16(const LAS unsigned char* p) { return __builtin_bit_cast(s16x4, __builtin_amdgcn_ds_read_tr16_b64_v4i16((LAS v4i16_t*)p)); }
template <int MODE>
__device__ __forceinline__ void attn_phase(Frame& F, int l) {
    ArgsP a = kargs();
    constexpr int NS = MODE ? 2 : 1;
    const bf16* P = (const bf16*)(F.ws + WS_PU);
    bf16* Y = (bf16*)(F.ws + WS_Y) + (size_t)(MODE ? 3 : 2) * S * 256;
    const int colQ = MODE ? C_QD : C_QC, colK = MODE ? C_KD : C_KC, colV = MODE ? C_VD : C_VC;
    const float sc2 = (MODE ? 0.17677669529663687f : 0.125f) * 1.4426950408889634f;
    LAS unsigned char* Kb = F.lds; LAS unsigned char* Vb = F.lds + 16384; LAS float* btab = (LAS float*)(F.lds + 32768);
    const int lane = F.lane, w = F.wave, r = lane & 31, hh = lane >> 5;
    for (int u = F.bid; u < 256; u += F.G) {
        const int head = u & 3, ug = u >> 2;
        int qrow, cw, lo_w, T0, T1;
        if (MODE) { qrow = ug * 256 + w * 32; cw = ug * 4 + (w >> 1); lo_w = 0; T0 = 0; T1 = ug * 4 + 3; }
        else { cw = ug * 4 + (w >> 1); qrow = cw * 64 + (w & 1) * 32; lo_w = cw - 8 < 0 ? 0 : cw - 8; T0 = ug * 4 - 8 < 0 ? 0 : ug * 4 - 8; T1 = ug * 4 + 3; }
        if (!MODE) { __syncthreads(); if (F.tid < 192) btab[F.tid] = a->in[8][(size_t)(l * 4 + head) * 192 + F.tid] * 1.4426950408889634f; }
        bf16x8 Qf[4];
#pragma unroll
        for (int kk = 0; kk < 4; ++kk) Qf[kk] = *(const bf16x8*)(P + (size_t)(qrow + r) * PW + colQ + head * 64 + kk * 16 + 8 * hh);
        f32x16 O[NS][2]; float m[NS], lsum[NS];
#pragma unroll
        for (int s = 0; s < NS; ++s) { m[s] = -1e30f; lsum[s] = 0.f;
#pragma unroll
            for (int d = 0; d < 2; ++d)
#pragma unroll
                for (int i = 0; i < 16; ++i) O[s][d][i] = 0.f; }
        const int srow = F.tid >> 3, sch = F.tid & 7;
        const bf16* gK = P + (size_t)srow * PW + colK + head * 64 + sch * 8; const bf16* gV = P + (size_t)srow * PW + colV + head * 64 + sch * 8;
        const int kwoff = srow * 128 + ((sch ^ (srow & 7)) << 4), vwoff = srow * 128 + sch * 16;
        u32x4 kreg = *(const u32x4*)(gK + (size_t)T0 * 64 * PW), vreg = *(const u32x4*)(gV + (size_t)T0 * 64 * PW);
        __syncthreads();
        *(LAS u32x4*)(Kb + kwoff) = kreg; *(LAS u32x4*)(Vb + vwoff) = vreg;
        __syncthreads();
        for (int j = T0; j <= T1; ++j) {
            const int buf = (j - T0) & 1;
            if (j < T1) { kreg = *(const u32x4*)(gK + (size_t)(j + 1) * 64 * PW); vreg = *(const u32x4*)(gV + (size_t)(j + 1) * 64 * PW); }
            if (j >= lo_w && j <= cw) {
                const LAS unsigned char* Kt = Kb + buf * 8192; const LAS unsigned char* Vt = Vb + buf * 8192;
                bf16x8 pf[NS][4];
#pragma unroll
                for (int s = 0; s < NS; ++s) {
                    f32x16 Sq[2];
#pragma unroll
                    for (int kb = 0; kb < 2; ++kb) {
#pragma unroll
                        for (int i = 0; i < 16; ++i) Sq[kb][i] = 0.f;
#pragma unroll
                        for (int k2 = 0; k2 < (MODE ? 2 : 4); ++k2) { const int kk = MODE ? 2 * s + k2 : k2; const int row = kb * 32 + r;
                            const bf16x8 kf = *(const LAS bf16x8*)(Kt + row * 128 + (((kk * 2 + hh) ^ (row & 7)) << 4));
                            Sq[kb] = __builtin_amdgcn_mfma_f32_32x32x16_bf16(kf, Qf[kk], Sq[kb], 0, 0, 0); }
                    }
                    float mx = -1e30f;
                    if (!MODE) {
                        const int dj = cw - j;
                        if (dj >= 3) { const float bc = btab[191];
#pragma unroll
                            for (int kb = 0; kb < 2; ++kb)
#pragma unroll
                                for (int i = 0; i < 16; ++i) { const float t = Sq[kb][i] * sc2 + bc; Sq[kb][i] = t; mx = fmaxf(mx, t); } }
                        else { const int base = dj * 64 + (w & 1) * 32 + r - 4 * hh + 63;
#pragma unroll
                            for (int kb = 0; kb < 2; ++kb)
#pragma unroll
                                for (int i = 0; i < 16; ++i) { int rid = base - (kb * 32 + (i & 3) + 8 * (i >> 2)); rid = rid < 0 ? 0 : (rid > 191 ? 191 : rid);
                                    const float t = Sq[kb][i] * sc2 + btab[rid]; Sq[kb][i] = t; mx = fmaxf(mx, t); } }
                    } else {
#pragma unroll
                        for (int kb = 0; kb < 2; ++kb)
#pragma unroll
                            for (int i = 0; i < 16; ++i) { const float t = Sq[kb][i] * sc2; Sq[kb][i] = t; mx = fmaxf(mx, t); }
                    }
                    mx = fmaxf(mx, __shfl_xor(mx, 32));
                    const float mn = fmaxf(m[s], mx), alpha = __builtin_amdgcn_exp2f(m[s] - mn); m[s] = mn;
                    float rs = 0.f;
#pragma unroll
                    for (int kb = 0; kb < 2; ++kb)
#pragma unroll
                        for (int i = 0; i < 16; ++i) { const float p = __builtin_amdgcn_exp2f(Sq[kb][i] - mn); Sq[kb][i] = p; rs += p; }
                    lsum[s] = lsum[s] * alpha + rs;
#pragma unroll
                    for (int d = 0; d < 2; ++d)
#pragma unroll
                        for (int i = 0; i < 16; ++i) O[s][d][i] *= alpha;
#pragma unroll
                    for (int kb = 0; kb < 2; ++kb)
#pragma unroll
                        for (int ss = 0; ss < 2; ++ss) { u32x4 pw;
                            pw.x = pg8::cvt_pk_bf16(Sq[kb][8 * ss + 0], Sq[kb][8 * ss + 1]); pw.y = pg8::cvt_pk_bf16(Sq[kb][8 * ss + 2], Sq[kb][8 * ss + 3]);
                            pw.z = pg8::cvt_pk_bf16(Sq[kb][8 * ss + 4], Sq[kb][8 * ss + 5]); pw.w = pg8::cvt_pk_bf16(Sq[kb][8 * ss + 6], Sq[kb][8 * ss + 7]);
                            pf[s][kb * 2 + ss] = __builtin_bit_cast(bf16x8, pw); }
                    __builtin_amdgcn_sched_barrier(0);
                }
                const int li = lane & 15, lg = lane >> 4;
                const LAS unsigned char* vbase = Vt + (4 * (lg >> 1) + (li >> 2)) * 128 + (16 * (lg & 1) + 4 * (li & 3)) * 2;
#pragma unroll
                for (int d = 0; d < 2; ++d)
#pragma unroll
                    for (int st = 0; st < 4; ++st) {
                        const s16x4 v0 = ds_tr16(vbase + (st * 16) * 128 + d * 64), v1 = ds_tr16(vbase + (st * 16 + 8) * 128 + d * 64);
                        const bf16x8 vf = (bf16x8){v0[0], v0[1], v0[2], v0[3], v1[0], v1[1], v1[2], v1[3]};
#pragma unroll
                        for (int s = 0; s < NS; ++s) O[s][d] = __builtin_amdgcn_mfma_f32_32x32x16_bf16(vf, pf[s][st], O[s][d], 0, 0, 0);
                        if (st & 1) __builtin_amdgcn_sched_barrier(0);
                    }
            }
            if (j < T1) { *(LAS u32x4*)(Kb + (buf ^ 1) * 8192 + kwoff) = kreg; *(LAS u32x4*)(Vb + (buf ^ 1) * 8192 + vwoff) = vreg; }
            __syncthreads();
        }
        float inv[NS];
#pragma unroll
        for (int s = 0; s < NS; ++s) { const float lt = lsum[s] + __shfl_xor(lsum[s], 32); inv[s] = 1.f / lt; }
        bf16* yrow = Y + (size_t)(qrow + r) * 256 + head * 64 + 4 * hh;
        if (MODE) {
            const float* lp = a->in[9] + (size_t)l * 128 + (lane & 31); float s1 = (lane < 32) ? lp[0] * lp[32] : 0.f, s2 = (lane < 32) ? lp[64] * lp[96] : 0.f;
            s1 = wave_sum(s1); s2 = wave_sum(s2);
            const float lam_init = 0.8f - 0.6f * __expf(-0.3f * (float)l), lam = __expf(s1) - __expf(s2) + lam_init;
            const float* gn = a->in[10] + (size_t)l * 256 + head * 64 + 4 * hh;
            float ss = 0.f;
#pragma unroll
            for (int d = 0; d < 2; ++d)
#pragma unroll
                for (int i = 0; i < 16; ++i) { const float o = O[0][d][i] * inv[0] - lam * (O[NS - 1][d][i] * inv[NS - 1]); O[0][d][i] = o; ss += o * o; }
            ss += __shfl_xor(ss, 32);
            const float rstd = rsqrtf(ss * (1.f / 64.f) + RMS_EPS) * (1.f - lam_init);
#pragma unroll
            for (int d = 0; d < 2; ++d)
#pragma unroll
                for (int g = 0; g < 4; ++g) { const f32x4 gg = *(const f32x4*)(gn + d * 32 + 8 * g); u32x2 o2;
                    o2.x = pk2(O[0][d][4 * g + 0] * rstd * gg.x, O[0][d][4 * g + 1] * rstd * gg.y); o2.y = pk2(O[0][d][4 * g + 2] * rstd * gg.z, O[0][d][4 * g + 3] * rstd * gg.w);
                    *(u32x2*)(yrow + d * 32 + 8 * g) = o2; }
        } else {
#pragma unroll
            for (int d = 0; d < 2; ++d)
#pragma unroll
                for (int g = 0; g < 4; ++g) { u32x2 o2;
                    o2.x = pk2(O[0][d][4 * g + 0] * inv[0], O[0][d][4 * g + 1] * inv[0]); o2.y = pk2(O[0][d][4 * g + 2] * inv[0], O[0][d][4 * g + 3] * inv[0]);
                    *(u32x2*)(yrow + d * 32 + 8 * g) = o2; }
        }
    }
    __syncthreads();
}


__device__ __forceinline__ float vmax3_(float a, float b, float c) { float r; asm("v_max3_f32 %0, %1, %2, %3" : "=v"(r) : "v"(a), "v"(b), "v"(c)); return r; }
__device__ __forceinline__ void attnD_phase(Frame& F, int l) {
    ArgsP a = kargs();
    const bf16* P = (const bf16*)(F.ws + WS_PU);
    bf16* Y = (bf16*)(F.ws + WS_Y) + (size_t)3 * S * 256;
    const float sc2 = 0.17677669529663687f * 1.4426950408889634f;
    const int lane = F.lane, w = F.wave, r = lane & 31, hh = lane >> 5, rw = w & 3, ksel = w >> 2;
    const int srow = F.tid >> 3, sch = F.tid & 7;
    const int kwoff = srow * 128 + ((sch ^ (srow & 7)) << 4), vwoff = srow * 128 + sch * 16;
#pragma unroll 1
    for (int pr = F.bid; pr < 256; pr += F.G) {
        const int head = pr & 3, bp = pr >> 2;
#pragma unroll 1
        for (int rep = 0; rep < 2; ++rep) {
            const int b = rep ? 127 - bp : bp;
            const int qrow = b * 128 + rw * 32, cw = 2 * b + (rw >> 1);
            bf16x8 Qf[4];
#pragma unroll
            for (int kk = 0; kk < 4; ++kk) Qf[kk] = *(const bf16x8*)(P + (size_t)(qrow + r) * PW + C_QD + head * 64 + kk * 16 + 8 * hh);
            f32x16 O[2][2]; float m[2], lsum[2];
#pragma unroll
            for (int s2 = 0; s2 < 2; ++s2) { m[s2] = -1e30f; lsum[s2] = 0.f;
#pragma unroll
                for (int d = 0; d < 2; ++d)
#pragma unroll
                    for (int i = 0; i < 16; ++i) O[s2][d][i] = 0.f; }
            const bf16* gK = P + (size_t)srow * PW + C_KD + head * 64 + sch * 8; const bf16* gV = P + (size_t)srow * PW + C_VD + head * 64 + sch * 8;
            u32x4 kr0 = *(const u32x4*)gK, kr1 = *(const u32x4*)(gK + (size_t)64 * PW), vr0 = *(const u32x4*)gV, vr1 = *(const u32x4*)(gV + (size_t)64 * PW);
            __syncthreads();
            *(LAS u32x4*)(F.lds + kwoff) = kr0; *(LAS u32x4*)(F.lds + 8192 + kwoff) = kr1; *(LAS u32x4*)(F.lds + 16384 + vwoff) = vr0; *(LAS u32x4*)(F.lds + 24576 + vwoff) = vr1;
            __syncthreads();
#pragma unroll 1
            for (int i = 0; i <= b; ++i) {
                const int buf = i & 1, j = 2 * i + ksel;
                if (i < b) { const size_t go = (size_t)(2 * i + 2) * 64 * PW; kr0 = *(const u32x4*)(gK + go); kr1 = *(const u32x4*)(gK + go + (size_t)64 * PW); vr0 = *(const u32x4*)(gV + go); vr1 = *(const u32x4*)(gV + go + (size_t)64 * PW); }
                if (j <= cw) {
                    const LAS unsigned char* Kt = F.lds + buf * 32768 + ksel * 8192; const LAS unsigned char* Vt = F.lds + buf * 32768 + 16384 + ksel * 8192;
                    bf16x8 pf[2][4];
#pragma unroll
                    for (int s2 = 0; s2 < 2; ++s2) {
                        f32x16 Sq[2];
#pragma unroll
                        for (int kb = 0; kb < 2; ++kb) {
#pragma unroll
                            for (int ii = 0; ii < 16; ++ii) Sq[kb][ii] = 0.f;
#pragma unroll
                            for (int k2 = 0; k2 < 2; ++k2) { const int kk = 2 * s2 + k2; const int row = kb * 32 + r;
                                const bf16x8 kf = *(const LAS bf16x8*)(Kt + row * 128 + (((kk * 2 + hh) ^ (row & 7)) << 4));
                                Sq[kb] = __builtin_amdgcn_mfma_f32_32x32x16_bf16(kf, Qf[kk], Sq[kb], 0, 0, 0); }
                        }
                        __builtin_amdgcn_sched_barrier(0);
                        asm volatile("s_nop 15\n\ts_nop 3" ::: "memory");
                        __builtin_amdgcn_sched_barrier(0);
                        float mx = vmax3_(Sq[0][0], Sq[0][1], Sq[0][2]);
#pragma unroll
                        for (int ii = 3; ii < 15; ii += 2) mx = vmax3_(mx, Sq[0][ii], Sq[0][ii + 1]);
                        mx = vmax3_(mx, Sq[0][15], Sq[1][0]);
#pragma unroll
                        for (int ii = 1; ii < 15; ii += 2) mx = vmax3_(mx, Sq[1][ii], Sq[1][ii + 1]);
                        mx = fmaxf(mx, Sq[1][15]);
                        mx = fmaxf(mx, __shfl_xor(mx, 32)) * sc2;
                        if (__any(mx > m[s2] + 8.f)) { const float mn = fmaxf(m[s2], mx), al = __builtin_amdgcn_exp2f(m[s2] - mn); m[s2] = mn; lsum[s2] *= al;
#pragma unroll
                            for (int d = 0; d < 2; ++d)
#pragma unroll
                                for (int ii = 0; ii < 16; ++ii) O[s2][d][ii] *= al; }
                        const float negm = -m[s2]; float rs = 0.f;
#pragma unroll
                        for (int kb = 0; kb < 2; ++kb)
#pragma unroll
                            for (int ii = 0; ii < 16; ++ii) { const float p = __builtin_amdgcn_exp2f(fmaf(Sq[kb][ii], sc2, negm)); Sq[kb][ii] = p; rs += p; }
                        lsum[s2] += rs;
#pragma unroll
                        for (int kb = 0; kb < 2; ++kb)
#pragma unroll
                            for (int ss = 0; ss < 2; ++ss) { u32x4 pw;
                                pw.x = pg8::cvt_pk_bf16(Sq[kb][8 * ss + 0], Sq[kb][8 * ss + 1]); pw.y = pg8::cvt_pk_bf16(Sq[kb][8 * ss + 2], Sq[kb][8 * ss + 3]);
                                pw.z = pg8::cvt_pk_bf16(Sq[kb][8 * ss + 4], Sq[kb][8 * ss + 5]); pw.w = pg8::cvt_pk_bf16(Sq[kb][8 * ss + 6], Sq[kb][8 * ss + 7]);
                                pf[s2][kb * 2 + ss] = __builtin_bit_cast(bf16x8, pw); }
                        __builtin_amdgcn_sched_barrier(0);
                    }
                    const int li = lane & 15, lg = lane >> 4;
                    const LAS unsigned char* vbase = Vt + (4 * (lg >> 1) + (li >> 2)) * 128 + (16 * (lg & 1) + 4 * (li & 3)) * 2;
#pragma unroll
                    for (int d = 0; d < 2; ++d)
#pragma unroll
                        for (int st = 0; st < 4; ++st) {
                            const s16x4 v0 = ds_tr16(vbase + (st * 16) * 128 + d * 64), v1 = ds_tr16(vbase + (st * 16 + 8) * 128 + d * 64);
                            const bf16x8 vf = (bf16x8){v0[0], v0[1], v0[2], v0[3], v1[0], v1[1], v1[2], v1[3]};
                            O[0][d] = __builtin_amdgcn_mfma_f32_32x32x16_bf16(vf, pf[0][st], O[0][d], 0, 0, 0);
                            O[1][d] = __builtin_amdgcn_mfma_f32_32x32x16_bf16(vf, pf[1][st], O[1][d], 0, 0, 0);
                            if (st & 1) __builtin_amdgcn_sched_barrier(0);
                        }
                }
                if (i < b) { LAS unsigned char* nb = F.lds + (buf ^ 1) * 32768; *(LAS u32x4*)(nb + kwoff) = kr0; *(LAS u32x4*)(nb + 8192 + kwoff) = kr1; *(LAS u32x4*)(nb + 16384 + vwoff) = vr0; *(LAS u32x4*)(nb + 24576 + vwoff) = vr1; }
                __syncthreads();
            }
            LAS float* xo = (LAS float*)F.lds + rw * 4096; LAS float* xm = (LAS float*)(F.lds + 65536) + rw * 256;
            if (ksel) {
#pragma unroll
                for (int s2 = 0; s2 < 2; ++s2) { xm[s2 * 64 + lane] = m[s2]; xm[128 + s2 * 64 + lane] = lsum[s2];
#pragma unroll
                    for (int d = 0; d < 2; ++d)
#pragma unroll
                        for (int ii = 0; ii < 16; ++ii) xo[((s2 * 2 + d) * 16 + ii) * 64 + lane] = O[s2][d][ii]; }
            }
            __syncthreads();
            if (!ksel) {
                float inv[2];
#pragma unroll
                for (int s2 = 0; s2 < 2; ++s2) { const float mb = xm[s2 * 64 + lane], lb = xm[128 + s2 * 64 + lane]; const float mn = fmaxf(m[s2], mb), aa = __builtin_amdgcn_exp2f(m[s2] - mn), ab = __builtin_amdgcn_exp2f(mb - mn);
                    float lt = lsum[s2] * aa + lb * ab; lt += __shfl_xor(lt, 32); inv[s2] = 1.f / lt;
#pragma unroll
                    for (int d = 0; d < 2; ++d)
#pragma unroll
                        for (int ii = 0; ii < 16; ++ii) O[s2][d][ii] = (O[s2][d][ii] * aa + xo[((s2 * 2 + d) * 16 + ii) * 64 + lane] * ab) * inv[s2]; }
                const float* lp = a->in[9] + (size_t)l * 128 + (lane & 31); float s1 = (lane < 32) ? lp[0] * lp[32] : 0.f, s3 = (lane < 32) ? lp[64] * lp[96] : 0.f;
                s1 = wave_sum(s1); s3 = wave_sum(s3);
                const float lam_init = 0.8f - 0.6f * __expf(-0.3f * (float)l), lam = __expf(s1) - __expf(s3) + lam_init;
                const float* gn = a->in[10] + (size_t)l * 256 + head * 64 + 4 * hh;
                float ss = 0.f;
#pragma unroll
                for (int d = 0; d < 2; ++d)
#pragma unroll
                    for (int ii = 0; ii < 16; ++ii) { const float o = O[0][d][ii] - lam * O[1][d][ii]; O[0][d][ii] = o; ss += o * o; }
                ss += __shfl_xor(ss, 32);
                const float rstd = rsqrtf(ss * (1.f / 64.f) + RMS_EPS) * (1.f - lam_init);
                bf16* yrow = Y + (size_t)(qrow + r) * 256 + head * 64 + 4 * hh;
#pragma unroll
                for (int d = 0; d < 2; ++d)
#pragma unroll
                    for (int g = 0; g < 4; ++g) { const f32x4 gg = *(const f32x4*)(gn + d * 32 + 8 * g); u32x2 o2;
                        o2.x = pk2(O[0][d][4 * g + 0] * rstd * gg.x, O[0][d][4 * g + 1] * rstd * gg.y); o2.y = pk2(O[0][d][4 * g + 2] * rstd * gg.z, O[0][d][4 * g + 3] * rstd * gg.w);
                        *(u32x2*)(yrow + d * 32 + 8 * g) = o2; }
            }
        }
    }
    __syncthreads();
}

using pg8::sigmoidf_;
constexpr int ML_CE = 0, ML_G = 1024, ML_SC = 2048;
__device__ __forceinline__ float logsigmoidf_(float f) { return f >= 0.f ? -log1pf(__expf(-f)) : f - log1pf(__expf(f)); }
__device__ __forceinline__ void ml_gates(const bf16* P, const float* ib, const float* fb, int c, int h, int lane, float& a_t, float& i_t) {
    const bf16* pr = P + (size_t)(c * 64 + lane) * PW;
    i_t = bf2f(pr[C_IB + h]) + ib[h]; a_t = logsigmoidf_(bf2f(pr[C_FB + h]) + fb[h]);
}
__device__ __forceinline__ float wave_scan_add(float v, int lane) {
#pragma unroll
    for (int o = 1; o < 64; o <<= 1) { const float u = __shfl_up(v, o); if (lane >= o) v += u; }
    return v;
}
__device__ __forceinline__ float wave_scan_max(float v, int lane) {
#pragma unroll
    for (int o = 1; o < 64; o <<= 1) { const float u = __shfl_up(v, o); if (lane >= o) v = fmaxf(v, u); }
    return v;
}
__device__ __forceinline__ void ml_phase1(Frame& F, int l) {
    ArgsP a = kargs(); const bf16* P = (const bf16*)(F.ws + WS_PU); float* mls = (float*)(F.ws + WS_MLS);
    const float* ib = a->in[5] + l * 4; const float* fb = a->in[6] + l * 4;
    for (int u = F.bid * 8 + F.wave; u < NCH * 4; u += F.G * 8) {
        const int c = u >> 2, h = u & 3; float at, it; ml_gates(P, ib, fb, c, h, F.lane, at, it);
        const float cum = wave_scan_add(at, F.lane), ce = __shfl(cum, 63), g = ce - cum + it, G = wave_max(g);
        if (F.lane == 0) { mls[ML_CE + u] = ce; mls[ML_G + u] = G; }
    }
}
__device__ __forceinline__ void ml_mscan(Frame& F, LAS float* mt, LAS float* tmp) {
    const float* mls = (const float*)(F.ws + WS_MLS);
    __syncthreads();
    for (int i = F.tid; i < 1024; i += 512) { tmp[i] = mls[ML_CE + i]; tmp[1024 + i] = mls[ML_G + i]; }
    __syncthreads();
    if (F.tid < 4) { float m = 0.f;
#pragma unroll 1
        for (int c = 0; c < NCH; ++c) { mt[F.tid * 257 + c] = m; m = fmaxf(tmp[c * 4 + F.tid] + m, tmp[1024 + c * 4 + F.tid]); }
        mt[F.tid * 257 + 256] = m; }
    __syncthreads();
}
__device__ __forceinline__ void ml_stage_conv(const bf16* P, int col0, const float* cw, const float* cb, int row0, float sc, LAS float* dst, int tid) {
    const int t = tid >> 3, d0 = (tid & 7) * 8;
    float acc[8];
#pragma unroll
    for (int i = 0; i < 8; ++i) acc[i] = cb[d0 + i];
#pragma unroll
    for (int j = 0; j < 4; ++j) { const int r = row0 + t - 3 + j;
        if (r >= 0) { const u32x4 x = *(const u32x4*)(P + (size_t)r * PW + col0 + d0); const float* w = cw + j * 512 + d0;
            acc[0] += w[0] * bflo(x.x); acc[1] += w[1] * bfhi(x.x); acc[2] += w[2] * bflo(x.y); acc[3] += w[3] * bfhi(x.y);
            acc[4] += w[4] * bflo(x.z); acc[5] += w[5] * bfhi(x.z); acc[6] += w[6] * bflo(x.w); acc[7] += w[7] * bfhi(x.w); } }
#pragma unroll
    for (int i = 0; i < 8; ++i) dst[t * 65 + d0 + i] = acc[i] * sigmoidf_(acc[i]) * sc;
}
__device__ __forceinline__ void ml_stage_plain(const bf16* P, int col0, int row0, const LAS float* rs, LAS float* dst, int tid) {
    const int t = tid >> 3, d0 = (tid & 7) * 8; const float sc = rs ? rs[t] : 1.f;
    const u32x4 x = *(const u32x4*)(P + (size_t)(row0 + t) * PW + col0 + d0); LAS float* d = dst + t * 65 + d0;
    d[0] = bflo(x.x) * sc; d[1] = bfhi(x.x) * sc; d[2] = bflo(x.y) * sc; d[3] = bfhi(x.y) * sc; d[4] = bflo(x.z) * sc; d[5] = bfhi(x.z) * sc; d[6] = bflo(x.w) * sc; d[7] = bfhi(x.w) * sc;
}
__device__ __forceinline__ void ml_phase3(Frame& F, int l) {
    ArgsP a = kargs(); const bf16* P = (const bf16*)(F.ws + WS_PU); float* mls = (float*)(F.ws + WS_MLS);
    float* dC = (float*)(F.ws + WS_MLC); float* dn = (float*)(F.ws + WS_MLN);
    const float* ib = a->in[5] + l * 4; const float* fb = a->in[6] + l * 4; const float* cw = a->in[3] + (size_t)l * 2048; const float* cb = a->in[4] + (size_t)l * 512;
    LAS float* Kl = (LAS float*)F.lds; LAS float* Vl = Kl + 64 * 65; LAS float* srcL = Vl + 64 * 65; LAS float* mt = srcL + 64; LAS float* tmp = mt + 4 * 257 + 4;
    ml_mscan(F, mt, tmp);
    const int lane = F.lane, w = F.wave, li = lane & 15, kq = lane >> 4, bi = w >> 1, bj0 = (w & 1) * 2;
    for (int u = F.bid; u < NCH * 4; u += F.G) {
        const int c = u >> 2, h = u & 3; const float m0 = mt[h * 257 + c], m1 = mt[h * 257 + c + 1];
        __syncthreads();
        if (w == 0) { float at, it; ml_gates(P, ib, fb, c, h, lane, at, it); const float cum = wave_scan_add(at, lane), ce = __shfl(cum, 63);
            srcL[lane] = __expf(ce - cum + it - m1); if (lane == 0) mls[ML_SC + u] = __expf(ce + m0 - m1); }
        ml_stage_conv(P, C_KB + h * 64, cw + 256 + h * 64, cb + 256 + h * 64, c * 64, 0.125f, Kl, F.tid);
        __syncthreads();
        ml_stage_plain(P, C_VB + h * 64, c * 64, srcL, Vl, F.tid);
        __syncthreads();
        f32x4 acc0 = {0.f, 0.f, 0.f, 0.f}, acc1 = {0.f, 0.f, 0.f, 0.f};
#pragma unroll 4
        for (int k0 = 0; k0 < 64; k0 += 4) { const float av = Vl[(k0 + kq) * 65 + bi * 16 + li];
            acc0 = MFMA_F32(av, Kl[(k0 + kq) * 65 + bj0 * 16 + li], acc0); acc1 = MFMA_F32(av, Kl[(k0 + kq) * 65 + (bj0 + 1) * 16 + li], acc1); }
        float* o = dC + (size_t)u * 4096 + (bi * 16 + kq * 4) * 64 + li;
#pragma unroll
        for (int r = 0; r < 4; ++r) { o[r * 64 + bj0 * 16] = acc0[r]; o[r * 64 + (bj0 + 1) * 16] = acc1[r]; }
        if (F.tid < 64) { float sacc = 0.f; for (int s2 = 0; s2 < 64; ++s2) sacc += srcL[s2] * Kl[s2 * 65 + F.tid]; dn[(size_t)u * 64 + F.tid] = sacc; }
    }
    __syncthreads();
}
__device__ __forceinline__ void ml_phase4(Frame& F) {
    float* dC = (float*)(F.ws + WS_MLC); float* dn = (float*)(F.ws + WS_MLN); const float* sc = (const float*)(F.ws + WS_MLS) + ML_SC;
    float* base; size_t stride; int h;
    if (F.wave == 0) { const int e = F.bid * 64 + F.lane; if (e >= 16384) return; h = e >> 12; base = dC + (size_t)h * 4096 + (e & 4095); stride = 4 * 4096; }
    else if (F.wave == 1 && F.bid < 4) { h = F.bid; base = dn + (size_t)h * 64 + F.lane; stride = 4 * 64; }
    else return;
    float st = 0.f;
    for (int c0 = 0; c0 < NCH; c0 += 8) {
        float v[8], g[8];
#pragma unroll
        for (int i = 0; i < 8; ++i) { v[i] = base[(size_t)(c0 + i) * stride]; g[i] = sc[(c0 + i) * 4 + h]; }
#pragma unroll
        for (int i = 0; i < 8; ++i) { base[(size_t)(c0 + i) * stride] = st; st = g[i] * st + v[i]; }
    }
}
__device__ __forceinline__ void ml_phase5(Frame& F, int l) {
    ArgsP a = kargs(); const bf16* P = (const bf16*)(F.ws + WS_PU);
    const float* Cst = (const float*)(F.ws + WS_MLC); const float* nst = (const float*)(F.ws + WS_MLN);
    const float* ib = a->in[5] + l * 4; const float* fb = a->in[6] + l * 4; const float* cw = a->in[3] + (size_t)l * 2048; const float* cb = a->in[4] + (size_t)l * 512;
    const float* gn = a->in[7] + (size_t)l * 256;
    bf16* Y = (bf16*)(F.ws + WS_Y) + (size_t)1 * S * 256;
    LAS float* Ql = (LAS float*)F.lds; LAS float* Kl = Ql + 64 * 65; LAS float* Vl = Kl + 64 * 65; LAS float* Cl = Vl + 64 * 65; LAS float* Wl = Cl + 64 * 65;
    LAS float* cumL = Wl + 64 * 65; LAS float* bL = cumL + 64; LAS float* mtL = bL + 64; LAS float* inL = mtL + 64; LAS float* nL = inL + 64; LAS float* denL = nL + 64;
    LAS float* mt = denL + 64; LAS float* tmp = mt + 4 * 257 + 4;
    ml_mscan(F, mt, tmp);
    const int lane = F.lane, w = F.wave, li = lane & 15, kq = lane >> 4, bi = w >> 1, bj0 = (w & 1) * 2;
    for (int u = F.bid; u < NCH * 4; u += F.G) {
        const int c = u >> 2, h = u & 3; const float m0 = mt[h * 257 + c];
        __syncthreads();
        if (w == 0) { float at, it; ml_gates(P, ib, fb, c, h, lane, at, it); const float cum = wave_scan_add(at, lane);
            const float bb = it - cum, pm = wave_scan_max(bb, lane), mtt = fmaxf(cum + m0, cum + pm);
            cumL[lane] = cum; bL[lane] = bb; mtL[lane] = mtt; inL[lane] = __expf(cum + m0 - mtt); nL[lane] = nst[(size_t)u * 64 + lane]; }
        ml_stage_conv(P, C_QB + h * 64, cw + h * 64, cb + h * 64, c * 64, 1.f, Ql, F.tid);
        ml_stage_conv(P, C_KB + h * 64, cw + 256 + h * 64, cb + 256 + h * 64, c * 64, 0.125f, Kl, F.tid);
        ml_stage_plain(P, C_VB + h * 64, c * 64, nullptr, Vl, F.tid);
        { const int t = F.tid >> 3, d0 = (F.tid & 7) * 8; const f32x4 c0 = *(const f32x4*)(Cst + (size_t)u * 4096 + t * 64 + d0), c1 = *(const f32x4*)(Cst + (size_t)u * 4096 + t * 64 + d0 + 4);
          LAS float* d = Cl + t * 65 + d0; d[0] = c0.x; d[1] = c0.y; d[2] = c0.z; d[3] = c0.w; d[4] = c1.x; d[5] = c1.y; d[6] = c1.z; d[7] = c1.w; }
        __syncthreads();
        {
            f32x4 acc0 = {0.f, 0.f, 0.f, 0.f}, acc1 = {0.f, 0.f, 0.f, 0.f};
#pragma unroll 4
            for (int k0 = 0; k0 < 64; k0 += 4) { const float av = Ql[(bi * 16 + li) * 65 + k0 + kq];
                acc0 = MFMA_F32(av, Kl[(bj0 * 16 + li) * 65 + k0 + kq], acc0); acc1 = MFMA_F32(av, Kl[((bj0 + 1) * 16 + li) * 65 + k0 + kq], acc1); }
#pragma unroll
            for (int r = 0; r < 4; ++r) { const int t = bi * 16 + kq * 4 + r; const float ct = cumL[t] - mtL[t];
                { const int s2 = bj0 * 16 + li; Wl[t * 65 + s2] = (s2 <= t) ? __expf(ct + bL[s2]) * acc0[r] : 0.f; }
                { const int s2 = (bj0 + 1) * 16 + li; Wl[t * 65 + s2] = (s2 <= t) ? __expf(ct + bL[s2]) * acc1[r] : 0.f; } }
        }
        __syncthreads();
        if (F.tid < 64) { const int t = F.tid; float qn = 0.f, sw = 0.f;
            for (int k = 0; k < 64; ++k) { qn += Ql[t * 65 + k] * nL[k]; sw += Wl[t * 65 + k]; }
            const float den = inL[t] * qn + sw; denL[t] = 1.f / fmaxf(fabsf(den), __expf(-mtL[t])); }
        f32x4 acc0 = {0.f, 0.f, 0.f, 0.f}, acc1 = {0.f, 0.f, 0.f, 0.f};
#pragma unroll 4
        for (int k0 = 0; k0 < 64; k0 += 4) { const float av = Ql[(bi * 16 + li) * 65 + k0 + kq];
            acc0 = MFMA_F32(av, Cl[(bj0 * 16 + li) * 65 + k0 + kq], acc0); acc1 = MFMA_F32(av, Cl[((bj0 + 1) * 16 + li) * 65 + k0 + kq], acc1); }
#pragma unroll
        for (int r = 0; r < 4; ++r) { const float it = inL[bi * 16 + kq * 4 + r]; acc0[r] *= it; acc1[r] *= it; }
#pragma unroll 4
        for (int k0 = 0; k0 < 64; k0 += 4) { const float av = Wl[(bi * 16 + li) * 65 + k0 + kq];
            acc0 = MFMA_F32(av, Vl[(k0 + kq) * 65 + bj0 * 16 + li], acc0); acc1 = MFMA_F32(av, Vl[(k0 + kq) * 65 + (bj0 + 1) * 16 + li], acc1); }
        __syncthreads();
#pragma unroll
        for (int r = 0; r < 4; ++r) { const int t = bi * 16 + kq * 4 + r; const float dv = denL[t]; Wl[t * 65 + bj0 * 16 + li] = acc0[r] * dv; Wl[t * 65 + (bj0 + 1) * 16 + li] = acc1[r] * dv; }
        __syncthreads();
        { const int t = F.tid >> 3, d0 = (F.tid & 7) * 8; float hv[8], ss = 0.f;
#pragma unroll
          for (int i = 0; i < 8; ++i) { hv[i] = Wl[t * 65 + d0 + i]; ss += hv[i] * hv[i]; }
          ss += __shfl_xor(ss, 1); ss += __shfl_xor(ss, 2); ss += __shfl_xor(ss, 4);
          const float rstd = rsqrtf(ss * (1.f / 64.f) + RMS_EPS);
          const u32x4 ov = *(const u32x4*)(P + (size_t)(c * 64 + t) * PW + C_OB + h * 64 + d0); const float* g = gn + h * 64 + d0;
          const float o0 = sigmoidf_(bflo(ov.x)), o1 = sigmoidf_(bfhi(ov.x)), o2 = sigmoidf_(bflo(ov.y)), o3 = sigmoidf_(bfhi(ov.y)), o4 = sigmoidf_(bflo(ov.z)), o5 = sigmoidf_(bfhi(ov.z)), o6 = sigmoidf_(bflo(ov.w)), o7 = sigmoidf_(bfhi(ov.w));
          u32x4 y; y.x = pk2(o0 * hv[0] * rstd * g[0], o1 * hv[1] * rstd * g[1]); y.y = pk2(o2 * hv[2] * rstd * g[2], o3 * hv[3] * rstd * g[3]);
          y.z = pk2(o4 * hv[4] * rstd * g[4], o5 * hv[5] * rstd * g[5]); y.w = pk2(o6 * hv[6] * rstd * g[6], o7 * hv[7] * rstd * g[7]);
          *(u32x4*)(Y + (size_t)(c * 64 + t) * 256 + h * 64 + d0) = y; }
    }
    __syncthreads();
}


constexpr int DSA_CAP = 2048, DSA_TRIG = 1024, QHP = 260;
__device__ __forceinline__ u32x2 ld_list(const u32x2* p) { const unsigned long long v = __hip_atomic_load((const unsigned long long*)p, __ATOMIC_RELAXED, __HIP_MEMORY_SCOPE_AGENT); return (u32x2){(unsigned)v, (unsigned)(v >> 32)}; }

__device__ __forceinline__ unsigned wave_prefix_incl(unsigned v) {
    v += (unsigned)__builtin_amdgcn_update_dpp(0, (int)v, 0x111, 0xf, 0xf, false);
    v += (unsigned)__builtin_amdgcn_update_dpp(0, (int)v, 0x112, 0xf, 0xf, false);
    v += (unsigned)__builtin_amdgcn_update_dpp(0, (int)v, 0x114, 0xf, 0xf, false);
    v += (unsigned)__builtin_amdgcn_update_dpp(0, (int)v, 0x118, 0xf, 0xf, false);
    v += (unsigned)__builtin_amdgcn_update_dpp(0, (int)v, 0x142, 0xa, 0xf, false);
    v += (unsigned)__builtin_amdgcn_update_dpp(0, (int)v, 0x143, 0xc, 0xf, false);
    return v;
}
__device__ __forceinline__ unsigned sortable(float v) { const unsigned b = __builtin_bit_cast(unsigned, v); return (b & 0x80000000u) ? ~b : (b | 0x80000000u); }
__device__ __forceinline__ unsigned lanes_below(unsigned long long m) { return __builtin_amdgcn_mbcnt_hi((unsigned)(m >> 32), __builtin_amdgcn_mbcnt_lo((unsigned)m, 0u)); }

__device__ __forceinline__ unsigned dsa_bin(unsigned sv) {
    const bool pos = (sv >> 31) != 0u; const unsigned mag = (pos ? sv : ~sv) & 0x7fffffffu; int t = (int)(mag >> 19) - 1904; t = t < 0 ? 0 : (t > 255 ? 255 : t);
    return pos ? 256u + (unsigned)t : 255u - (unsigned)t;
}
__device__ __forceinline__ unsigned dsa_bin_T(unsigned B) {
    if (B >= 257u) return (0x80000000u | ((1904u + (B - 256u)) << 19)) - 1u;
    if (B == 256u) return 0x7fffffffu;
    if (B == 0u) return 0u;
    const unsigned t = 255u - B, mag = ((1905u + t) << 19) - 1u; return (0x7fffffffu - mag) - 1u;
}
__device__ __forceinline__ unsigned dsa_hist_T(const LAS unsigned* qh, int lane) {
    const int grp = 63 - lane;
    const u32x4 h = *(const LAS u32x4*)(qh + 4 * grp);
    const unsigned c[8] = {h.x & 0xffffu, h.x >> 16, h.y & 0xffffu, h.y >> 16, h.z & 0xffffu, h.z >> 16, h.w & 0xffffu, h.w >> 16};
    unsigned tl = 0u;
#pragma unroll
    for (int i = 0; i < 8; ++i) tl += c[i];
    const unsigned suf = wave_prefix_incl(tl);
    const unsigned above = suf - tl; const bool mine = (above < 256u) && (256u <= suf);
    unsigned B = 0u;
    if (mine) { unsigned cc = above; B = 8u * grp;
#pragma unroll
        for (int i = 7; i >= 0; --i) { cc += c[i]; if (cc >= 256u) { B = 8u * grp + i; break; } } }
    const unsigned long long mm = __ballot(mine); if (!mm) return 0u;
    B = (unsigned)__builtin_amdgcn_readlane((int)B, (int)__builtin_ctzll(mm));
    return dsa_bin_T(B);
}
template <int NPASS, class KF, class PF>
__device__ __forceinline__ unsigned radix_kth(int n, KF key, PF pred, unsigned& want, LAS unsigned* hist, int lane) {
    unsigned prefix = 0u, himask = 0u;
#pragma unroll 1
    for (int p = 0; p < NPASS; ++p) {
        const int shift = 8 * (NPASS - 1 - p);
        *(LAS u32x4*)(hist + 4 * lane) = (u32x4){0u, 0u, 0u, 0u};
        asm volatile("s_waitcnt lgkmcnt(0)" ::: "memory");
#pragma unroll 4
        for (int i = lane; i < n; i += 64) { const unsigned k = key(i); if (pred(i) && ((k ^ prefix) & himask) == 0u) (void)__hip_atomic_fetch_add(hist + ((k >> shift) & 255u), 1u, __ATOMIC_RELAXED, __HIP_MEMORY_SCOPE_WORKGROUP); }
        asm volatile("s_waitcnt lgkmcnt(0)" ::: "memory");
        const int grp = 63 - lane;
        const u32x4 h = *(LAS u32x4*)(hist + 4 * grp);
        const unsigned tl = h.x + h.y + h.z + h.w; const unsigned suf = wave_prefix_incl(tl);
        const unsigned above = suf - tl;
        const bool mine = (above < want) && (want <= suf);
        unsigned D = 0u, nw = 0u;
        if (mine) { unsigned c = above;
            if (c + h.w >= want) { D = 4 * grp + 3; nw = want - c; } else { c += h.w;
            if (c + h.z >= want) { D = 4 * grp + 2; nw = want - c; } else { c += h.z;
            if (c + h.y >= want) { D = 4 * grp + 1; nw = want - c; } else { c += h.y; D = 4 * grp; nw = want - c; } } } }
        const unsigned long long mm = __ballot(mine); const int src = mm ? (int)__builtin_ctzll(mm) : 0;
        D = (unsigned)__builtin_amdgcn_readlane((int)D, src); nw = (unsigned)__builtin_amdgcn_readlane((int)nw, src);
        prefix |= D << shift; himask |= 0xffu << shift; want = nw;
    }
    return prefix;
}
__device__ __forceinline__ void dsa_prune(u32x2* list, LAS unsigned* nq, LAS unsigned* Tq, int q, LAS u32x2* st, LAS unsigned* hist, int lane, bool exact, unsigned tmin) {
    const int n0 = (int)nq[q]; int n = 0;
#pragma unroll 1
    for (int i0 = 0; i0 < n0; i0 += 256) {
        u32x2 t8[4];
#pragma unroll
        for (int u = 0; u < 4; ++u) { const int i = i0 + u * 64 + lane; t8[u] = (i < n0) ? ld_list(list + i) : (u32x2){0u, 0u}; }
#pragma unroll
        for (int u = 0; u < 4; ++u) { const int i = i0 + u * 64 + lane; const bool k = (i < n0) && t8[u].x > tmin;
            const unsigned long long m = __ballot(k); if (k) st[n + (int)lanes_below(m)] = t8[u]; n += (int)__popcll(m); } }
    asm volatile("s_waitcnt vmcnt(0) lgkmcnt(0)" ::: "memory");
    if (n <= 256) {
#pragma unroll 1
        for (int i = lane; i < n; i += 64) list[i] = st[i];
        if (lane == 0) { nq[q] = (unsigned)n; if (tmin > Tq[q]) Tq[q] = tmin; }
        asm volatile("s_waitcnt vmcnt(0)" ::: "memory");
        return;
    }
    if (!exact) {
        unsigned want = 256u;
        const unsigned Th = radix_kth<2>(n, [st](int i) { return st[i].x >> 16; }, [](int) { return true; }, want, hist, lane);
        unsigned cnt_ge = 0u;
#pragma unroll 1
        for (int i0 = 0; i0 < n; i0 += 64) { const int i = i0 + lane; cnt_ge += (unsigned)__popcll(__ballot(i < n && (st[i].x >> 16) >= Th)); }
        if (cnt_ge <= 512u && Th > 0u) {
            unsigned base = 0u;
#pragma unroll 1
            for (int i0 = 0; i0 < n; i0 += 64) { const int i = i0 + lane; const u32x2 t = (i < n) ? st[i] : (u32x2){0u, 0u};
                const bool keep = (i < n) && (t.x >> 16) >= Th;
                const unsigned long long m = __ballot(keep); if (keep) list[base + lanes_below(m)] = t; base += (unsigned)__popcll(m); }
            if (lane == 0) { nq[q] = base; const unsigned tn = (Th << 16) - 1u; Tq[q] = tn > tmin ? tn : tmin; }
            asm volatile("s_waitcnt vmcnt(0)" ::: "memory");
            return;
        }
    }
    unsigned want = 256u;
    const unsigned Ts = radix_kth<4>(n, [st](int i) { return st[i].x; }, [](int) { return true; }, want, hist, lane);
    unsigned cnt_eq = 0u;
#pragma unroll 1
    for (int i0 = 0; i0 < n; i0 += 64) { const int i = i0 + lane; cnt_eq += (unsigned)__popcll(__ballot(i < n && st[i].x == Ts)); }
    unsigned Tk = 0u;
    if (cnt_eq > want) Tk = radix_kth<2>(n, [st](int i) { return 0x3fffu - st[i].y; }, [st, Ts](int i) { return st[i].x == Ts; }, want, hist, lane);
    unsigned base = 0u;
#pragma unroll 1
    for (int i0 = 0; i0 < n; i0 += 64) { const int i = i0 + lane; const u32x2 t = (i < n) ? st[i] : (u32x2){0u, 0u};
        const bool keep = (i < n) && (t.x > Ts || (t.x == Ts && (0x3fffu - t.y) >= Tk));
        const unsigned long long m = __ballot(keep); if (keep) list[base + lanes_below(m)] = t; base += (unsigned)__popcll(m); }
    if (lane == 0) { nq[q] = base; Tq[q] = Ts; }
    asm volatile("s_waitcnt vmcnt(0)" ::: "memory");
}
__device__ __forceinline__ int dsa_final(const u32x2* list, int n0, unsigned tmin, LAS u32x2* st, LAS unsigned* hist, LAS unsigned* bmp, int lane) {
    int n = 0;
#pragma unroll 1
    for (int i0 = 0; i0 < n0; i0 += 512) {
        u32x4 t4[4];
#pragma unroll
        for (int u = 0; u < 4; ++u) { const int i = i0 + u * 128 + 2 * lane; t4[u] = (i < n0) ? *(const u32x4*)(list + i) : (u32x4){0u, 0u, 0u, 0u}; }
#pragma unroll
        for (int u = 0; u < 4; ++u) { const int i = i0 + u * 128 + 2 * lane;
            { const bool k = (i < n0) && t4[u].x > tmin; const unsigned long long m = __ballot(k); if (k) st[n + (int)lanes_below(m)] = (u32x2){t4[u].x, t4[u].y}; n += (int)__popcll(m); }
            { const bool k = (i + 1 < n0) && t4[u].z > tmin; const unsigned long long m = __ballot(k); if (k) st[n + (int)lanes_below(m)] = (u32x2){t4[u].z, t4[u].w}; n += (int)__popcll(m); } }
    }
    asm volatile("s_waitcnt lgkmcnt(0)" ::: "memory");
    unsigned Ts = 0u, Tk = 0u;
    if (n > 256) {
        unsigned want = 256u;
        Ts = radix_kth<4>(n, [st](int i) { return st[i].x; }, [](int) { return true; }, want, hist, lane);
        unsigned cnt_eq = 0u;
#pragma unroll 1
        for (int i0 = 0; i0 < n; i0 += 64) { const int i = i0 + lane; cnt_eq += (unsigned)__popcll(__ballot(i < n && st[i].x == Ts)); }
        if (cnt_eq > want) Tk = radix_kth<2>(n, [st](int i) { return 0x3fffu - st[i].y; }, [st, Ts](int i) { return st[i].x == Ts; }, want, hist, lane);
    }
    int cnt = 0;
#pragma unroll 1
    for (int i0 = 0; i0 < n; i0 += 64) { const int i = i0 + lane; const u32x2 t = (i < n) ? st[i] : (u32x2){0u, 0u};
        const bool keep = (i < n) && (n <= 256 || t.x > Ts || (t.x == Ts && (0x3fffu - t.y) >= Tk));
        if (keep) (void)__hip_atomic_fetch_or(bmp + (t.y >> 5), 1u << (t.y & 31u), __ATOMIC_RELAXED, __HIP_MEMORY_SCOPE_WORKGROUP);
        cnt += (int)__popcll(__ballot(keep)); }
    asm volatile("s_waitcnt lgkmcnt(0)" ::: "memory");
    return cnt;
}
__device__ __forceinline__ void dsa_unit(Frame& F, int G32) {
    const bf16* P = (const bf16*)(F.ws + WS_PU);
    bf16* Y = (bf16*)(F.ws + WS_Y);
    u32x2* cand = (u32x2*)(F.ws + WS_CAND) + (size_t)F.bid * 32 * DSA_CAP;
    const int lane = F.lane, w = F.wave, r = lane & 31, hh = lane >> 5;
    LAS unsigned char* wscr = F.lds + w * 12288;
    LAS unsigned* Tq = (LAS unsigned*)(F.lds + 98304); LAS unsigned* nq = Tq + 32;
    LAS unsigned* hist = (LAS unsigned*)(F.lds + 98816 + w * 1024);
    LAS unsigned* qhist = (LAS unsigned*)(F.lds + 107008);
    const int q0 = G32 * 32, c = G32 >> 1, nt = c + 1, nrounds = (nt + 7) >> 3;
    __syncthreads();
    if (F.tid < 32) { Tq[F.tid] = 0u; nq[F.tid] = 0u; nq[32 + F.tid] = 0u; nq[64 + F.tid] = 0u; }
#pragma unroll
    for (int k = 0; k < 4; ++k) *(LAS u32x4*)(qhist + F.tid * 4 + k * 2048) = (u32x4){0u, 0u, 0u, 0u};
    if (F.tid < 32) *(LAS u32x4*)(qhist + 8192 + F.tid * 4) = (u32x4){0u, 0u, 0u, 0u};
    bf16x8 Qf[4][2]; float wh[4];
    { const bf16* qp = P + (size_t)(q0 + r) * PW;
#pragma unroll
      for (int h = 0; h < 4; ++h) { wh[h] = bf2f(qp[C_WI + h]);
#pragma unroll
          for (int kk = 0; kk < 2; ++kk) Qf[h][kk] = *(const bf16x8*)(qp + C_QI + h * 32 + kk * 16 + 8 * hh); } }
    bf16x8 Kf[2][2];
    { const int jf = (nrounds - (nrounds < 4 ? nrounds : 4)) * 8 + w; const int j0 = jf < nt ? jf : 0;
#pragma unroll
      for (int kb = 0; kb < 2; ++kb)
#pragma unroll
          for (int kk = 0; kk < 2; ++kk) Kf[kb][kk] = *(const bf16x8*)(P + (size_t)(j0 * 64 + kb * 32 + r) * PW + C_KI + kk * 16 + 8 * hh); }
    __syncthreads();
    LAS unsigned* nlast = nq + 32;
    const int R0 = nrounds < 4 ? nrounds : 4, nvr = nrounds + R0;
    for (int vr = 0; vr < nvr; ++vr) {
        const int rd = vr < R0 ? nrounds - R0 + vr : vr - R0;
        const int mode = vr < R0 ? 0 : (rd >= nrounds - R0 ? 2 : 1);
        const int j = rd * 8 + w;
        int rr = r; asm volatile("" : "+v"(rr));
        u32x2* myl = cand + (size_t)rr * DSA_CAP;
        if (j < nt) {
            f32x16 acc[2];
#pragma unroll
            for (int h = 0; h < 4; ++h)
#pragma unroll
                for (int kb = 0; kb < 2; ++kb) { f32x16 sv;
#pragma unroll
                    for (int i = 0; i < 16; ++i) sv[i] = 0.f;
                    sv = __builtin_amdgcn_mfma_f32_32x32x16_bf16(Kf[kb][0], Qf[h][0], sv, 0, 0, 0); sv = __builtin_amdgcn_mfma_f32_32x32x16_bf16(Kf[kb][1], Qf[h][1], sv, 0, 0, 0);
#pragma unroll
                    for (int i = 0; i < 16; ++i) { const float rl = __builtin_amdgcn_fmed3f(sv[i], 0.f, __builtin_inff()); acc[kb][i] = (h == 0) ? (wh[0] * rl + 0.f) : fmaf(wh[h], rl, acc[kb][i]); } }
            const unsigned T = mode ? Tq[rr] : 0xffffffffu;
            LAS unsigned* myv = (LAS unsigned*)wscr + lane * 36;
            unsigned pm = 0u;
#pragma unroll
            for (int kb = 0; kb < 2; ++kb)
#pragma unroll
                for (int g = 0; g < 4; ++g) { u32x4 v4;
                    v4.x = sortable(acc[kb][4 * g]); v4.y = sortable(acc[kb][4 * g + 1]); v4.z = sortable(acc[kb][4 * g + 2]); v4.w = sortable(acc[kb][4 * g + 3]);
                    pm |= (v4.x > T ? 1u : 0u) << (kb * 16 + 4 * g) | (v4.y > T ? 2u : 0u) << (kb * 16 + 4 * g) | (v4.z > T ? 4u : 0u) << (kb * 16 + 4 * g) | (v4.w > T ? 8u : 0u) << (kb * 16 + 4 * g);
                    *(LAS u32x4*)(myv + kb * 16 + 4 * g) = v4;
                    if (mode == 0) { const unsigned b0 = dsa_bin(v4.x), b1 = dsa_bin(v4.y), b2 = dsa_bin(v4.z), b3 = dsa_bin(v4.w); LAS unsigned* qh = qhist + rr * QHP;
                        (void)__hip_atomic_fetch_add(qh + (b0 >> 1), 1u << (16u * (b0 & 1u)), __ATOMIC_RELAXED, __HIP_MEMORY_SCOPE_WORKGROUP); (void)__hip_atomic_fetch_add(qh + (b1 >> 1), 1u << (16u * (b1 & 1u)), __ATOMIC_RELAXED, __HIP_MEMORY_SCOPE_WORKGROUP);
                        (void)__hip_atomic_fetch_add(qh + (b2 >> 1), 1u << (16u * (b2 & 1u)), __ATOMIC_RELAXED, __HIP_MEMORY_SCOPE_WORKGROUP); (void)__hip_atomic_fetch_add(qh + (b3 >> 1), 1u << (16u * (b3 & 1u)), __ATOMIC_RELAXED, __HIP_MEMORY_SCOPE_WORKGROUP); } }
            asm volatile("s_waitcnt lgkmcnt(0)" ::: "memory");
            while (__any(pm != 0u)) {
                if (pm) { const int e = __builtin_ctz(pm); pm &= pm - 1u; const unsigned sv1 = myv[e];
                    const unsigned pos1 = __hip_atomic_fetch_add(nq + rr, 1u, __ATOMIC_RELAXED, __HIP_MEMORY_SCOPE_WORKGROUP);
                    if (mode == 1) { const unsigned bn = dsa_bin(sv1); (void)__hip_atomic_fetch_add(qhist + rr * QHP + (bn >> 1), 1u << (16u * (bn & 1u)), __ATOMIC_RELAXED, __HIP_MEMORY_SCOPE_WORKGROUP); }
                    myl[pos1] = (u32x2){sv1, (unsigned)(j * 64 + (e >> 4) * 32 + (e & 3) + 8 * ((e & 15) >> 2) + 4 * hh)}; }
            }
        }
        { const int nv = vr + 1, nrd = nv < R0 ? nrounds - R0 + nv : nv - R0; int jn = nrd * 8 + w; if (jn >= nt || nv >= nvr) jn = (j < nt ? j : 0);
#pragma unroll
          for (int kb = 0; kb < 2; ++kb)
#pragma unroll
              for (int kk = 0; kk < 2; ++kk) Kf[kb][kk] = *(const bf16x8*)(P + (size_t)(jn * 64 + kb * 32 + r) * PW + C_KI + kk * 16 + 8 * hh); }
        LAS unsigned* oflag = nq + 64;
#pragma unroll 1
        for (int qq = 0; qq < 4; ++qq) { const int q = w * 4 + qq; const unsigned n = nq[q];
            if (n > (unsigned)DSA_TRIG) { if (lane == 0) oflag[0] = 1u; continue; }
            if (mode == 1 && n < nlast[q] + 48u) continue;
            if (lane == 0) nlast[q] = n;
            const unsigned Th = dsa_hist_T(qhist + q * QHP, lane);
            if (lane == 0 && Th > Tq[q]) Tq[q] = Th; }
        __syncthreads();
        if (oflag[0]) {
            asm volatile("s_waitcnt vmcnt(0)" ::: "memory");
            __syncthreads();
#pragma unroll 1
            for (int qq = 0; qq < 4; ++qq) { const int q = w * 4 + qq; const unsigned n = nq[q];
                if (n > (unsigned)DSA_TRIG) {
                    const unsigned Th = dsa_hist_T(qhist + q * QHP, lane);
                    dsa_prune(cand + (size_t)q * DSA_CAP, nq, Tq, q, (LAS u32x2*)wscr, hist, lane, false, Th > Tq[q] ? Th : Tq[q]);
                    const int n2 = (int)nq[q]; LAS unsigned* qh = qhist + q * QHP;
                    *(LAS u32x4*)(qh + 4 * lane) = (u32x4){0u, 0u, 0u, 0u};
                    asm volatile("s_waitcnt lgkmcnt(0)" ::: "memory");
#pragma unroll 1
                    for (int i = lane; i < n2; i += 64) { const unsigned bn = dsa_bin(ld_list(cand + (size_t)q * DSA_CAP + i).x); (void)__hip_atomic_fetch_add(qh + (bn >> 1), 1u << (16u * (bn & 1u)), __ATOMIC_RELAXED, __HIP_MEMORY_SCOPE_WORKGROUP); }
                    __builtin_amdgcn_fence(__ATOMIC_ACQUIRE, "agent");
                    asm volatile("s_waitcnt vmcnt(0) lgkmcnt(0)" ::: "memory");
                    if (lane == 0) nlast[q] = (unsigned)n2;
                } }
            __syncthreads();
            if (F.tid == 0) oflag[0] = 0u;
            __syncthreads();
        }
    }
    asm volatile("s_waitcnt vmcnt(0)" ::: "memory");
    __syncthreads();
#pragma unroll 1
    for (int qq = 0; qq < 4; ++qq) { const int q = w * 4 + qq; const unsigned Th = dsa_hist_T(qhist + q * QHP, lane); if (lane == 0 && Th > Tq[q]) Tq[q] = Th; }
    __syncthreads();
#pragma unroll 1
    for (int qq = 0; qq < 4; ++qq) {
        const int q = w * 4 + qq, qrow = q0 + q; const int n0 = (int)nq[q];
        LAS unsigned* bmp = (LAS unsigned*)(F.lds + 107008 + w * 2048);
        *(LAS u32x4*)(bmp + 8 * lane) = (u32x4){0u, 0u, 0u, 0u}; *(LAS u32x4*)(bmp + 8 * lane + 4) = (u32x4){0u, 0u, 0u, 0u};
        asm volatile("s_waitcnt lgkmcnt(0)" ::: "memory");
        const int n = dsa_final(cand + (size_t)q * DSA_CAP, n0, n0 > 256 ? Tq[q] : 0u, (LAS u32x2*)wscr, hist, bmp, lane);
        unsigned short* srow = (unsigned short*)(F.ws + WS_SEL) + (size_t)qrow * 256;
        { const u32x4 b0 = *(LAS u32x4*)(bmp + 8 * lane), b1 = *(LAS u32x4*)(bmp + 8 * lane + 4); const unsigned wd[8] = {b0.x, b0.y, b0.z, b0.w, b1.x, b1.y, b1.z, b1.w};
          unsigned cnt = 0u;
#pragma unroll
          for (int i = 0; i < 8; ++i) cnt += (unsigned)__popc(wd[i]);
          unsigned pos = wave_prefix_incl(cnt) - cnt;
#pragma unroll
          for (int i = 0; i < 8; ++i) { unsigned wv = wd[i]; while (wv) { const int bpos = __builtin_ctz(wv); srow[pos++] = (unsigned short)(lane * 256 + i * 32 + bpos); wv &= wv - 1u; } } }
        if (lane == 0) ((int*)(F.ws + WS_NSEL))[qrow] = n;
    }
    asm volatile("s_waitcnt vmcnt(0)" ::: "memory");
}
__device__ __forceinline__ void dsa_pack_phase(Frame& F) {
    const bf16* P = (const bf16*)(F.ws + WS_PU); unsigned char* T8 = F.ws + WS_KV8;
    for (int t = F.bid * 512 + F.tid; t < S * 32; t += F.G * 512) {
        const int row = t >> 5, ch = t & 31;
        const bf16* src = P + (size_t)row * PW + C_KA + ch * 16;
        const u32x4 a0 = *(const u32x4*)src, a1 = *(const u32x4*)(src + 8);
        u32x4 o; int v;
        v = __builtin_amdgcn_cvt_pk_fp8_f32(bflo(a0.x), bfhi(a0.x), 0, false); v = __builtin_amdgcn_cvt_pk_fp8_f32(bflo(a0.y), bfhi(a0.y), v, true); o.x = (unsigned)v;
        v = __builtin_amdgcn_cvt_pk_fp8_f32(bflo(a0.z), bfhi(a0.z), 0, false); v = __builtin_amdgcn_cvt_pk_fp8_f32(bflo(a0.w), bfhi(a0.w), v, true); o.y = (unsigned)v;
        v = __builtin_amdgcn_cvt_pk_fp8_f32(bflo(a1.x), bfhi(a1.x), 0, false); v = __builtin_amdgcn_cvt_pk_fp8_f32(bflo(a1.y), bfhi(a1.y), v, true); o.z = (unsigned)v;
        v = __builtin_amdgcn_cvt_pk_fp8_f32(bflo(a1.z), bfhi(a1.z), 0, false); v = __builtin_amdgcn_cvt_pk_fp8_f32(bflo(a1.w), bfhi(a1.w), v, true); o.w = (unsigned)v;
        *(u32x4*)(T8 + (size_t)row * 512 + ch * 16) = o;
    }
}
__device__ __forceinline__ void dsa_sparse_unit(Frame& F, int G32) {
    const bf16* P = (const bf16*)(F.ws + WS_PU); bf16* Y = (bf16*)(F.ws + WS_Y);
    const int lane = F.lane, w = F.wave, q0 = G32 * 32;
#pragma unroll 1
    for (int qq = 0; qq < 4; ++qq) {
        int l2 = lane; asm volatile("" : "+v"(l2)); const int ks = l2 >> 4, dg = l2 & 15;
        const int q = w * 4 + qq, qrow = q0 + q; const int n = ((const int*)(F.ws + WS_NSEL))[qrow];
        LAS unsigned short* srt = (LAS unsigned short*)(F.lds + w * 1024 + (qq & 1) * 512);
        { const unsigned long long* g8 = (const unsigned long long*)((const unsigned short*)(F.ws + WS_SEL) + (size_t)qrow * 256); ((LAS unsigned long long*)srt)[lane] = g8[lane]; }
        asm volatile("s_waitcnt vmcnt(0) lgkmcnt(0)" ::: "memory");
        float qv[16];
        { const u32x4 a0 = *(const u32x4*)(P + (size_t)qrow * PW + C_QA + dg * 16), a1 = *(const u32x4*)(P + (size_t)qrow * PW + C_QA + dg * 16 + 8); const float sc = 0.125f * 1.4426950408889634f;
          qv[0] = bflo(a0.x) * sc; qv[1] = bfhi(a0.x) * sc; qv[2] = bflo(a0.y) * sc; qv[3] = bfhi(a0.y) * sc; qv[4] = bflo(a0.z) * sc; qv[5] = bfhi(a0.z) * sc; qv[6] = bflo(a0.w) * sc; qv[7] = bfhi(a0.w) * sc;
          qv[8] = bflo(a1.x) * sc; qv[9] = bfhi(a1.x) * sc; qv[10] = bflo(a1.y) * sc; qv[11] = bfhi(a1.y) * sc; qv[12] = bflo(a1.z) * sc; qv[13] = bfhi(a1.z) * sc; qv[14] = bflo(a1.w) * sc; qv[15] = bfhi(a1.w) * sc; }
        float mrun = -1e30f, lrun = 0.f, o[16];
#pragma unroll
        for (int i = 0; i < 16; ++i) o[i] = 0.f;
        const int nb = (n + 31) >> 5;
        const unsigned char* T8 = F.ws + WS_KV8 + dg * 16;
#pragma unroll 1
        for (int bt = 0; bt < nb; ++bt) {
            u32x4 kk[8], vv[8]; bool val[8];
#pragma unroll
            for (int t = 0; t < 8; ++t) { const int jn = bt * 32 + t * 4 + ks; val[t] = jn < n; const unsigned idx = val[t] ? (unsigned)srt[jn] : 0u;
                const unsigned char* kp = T8 + (size_t)idx * 512; kk[t] = *(const u32x4*)kp; vv[t] = *(const u32x4*)(kp + 256); }
#pragma unroll
            for (int t = 0; t < 8; ++t) {
                float d = 0.f;
#pragma unroll
                for (int c4 = 0; c4 < 4; ++c4) { const int wd = (int)kk[t][c4]; const f32x2 lo = __builtin_amdgcn_cvt_pk_f32_fp8(wd, false), hi = __builtin_amdgcn_cvt_pk_f32_fp8(wd, true);
                    d = fmaf(qv[4 * c4], lo.x, d); d = fmaf(qv[4 * c4 + 1], lo.y, d); d = fmaf(qv[4 * c4 + 2], hi.x, d); d = fmaf(qv[4 * c4 + 3], hi.y, d); }
                d += __builtin_bit_cast(float, __builtin_amdgcn_update_dpp(0, __builtin_bit_cast(int, d), 0xB1, 0xf, 0xf, false));
                d += __builtin_bit_cast(float, __builtin_amdgcn_update_dpp(0, __builtin_bit_cast(int, d), 0x4E, 0xf, 0xf, false));
                if (!val[t]) d = -1e30f;
                if (__any(d > mrun + 8.f)) { const float mn = fmaxf(mrun, d), al = __builtin_amdgcn_exp2f(mrun - mn); mrun = mn; lrun *= al;
#pragma unroll
                    for (int i = 0; i < 16; ++i) o[i] *= al; }
                const float p = val[t] ? __builtin_amdgcn_exp2f(d - mrun) : 0.f; lrun += p;
#pragma unroll
                for (int c4 = 0; c4 < 4; ++c4) { const int wd = (int)vv[t][c4]; const f32x2 lo = __builtin_amdgcn_cvt_pk_f32_fp8(wd, false), hi = __builtin_amdgcn_cvt_pk_f32_fp8(wd, true);
                    o[4 * c4] = fmaf(p, lo.x, o[4 * c4]); o[4 * c4 + 1] = fmaf(p, lo.y, o[4 * c4 + 1]); o[4 * c4 + 2] = fmaf(p, hi.x, o[4 * c4 + 2]); o[4 * c4 + 3] = fmaf(p, hi.y, o[4 * c4 + 3]); }
            }
        }
        { float ma = fmaxf(mrun, __shfl_xor(mrun, 16)); ma = fmaxf(ma, __shfl_xor(ma, 32)); const float al = __builtin_amdgcn_exp2f(mrun - ma);
          lrun *= al; lrun += __shfl_xor(lrun, 16); lrun += __shfl_xor(lrun, 32); const float iv = 1.f / lrun;
#pragma unroll
          for (int i = 0; i < 16; ++i) { float t = o[i] * al; t += __shfl_xor(t, 16); t += __shfl_xor(t, 32); o[i] = t * iv; } }
        if (ks == 0) { u32x4 y0, y1; y0.x = pk2(o[0], o[1]); y0.y = pk2(o[2], o[3]); y0.z = pk2(o[4], o[5]); y0.w = pk2(o[6], o[7]); y1.x = pk2(o[8], o[9]); y1.y = pk2(o[10], o[11]); y1.z = pk2(o[12], o[13]); y1.w = pk2(o[14], o[15]);
            *(u32x4*)(Y + (size_t)qrow * 256 + dg * 16) = y0; *(u32x4*)(Y + (size_t)qrow * 256 + dg * 16 + 8) = y1; }
    }
}
__device__ __forceinline__ void dsa_phase(Frame& F) {
#pragma unroll 1
    for (int i2 = F.bid * 2; i2 < 512; i2 += F.G * 2)
#pragma unroll 1
        for (int rep = 0; rep < 2; ++rep) dsa_unit(F, rep ? 511 - (i2 >> 1) : (i2 >> 1));
    __syncthreads();
}
__device__ __forceinline__ void dsa_sparse_phase(Frame& F) {
#pragma unroll 1
    for (int i2 = F.bid * 2; i2 < 512; i2 += F.G * 2)
#pragma unroll 1
        for (int rep = 0; rep < 2; ++rep) dsa_sparse_unit(F, rep ? 511 - (i2 >> 1) : (i2 >> 1));
}

__device__ __forceinline__ void phase_mixers_stub(Frame& F) {
    u32x4* y = (u32x4*)(F.ws + WS_Y); const size_t n = (size_t)1 * S * 256 * 2 / 16;
    for (size_t i = (size_t)F.bid * 512 + F.tid; i < n; i += (size_t)F.G * 512) y[i] = (u32x4){0u, 0u, 0u, 0u};
}

__device__ __forceinline__ Frame mkframe() {
    Frame F; int t = threadIdx.x; asm volatile("" : "+v"(t));
    extern __shared__ __attribute__((aligned(16))) unsigned char lds_raw[];
    F.lds = (LAS unsigned char*)lds_raw; F.ws = kargs()->ws; F.ctl = (unsigned*)(F.ws + WS_CTL);
    F.tid = t; F.lane = t & 63; F.wave = __builtin_amdgcn_readfirstlane(t >> 6); F.G = gridDim.x; F.bid = blockIdx.x;
    return F;
}
__device__ __forceinline__ void grid_barrier() {
    extern __shared__ __attribute__((aligned(16))) unsigned char lds_raw[];
    XcdBarrier b; b.bar = (unsigned*)(kargs()->ws + WS_CTL) + CW_BAR; b.x = xb_xcc_id(); b.st = (volatile LAS unsigned*)((LAS unsigned char*)lds_raw + MISC_OFF) + 8;
    xcd_barrier(b);
}
constexpr int NSEG = 14;
#ifndef SEGMASK
#define SEGMASK 0xffff
#endif
template <int l> __device__ __forceinline__ void layer_body() {
#if MK_MULTI
#define RUN(k) (((SEGMASK >> (k)) & 1) && (l * NSEG + (k)) >= kargs()->seg_lo && (l * NSEG + (k)) < kargs()->seg_hi)
#define SEAM(k) do { } while (0)
#else
#define RUN(k) ((SEGMASK >> (k)) & 1)
#define SEAM(k) grid_barrier()
#endif
    {
        if (RUN(0) && l == 0) {
            Frame F = mkframe();
            phase_convert(F, l);
            if (l == 0) { const int gw = F.bid * 8 + F.wave, NGW = F.G * 8; const float* x0 = kargs()->in[0]; const float* g0 = kargs()->in[1];
                for (int m = gw; m < S; m += NGW) rms_row_to_bf16(x0 + (size_t)m * D, g0, (bf16*)(F.ws + WS_H) + (size_t)m * D, F.lane); }
        }
        if (l == 0) SEAM(0);
        if (RUN(1)) {
            Frame F = mkframe();
            pg8::Gemm g{(const bf16*)(F.ws + WS_H), (const bf16*)(F.ws + WS_WIN), S, PW, 1024}; pg8::StaticOrder So; So.init(S, PW, F.G, F.bid);
            pg8::EpiStore E{(bf16*)(F.ws + WS_PU), PW, 0x7fffffff, F.ws + WS_KV8};
            pg8::gemm_phase<pg8::EpiStore, pg8::StaticOrder, true, true>(F.lds, g, So, E, F.tid);
        }
        SEAM(1);
        if (RUN(2)) { Frame F = mkframe(); ml_phase1(F, l); }
        if (RUN(2)) { Frame F = mkframe(); attn_phase<0>(F, l); }
        SEAM(2);
        if (RUN(3)) { Frame F = mkframe(); ml_phase3(F, l); }
        if (RUN(3)) { Frame F = mkframe(); attnD_phase(F, l); }
        SEAM(3);
        if (RUN(4)) { Frame F = mkframe(); ml_phase4(F); }
        if (RUN(4)) { Frame F = mkframe(); dsa_phase(F); }
        if (RUN(4)) { Frame F = mkframe(); dsa_sparse_phase(F); }
        SEAM(4);
        if (RUN(5)) { Frame F = mkframe(); ml_phase5(F, l); }
        SEAM(5);
        if (RUN(6)) {
            Frame F = mkframe();
            pg8::Gemm g{(const bf16*)(F.ws + WS_Y), (const bf16*)(F.ws + WS_WBR), 4 * S, 4096, 256}; pg8::SchedUp Su{F.G, F.bid};
            pg8::EpiStore E{(bf16*)(F.ws + WS_PU), 4096, 63, nullptr};
            pg8::gemm_phase<pg8::EpiStore, pg8::SchedUp, true, true>(F.lds, g, Su, E, F.tid);
        }
        SEAM(6);
        if (RUN(7)) {
            Frame F = mkframe();
            pg8::Gemm g{(const bf16*)(F.ws + WS_H), (const bf16*)(F.ws + WS_WGATE), S, 4096, 1024}; pg8::StaticOrder So; So.init(S, 4096, F.G, F.bid);
            pg8::EpiGateMix E{(const bf16*)(F.ws + WS_PU), (bf16*)(F.ws + WS_MIXED)};
            pg8::gemm_phase<pg8::EpiGateMix, pg8::StaticOrder, true, true>(F.lds, g, So, E, F.tid);
        }
        SEAM(7);
        if (RUN(8)) {
            Frame F = mkframe();
            pg8::Gemm g{(const bf16*)(F.ws + WS_MIXED), (const bf16*)(F.ws + WS_WOUT), S, 1024, 1024}; pg8::StaticOrder So; So.init(S, 1024, F.G, F.bid);
            float* xo = kargs()->out;
            pg8::EpiResid E{(l == 0) ? kargs()->in[0] : (const float*)xo, xo};
            pg8::gemm_phase<pg8::EpiResid, pg8::StaticOrder, true, true>(F.lds, g, So, E, F.tid);
        }
        SEAM(8);
        if (RUN(9)) { Frame F = mkframe(); phase_router(F, l, kargs()->out); }
        SEAM(9);
        if (RUN(10)) { Frame F = mkframe(); phase_scatter(F, l); }
        SEAM(10);
        if (RUN(11)) {
            Frame F = mkframe();
            moe_table(F, l); const LAS int* tab = (const LAS int*)(F.lds + LDSCTL_OFF);
            pg8::Gemm g{(const bf16*)(F.ws + WS_XS), (const bf16*)(F.ws + WS_W13), NRMAX, NE * 1024, 1024}; pg8::SchedMoe Sm{F.G, F.bid, __builtin_amdgcn_readfirstlane(tab[224]) * 4, tab};
            pg8::EpiSwiglu E{(bf16*)(F.ws + WS_ACT)};
            pg8::gemm_phase<pg8::EpiSwiglu, pg8::SchedMoe, true, true>(F.lds, g, Sm, E, F.tid);
        }
        SEAM(11);
        if (RUN(12)) {
            Frame F = mkframe();
            moe_table(F, l); const LAS int* tab = (const LAS int*)(F.lds + LDSCTL_OFF);
            pg8::Gemm g{(const bf16*)(F.ws + WS_ACT), (const bf16*)(F.ws + WS_W2), NRMAX, NE * 1024, FE}; pg8::SchedMoe Sm{F.G, F.bid, __builtin_amdgcn_readfirstlane(tab[224]) * 4, tab};
            pg8::EpiDown E{(bf16*)(F.ws + WS_YE), (const float*)(F.ws + WS_RT + 393216)};
            pg8::gemm_phase<pg8::EpiDown, pg8::SchedMoe, true, true>(F.lds, g, Sm, E, F.tid);
        }
        SEAM(12);
        if (RUN(13)) { Frame F = mkframe(); phase_combine(F, l, kargs()->out); }
        if (RUN(13) && l + 1 < NL) { Frame F = mkframe(); phase_convert(F, l + 1); }
        if (l + 1 < NL) SEAM(13);
    }
#undef RUN
#undef SEAM
}
__global__ void __launch_bounds__(512, 2) fwd_kernel(Args args) {
    extern __shared__ __attribute__((aligned(16))) unsigned char lds_raw[];
    {
        LAS unsigned char* lds = (LAS unsigned char*)lds_raw;
        for (int u = threadIdx.x; u < (LDS_BYTES - LDSCTL_OFF) / 4; u += 512) ((LAS unsigned*)(lds + LDSCTL_OFF))[u] = 0u;
        __syncthreads();
        if (!MK_MULTI) (void)xcd_barrier_post((unsigned*)(kargs()->ws + WS_CTL) + CW_BAR, (volatile LAS unsigned*)(lds + MISC_OFF) + 8);
    }
    layer_body<0>();
    layer_body<1>();
}

extern "C" void kernel_launch(void* const* d_in, const int* in_sizes, int n_in, void* d_out, int out_size, void* d_ws, size_t ws_size, hipStream_t stream) {
    static int grid = 0;
    if (grid == 0) {
        if (n_in != 23 || out_size != S * D || ws_size < WS_END) { fprintf(stderr, "kernel_launch: unexpected shapes (n_in %d out %d ws %zu need %zu)\n", n_in, out_size, ws_size, (size_t)WS_END); grid = -1; return; }
        int dev = 0, cus = 0, per_cu = 0;
        if (hipGetDevice(&dev) != hipSuccess || hipDeviceGetAttribute(&cus, hipDeviceAttributeMultiprocessorCount, dev) != hipSuccess) { grid = -1; return; }
        if (hipFuncSetAttribute((const void*)fwd_kernel, hipFuncAttributeMaxDynamicSharedMemorySize, LDS_BYTES) != hipSuccess) { fprintf(stderr, "kernel_launch: hipFuncSetAttribute failed\n"); grid = -1; return; }
        if (hipOccupancyMaxActiveBlocksPerMultiprocessor(&per_cu, (const void*)fwd_kernel, 512, LDS_BYTES) != hipSuccess || per_cu < 1) fprintf(stderr, "kernel_launch: occupancy query says %d\n", per_cu);
        (void)hipGetLastError();
        grid = cus;
    }
    if (grid < 0) return;
    if (hipMemsetAsync((char*)d_ws + WS_CTL, 0, CTL_ZERO_BYTES, stream) != hipSuccess) return;
    Args a{};
    for (int i = 0; i < 23; ++i) a.in[i] = (const float*)d_in[i];
    a.out = (float*)d_out; a.ws = (unsigned char*)d_ws;
#if MK_MULTI
    for (int s = 0; s < NL * NSEG; ++s) { a.seg_lo = s; a.seg_hi = s + 1; hipLaunchKernelGGL(fwd_kernel, dim3(grid), dim3(512), LDS_BYTES, stream, a); }
#else
    a.seg_lo = 0; a.seg_hi = NL * NSEG;
    hipLaunchKernelGGL(fwd_kernel, dim3(grid), dim3(512), LDS_BYTES, stream, a);
#endif
}
```

```cpp
#include <hip/hip_runtime.h>
#include <cstdio>
#include <cstdint>

#define GAS __attribute__((address_space(1)))
#define LAS __attribute__((address_space(3)))
typedef unsigned short bf16;
typedef short bf16x8 __attribute__((ext_vector_type(8)));
typedef short s16x4 __attribute__((ext_vector_type(4)));
typedef float f32x2 __attribute__((ext_vector_type(2)));
typedef float f32x4 __attribute__((ext_vector_type(4)));
typedef float f32x16 __attribute__((ext_vector_type(16)));
typedef unsigned u32x2 __attribute__((ext_vector_type(2)));
typedef unsigned u32x4 __attribute__((ext_vector_type(4)));

#ifndef MK_MULTI
#define MK_MULTI 0
#endif

constexpr int S = 16384, D = 1024, NL = 2, NCH = 256;
constexpr int PW = 3584;
constexpr int C_QA = 0, C_KA = 256, C_VA = 512, C_QI = 768, C_KI = 896, C_WI = 928, C_IB = 932, C_FB = 936, C_QB = 960, C_KB = 1216,
              C_VB = 1472, C_OB = 1728, C_QC = 1984, C_KC = 2240, C_VC = 2496, C_QD = 2752, C_KD = 3008, C_VD = 3264;
constexpr int CIN = 3500;
constexpr int NE = 32, FE = 512, NRMAX = 40960, NBMAX = 160;
constexpr float RMS_EPS = 1e-6f;

constexpr size_t MiB = 1u << 20;
constexpr size_t WS_CTL = 0, CTL_ZERO_BYTES = 1 * MiB;
constexpr size_t WS_WIN = 1 * MiB;
constexpr size_t WS_WBR = WS_WIN + 7 * MiB;
constexpr size_t WS_WGATE = WS_WBR + 2 * MiB;
constexpr size_t WS_WOUT = WS_WGATE + 8 * MiB;
constexpr size_t WS_W13 = WS_WOUT + 2 * MiB;
constexpr size_t WS_W2 = WS_W13 + 64 * MiB;
constexpr size_t WS_H = WS_W2 + 32 * MiB;
constexpr size_t WS_PU = WS_H + 32 * MiB;
constexpr size_t WS_XS = WS_PU;
constexpr size_t WS_ACT = WS_PU + 80 * MiB;
constexpr size_t WS_Y = WS_PU + 128 * MiB;
constexpr size_t WS_MIXED = WS_Y + 32 * MiB;
constexpr size_t WS_CAND = WS_MIXED + 32 * MiB;
constexpr size_t WS_YE = WS_Y;
constexpr size_t WS_MLC = WS_CAND + 128 * MiB;
constexpr size_t WS_MLN = WS_MLC + 16 * MiB;
constexpr size_t WS_MLS = WS_MLN + 256 * 1024;
constexpr size_t WS_RT = WS_MLS + 64 * 1024;
constexpr size_t WS_SEL = WS_RT + 1 * MiB;
constexpr size_t WS_NSEL = WS_SEL + 8 * MiB;
constexpr size_t WS_KV8 = WS_NSEL + 1 * MiB;
constexpr size_t WS_END = WS_KV8 + 8 * MiB;
static_assert(WS_YE + (size_t)NRMAX * 1024 * 2 <= WS_MLC, "ye overlay");
static_assert(WS_ACT + (size_t)NRMAX * 512 * 2 <= WS_Y, "act overlay");
constexpr int CW_BAR = 4096;
constexpr int CW_CNT = 16384;
constexpr int CW_FILL = 16384 + 64;

constexpr int RING_BYTES = 131072;
constexpr int LDS_BYTES = 163840;
constexpr int LDSCTL_OFF = LDS_BYTES - 2048;
constexpr int MISC_OFF = LDSCTL_OFF + 1024;

__device__ __forceinline__ unsigned f2bf(float f) { unsigned u = __builtin_bit_cast(unsigned, f); return (u + 0x7fffu + ((u >> 16) & 1u)) >> 16; }
__device__ __forceinline__ unsigned pk2(float lo, float hi) { return f2bf(lo) | (f2bf(hi) << 16); }
__device__ __forceinline__ float bflo(unsigned w) { return __builtin_bit_cast(float, w << 16); }
__device__ __forceinline__ float bfhi(unsigned w) { return __builtin_bit_cast(float, w & 0xffff0000u); }
__device__ __forceinline__ float bf2f(bf16 b) { return __builtin_bit_cast(float, (unsigned)b << 16); }
#define LDS_WAIT() asm volatile("s_waitcnt lgkmcnt(0)" ::: "memory")
#define VM_WAIT() asm volatile("s_waitcnt vmcnt(0)" ::: "memory")
__device__ __forceinline__ float wave_sum(float v) {
#pragma unroll
    for (int o = 1; o < 64; o <<= 1) v += __shfl_xor(v, o);
    return v;
}
__device__ __forceinline__ float wave_max(float v) {
#pragma unroll
    for (int o = 1; o < 64; o <<= 1) v = fmaxf(v, __shfl_xor(v, o));
    return v;
}

namespace pg8 {
#define PG8_LAS __attribute__((address_space(3)))
typedef unsigned short bf16_t;
constexpr int BM = 256, BK = 64, HALF = 128, HTB = HALF * BK * 2, STAGE_BYTES = 8 * HTB, NXCD = 8, WGM = 8;
__host__ __device__ __forceinline__ int lds_byte(int r, int c) { const int st = (r >> 4) * 2 + (c >> 5), rr = r & 15, cc = c & 31, ob = rr * 64 + cc * 2; return st * 1024 + (ob ^ (((ob >> 9) & 1) << 5)); }
__host__ __device__ __forceinline__ void stage_rc(int b, int& R, int& C) { const int st = b / 1024, sb = b % 1024, swz = sb ^ (((sb >> 9) & 1) << 5); R = (st >> 1) * 16 + swz / 64; C = (st & 1) * 32 + (swz % 64) / 2; }
__host__ __device__ __forceinline__ int perm32(int rho) { const int n = rho >> 4, i = rho & 15; return 8 * (i >> 2) + 4 * n + (i & 3); }
struct Unit { int pm, pn; };
struct Gemm { const bf16_t* A; const bf16_t* Bt; int M, N, K; };
struct StaticOrder {
    int nM, nN, nwg, G, c;
    __host__ __device__ void init(int M, int N, int G_, int c_) { nM = M / BM; nN = N / BM; nwg = nM * nN; G = G_; c = c_; }
    __host__ __device__ bool next(int i, Unit& u) const {
        const long L = (long)i * G + c; if (L >= nwg) return false;
        int wgid = (int)L; { const int q = nwg / NXCD, r = nwg % NXCD, xcd = wgid % NXCD, off = wgid / NXCD; wgid = (xcd < r ? xcd * (q + 1) : r * (q + 1) + (xcd - r) * q) + off; }
        const int nig = WGM * nN, gid = wgid / nig, fm = gid * WGM, gsz = (nM - fm) < WGM ? (nM - fm) : WGM;
        u.pm = fm + ((wgid % nig) % gsz); u.pn = (wgid % nig) / gsz; return true;
    }
    __device__ __forceinline__ void a_ready(const Unit&) const {}
    __device__ __forceinline__ void done(const Unit&) const {}
};
__device__ __forceinline__ unsigned cvt_pk_bf16(float lo, float hi) { unsigned r; asm volatile("v_cvt_pk_bf16_f32 %0, %1, %2" : "=v"(r) : "v"(lo), "v"(hi)); return r; }

template <class Epi, class Sched, bool ALIGN_EPI = false, bool SP2 = false>
__device__ __forceinline__ void gemm_phase(PG8_LAS unsigned char* lds, const Gemm g, const Sched& S, const Epi& E, const int tid) {
    const int wid = __builtin_amdgcn_readfirstlane(tid >> 6), lane = tid & 63, wr = wid >> 2, wc = wid & 3, fr = lane & 15, fq = lane >> 4;
    int Kl_ = g.K; asm volatile("" : "+s"(Kl_));
    const int K = Kl_, nt = K / BK;
    unsigned voffA[2], voffB[2];
#pragma unroll
    for (int i = 0; i < 2; ++i) { int R, C; stage_rc(tid * 16 + i * 8192, R, C); const int Rb = Epi::PERM ? ((R & ~31) + perm32(R & 31)) : R;
        voffA[i] = (unsigned)(R * K + C) * 2u; voffB[i] = (unsigned)(Rb * K + C) * 2u; }
    const size_t kstep = (size_t)(BK * 2);
    const size_t hstep = (size_t)HALF * K * 2;
    const size_t tstep = 2 * hstep;
    const unsigned ldsw = (unsigned)wid * 1024u;
    const int aoff = lds_byte(wr * 64 + fr, fq * 8), boff = lds_byte(wc * 32 + fr, fq * 8);
#define PG8_SA(b, h) (((b) * 2 + (h)) * HTB)
#define PG8_SB(b, h) ((4 + (b) * 2 + (h)) * HTB)
#define PG8_STAGE(bufoff, gbase, voff) do { _Pragma("unroll") for (int _i = 0; _i < 2; ++_i) \
        __builtin_amdgcn_global_load_lds((const unsigned*)((const char*)(gbase) + (voff)[_i]), (PG8_LAS unsigned*)(lds + (bufoff) + ldsw + _i * 8192), 16, 0, 0); } while (0)
#define PG8_LDA(dst, b, h) do { _Pragma("unroll") for (int m = 0; m < 4; ++m) _Pragma("unroll") for (int k = 0; k < 2; ++k) dst[m][k] = *(const PG8_LAS bf16x8*)(lds + PG8_SA(b, h) + aoff + m * 2048 + k * 1024); } while (0)
#define PG8_LDB(dst, b, h) do { _Pragma("unroll") for (int n = 0; n < 2; ++n) _Pragma("unroll") for (int k = 0; k < 2; ++k) dst[n][k] = *(const PG8_LAS bf16x8*)(lds + PG8_SB(b, h) + boff + n * 2048 + k * 1024); } while (0)
#define PG8_MMA(ai, bj, At, Bt) do { __builtin_amdgcn_s_setprio(1); _Pragma("unroll") for (int m = 0; m < 4; ++m) _Pragma("unroll") for (int n = 0; n < 2; ++n) _Pragma("unroll") for (int k = 0; k < 2; ++k) \
        acc[ai][bj][m][n] = __builtin_amdgcn_mfma_f32_16x16x32_bf16(Bt[n][k], At[m][k], acc[ai][bj][m][n], 0, 0, 0); __builtin_amdgcn_s_setprio(0); } while (0)
#define PG8_WAIT_V(n) asm volatile("s_waitcnt vmcnt(" #n ")" ::: "memory")
#define PG8_WAIT_L(n) asm volatile("s_waitcnt lgkmcnt(" #n ")" ::: "memory")
#define PG8_BAR __builtin_amdgcn_s_barrier()
#define PG8_SCHED __builtin_amdgcn_sched_barrier(0)
    Unit cur, nxt; int ui = 0;
    if (!S.next(0, cur)) return;
    f32x4 acc[2][2][4][2];
#pragma unroll
    for (int a = 0; a < 2; ++a)
#pragma unroll
        for (int b = 0; b < 2; ++b)
#pragma unroll
            for (int m = 0; m < 4; ++m)
#pragma unroll
                for (int n = 0; n < 2; ++n) acc[a][b][m][n] = (f32x4){0.f, 0.f, 0.f, 0.f};
    bf16x8 At[4][2], B0[2][2], B1[2][2];
    const char* cA = (const char*)g.A + (size_t)cur.pm * tstep; const char* cB = (const char*)g.Bt + (size_t)cur.pn * tstep;
    S.a_ready(cur);
    if constexpr (SP2) {
        PG8_STAGE(PG8_SB(0, 0), cB, voffB); PG8_STAGE(PG8_SB(0, 1), cB + hstep, voffB); PG8_STAGE(PG8_SA(0, 0), cA, voffA); PG8_STAGE(PG8_SA(0, 1), cA + hstep, voffA);
        if (wr == 1) PG8_BAR;
        PG8_WAIT_V(2); PG8_BAR;
        PG8_STAGE(PG8_SB(1, 0), cB + kstep, voffB); PG8_STAGE(PG8_SA(1, 0), cA + kstep, voffA); PG8_STAGE(PG8_SB(1, 1), cB + hstep + kstep, voffB);
        PG8_WAIT_V(6); PG8_BAR;
    } else {
        PG8_STAGE(PG8_SB(0, 0), cB, voffB); PG8_STAGE(PG8_SA(0, 0), cA, voffA); PG8_STAGE(PG8_SB(0, 1), cB + hstep, voffB); PG8_STAGE(PG8_SA(0, 1), cA + hstep, voffA);
        if (wr == 1) PG8_BAR;
        PG8_WAIT_V(4); PG8_BAR;
        PG8_STAGE(PG8_SB(1, 0), cB + kstep, voffB); PG8_STAGE(PG8_SA(1, 0), cA + kstep, voffA); PG8_STAGE(PG8_SB(1, 1), cB + hstep + kstep, voffB);
        PG8_WAIT_V(6); PG8_BAR;
    }
    for (;;) {
        const bool has_next = S.next(ui + 1, nxt);
        const char* nA = has_next ? (const char*)g.A + (size_t)nxt.pm * tstep : cA; const char* nB = has_next ? (const char*)g.Bt + (size_t)nxt.pn * tstep : cB;
        for (int t = 0; t < nt; t += 2) {
            const bool last = (t == nt - 2);
            const char* a1 = cA + (size_t)(t + 1) * kstep;
            const char* a2 = last ? nA : cA + (size_t)(t + 2) * kstep; const char* b2 = last ? nB : cB + (size_t)(t + 2) * kstep;
            const char* a3 = a2 + kstep; const char* b3 = b2 + kstep;
            if (last && has_next) S.a_ready(nxt);
            if constexpr (SP2) {
            PG8_LDB(B0, 0, 0); PG8_LDB(B1, 0, 1); PG8_SCHED; PG8_LDA(At, 0, 0); PG8_STAGE(PG8_SA(1, 1), a1 + hstep, voffA);
            PG8_WAIT_V(8); PG8_WAIT_L(0); PG8_BAR; PG8_MMA(0, 0, At, B0); PG8_MMA(0, 1, At, B1); PG8_BAR; PG8_SCHED;
            PG8_LDA(At, 0, 1); PG8_STAGE(PG8_SB(0, 0), b2, voffB); PG8_STAGE(PG8_SB(0, 1), b2 + hstep, voffB); PG8_STAGE(PG8_SA(0, 0), a2, voffA);
            PG8_WAIT_V(8); PG8_WAIT_L(0); PG8_BAR; PG8_MMA(1, 0, At, B0); PG8_MMA(1, 1, At, B1); PG8_BAR; PG8_SCHED;
            PG8_LDB(B0, 1, 0); PG8_LDB(B1, 1, 1); PG8_SCHED; PG8_LDA(At, 1, 0); PG8_STAGE(PG8_SA(0, 1), a2 + hstep, voffA);
            PG8_WAIT_V(8); PG8_WAIT_L(0); PG8_BAR; PG8_MMA(0, 0, At, B0); PG8_MMA(0, 1, At, B1); PG8_BAR; PG8_SCHED;
            PG8_LDA(At, 1, 1); PG8_STAGE(PG8_SB(1, 0), b3, voffB); PG8_STAGE(PG8_SB(1, 1), b3 + hstep, voffB); PG8_STAGE(PG8_SA(1, 0), a3, voffA);
            PG8_WAIT_V(8); PG8_WAIT_L(0); PG8_BAR; PG8_MMA(1, 0, At, B0); PG8_MMA(1, 1, At, B1); PG8_BAR; PG8_SCHED;
            } else {
            PG8_LDB(B0, 0, 0); PG8_SCHED; PG8_LDA(At, 0, 0); PG8_STAGE(PG8_SA(1, 1), a1 + hstep, voffA);
            PG8_WAIT_L(8); PG8_BAR; PG8_WAIT_L(0); PG8_MMA(0, 0, At, B0); PG8_BAR; PG8_SCHED;
            PG8_LDB(B1, 0, 1); PG8_STAGE(PG8_SB(0, 0), b2, voffB);
            PG8_BAR; PG8_WAIT_L(0); PG8_MMA(0, 1, At, B1); PG8_BAR;
            PG8_LDA(At, 0, 1); PG8_STAGE(PG8_SA(0, 0), a2, voffA);
            PG8_BAR; PG8_WAIT_L(0); PG8_MMA(1, 0, At, B0); PG8_BAR; PG8_SCHED;
            PG8_STAGE(PG8_SB(0, 1), b2 + hstep, voffB);
            PG8_WAIT_V(6); PG8_BAR; PG8_MMA(1, 1, At, B1); PG8_BAR;
            PG8_LDB(B0, 1, 0); PG8_SCHED; PG8_LDA(At, 1, 0); PG8_STAGE(PG8_SA(0, 1), a2 + hstep, voffA);
            PG8_WAIT_L(8); PG8_BAR; PG8_WAIT_L(0); PG8_MMA(0, 0, At, B0); PG8_BAR; PG8_SCHED;
            PG8_LDB(B1, 1, 1); PG8_STAGE(PG8_SB(1, 0), b3, voffB);
            PG8_BAR; PG8_WAIT_L(0); PG8_MMA(0, 1, At, B1); PG8_BAR;
            PG8_LDA(At, 1, 1); PG8_STAGE(PG8_SA(1, 0), a3, voffA);
            PG8_BAR; PG8_WAIT_L(0); PG8_MMA(1, 0, At, B0); PG8_BAR; PG8_SCHED;
            PG8_STAGE(PG8_SB(1, 1), b3 + hstep, voffB);
            PG8_WAIT_V(6); PG8_BAR; PG8_MMA(1, 1, At, B1); PG8_BAR;
            }
        }
        if constexpr (ALIGN_EPI) { if (wr == 0) PG8_BAR; }
        E(acc, cur, wr, wc, fr, fq); S.done(cur);
        if (!has_next) break;
#pragma unroll
        for (int a = 0; a < 2; ++a)
#pragma unroll
            for (int b = 0; b < 2; ++b)
#pragma unroll
                for (int m = 0; m < 4; ++m)
#pragma unroll
                    for (int n = 0; n < 2; ++n) acc[a][b][m][n] = (f32x4){0.f, 0.f, 0.f, 0.f};
        cur = nxt; cA = nA; cB = nB; ++ui;
        if constexpr (ALIGN_EPI) { if (wr == 1) PG8_BAR; }
    }
    PG8_WAIT_V(0);
    if constexpr (!ALIGN_EPI) { if (wr == 0) PG8_BAR; }
    PG8_BAR;
#undef PG8_SA
#undef PG8_SB
#undef PG8_STAGE
#undef PG8_LDA
#undef PG8_LDB
#undef PG8_MMA
#undef PG8_WAIT_V
#undef PG8_WAIT_L
#undef PG8_BAR
#undef PG8_SCHED
}

struct EpiStore {
    static constexpr bool PERM = true;
    bf16_t* O; int ldc; int rowmask; unsigned char* T8;
    __device__ __forceinline__ void operator()(const f32x4 (&acc)[2][2][4][2], const Unit& u, int wr, int wc, int fr, int fq) const {
        const int row0 = (u.pm & rowmask) * BM + wr * 64 + fr, col0 = u.pn * BM + wc * 32 + 8 * fq;
        const bool side = T8 != nullptr && (u.pn == 1 || u.pn == 2);
#pragma unroll
        for (int ai = 0; ai < 2; ++ai)
#pragma unroll
            for (int m = 0; m < 4; ++m) { int row = row0 + ai * HALF + m * 16; asm volatile("" : "+v"(row)); bf16_t* rowp = O + (size_t)row * ldc + col0;
#pragma unroll
                for (int bj = 0; bj < 2; ++bj) { const f32x4 v0 = acc[ai][bj][m][0], v1 = acc[ai][bj][m][1];
                    u32x4 w; w.x = cvt_pk_bf16(v0[0], v0[1]); w.y = cvt_pk_bf16(v0[2], v0[3]); w.z = cvt_pk_bf16(v1[0], v1[1]); w.w = cvt_pk_bf16(v1[2], v1[3]);
                    *(u32x4*)(rowp + bj * HALF) = w;
                    if (side) { int q0 = __builtin_amdgcn_cvt_pk_fp8_f32(v0[0], v0[1], 0, false); q0 = __builtin_amdgcn_cvt_pk_fp8_f32(v0[2], v0[3], q0, true);
                        int q1 = __builtin_amdgcn_cvt_pk_fp8_f32(v1[0], v1[1], 0, false); q1 = __builtin_amdgcn_cvt_pk_fp8_f32(v1[2], v1[3], q1, true);
                        *(u32x2*)(T8 + (size_t)row * 512 + (col0 + bj * HALF - 256)) = (u32x2){(unsigned)q0, (unsigned)q1}; } } }
    }
};
__device__ __forceinline__ float sigmoidf_(float x) { return 1.f / (1.f + __expf(-x)); }
struct EpiGateMix {
    static constexpr bool PERM = true;
    const bf16_t* U; bf16_t* MX;
    __device__ __forceinline__ void operator()(const f32x4 (&acc)[2][2][4][2], const Unit& u, int wr, int wc, int fr, int fq) const {
        const int row0 = u.pm * BM + wr * 64 + fr, dcol = u.pn * 64 + wc * 16 + fq * 4;
        u32x2 un[4];
        { int row = row0; asm volatile("" : "+v"(row)); const bf16_t* up = U + (size_t)row * 4096 + dcol;
#pragma unroll
          for (int b4 = 0; b4 < 4; ++b4) un[b4] = *(const u32x2*)(up + b4 * 1024); }
#pragma unroll
        for (int it = 0; it < 8; ++it) { const int ai = it >> 2, m = it & 3;
            u32x2 uc[4];
#pragma unroll
            for (int b4 = 0; b4 < 4; ++b4) uc[b4] = un[b4];
            if (it < 7) { int rown = row0 + ((it + 1) >> 2) * HALF + ((it + 1) & 3) * 16; asm volatile("" : "+v"(rown)); const bf16_t* up = U + (size_t)rown * 4096 + dcol;
#pragma unroll
                for (int b4 = 0; b4 < 4; ++b4) un[b4] = *(const u32x2*)(up + b4 * 1024); }
            int row = row0 + ai * HALF + m * 16; asm volatile("" : "+v"(row));
            float o0 = 0.f, o1 = 0.f, o2 = 0.f, o3 = 0.f;
#pragma unroll
            for (int bj = 0; bj < 2; ++bj)
#pragma unroll
                for (int n = 0; n < 2; ++n) { const u32x2 uu = uc[2 * bj + n]; const f32x4 a = acc[ai][bj][m][n];
                    o0 += sigmoidf_(a[0]) * bflo(uu.x); o1 += sigmoidf_(a[1]) * bfhi(uu.x); o2 += sigmoidf_(a[2]) * bflo(uu.y); o3 += sigmoidf_(a[3]) * bfhi(uu.y); }
            u32x2 w; w.x = cvt_pk_bf16(o0, o1); w.y = cvt_pk_bf16(o2, o3);
            *(u32x2*)(MX + (size_t)row * 1024 + dcol) = w; }
    }
};
struct EpiResid {
    static constexpr bool PERM = true;
    const float* xin; float* xout;
    __device__ __forceinline__ void operator()(const f32x4 (&acc)[2][2][4][2], const Unit& u, int wr, int wc, int fr, int fq) const {
        const int row0 = u.pm * BM + wr * 64 + fr, col0 = u.pn * BM + wc * 32 + 8 * fq;
        f32x4 xn[4];
        { int row = row0; asm volatile("" : "+v"(row)); const float* xp = xin + (size_t)row * 1024 + col0;
#pragma unroll
          for (int q4 = 0; q4 < 4; ++q4) xn[q4] = *(const f32x4*)(xp + (q4 >> 1) * HALF + 4 * (q4 & 1)); }
#pragma unroll
        for (int it = 0; it < 8; ++it) { const int ai = it >> 2, m = it & 3;
            f32x4 xc[4];
#pragma unroll
            for (int q4 = 0; q4 < 4; ++q4) xc[q4] = xn[q4];
            if (it < 7) { int rown = row0 + ((it + 1) >> 2) * HALF + ((it + 1) & 3) * 16; asm volatile("" : "+v"(rown)); const float* xp = xin + (size_t)rown * 1024 + col0;
#pragma unroll
                for (int q4 = 0; q4 < 4; ++q4) xn[q4] = *(const f32x4*)(xp + (q4 >> 1) * HALF + 4 * (q4 & 1)); }
            int row = row0 + ai * HALF + m * 16; asm volatile("" : "+v"(row)); const size_t ro = (size_t)row * 1024 + col0;
#pragma unroll
            for (int bj = 0; bj < 2; ++bj)
#pragma unroll
                for (int n = 0; n < 2; ++n) *(f32x4*)(xout + ro + bj * HALF + 4 * n) = xc[2 * bj + n] + acc[ai][bj][m][n]; }
    }
};
struct EpiSwiglu {
    static constexpr bool PERM = true;
    bf16_t* ACT;
    __device__ __forceinline__ void operator()(const f32x4 (&acc)[2][2][4][2], const Unit& u, int wr, int wc, int fr, int fq) const {
        const int row0 = u.pm * BM + wr * 64 + fr, col0 = (u.pn & 3) * 128 + wc * 32 + 8 * fq;
#pragma unroll
        for (int ai = 0; ai < 2; ++ai)
#pragma unroll
            for (int m = 0; m < 4; ++m) { int row = row0 + ai * HALF + m * 16; asm volatile("" : "+v"(row)); float v[8];
#pragma unroll
                for (int n = 0; n < 2; ++n)
#pragma unroll
                    for (int i = 0; i < 4; ++i) { const float a = acc[ai][0][m][n][i], b = acc[ai][1][m][n][i]; v[4 * n + i] = a * sigmoidf_(a) * b; }
                u32x4 w; w.x = cvt_pk_bf16(v[0], v[1]); w.y = cvt_pk_bf16(v[2], v[3]); w.z = cvt_pk_bf16(v[4], v[5]); w.w = cvt_pk_bf16(v[6], v[7]);
                *(u32x4*)(ACT + (size_t)row * 512 + col0) = w; }
    }
};
struct EpiDown {
    static constexpr bool PERM = true;
    bf16_t* YE; const float* roww;
    __device__ __forceinline__ void operator()(const f32x4 (&acc)[2][2][4][2], const Unit& u, int wr, int wc, int fr, int fq) const {
        const int row0 = u.pm * BM + wr * 64 + fr, col0 = (u.pn & 3) * BM + wc * 32 + 8 * fq;
        float sw[8];
#pragma unroll
        for (int it = 0; it < 8; ++it) sw[it] = roww[row0 + (it >> 2) * HALF + (it & 3) * 16];
#pragma unroll
        for (int ai = 0; ai < 2; ++ai)
#pragma unroll
            for (int m = 0; m < 4; ++m) { int row = row0 + ai * HALF + m * 16; asm volatile("" : "+v"(row)); const float s = sw[ai * 4 + m]; bf16_t* rowp = YE + (size_t)row * 1024 + col0;
#pragma unroll
                for (int bj = 0; bj < 2; ++bj) { const f32x4 v0 = acc[ai][bj][m][0] * s, v1 = acc[ai][bj][m][1] * s;
                    u32x4 w; w.x = cvt_pk_bf16(v0[0], v0[1]); w.y = cvt_pk_bf16(v0[2], v0[3]); w.z = cvt_pk_bf16(v1[0], v1[1]); w.w = cvt_pk_bf16(v1[2], v1[3]);
                    *(u32x4*)(rowp + bj * HALF) = w; } }
    }
};
struct SchedUp {
    int G, c;
    __device__ __forceinline__ bool next(int i, Unit& u) const { const int L = i * G + c; if (L >= 1024) return false; const int n = L >> 8, pm = (L >> 2) & 63, pn = L & 3; u.pm = n * 64 + pm; u.pn = n * 4 + pn; return true; }
    __device__ __forceinline__ void a_ready(const Unit&) const {}
    __device__ __forceinline__ void done(const Unit&) const {}
};
struct SchedMoe {
    int G, c, nunits; const PG8_LAS int* tab;
    __device__ __forceinline__ bool next(int i, Unit& u) const { const int L = i * G + c; if (L >= nunits) return false; const int b = L >> 2, t = L & 3; const int e = __builtin_amdgcn_readfirstlane(tab[b]); u.pm = b; u.pn = e * 4 + t; return true; }
    __device__ __forceinline__ void a_ready(const Unit&) const {}
    __device__ __forceinline__ void done(const Unit&) const {}
};
}

#define XB_TMO      128
#define XB_XCNT(j)  (256  + 64 * (j))
#define XB_XSUB(j)  (1280 + 64 * (j))
#define XB_XGEN(j)  (2304 + 64 * (j))
#define XB_TOP      3328
#define XB_TOPGEN   3392
#define XCD_BAR_WORDS 3456
#define XB_SPIN_CAP (1u << 18)
__device__ __forceinline__ unsigned xb_ld(unsigned* p)              { return __hip_atomic_load(p, __ATOMIC_RELAXED, __HIP_MEMORY_SCOPE_AGENT); }
__device__ __forceinline__ unsigned xb_add(unsigned* p, unsigned v) { return __hip_atomic_fetch_add(p, v, __ATOMIC_RELAXED, __HIP_MEMORY_SCOPE_AGENT); }
__device__ __forceinline__ unsigned xb_xcc_id() { return (unsigned)__builtin_amdgcn_s_getreg((3 << 11) | 20) & 0xFu; }
#define XB_SPIN(cond, bar) do { unsigned _sp = 0; while (cond) { __builtin_amdgcn_s_sleep(1); \
    if ((++_sp & 255u) == 0u) { if (xb_ld(&(bar)[XB_TMO])) break; if (_sp > XB_SPIN_CAP) { atomicAdd(&(bar)[XB_TMO], 1u); break; } } } } while (0)
struct XcdBarrier { unsigned* bar; unsigned x; volatile LAS unsigned* st; };
__device__ __forceinline__ XcdBarrier xcd_barrier_post(unsigned* bar, volatile LAS unsigned* st) {
    XcdBarrier b; b.bar = bar; b.x = xb_xcc_id(); b.st = st;
    if (threadIdx.x == 0) (void)xb_add(&bar[XB_XCNT(b.x)], 1u);
    return b;
}
__device__ __forceinline__ void xcd_barrier_complete(unsigned* bar, unsigned x, unsigned& nloc, unsigned& nx) {
    const unsigned G = gridDim.x * gridDim.y * gridDim.z;
    unsigned sum, cnt, mine, sp = 0u;
    for (;;) {
        sum = 0u; cnt = 0u; mine = 0u;
#pragma unroll
        for (unsigned j = 0; j < 16; ++j) { const unsigned c = xb_ld(&bar[XB_XCNT(j)]); sum += c; cnt += (c > 0u) ? 1u : 0u; mine = (j == x) ? c : mine; }
        if (sum == G) break;
        __builtin_amdgcn_s_sleep(1);
        if ((++sp & 255u) == 0u) { if (xb_ld(&bar[XB_TMO])) break; if (sp > XB_SPIN_CAP) { atomicAdd(&bar[XB_TMO], 1u); break; } }
    }
    nloc = mine > 0u ? mine : 1u; nx = cnt > 0u ? cnt : 1u;
}
__device__ __forceinline__ void xcd_barrier(const XcdBarrier& b) {
    asm volatile("s_waitcnt vmcnt(0)" ::: "memory");
    __syncthreads();
    if (threadIdx.x == 0) {
        unsigned* bar = b.bar;
        __builtin_amdgcn_s_waitcnt(0);
        unsigned nloc = b.st[0], nx = b.st[1];
        if (nloc == 0u) { xcd_barrier_complete(bar, b.x, nloc, nx); b.st[0] = nloc; b.st[1] = nx; }
        const unsigned old = xb_add(&bar[XB_XSUB(b.x)], 1u);
        const unsigned gen = old / nloc;
        if (old + 1u == (gen + 1u) * nloc) {
            __builtin_amdgcn_fence(__ATOMIC_RELEASE, "agent");
            asm volatile("s_waitcnt vmcnt(0)" ::: "memory");
            const unsigned og = xb_add(&bar[XB_TOP], 1u);
            const unsigned tg = og / nx;
            if (og + 1u == (tg + 1u) * nx) xb_add(&bar[XB_TOPGEN], 1u);
            else XB_SPIN(xb_ld(&bar[XB_TOPGEN]) == tg, bar);
            __builtin_amdgcn_fence(__ATOMIC_ACQUIRE, "agent");
            xb_add(&bar[XB_XGEN(b.x)], 1u);
            asm volatile("s_waitcnt vmcnt(0)" ::: "memory");
        } else {
            XB_SPIN(xb_ld(&bar[XB_XGEN(b.x)]) == gen, bar);
            __builtin_amdgcn_fence(__ATOMIC_ACQUIRE, "agent");
            asm volatile("s_waitcnt vmcnt(0)" ::: "memory");
        }
    }
    __syncthreads();
}

struct Args {
    const float* in[23]; float* out; unsigned char* ws; int seg_lo, seg_hi;
};
typedef const __attribute__((address_space(4))) Args* ArgsP;
__device__ __forceinline__ ArgsP kargs() { unsigned long long v = (unsigned long long)__builtin_amdgcn_kernarg_segment_ptr(); asm volatile("" : "+s"(v)); return (ArgsP)v; }
struct Frame {
    LAS unsigned char* lds; unsigned char* ws; unsigned* ctl;
    int tid, lane, wave, G, bid;
};

template <class SC>
__device__ __forceinline__ void cvt_item(const float* W, int ldw, int K, bf16* WT, int k0, int n0, SC sc, LAS float* scr, int lane) {
    const int nl = lane & 31; const int scol = sc(n0 + nl);
#pragma unroll 8
    for (int i = 0; i < 32; ++i) { const int kk = 2 * i + (lane >> 5); scr[kk * 33 + nl] = scol >= 0 ? W[(size_t)(k0 + kk) * ldw + scol] : 0.f; }
    LDS_WAIT(); asm volatile("" ::: "memory");
    const int c = lane & 7;
#pragma unroll
    for (int j = 0; j < 4; ++j) { const int n = (lane >> 3) + 8 * j; const LAS float* s = scr + (8 * c) * 33 + n;
        u32x4 o; o.x = pk2(s[0 * 33], s[1 * 33]); o.y = pk2(s[2 * 33], s[3 * 33]); o.z = pk2(s[4 * 33], s[5 * 33]); o.w = pk2(s[6 * 33], s[7 * 33]);
        *(u32x4*)(WT + (size_t)(n0 + n) * K + k0 + 8 * c) = o; }
    LDS_WAIT(); asm volatile("" ::: "memory");
}
__device__ __forceinline__ int src_col_win(int dc) {
    if (dc < 932) return dc;
    if (dc < 936) return 1700 + (dc - 932);
    if (dc < 940) return 1704 + (dc - 936);
    if (dc < 960) return -1;
    if (dc < 1728) return 932 + (dc - 960);
    if (dc < 1984) return 1708 + (dc - 1728);
    if (dc < 3520) return 1964 + (dc - 1984);
    return -1;
}
__device__ __forceinline__ void phase_convert(Frame& F, int l) {
    ArgsP a = kargs();
    LAS float* scr = (LAS float*)(F.lds + F.wave * 16384);
    const int gw = F.bid * 8 + F.wave, NGW = F.G * 8;
    constexpr int I_WIN = 16 * 112, I_WBR = 4 * 4 * 32, I_WG = 16 * 128, I_WO = 16 * 32, I_W13 = 32 * 16 * 32, I_W2 = 32 * 8 * 32;
    constexpr int NIT = I_WIN + I_WBR + I_WG + I_WO + I_W13 + I_W2;
    const float* w_in = a->in[2] + (size_t)l * 1024 * CIN;
    const float* w_br = a->in[11] + (size_t)l * 4 * 256 * 1024;
    const float* w_gate = a->in[12] + (size_t)l * 1024 * 4096;
    const float* w_out = a->in[13] + (size_t)l * 1024 * 1024;
    const float* w1 = a->in[19] + (size_t)l * NE * 1024 * FE;
    const float* w3 = a->in[20] + (size_t)l * NE * 1024 * FE;
    const float* w2 = a->in[21] + (size_t)l * NE * FE * 1024;
    for (int it = gw; it < NIT; it += NGW) {
        int r = it;
        if (r < I_WIN) { const int kb = r / 112, nb = r % 112; cvt_item(w_in, CIN, 1024, (bf16*)(F.ws + WS_WIN), kb * 64, nb * 32, [](int n) { return src_col_win(n); }, scr, F.lane); continue; } r -= I_WIN;
        if (r < I_WBR) { const int n = r / 128, q = r % 128, kb = q / 32, nb = q % 32; cvt_item(w_br + (size_t)n * 256 * 1024, 1024, 256, (bf16*)(F.ws + WS_WBR) + (size_t)n * 1024 * 256, kb * 64, nb * 32, [](int c) { return c; }, scr, F.lane); continue; } r -= I_WBR;
        if (r < I_WG) { const int kb = r / 128, nb = r % 128;
            cvt_item(w_gate, 4096, 1024, (bf16*)(F.ws + WS_WGATE), kb * 64, nb * 32, [](int np) { const int pn = np >> 8, L = np & 255, bj = L >> 7, wc = (L >> 5) & 3, fq = (L >> 3) & 3, n = (L >> 2) & 1, i = L & 3;
                return (2 * bj + n) * 1024 + pn * 64 + wc * 16 + fq * 4 + i; }, scr, F.lane); continue; } r -= I_WG;
        if (r < I_WO) { const int kb = r / 32, nb = r % 32; cvt_item(w_out, 1024, 1024, (bf16*)(F.ws + WS_WOUT), kb * 64, nb * 32, [](int c) { return c; }, scr, F.lane); continue; } r -= I_WO;
        if (r < I_W13) { const int e = r / 512, q = r % 512, kb = q / 32, nb = q % 32;
            const int t = (nb * 32) >> 8, L0 = (nb * 32) & 255; const float* src = (L0 < 128 ? w1 : w3) + (size_t)e * 1024 * FE; const int cbase = t * 128 + (L0 & 127) - nb * 32;
            cvt_item(src, FE, 1024, (bf16*)(F.ws + WS_W13) + (size_t)e * 1024 * 1024, kb * 64, nb * 32, [cbase](int np) { return np + cbase; }, scr, F.lane); continue; } r -= I_W13;
        { const int e = r / 256, q = r % 256, kb = q / 32, nb = q % 32; cvt_item(w2 + (size_t)e * FE * 1024, 1024, FE, (bf16*)(F.ws + WS_W2) + (size_t)e * 1024 * FE, kb * 64, nb * 32, [](int c) { return c; }, scr, F.lane); }
    }
}
__device__ __forceinline__ void rms_row_to_bf16(const float* xrow, const float* g, bf16* orow, int lane) {
    const f32x4* xr = (const f32x4*)xrow + lane; const f32x4* gr = (const f32x4*)g + lane;
    f32x4 v[4]; float s = 0.f;
#pragma unroll
    for (int j = 0; j < 4; ++j) { v[j] = xr[64 * j]; s += (v[j].x * v[j].x + v[j].y * v[j].y) + (v[j].z * v[j].z + v[j].w * v[j].w); }
    const float rstd = rsqrtf(wave_sum(s) * (1.f / D) + RMS_EPS);
    unsigned long long* o8 = (unsigned long long*)orow + lane;
#pragma unroll
    for (int j = 0; j < 4; ++j) { const f32x4 gg = gr[64 * j]; o8[64 * j] = (unsigned long long)pk2(v[j].x * rstd * gg.x, v[j].y * rstd * gg.y) | ((unsigned long long)pk2(v[j].z * rstd * gg.z, v[j].w * rstd * gg.w) << 32); }
}

#ifndef MFMA_F32
#define MFMA_F32(av, bv, cv) __builtin_amdgcn_mfma_f32_16x16x4f32((av), (bv), (cv), 0, 0, 0)
#endif
__device__ __forceinline__ void phase_router(Frame& F, int l, const float* xcur) {
    ArgsP a = kargs();
    LAS float* xs = (LAS float*)F.lds;
    LAS float* wsm = xs + 64 * 65;
    LAS float* lg = wsm + 64 * 48;
    LAS float* rs = lg + 64 * 37;
    const float* g = a->in[14] + (size_t)l * D;
    const float* rgw = a->in[15] + (size_t)l * D * 4; const float* rgb = a->in[16] + (size_t)l * 4;
    const float* rew = a->in[17] + (size_t)l * D * 32; const float* reb = a->in[18] + (size_t)l * 32;
    bf16* h2 = (bf16*)(F.ws + WS_H);
    int* tok_e = (int*)(F.ws + WS_RT); float* tok_w = (float*)(F.ws + WS_RT + 131072);
    unsigned* cnt = F.ctl + CW_CNT + l * 32;
    const int r = F.tid & 63;
    const int li = F.lane & 15, kq = F.lane >> 4, rb = F.wave & 3, cset = F.wave >> 2;
    for (int blk = F.bid; blk < S / 64; blk += F.G) {
        const int row0 = blk * 64;
        f32x4 acc0 = {0.f, 0.f, 0.f, 0.f}, acc1 = {0.f, 0.f, 0.f, 0.f}; float ss = 0.f;
        for (int kc = 0; kc < 16; ++kc) {
            __syncthreads();
            { const int rr = F.tid >> 3, kk = (F.tid & 7) * 8; const float* xp = xcur + (size_t)(row0 + rr) * D + kc * 64 + kk; const float* gp = g + kc * 64 + kk;
              const f32x4 x0 = *(const f32x4*)xp, x1 = *(const f32x4*)(xp + 4), g0 = *(const f32x4*)gp, g1 = *(const f32x4*)(gp + 4);
              LAS float* d = xs + rr * 65 + kk; d[0] = x0.x * g0.x; d[1] = x0.y * g0.y; d[2] = x0.z * g0.z; d[3] = x0.w * g0.w; d[4] = x1.x * g1.x; d[5] = x1.y * g1.y; d[6] = x1.z * g1.z; d[7] = x1.w * g1.w;
              ss += (x0.x * x0.x + x0.y * x0.y) + (x0.z * x0.z + x0.w * x0.w) + (x1.x * x1.x + x1.y * x1.y) + (x1.z * x1.z + x1.w * x1.w); }
            { const int kk = F.tid >> 3, c0 = (F.tid & 7) * 6; const size_t kg = (size_t)(kc * 64 + kk);
#pragma unroll
              for (int i = 0; i < 6; ++i) { const int c = c0 + i; wsm[kk * 48 + c] = c < 4 ? rgw[kg * 4 + c] : (c < 36 ? rew[kg * 32 + (c - 4)] : 0.f); } }
            __syncthreads();
            if (cset == 0) {
#pragma unroll 4
                for (int k0 = 0; k0 < 64; k0 += 4) { const float av = xs[(rb * 16 + li) * 65 + k0 + kq];
                    acc0 = MFMA_F32(av, wsm[(k0 + kq) * 48 + li], acc0); acc1 = MFMA_F32(av, wsm[(k0 + kq) * 48 + 16 + li], acc1); }
            } else {
#pragma unroll 4
                for (int k0 = 0; k0 < 64; k0 += 4) { const float av = xs[(rb * 16 + li) * 65 + k0 + kq]; acc0 = MFMA_F32(av, wsm[(k0 + kq) * 48 + 32 + li], acc0); }
            }
        }
        ss += __shfl_xor(ss, 1); ss += __shfl_xor(ss, 2); ss += __shfl_xor(ss, 4);
        __syncthreads();
        if ((F.tid & 7) == 0) rs[F.tid >> 3] = rsqrtf(ss * (1.f / D) + RMS_EPS);
        __syncthreads();
#pragma unroll
        for (int i = 0; i < 4; ++i) { const int rw = rb * 16 + kq * 4 + i; const float rstd = rs[rw];
            if (cset == 0) { lg[rw * 37 + li] = acc0[i] * rstd; lg[rw * 37 + 16 + li] = acc1[i] * rstd; } else if (li < 4) lg[rw * 37 + 32 + li] = acc0[i] * rstd; }
        __syncthreads();
        if (F.tid < 64) {
            const LAS float* L = lg + F.tid * 37; const int tok = row0 + F.tid;
            float gl[4]; int gs = 0; float gm = -3.0e38f;
#pragma unroll
            for (int i = 0; i < 4; ++i) { gl[i] = L[i] + rgb[i]; if (gl[i] > gm) { gm = gl[i]; gs = i; } }
            float gsum = 0.f;
#pragma unroll
            for (int i = 0; i < 4; ++i) gsum += __expf(gl[i] - gm);
            const float ggate = 1.f / gsum;
            float v0 = -3.0e38f, v1 = -3.0e38f; int i0 = 0, i1 = 0;
            for (int i = 0; i < 8; ++i) { const float v = L[4 + gs * 8 + i] + reb[gs * 8 + i]; if (v > v0) { v1 = v0; i1 = i0; v0 = v; i0 = i; } else if (v > v1) { v1 = v; i1 = i; } }
            const float e1 = __expf(v1 - v0), den = 1.f / (1.f + e1);
            const int ea = gs * 8 + i0, eb = gs * 8 + i1;
            tok_e[tok * 2] = ea; tok_e[tok * 2 + 1] = eb; tok_w[tok * 2] = den * ggate; tok_w[tok * 2 + 1] = e1 * den * ggate;
            atomicAdd(&cnt[ea], 1u); atomicAdd(&cnt[eb], 1u);
        }
        for (int i = 0; i < 8; ++i) { const int rr = F.wave * 8 + i; const float rstd = rs[rr];
            const f32x4* xr = (const f32x4*)(xcur + (size_t)(row0 + rr) * D) + F.lane; const f32x4* gr = (const f32x4*)g + F.lane; unsigned long long* o8 = (unsigned long long*)(h2 + (size_t)(row0 + rr) * D) + F.lane;
#pragma unroll
            for (int j = 0; j < 4; ++j) { const f32x4 v = xr[64 * j], gg = gr[64 * j]; o8[64 * j] = (unsigned long long)pk2(v.x * rstd * gg.x, v.y * rstd * gg.y) | ((unsigned long long)pk2(v.z * rstd * gg.z, v.w * rstd * gg.w) << 32); } }
    }
    __syncthreads();
}
__device__ __forceinline__ void moe_table(Frame& F, int l) {
    LAS int* tab = (LAS int*)(F.lds + LDSCTL_OFF);
    if (F.tid == 0) { int bo = 0;
#pragma unroll 1
        for (int e = 0; e < NE; ++e) { const int c = (int)__hip_atomic_load(F.ctl + CW_CNT + l * 32 + e, __ATOMIC_RELAXED, __HIP_MEMORY_SCOPE_AGENT); const int nb = (c + 255) >> 8; tab[192 + e] = bo * 256; for (int b = 0; b < nb; ++b) tab[bo + b] = e; bo += nb; } tab[224] = bo; }
    __syncthreads();
}
__device__ __forceinline__ void phase_scatter(Frame& F, int l) {
    moe_table(F, l);
    LAS int* tab = (LAS int*)(F.lds + LDSCTL_OFF);
    const bf16* h2 = (const bf16*)(F.ws + WS_H); bf16* xs = (bf16*)(F.ws + WS_XS);
    const int* tok_e = (const int*)(F.ws + WS_RT); const float* tok_w = (const float*)(F.ws + WS_RT + 131072);
    int* slot_row = (int*)(F.ws + WS_RT + 262144); float* row_w = (float*)(F.ws + WS_RT + 393216);
    unsigned* fill = F.ctl + CW_FILL + l * 32;
    const int gw = F.bid * 8 + F.wave, NGW = F.G * 8;
    for (int b0 = gw * 16; b0 < S * 2; b0 += NGW * 16) {
        int row = 0;
        if (F.lane < 16) { const int sl = b0 + F.lane; const int e = tok_e[sl]; const unsigned p = atomicAdd(&fill[e], 1u); row = tab[192 + e] + (int)p; slot_row[sl] = row; row_w[row] = tok_w[sl]; }
#pragma unroll 4
        for (int k = 0; k < 16; ++k) { const int rk = __builtin_amdgcn_readlane(row, k); const int sl = b0 + k;
            const u32x4* src = (const u32x4*)(h2 + (size_t)(sl >> 1) * D) + F.lane; u32x4* dst = (u32x4*)(xs + (size_t)rk * D) + F.lane;
            dst[0] = src[0]; dst[64] = src[64]; }
    }
}
__device__ __forceinline__ void phase_combine(Frame& F, int l, float* xcur) {
    ArgsP a = kargs();
    const bf16* ye = (const bf16*)(F.ws + WS_YE); const int* slot_row = (const int*)(F.ws + WS_RT + 262144);
    const bool last = (l == NL - 1);
    const float* g = last ? a->in[22] : a->in[1] + (size_t)(l + 1) * D;
    bf16* h = (bf16*)(F.ws + WS_H);
    const int gw = F.bid * 8 + F.wave, NGW = F.G * 8;
    int srl = 0; { const int k = F.lane >> 1, m = gw + k * NGW; if (F.lane < 16 && m < S) srl = slot_row[2 * m + (F.lane & 1)]; }
    const f32x4* gr = (const f32x4*)g + F.lane; f32x4 gg[4];
#pragma unroll
    for (int j = 0; j < 4; ++j) gg[j] = gr[64 * j];
    f32x4 xn[4]; u32x2 p0n[4], p1n[4];
#define CMB_LOAD(mm, kk) do { const int r0_ = __shfl(srl, 2 * (kk)), r1_ = __shfl(srl, 2 * (kk) + 1); const f32x4* xr_ = (const f32x4*)(xcur + (size_t)(mm) * D) + F.lane; \
        const u32x2* y0_ = (const u32x2*)(ye + (size_t)r0_ * D) + F.lane; const u32x2* y1_ = (const u32x2*)(ye + (size_t)r1_ * D) + F.lane; \
        _Pragma("unroll") for (int j = 0; j < 4; ++j) { xn[j] = xr_[64 * j]; p0n[j] = y0_[64 * j]; p1n[j] = y1_[64 * j]; } } while (0)
    if (gw < S) CMB_LOAD(gw, 0);
    int kk_ = 0;
    for (int m = gw; m < S; m += NGW, ++kk_) {
        f32x4 v[4]; float s = 0.f;
#pragma unroll
        for (int j = 0; j < 4; ++j) { const u32x2 p0 = p0n[j], p1 = p1n[j]; f32x4 x = xn[j];
            x.x = (x.x + bflo(p0.x)) + bflo(p1.x); x.y = (x.y + bfhi(p0.x)) + bfhi(p1.x); x.z = (x.z + bflo(p0.y)) + bflo(p1.y); x.w = (x.w + bfhi(p0.y)) + bfhi(p1.y);
            v[j] = x; s += (x.x * x.x + x.y * x.y) + (x.z * x.z + x.w * x.w); }
        if (m + NGW < S) CMB_LOAD(m + NGW, kk_ + 1);
        const float rstd = rsqrtf(wave_sum(s) * (1.f / D) + RMS_EPS);
        f32x4* xr = (f32x4*)(xcur + (size_t)m * D) + F.lane;
        if (last) {
#pragma unroll
            for (int j = 0; j < 4; ++j) xr[64 * j] = (f32x4){v[j].x * rstd * gg[j].x, v[j].y * rstd * gg[j].y, v[j].z * rstd * gg[j].z, v[j].w * rstd * gg[j].w};
        } else {
            unsigned long long* o8 = (unsigned long long*)(h + (size_t)m * D) + F.lane;
#pragma unroll
            for (int j = 0; j < 4; ++j) { xr[64 * j] = v[j];
                o8[64 * j] = (unsigned long long)pk2(v[j].x * rstd * gg[j].x, v[j].y * rstd * gg[j].y) | ((unsigned long long)pk2(v[j].z * rstd * gg[j].z, v[j].w * rstd * gg[j].w) << 32); }
        }
    }
#undef CMB_LOAD
}


typedef short v4i16_t __attribute__((ext_vector_type(4)));
__device__ __forceinline__ s16x4 ds_tr16(const LAS unsigned char* p) { return __builtin_bit_cast(s16x4, __builtin_amdgcn_ds_read_tr16_b64_v4i16((LAS v4i16_t*)p)); }
template <int MODE>
__device__ __forceinline__ void attn_phase(Frame& F, int l) {
    ArgsP a = kargs();
    constexpr int NS = MODE ? 2 : 1;
    const bf16* P = (const bf16*)(F.ws + WS_PU);
    bf16* Y = (bf16*)(F.ws + WS_Y) + (size_t)(MODE ? 3 : 2) * S * 256;
    const int colQ = MODE ? C_QD : C_QC, colK = MODE ? C_KD : C_KC, colV = MODE ? C_VD : C_VC;
    const float sc2 = (MODE ? 0.17677669529663687f : 0.125f) * 1.4426950408889634f;
    LAS unsigned char* Kb = F.lds; LAS unsigned char* Vb = F.lds + 16384; LAS float* btab = (LAS float*)(F.lds + 32768);
    const int lane = F.lane, w = F.wave, r = lane & 31, hh = lane >> 5;
    for (int u = F.bid; u < 256; u += F.G) {
        const int head = u & 3, ug = u >> 2;
        int qrow, cw, lo_w, T0, T1;
        if (MODE) { qrow = ug * 256 + w * 32; cw = ug * 4 + (w >> 1); lo_w = 0; T0 = 0; T1 = ug * 4 + 3; }
        else { cw = ug * 4 + (w >> 1); qrow = cw * 64 + (w & 1) * 32; lo_w = cw - 8 < 0 ? 0 : cw - 8; T0 = ug * 4 - 8 < 0 ? 0 : ug * 4 - 8; T1 = ug * 4 + 3; }
        if (!MODE) { __syncthreads(); if (F.tid < 192) btab[F.tid] = a->in[8][(size_t)(l * 4 + head) * 192 + F.tid] * 1.4426950408889634f; }
        bf16x8 Qf[4];
#pragma unroll
        for (int kk = 0; kk < 4; ++kk) Qf[kk] = *(const bf16x8*)(P + (size_t)(qrow + r) * PW + colQ + head * 64 + kk * 16 + 8 * hh);
        f32x16 O[NS][2]; float m[NS], lsum[NS];
#pragma unroll
        for (int s = 0; s < NS; ++s) { m[s] = -1e30f; lsum[s] = 0.f;
#pragma unroll
            for (int d = 0; d < 2; ++d)
#pragma unroll
                for (int i = 0; i < 16; ++i) O[s][d][i] = 0.f; }
        const int srow = F.tid >> 3, sch = F.tid & 7;
        const bf16* gK = P + (size_t)srow * PW + colK + head * 64 + sch * 8; const bf16* gV = P + (size_t)srow * PW + colV + head * 64 + sch * 8;
        const int kwoff = srow * 128 + ((sch ^ (srow & 7)) << 4), vwoff = srow * 128 + sch * 16;
        u32x4 kreg = *(const u32x4*)(gK + (size_t)T0 * 64 * PW), vreg = *(const u32x4*)(gV + (size_t)T0 * 64 * PW);
        __syncthreads();
        *(LAS u32x4*)(Kb + kwoff) = kreg; *(LAS u32x4*)(Vb + vwoff) = vreg;
        __syncthreads();
        for (int j = T0; j <= T1; ++j) {
            const int buf = (j - T0) & 1;
            if (j < T1) { kreg = *(const u32x4*)(gK + (size_t)(j + 1) * 64 * PW); vreg = *(const u32x4*)(gV + (size_t)(j + 1) * 64 * PW); }
            if (j >= lo_w && j <= cw) {
                const LAS unsigned char* Kt = Kb + buf * 8192; const LAS unsigned char* Vt = Vb + buf * 8192;
                bf16x8 pf[NS][4];
#pragma unroll
                for (int s = 0; s < NS; ++s) {
                    f32x16 Sq[2];
#pragma unroll
                    for (int kb = 0; kb < 2; ++kb) {
#pragma unroll
                        for (int i = 0; i < 16; ++i) Sq[kb][i] = 0.f;
#pragma unroll
                        for (int k2 = 0; k2 < (MODE ? 2 : 4); ++k2) { const int kk = MODE ? 2 * s + k2 : k2; const int row = kb * 32 + r;
                            const bf16x8 kf = *(const LAS bf16x8*)(Kt + row * 128 + (((kk * 2 + hh) ^ (row & 7)) << 4));
                            Sq[kb] = __builtin_amdgcn_mfma_f32_32x32x16_bf16(kf, Qf[kk], Sq[kb], 0, 0, 0); }
                    }
                    float mx = -1e30f;
                    if (!MODE) {
                        const int dj = cw - j;
                        if (dj >= 3) { const float bc = btab[191];
#pragma unroll
                            for (int kb = 0; kb < 2; ++kb)
#pragma unroll
                                for (int i = 0; i < 16; ++i) { const float t = Sq[kb][i] * sc2 + bc; Sq[kb][i] = t; mx = fmaxf(mx, t); } }
                        else { const int base = dj * 64 + (w & 1) * 32 + r - 4 * hh + 63;
#pragma unroll
                            for (int kb = 0; kb < 2; ++kb)
#pragma unroll
                                for (int i = 0; i < 16; ++i) { int rid = base - (kb * 32 + (i & 3) + 8 * (i >> 2)); rid = rid < 0 ? 0 : (rid > 191 ? 191 : rid);
                                    const float t = Sq[kb][i] * sc2 + btab[rid]; Sq[kb][i] = t; mx = fmaxf(mx, t); } }
                    } else {
#pragma unroll
                        for (int kb = 0; kb < 2; ++kb)
#pragma unroll
                            for (int i = 0; i < 16; ++i) { const float t = Sq[kb][i] * sc2; Sq[kb][i] = t; mx = fmaxf(mx, t); }
                    }
                    mx = fmaxf(mx, __shfl_xor(mx, 32));
                    const float mn = fmaxf(m[s], mx), alpha = __builtin_amdgcn_exp2f(m[s] - mn); m[s] = mn;
                    float rs = 0.f;
#pragma unroll
                    for (int kb = 0; kb < 2; ++kb)
#pragma unroll
                        for (int i = 0; i < 16; ++i) { const float p = __builtin_amdgcn_exp2f(Sq[kb][i] - mn); Sq[kb][i] = p; rs += p; }
                    lsum[s] = lsum[s] * alpha + rs;
#pragma unroll
                    for (int d = 0; d < 2; ++d)
#pragma unroll
                        for (int i = 0; i < 16; ++i) O[s][d][i] *= alpha;
#pragma unroll
                    for (int kb = 0; kb < 2; ++kb)
#pragma unroll
                        for (int ss = 0; ss < 2; ++ss) { u32x4 pw;
                            pw.x = pg8::cvt_pk_bf16(Sq[kb][8 * ss + 0], Sq[kb][8 * ss + 1]); pw.y = pg8::cvt_pk_bf16(Sq[kb][8 * ss + 2], Sq[kb][8 * ss + 3]);
                            pw.z = pg8::cvt_pk_bf16(Sq[kb][8 * ss + 4], Sq[kb][8 * ss + 5]); pw.w = pg8::cvt_pk_bf16(Sq[kb][8 * ss + 6], Sq[kb][8 * ss + 7]);
                            pf[s][kb * 2 + ss] = __builtin_bit_cast(bf16x8, pw); }
                    __builtin_amdgcn_sched_barrier(0);
                }
                const int li = lane & 15, lg = lane >> 4;
                const LAS unsigned char* vbase = Vt + (4 * (lg >> 1) + (li >> 2)) * 128 + (16 * (lg & 1) + 4 * (li & 3)) * 2;
#pragma unroll
                for (int d = 0; d < 2; ++d)
#pragma unroll
                    for (int st = 0; st < 4; ++st) {
                        const s16x4 v0 = ds_tr16(vbase + (st * 16) * 128 + d * 64), v1 = ds_tr16(vbase + (st * 16 + 8) * 128 + d * 64);
                        const bf16x8 vf = (bf16x8){v0[0], v0[1], v0[2], v0[3], v1[0], v1[1], v1[2], v1[3]};
#pragma unroll
                        for (int s = 0; s < NS; ++s) O[s][d] = __builtin_amdgcn_mfma_f32_32x32x16_bf16(vf, pf[s][st], O[s][d], 0, 0, 0);
                        if (st & 1) __builtin_amdgcn_sched_barrier(0);
                    }
            }
            if (j < T1) { *(LAS u32x4*)(Kb + (buf ^ 1) * 8192 + kwoff) = kreg; *(LAS u32x4*)(Vb + (buf ^ 1) * 8192 + vwoff) = vreg; }
            __syncthreads();
        }
        float inv[NS];
#pragma unroll
        for (int s = 0; s < NS; ++s) { const float lt = lsum[s] + __shfl_xor(lsum[s], 32); inv[s] = 1.f / lt; }
        bf16* yrow = Y + (size_t)(qrow + r) * 256 + head * 64 + 4 * hh;
        if (MODE) {
            const float* lp = a->in[9] + (size_t)l * 128 + (lane & 31); float s1 = (lane < 32) ? lp[0] * lp[32] : 0.f, s2 = (lane < 32) ? lp[64] * lp[96] : 0.f;
            s1 = wave_sum(s1); s2 = wave_sum(s2);
            const float lam_init = 0.8f - 0.6f * __expf(-0.3f * (float)l), lam = __expf(s1) - __expf(s2) + lam_init;
            const float* gn = a->in[10] + (size_t)l * 256 + head * 64 + 4 * hh;
            float ss = 0.f;
#pragma unroll
            for (int d = 0; d < 2; ++d)
#pragma unroll
                for (int i = 0; i < 16; ++i) { const float o = O[0][d][i] * inv[0] - lam * (O[NS - 1][d][i] * inv[NS - 1]); O[0][d][i] = o; ss += o * o; }
            ss += __shfl_xor(ss, 32);
            const float rstd = rsqrtf(ss * (1.f / 64.f) + RMS_EPS) * (1.f - lam_init);
#pragma unroll
            for (int d = 0; d < 2; ++d)
#pragma unroll
                for (int g = 0; g < 4; ++g) { const f32x4 gg = *(const f32x4*)(gn + d * 32 + 8 * g); u32x2 o2;
                    o2.x = pk2(O[0][d][4 * g + 0] * rstd * gg.x, O[0][d][4 * g + 1] * rstd * gg.y); o2.y = pk2(O[0][d][4 * g + 2] * rstd * gg.z, O[0][d][4 * g + 3] * rstd * gg.w);
                    *(u32x2*)(yrow + d * 32 + 8 * g) = o2; }
        } else {
#pragma unroll
            for (int d = 0; d < 2; ++d)
#pragma unroll
                for (int g = 0; g < 4; ++g) { u32x2 o2;
                    o2.x = pk2(O[0][d][4 * g + 0] * inv[0], O[0][d][4 * g + 1] * inv[0]); o2.y = pk2(O[0][d][4 * g + 2] * inv[0], O[0][d][4 * g + 3] * inv[0]);
                    *(u32x2*)(yrow + d * 32 + 8 * g) = o2; }
        }
    }
    __syncthreads();
}


__device__ __forceinline__ float vmax3_(float a, float b, float c) { float r; asm("v_max3_f32 %0, %1, %2, %3" : "=v"(r) : "v"(a), "v"(b), "v"(c)); return r; }
__device__ __forceinline__ void attnD_phase(Frame& F, int l) {
    ArgsP a = kargs();
    const bf16* P = (const bf16*)(F.ws + WS_PU);
    bf16* Y = (bf16*)(F.ws + WS_Y) + (size_t)3 * S * 256;
    const float sc2 = 0.17677669529663687f * 1.4426950408889634f;
    const int lane = F.lane, w = F.wave, r = lane & 31, hh = lane >> 5, rw = w & 3, ksel = w >> 2;
    const int srow = F.tid >> 3, sch = F.tid & 7;
#pragma unroll 1
    for (int pr = F.bid; pr < 256; pr += F.G) {
        const int head = pr & 3, bp = pr >> 2;
#pragma unroll 1
        for (int rep = 0; rep < 2; ++rep) {
            const int b = rep ? 127 - bp : bp;
            const int qrow = b * 128 + rw * 32, cw = 2 * b + (rw >> 1);
            bf16x8 Qf[4];
#pragma unroll
            for (int kk = 0; kk < 4; ++kk) { const u32x4 qw = *(const u32x4*)(P + (size_t)(qrow + r) * PW + C_QD + head * 64 + kk * 16 + 8 * hh); u32x4 qs;
                qs.x = pk2(bflo(qw.x) * sc2, bfhi(qw.x) * sc2); qs.y = pk2(bflo(qw.y) * sc2, bfhi(qw.y) * sc2); qs.z = pk2(bflo(qw.z) * sc2, bfhi(qw.z) * sc2); qs.w = pk2(bflo(qw.w) * sc2, bfhi(qw.w) * sc2);
                Qf[kk] = __builtin_bit_cast(bf16x8, qs); }
            f32x16 O[2][2], negM[2]; float m[2], lsum[2]; bool seen = false;
#pragma unroll
            for (int s2 = 0; s2 < 2; ++s2) { m[s2] = 0.f; lsum[s2] = 0.f;
#pragma unroll
                for (int i = 0; i < 16; ++i) negM[s2][i] = 0.f;
                asm volatile("" : "+v"(negM[s2]));
#pragma unroll
                for (int d = 0; d < 2; ++d)
#pragma unroll
                    for (int i = 0; i < 16; ++i) O[s2][d][i] = 0.f; }
            int srow_ = srow, sch_ = sch; asm volatile("" : "+v"(srow_), "+v"(sch_));
            const bf16* gK = P + (size_t)srow_ * PW + C_KD + head * 64 + (sch_ ^ (srow_ & 7)) * 8; const bf16* gV = P + (size_t)srow_ * PW + C_VD + head * 64 + sch_ * 8;
            LAS unsigned char* dma0 = F.lds + w * 1024;
#define D_STAGE(bufb, go) do { __builtin_amdgcn_global_load_lds((const unsigned*)(gK + (go)), (LAS unsigned*)(dma0 + (bufb)), 16, 0, 0); \
                __builtin_amdgcn_global_load_lds((const unsigned*)(gK + (go) + (size_t)64 * PW), (LAS unsigned*)(dma0 + (bufb) + 8192), 16, 0, 0); \
                __builtin_amdgcn_global_load_lds((const unsigned*)(gV + (go)), (LAS unsigned*)(dma0 + (bufb) + 16384), 16, 0, 0); \
                __builtin_amdgcn_global_load_lds((const unsigned*)(gV + (go) + (size_t)64 * PW), (LAS unsigned*)(dma0 + (bufb) + 24576), 16, 0, 0); } while (0)
            __syncthreads();
            D_STAGE(0, (size_t)0);
            VM_WAIT();
            __syncthreads();
#pragma unroll 1
            for (int i = 0; i <= b; ++i) {
                const int buf = i & 1, j = 2 * i + ksel;
                if (i < b) D_STAGE((buf ^ 1) * 32768, (size_t)(2 * i + 2) * 64 * PW);
                if (j <= cw) {
                    const LAS unsigned char* Kt = F.lds + buf * 32768 + ksel * 8192; const LAS unsigned char* Vt = F.lds + buf * 32768 + 16384 + ksel * 8192;
                    bf16x8 pf[2][4];
#pragma unroll
                    for (int s2 = 0; s2 < 2; ++s2) {
                        f32x16 Sq[2];
#pragma unroll
                        for (int kb = 0; kb < 2; ++kb) {
#pragma unroll
                            for (int k2 = 0; k2 < 2; ++k2) { const int kk = 2 * s2 + k2; const int row = kb * 32 + r;
                                const bf16x8 kf = *(const LAS bf16x8*)(Kt + row * 128 + (((kk * 2 + hh) ^ (row & 7)) << 4));
                                Sq[kb] = __builtin_amdgcn_mfma_f32_32x32x16_bf16(kf, Qf[kk], k2 ? Sq[kb] : negM[s2], 0, 0, 0); }
                        }
                        __builtin_amdgcn_sched_barrier(0);
                        asm volatile("s_nop 15\n\ts_nop 3" ::: "memory");
                        __builtin_amdgcn_sched_barrier(0);
                        float mx = vmax3_(Sq[0][0], Sq[0][1], Sq[0][2]);
#pragma unroll
                        for (int ii = 3; ii < 15; ii += 2) mx = vmax3_(mx, Sq[0][ii], Sq[0][ii + 1]);
                        mx = vmax3_(mx, Sq[0][15], Sq[1][0]);
#pragma unroll
                        for (int ii = 1; ii < 15; ii += 2) mx = vmax3_(mx, Sq[1][ii], Sq[1][ii + 1]);
                        mx = vmax3_(mx, Sq[1][15], Sq[1][15]);
                        mx = fmaxf(mx, __shfl_xor(mx, 32));
                        if (!seen || __any(mx > 8.f)) { const float dl = seen ? fmaxf(mx, 0.f) : mx; m[s2] += dl;
                            if (seen) { const float al = __builtin_amdgcn_exp2f(-dl); lsum[s2] *= al;
#pragma unroll
                                for (int d = 0; d < 2; ++d)
#pragma unroll
                                    for (int ii = 0; ii < 16; ++ii) O[s2][d][ii] *= al; }
#pragma unroll
                            for (int kb = 0; kb < 2; ++kb)
#pragma unroll
                                for (int ii = 0; ii < 16; ++ii) Sq[kb][ii] -= dl;
                            const float nm = -m[s2];
#pragma unroll
                            for (int ii = 0; ii < 16; ++ii) negM[s2][ii] = nm; }
                        float rs = 0.f;
#pragma unroll
                        for (int kb = 0; kb < 2; ++kb)
#pragma unroll
                            for (int ii = 0; ii < 16; ++ii) { const float p = __builtin_amdgcn_exp2f(Sq[kb][ii]); Sq[kb][ii] = p; rs += p; }
                        lsum[s2] += rs;
#pragma unroll
                        for (int kb = 0; kb < 2; ++kb)
#pragma unroll
                            for (int ss = 0; ss < 2; ++ss) { u32x4 pw;
                                pw.x = pg8::cvt_pk_bf16(Sq[kb][8 * ss + 0], Sq[kb][8 * ss + 1]); pw.y = pg8::cvt_pk_bf16(Sq[kb][8 * ss + 2], Sq[kb][8 * ss + 3]);
                                pw.z = pg8::cvt_pk_bf16(Sq[kb][8 * ss + 4], Sq[kb][8 * ss + 5]); pw.w = pg8::cvt_pk_bf16(Sq[kb][8 * ss + 6], Sq[kb][8 * ss + 7]);
                                pf[s2][kb * 2 + ss] = __builtin_bit_cast(bf16x8, pw); }
                        __builtin_amdgcn_sched_barrier(0);
                    }
                    const int li = lane & 15, lg = lane >> 4;
                    const LAS unsigned char* vbase = Vt + (4 * (lg >> 1) + (li >> 2)) * 128 + (16 * (lg & 1) + 4 * (li & 3)) * 2;
#pragma unroll
                    for (int d = 0; d < 2; ++d)
#pragma unroll
                        for (int st = 0; st < 4; ++st) {
                            const s16x4 v0 = ds_tr16(vbase + (st * 16) * 128 + d * 64), v1 = ds_tr16(vbase + (st * 16 + 8) * 128 + d * 64);
                            const bf16x8 vf = (bf16x8){v0[0], v0[1], v0[2], v0[3], v1[0], v1[1], v1[2], v1[3]};
                            O[0][d] = __builtin_amdgcn_mfma_f32_32x32x16_bf16(vf, pf[0][st], O[0][d], 0, 0, 0);
                            O[1][d] = __builtin_amdgcn_mfma_f32_32x32x16_bf16(vf, pf[1][st], O[1][d], 0, 0, 0);
                            if (st & 1) __builtin_amdgcn_sched_barrier(0);
                        }
                    seen = true;
                }
                VM_WAIT();
                __syncthreads();
            }
            LAS float* xo = (LAS float*)F.lds + rw * 4096; LAS float* xm = (LAS float*)(F.lds + 65536) + rw * 256;
            if (!seen) { m[0] = -1e30f; m[1] = -1e30f; }
            if (ksel) {
#pragma unroll
                for (int s2 = 0; s2 < 2; ++s2) { xm[s2 * 64 + lane] = m[s2]; xm[128 + s2 * 64 + lane] = lsum[s2];
#pragma unroll
                    for (int d = 0; d < 2; ++d)
#pragma unroll
                        for (int ii = 0; ii < 16; ++ii) xo[((s2 * 2 + d) * 16 + ii) * 64 + lane] = O[s2][d][ii]; }
            }
            __syncthreads();
            if (!ksel) {
                float inv[2];
#pragma unroll
                for (int s2 = 0; s2 < 2; ++s2) { const float mb = xm[s2 * 64 + lane], lb = xm[128 + s2 * 64 + lane]; const float mn = fmaxf(m[s2], mb), aa = __builtin_amdgcn_exp2f(m[s2] - mn), ab = __builtin_amdgcn_exp2f(mb - mn);
                    float lt = lsum[s2] * aa + lb * ab; lt += __shfl_xor(lt, 32); inv[s2] = 1.f / lt;
#pragma unroll
                    for (int d = 0; d < 2; ++d)
#pragma unroll
                        for (int ii = 0; ii < 16; ++ii) O[s2][d][ii] = (O[s2][d][ii] * aa + xo[((s2 * 2 + d) * 16 + ii) * 64 + lane] * ab) * inv[s2]; }
                int r_ = r, hh_ = hh; asm volatile("" : "+v"(r_), "+v"(hh_));
                const float* lp = a->in[9] + (size_t)l * 128 + r_; float s1 = (lane < 32) ? lp[0] * lp[32] : 0.f, s3 = (lane < 32) ? lp[64] * lp[96] : 0.f;
                s1 = wave_sum(s1); s3 = wave_sum(s3);
                const float lam_init = 0.8f - 0.6f * __expf(-0.3f * (float)l), lam = __expf(s1) - __expf(s3) + lam_init;
                const float* gn = a->in[10] + (size_t)l * 256 + head * 64 + 4 * hh_;
                float ss = 0.f;
#pragma unroll
                for (int d = 0; d < 2; ++d)
#pragma unroll
                    for (int ii = 0; ii < 16; ++ii) { const float o = O[0][d][ii] - lam * O[1][d][ii]; O[0][d][ii] = o; ss += o * o; }
                ss += __shfl_xor(ss, 32);
                const float rstd = rsqrtf(ss * (1.f / 64.f) + RMS_EPS) * (1.f - lam_init);
                bf16* yrow = Y + (size_t)(qrow + r_) * 256 + head * 64 + 4 * hh_;
#pragma unroll
                for (int d = 0; d < 2; ++d)
#pragma unroll
                    for (int g = 0; g < 4; ++g) { const f32x4 gg = *(const f32x4*)(gn + d * 32 + 8 * g); u32x2 o2;
                        o2.x = pk2(O[0][d][4 * g + 0] * rstd * gg.x, O[0][d][4 * g + 1] * rstd * gg.y); o2.y = pk2(O[0][d][4 * g + 2] * rstd * gg.z, O[0][d][4 * g + 3] * rstd * gg.w);
                        *(u32x2*)(yrow + d * 32 + 8 * g) = o2; }
            }
        }
    }
    __syncthreads();
}

using pg8::sigmoidf_;
constexpr int ML_CE = 0, ML_G = 1024, ML_SC = 2048;
__device__ __forceinline__ float logsigmoidf_(float f) { return f >= 0.f ? -log1pf(__expf(-f)) : f - log1pf(__expf(f)); }
__device__ __forceinline__ void ml_gates(const bf16* P, const float* ib, const float* fb, int c, int h, int lane, float& a_t, float& i_t) {
    const bf16* pr = P + (size_t)(c * 64 + lane) * PW;
    i_t = bf2f(pr[C_IB + h]) + ib[h]; a_t = logsigmoidf_(bf2f(pr[C_FB + h]) + fb[h]);
}
__device__ __forceinline__ float wave_scan_add(float v, int lane) {
#pragma unroll
    for (int o = 1; o < 64; o <<= 1) { const float u = __shfl_up(v, o); if (lane >= o) v += u; }
    return v;
}
__device__ __forceinline__ float wave_scan_max(float v, int lane) {
#pragma unroll
    for (int o = 1; o < 64; o <<= 1) { const float u = __shfl_up(v, o); if (lane >= o) v = fmaxf(v, u); }
    return v;
}
__device__ __forceinline__ void ml_phase1(Frame& F, int l) {
    ArgsP a = kargs(); const bf16* P = (const bf16*)(F.ws + WS_PU); float* mls = (float*)(F.ws + WS_MLS);
    const float* ib = a->in[5] + l * 4; const float* fb = a->in[6] + l * 4;
    for (int u = F.bid * 8 + F.wave; u < NCH * 4; u += F.G * 8) {
        const int c = u >> 2, h = u & 3; float at, it; ml_gates(P, ib, fb, c, h, F.lane, at, it);
        const float cum = wave_scan_add(at, F.lane), ce = __shfl(cum, 63), g = ce - cum + it, G = wave_max(g);
        if (F.lane == 0) { mls[ML_CE + u] = ce; mls[ML_G + u] = G; }
    }
}
__device__ __forceinline__ void ml_mscan(Frame& F, LAS float* mt, LAS float* tmp) {
    const float* mls = (const float*)(F.ws + WS_MLS);
    __syncthreads();
    for (int i = F.tid; i < 1024; i += 512) { tmp[i] = mls[ML_CE + i]; tmp[1024 + i] = mls[ML_G + i]; }
    __syncthreads();
    if (F.tid < 4) { float m = 0.f;
#pragma unroll 1
        for (int c = 0; c < NCH; ++c) { mt[F.tid * 257 + c] = m; m = fmaxf(tmp[c * 4 + F.tid] + m, tmp[1024 + c * 4 + F.tid]); }
        mt[F.tid * 257 + 256] = m; }
    __syncthreads();
}
__device__ __forceinline__ void ml_stage_conv(const bf16* P, int col0, const float* cw, const float* cb, int row0, float sc, LAS float* dst, int tid) {
    const int t = tid >> 3, d0 = (tid & 7) * 8;
    float acc[8];
#pragma unroll
    for (int i = 0; i < 8; ++i) acc[i] = cb[d0 + i];
#pragma unroll
    for (int j = 0; j < 4; ++j) { const int r = row0 + t - 3 + j;
        if (r >= 0) { const u32x4 x = *(const u32x4*)(P + (size_t)r * PW + col0 + d0); const float* w = cw + j * 512 + d0;
            acc[0] += w[0] * bflo(x.x); acc[1] += w[1] * bfhi(x.x); acc[2] += w[2] * bflo(x.y); acc[3] += w[3] * bfhi(x.y);
            acc[4] += w[4] * bflo(x.z); acc[5] += w[5] * bfhi(x.z); acc[6] += w[6] * bflo(x.w); acc[7] += w[7] * bfhi(x.w); } }
#pragma unroll
    for (int i = 0; i < 8; ++i) dst[t * 65 + d0 + i] = acc[i] * sigmoidf_(acc[i]) * sc;
}
__device__ __forceinline__ void ml_stage_plain(const bf16* P, int col0, int row0, const LAS float* rs, LAS float* dst, int tid) {
    const int t = tid >> 3, d0 = (tid & 7) * 8; const float sc = rs ? rs[t] : 1.f;
    const u32x4 x = *(const u32x4*)(P + (size_t)(row0 + t) * PW + col0 + d0); LAS float* d = dst + t * 65 + d0;
    d[0] = bflo(x.x) * sc; d[1] = bfhi(x.x) * sc; d[2] = bflo(x.y) * sc; d[3] = bfhi(x.y) * sc; d[4] = bflo(x.z) * sc; d[5] = bfhi(x.z) * sc; d[6] = bflo(x.w) * sc; d[7] = bfhi(x.w) * sc;
}
__device__ __forceinline__ void ml_phase3(Frame& F, int l) {
    ArgsP a = kargs(); const bf16* P = (const bf16*)(F.ws + WS_PU); float* mls = (float*)(F.ws + WS_MLS);
    float* dC = (float*)(F.ws + WS_MLC); float* dn = (float*)(F.ws + WS_MLN);
    const float* ib = a->in[5] + l * 4; const float* fb = a->in[6] + l * 4; const float* cw = a->in[3] + (size_t)l * 2048; const float* cb = a->in[4] + (size_t)l * 512;
    LAS float* Kl = (LAS float*)F.lds; LAS float* Vl = Kl + 64 * 65; LAS float* srcL = Vl + 64 * 65; LAS float* mt = srcL + 64; LAS float* tmp = mt + 4 * 257 + 4;
    ml_mscan(F, mt, tmp);
    const int lane = F.lane, w = F.wave, li = lane & 15, kq = lane >> 4, bi = w >> 1, bj0 = (w & 1) * 2;
    for (int u = F.bid; u < NCH * 4; u += F.G) {
        const int c = u >> 2, h = u & 3; const float m0 = mt[h * 257 + c], m1 = mt[h * 257 + c + 1];
        __syncthreads();
        if (w == 0) { float at, it; ml_gates(P, ib, fb, c, h, lane, at, it); const float cum = wave_scan_add(at, lane), ce = __shfl(cum, 63);
            srcL[lane] = __expf(ce - cum + it - m1); if (lane == 0) mls[ML_SC + u] = __expf(ce + m0 - m1); }
        ml_stage_conv(P, C_KB + h * 64, cw + 256 + h * 64, cb + 256 + h * 64, c * 64, 0.125f, Kl, F.tid);
        __syncthreads();
        ml_stage_plain(P, C_VB + h * 64, c * 64, srcL, Vl, F.tid);
        __syncthreads();
        f32x4 acc0 = {0.f, 0.f, 0.f, 0.f}, acc1 = {0.f, 0.f, 0.f, 0.f};
#pragma unroll 4
        for (int k0 = 0; k0 < 64; k0 += 4) { const float av = Vl[(k0 + kq) * 65 + bi * 16 + li];
            acc0 = MFMA_F32(av, Kl[(k0 + kq) * 65 + bj0 * 16 + li], acc0); acc1 = MFMA_F32(av, Kl[(k0 + kq) * 65 + (bj0 + 1) * 16 + li], acc1); }
        float* o = dC + (size_t)u * 4096 + (bi * 16 + kq * 4) * 64 + li;
#pragma unroll
        for (int r = 0; r < 4; ++r) { o[r * 64 + bj0 * 16] = acc0[r]; o[r * 64 + (bj0 + 1) * 16] = acc1[r]; }
        if (F.tid < 64) { float sacc = 0.f; for (int s2 = 0; s2 < 64; ++s2) sacc += srcL[s2] * Kl[s2 * 65 + F.tid]; dn[(size_t)u * 64 + F.tid] = sacc; }
    }
    __syncthreads();
}
__device__ __forceinline__ void ml_phase4(Frame& F) {
    float* dC = (float*)(F.ws + WS_MLC); float* dn = (float*)(F.ws + WS_MLN); const float* sc = (const float*)(F.ws + WS_MLS) + ML_SC;
    float* base; size_t stride; int h;
    if (F.wave == 0) { const int e = F.bid * 64 + F.lane; if (e >= 16384) return; h = e >> 12; base = dC + (size_t)h * 4096 + (e & 4095); stride = 4 * 4096; }
    else if (F.wave == 1 && F.bid < 4) { h = F.bid; base = dn + (size_t)h * 64 + F.lane; stride = 4 * 64; }
    else return;
    float st = 0.f;
    for (int c0 = 0; c0 < NCH; c0 += 8) {
        float v[8], g[8];
#pragma unroll
        for (int i = 0; i < 8; ++i) { v[i] = base[(size_t)(c0 + i) * stride]; g[i] = sc[(c0 + i) * 4 + h]; }
#pragma unroll
        for (int i = 0; i < 8; ++i) { base[(size_t)(c0 + i) * stride] = st; st = g[i] * st + v[i]; }
    }
}
__device__ __forceinline__ void ml_phase5(Frame& F, int l) {
    ArgsP a = kargs(); const bf16* P = (const bf16*)(F.ws + WS_PU);
    const float* Cst = (const float*)(F.ws + WS_MLC); const float* nst = (const float*)(F.ws + WS_MLN);
    const float* ib = a->in[5] + l * 4; const float* fb = a->in[6] + l * 4; const float* cw = a->in[3] + (size_t)l * 2048; const float* cb = a->in[4] + (size_t)l * 512;
    const float* gn = a->in[7] + (size_t)l * 256;
    bf16* Y = (bf16*)(F.ws + WS_Y) + (size_t)1 * S * 256;
    LAS float* Ql = (LAS float*)F.lds; LAS float* Kl = Ql + 64 * 65; LAS float* Vl = Kl + 64 * 65; LAS float* Cl = Vl + 64 * 65; LAS float* Wl = Cl + 64 * 65;
    LAS float* cumL = Wl + 64 * 65; LAS float* bL = cumL + 64; LAS float* mtL = bL + 64; LAS float* inL = mtL + 64; LAS float* nL = inL + 64; LAS float* denL = nL + 64;
    LAS float* mt = denL + 64; LAS float* tmp = mt + 4 * 257 + 4;
    ml_mscan(F, mt, tmp);
    const int lane = F.lane, w = F.wave, li = lane & 15, kq = lane >> 4, bi = w >> 1, bj0 = (w & 1) * 2;
    for (int u = F.bid; u < NCH * 4; u += F.G) {
        const int c = u >> 2, h = u & 3; const float m0 = mt[h * 257 + c];
        __syncthreads();
        if (w == 0) { float at, it; ml_gates(P, ib, fb, c, h, lane, at, it); const float cum = wave_scan_add(at, lane);
            const float bb = it - cum, pm = wave_scan_max(bb, lane), mtt = fmaxf(cum + m0, cum + pm);
            cumL[lane] = cum; bL[lane] = bb; mtL[lane] = mtt; inL[lane] = __expf(cum + m0 - mtt); nL[lane] = nst[(size_t)u * 64 + lane]; }
        ml_stage_conv(P, C_QB + h * 64, cw + h * 64, cb + h * 64, c * 64, 1.f, Ql, F.tid);
        ml_stage_conv(P, C_KB + h * 64, cw + 256 + h * 64, cb + 256 + h * 64, c * 64, 0.125f, Kl, F.tid);
        ml_stage_plain(P, C_VB + h * 64, c * 64, nullptr, Vl, F.tid);
        { const int t = F.tid >> 3, d0 = (F.tid & 7) * 8; const f32x4 c0 = *(const f32x4*)(Cst + (size_t)u * 4096 + t * 64 + d0), c1 = *(const f32x4*)(Cst + (size_t)u * 4096 + t * 64 + d0 + 4);
          LAS float* d = Cl + t * 65 + d0; d[0] = c0.x; d[1] = c0.y; d[2] = c0.z; d[3] = c0.w; d[4] = c1.x; d[5] = c1.y; d[6] = c1.z; d[7] = c1.w; }
        __syncthreads();
        {
            f32x4 acc0 = {0.f, 0.f, 0.f, 0.f}, acc1 = {0.f, 0.f, 0.f, 0.f};
#pragma unroll 4
            for (int k0 = 0; k0 < 64; k0 += 4) { const float av = Ql[(bi * 16 + li) * 65 + k0 + kq];
                acc0 = MFMA_F32(av, Kl[(bj0 * 16 + li) * 65 + k0 + kq], acc0); acc1 = MFMA_F32(av, Kl[((bj0 + 1) * 16 + li) * 65 + k0 + kq], acc1); }
#pragma unroll
            for (int r = 0; r < 4; ++r) { const int t = bi * 16 + kq * 4 + r; const float ct = cumL[t] - mtL[t];
                { const int s2 = bj0 * 16 + li; Wl[t * 65 + s2] = (s2 <= t) ? __expf(ct + bL[s2]) * acc0[r] : 0.f; }
                { const int s2 = (bj0 + 1) * 16 + li; Wl[t * 65 + s2] = (s2 <= t) ? __expf(ct + bL[s2]) * acc1[r] : 0.f; } }
        }
        __syncthreads();
        if (F.tid < 64) { const int t = F.tid; float qn = 0.f, sw = 0.f;
            for (int k = 0; k < 64; ++k) { qn += Ql[t * 65 + k] * nL[k]; sw += Wl[t * 65 + k]; }
            const float den = inL[t] * qn + sw; denL[t] = 1.f / fmaxf(fabsf(den), __expf(-mtL[t])); }
        f32x4 acc0 = {0.f, 0.f, 0.f, 0.f}, acc1 = {0.f, 0.f, 0.f, 0.f};
#pragma unroll 4
        for (int k0 = 0; k0 < 64; k0 += 4) { const float av = Ql[(bi * 16 + li) * 65 + k0 + kq];
            acc0 = MFMA_F32(av, Cl[(bj0 * 16 + li) * 65 + k0 + kq], acc0); acc1 = MFMA_F32(av, Cl[((bj0 + 1) * 16 + li) * 65 + k0 + kq], acc1); }
#pragma unroll
        for (int r = 0; r < 4; ++r) { const float it = inL[bi * 16 + kq * 4 + r]; acc0[r] *= it; acc1[r] *= it; }
#pragma unroll 4
        for (int k0 = 0; k0 < 64; k0 += 4) { const float av = Wl[(bi * 16 + li) * 65 + k0 + kq];
            acc0 = MFMA_F32(av, Vl[(k0 + kq) * 65 + bj0 * 16 + li], acc0); acc1 = MFMA_F32(av, Vl[(k0 + kq) * 65 + (bj0 + 1) * 16 + li], acc1); }
        __syncthreads();
#pragma unroll
        for (int r = 0; r < 4; ++r) { const int t = bi * 16 + kq * 4 + r; const float dv = denL[t]; Wl[t * 65 + bj0 * 16 + li] = acc0[r] * dv; Wl[t * 65 + (bj0 + 1) * 16 + li] = acc1[r] * dv; }
        __syncthreads();
        { const int t = F.tid >> 3, d0 = (F.tid & 7) * 8; float hv[8], ss = 0.f;
#pragma unroll
          for (int i = 0; i < 8; ++i) { hv[i] = Wl[t * 65 + d0 + i]; ss += hv[i] * hv[i]; }
          ss += __shfl_xor(ss, 1); ss += __shfl_xor(ss, 2); ss += __shfl_xor(ss, 4);
          const float rstd = rsqrtf(ss * (1.f / 64.f) + RMS_EPS);
          const u32x4 ov = *(const u32x4*)(P + (size_t)(c * 64 + t) * PW + C_OB + h * 64 + d0); const float* g = gn + h * 64 + d0;
          const float o0 = sigmoidf_(bflo(ov.x)), o1 = sigmoidf_(bfhi(ov.x)), o2 = sigmoidf_(bflo(ov.y)), o3 = sigmoidf_(bfhi(ov.y)), o4 = sigmoidf_(bflo(ov.z)), o5 = sigmoidf_(bfhi(ov.z)), o6 = sigmoidf_(bflo(ov.w)), o7 = sigmoidf_(bfhi(ov.w));
          u32x4 y; y.x = pk2(o0 * hv[0] * rstd * g[0], o1 * hv[1] * rstd * g[1]); y.y = pk2(o2 * hv[2] * rstd * g[2], o3 * hv[3] * rstd * g[3]);
          y.z = pk2(o4 * hv[4] * rstd * g[4], o5 * hv[5] * rstd * g[5]); y.w = pk2(o6 * hv[6] * rstd * g[6], o7 * hv[7] * rstd * g[7]);
          *(u32x4*)(Y + (size_t)(c * 64 + t) * 256 + h * 64 + d0) = y; }
    }
    __syncthreads();
}


constexpr int DSA_CAP = 2048, DSA_TRIG = 1024, QHP = 260;
__device__ __forceinline__ u32x2 ld_list(const u32x2* p) { const unsigned long long v = __hip_atomic_load((const unsigned long long*)p, __ATOMIC_RELAXED, __HIP_MEMORY_SCOPE_AGENT); return (u32x2){(unsigned)v, (unsigned)(v >> 32)}; }

__device__ __forceinline__ unsigned wave_prefix_incl(unsigned v) {
    v += (unsigned)__builtin_amdgcn_update_dpp(0, (int)v, 0x111, 0xf, 0xf, false);
    v += (unsigned)__builtin_amdgcn_update_dpp(0, (int)v, 0x112, 0xf, 0xf, false);
    v += (unsigned)__builtin_amdgcn_update_dpp(0, (int)v, 0x114, 0xf, 0xf, false);
    v += (unsigned)__builtin_amdgcn_update_dpp(0, (int)v, 0x118, 0xf, 0xf, false);
    v += (unsigned)__builtin_amdgcn_update_dpp(0, (int)v, 0x142, 0xa, 0xf, false);
    v += (unsigned)__builtin_amdgcn_update_dpp(0, (int)v, 0x143, 0xc, 0xf, false);
    return v;
}
__device__ __forceinline__ unsigned sortable(float v) { const unsigned b = __builtin_bit_cast(unsigned, v); return (b & 0x80000000u) ? ~b : (b | 0x80000000u); }
__device__ __forceinline__ unsigned lanes_below(unsigned long long m) { return __builtin_amdgcn_mbcnt_hi((unsigned)(m >> 32), __builtin_amdgcn_mbcnt_lo((unsigned)m, 0u)); }

__device__ __forceinline__ unsigned dsa_bin(unsigned sv) {
    const bool pos = (sv >> 31) != 0u; const unsigned mag = (pos ? sv : ~sv) & 0x7fffffffu; int t = (int)(mag >> 19) - 1904; t = t < 0 ? 0 : (t > 255 ? 255 : t);
    return pos ? 256u + (unsigned)t : 255u - (unsigned)t;
}
__device__ __forceinline__ unsigned dsa_bin_T(unsigned B) {
    if (B >= 257u) return (0x80000000u | ((1904u + (B - 256u)) << 19)) - 1u;
    if (B == 256u) return 0x7fffffffu;
    if (B == 0u) return 0u;
    const unsigned t = 255u - B, mag = ((1905u + t) << 19) - 1u; return (0x7fffffffu - mag) - 1u;
}
__device__ __forceinline__ unsigned dsa_hist_T(const LAS unsigned* qh, int lane) {
    const int grp = 63 - lane;
    const u32x4 h = *(const LAS u32x4*)(qh + 4 * grp);
    const unsigned c[8] = {h.x & 0xffffu, h.x >> 16, h.y & 0xffffu, h.y >> 16, h.z & 0xffffu, h.z >> 16, h.w & 0xffffu, h.w >> 16};
    unsigned tl = 0u;
#pragma unroll
    for (int i = 0; i < 8; ++i) tl += c[i];
    const unsigned suf = wave_prefix_incl(tl);
    const unsigned above = suf - tl; const bool mine = (above < 256u) && (256u <= suf);
    unsigned B = 0u;
    if (mine) { unsigned cc = above; B = 8u * grp;
#pragma unroll
        for (int i = 7; i >= 0; --i) { cc += c[i]; if (cc >= 256u) { B = 8u * grp + i; break; } } }
    const unsigned long long mm = __ballot(mine); if (!mm) return 0u;
    B = (unsigned)__builtin_amdgcn_readlane((int)B, (int)__builtin_ctzll(mm));
    return dsa_bin_T(B);
}
template <int NPASS, class KF, class PF>
__device__ __forceinline__ unsigned radix_kth(int n, KF key, PF pred, unsigned& want, LAS unsigned* hist, int lane) {
    unsigned prefix = 0u, himask = 0u;
#pragma unroll 1
    for (int p = 0; p < NPASS; ++p) {
        const int shift = 8 * (NPASS - 1 - p);
        *(LAS u32x4*)(hist + 4 * lane) = (u32x4){0u, 0u, 0u, 0u};
        asm volatile("s_waitcnt lgkmcnt(0)" ::: "memory");
#pragma unroll 4
        for (int i = lane; i < n; i += 64) { const unsigned k = key(i); if (pred(i) && ((k ^ prefix) & himask) == 0u) (void)__hip_atomic_fetch_add(hist + ((k >> shift) & 255u), 1u, __ATOMIC_RELAXED, __HIP_MEMORY_SCOPE_WORKGROUP); }
        asm volatile("s_waitcnt lgkmcnt(0)" ::: "memory");
        const int grp = 63 - lane;
        const u32x4 h = *(LAS u32x4*)(hist + 4 * grp);
        const unsigned tl = h.x + h.y + h.z + h.w; const unsigned suf = wave_prefix_incl(tl);
        const unsigned above = suf - tl;
        const bool mine = (above < want) && (want <= suf);
        unsigned D = 0u, nw = 0u;
        if (mine) { unsigned c = above;
            if (c + h.w >= want) { D = 4 * grp + 3; nw = want - c; } else { c += h.w;
            if (c + h.z >= want) { D = 4 * grp + 2; nw = want - c; } else { c += h.z;
            if (c + h.y >= want) { D = 4 * grp + 1; nw = want - c; } else { c += h.y; D = 4 * grp; nw = want - c; } } } }
        const unsigned long long mm = __ballot(mine); const int src = mm ? (int)__builtin_ctzll(mm) : 0;
        D = (unsigned)__builtin_amdgcn_readlane((int)D, src); nw = (unsigned)__builtin_amdgcn_readlane((int)nw, src);
        prefix |= D << shift; himask |= 0xffu << shift; want = nw;
    }
    return prefix;
}
__device__ __forceinline__ void dsa_prune(u32x2* list, LAS unsigned* nq, LAS unsigned* Tq, int q, LAS u32x2* st, LAS unsigned* hist, int lane, bool exact, unsigned tmin) {
    const int n0 = (int)nq[q]; int n = 0;
#pragma unroll 1
    for (int i0 = 0; i0 < n0; i0 += 256) {
        u32x2 t8[4];
#pragma unroll
        for (int u = 0; u < 4; ++u) { const int i = i0 + u * 64 + lane; t8[u] = (i < n0) ? ld_list(list + i) : (u32x2){0u, 0u}; }
#pragma unroll
        for (int u = 0; u < 4; ++u) { const int i = i0 + u * 64 + lane; const bool k = (i < n0) && t8[u].x > tmin;
            const unsigned long long m = __ballot(k); if (k) st[n + (int)lanes_below(m)] = t8[u]; n += (int)__popcll(m); } }
    asm volatile("s_waitcnt vmcnt(0) lgkmcnt(0)" ::: "memory");
    if (n <= 256) {
#pragma unroll 1
        for (int i = lane; i < n; i += 64) list[i] = st[i];
        if (lane == 0) { nq[q] = (unsigned)n; if (tmin > Tq[q]) Tq[q] = tmin; }
        asm volatile("s_waitcnt vmcnt(0)" ::: "memory");
        return;
    }
    if (!exact) {
        unsigned want = 256u;
        const unsigned Th = radix_kth<2>(n, [st](int i) { return st[i].x >> 16; }, [](int) { return true; }, want, hist, lane);
        unsigned cnt_ge = 0u;
#pragma unroll 1
        for (int i0 = 0; i0 < n; i0 += 64) { const int i = i0 + lane; cnt_ge += (unsigned)__popcll(__ballot(i < n && (st[i].x >> 16) >= Th)); }
        if (cnt_ge <= 512u && Th > 0u) {
            unsigned base = 0u;
#pragma unroll 1
            for (int i0 = 0; i0 < n; i0 += 64) { const int i = i0 + lane; const u32x2 t = (i < n) ? st[i] : (u32x2){0u, 0u};
                const bool keep = (i < n) && (t.x >> 16) >= Th;
                const unsigned long long m = __ballot(keep); if (keep) list[base + lanes_below(m)] = t; base += (unsigned)__popcll(m); }
            if (lane == 0) { nq[q] = base; const unsigned tn = (Th << 16) - 1u; Tq[q] = tn > tmin ? tn : tmin; }
            asm volatile("s_waitcnt vmcnt(0)" ::: "memory");
            return;
        }
    }
    unsigned want = 256u;
    const unsigned Ts = radix_kth<4>(n, [st](int i) { return st[i].x; }, [](int) { return true; }, want, hist, lane);
    unsigned cnt_eq = 0u;
#pragma unroll 1
    for (int i0 = 0; i0 < n; i0 += 64) { const int i = i0 + lane; cnt_eq += (unsigned)__popcll(__ballot(i < n && st[i].x == Ts)); }
    unsigned Tk = 0u;
    if (cnt_eq > want) Tk = radix_kth<2>(n, [st](int i) { return 0x3fffu - st[i].y; }, [st, Ts](int i) { return st[i].x == Ts; }, want, hist, lane);
    unsigned base = 0u;
#pragma unroll 1
    for (int i0 = 0; i0 < n; i0 += 64) { const int i = i0 + lane; const u32x2 t = (i < n) ? st[i] : (u32x2){0u, 0u};
        const bool keep = (i < n) && (t.x > Ts || (t.x == Ts && (0x3fffu - t.y) >= Tk));
        const unsigned long long m = __ballot(keep); if (keep) list[base + lanes_below(m)] = t; base += (unsigned)__popcll(m); }
    if (lane == 0) { nq[q] = base; Tq[q] = Ts; }
    asm volatile("s_waitcnt vmcnt(0)" ::: "memory");
}
__device__ __forceinline__ int dsa_final(const u32x2* list, int n0, unsigned tmin, LAS u32x2* st, LAS unsigned* hist, LAS unsigned* bmp, int lane) {
    int n = 0;
#pragma unroll 1
    for (int i0 = 0; i0 < n0; i0 += 512) {
        u32x4 t4[4];
#pragma unroll
        for (int u = 0; u < 4; ++u) { const int i = i0 + u * 128 + 2 * lane; t4[u] = (i < n0) ? *(const u32x4*)(list + i) : (u32x4){0u, 0u, 0u, 0u}; }
#pragma unroll
        for (int u = 0; u < 4; ++u) { const int i = i0 + u * 128 + 2 * lane;
            { const bool k = (i < n0) && t4[u].x > tmin; const unsigned long long m = __ballot(k); if (k) st[n + (int)lanes_below(m)] = (u32x2){t4[u].x, t4[u].y}; n += (int)__popcll(m); }
            { const bool k = (i + 1 < n0) && t4[u].z > tmin; const unsigned long long m = __ballot(k); if (k) st[n + (int)lanes_below(m)] = (u32x2){t4[u].z, t4[u].w}; n += (int)__popcll(m); } }
    }
    asm volatile("s_waitcnt lgkmcnt(0)" ::: "memory");
    unsigned Ts = 0u, Tk = 0u;
    if (n > 256) {
        unsigned want = 256u;
        Ts = radix_kth<4>(n, [st](int i) { return st[i].x; }, [](int) { return true; }, want, hist, lane);
        unsigned cnt_eq = 0u;
#pragma unroll 1
        for (int i0 = 0; i0 < n; i0 += 64) { const int i = i0 + lane; cnt_eq += (unsigned)__popcll(__ballot(i < n && st[i].x == Ts)); }
        if (cnt_eq > want) Tk = radix_kth<2>(n, [st](int i) { return 0x3fffu - st[i].y; }, [st, Ts](int i) { return st[i].x == Ts; }, want, hist, lane);
    }
    int cnt = 0;
#pragma unroll 1
    for (int i0 = 0; i0 < n; i0 += 64) { const int i = i0 + lane; const u32x2 t = (i < n) ? st[i] : (u32x2){0u, 0u};
        const bool keep = (i < n) && (n <= 256 || t.x > Ts || (t.x == Ts && (0x3fffu - t.y) >= Tk));
        if (keep) (void)__hip_atomic_fetch_or(bmp + (t.y >> 5), 1u << (t.y & 31u), __ATOMIC_RELAXED, __HIP_MEMORY_SCOPE_WORKGROUP);
        cnt += (int)__popcll(__ballot(keep)); }
    asm volatile("s_waitcnt lgkmcnt(0)" ::: "memory");
    return cnt;
}
__device__ __forceinline__ void dsa_unit(Frame& F, int G32) {
    const bf16* P = (const bf16*)(F.ws + WS_PU);
    bf16* Y = (bf16*)(F.ws + WS_Y);
    u32x2* cand = (u32x2*)(F.ws + WS_CAND) + (size_t)F.bid * 32 * DSA_CAP;
    const int lane = F.lane, w = F.wave, r = lane & 31, hh = lane >> 5;
    LAS unsigned char* wscr = F.lds + w * 12288;
    LAS unsigned* Tq = (LAS unsigned*)(F.lds + 98304); LAS unsigned* nq = Tq + 32;
    LAS unsigned* hist = (LAS unsigned*)(F.lds + 98816 + w * 1024);
    LAS unsigned* qhist = (LAS unsigned*)(F.lds + 107008);
    const int q0 = G32 * 32, c = G32 >> 1, nt = c + 1, nrounds = (nt + 7) >> 3;
    __syncthreads();
    if (F.tid < 32) { Tq[F.tid] = 0u; nq[F.tid] = 0u; nq[32 + F.tid] = 0u; nq[64 + F.tid] = 0u; }
#pragma unroll
    for (int k = 0; k < 4; ++k) *(LAS u32x4*)(qhist + F.tid * 4 + k * 2048) = (u32x4){0u, 0u, 0u, 0u};
    if (F.tid < 32) *(LAS u32x4*)(qhist + 8192 + F.tid * 4) = (u32x4){0u, 0u, 0u, 0u};
    bf16x8 Qf[4][2]; float wh[4];
    { const bf16* qp = P + (size_t)(q0 + r) * PW;
#pragma unroll
      for (int h = 0; h < 4; ++h) { wh[h] = bf2f(qp[C_WI + h]);
#pragma unroll
          for (int kk = 0; kk < 2; ++kk) Qf[h][kk] = *(const bf16x8*)(qp + C_QI + h * 32 + kk * 16 + 8 * hh); } }
    bf16x8 Kf[2][2];
    { const int jf = (nrounds - (nrounds < 4 ? nrounds : 4)) * 8 + w; const int j0 = jf < nt ? jf : 0;
#pragma unroll
      for (int kb = 0; kb < 2; ++kb)
#pragma unroll
          for (int kk = 0; kk < 2; ++kk) Kf[kb][kk] = *(const bf16x8*)(P + (size_t)(j0 * 64 + kb * 32 + r) * PW + C_KI + kk * 16 + 8 * hh); }
    __syncthreads();
    LAS unsigned* nlast = nq + 32;
    const int R0 = nrounds < 4 ? nrounds : 4, nvr = nrounds + R0;
    for (int vr = 0; vr < nvr; ++vr) {
        const int rd = vr < R0 ? nrounds - R0 + vr : vr - R0;
        const int mode = vr < R0 ? 0 : (rd >= nrounds - R0 ? 2 : 1);
        const int j = rd * 8 + w;
        int rr = r; asm volatile("" : "+v"(rr));
        u32x2* myl = cand + (size_t)rr * DSA_CAP;
        if (j < nt) {
            f32x16 acc[2];
#pragma unroll
            for (int h = 0; h < 4; ++h)
#pragma unroll
                for (int kb = 0; kb < 2; ++kb) { f32x16 sv;
#pragma unroll
                    for (int i = 0; i < 16; ++i) sv[i] = 0.f;
                    sv = __builtin_amdgcn_mfma_f32_32x32x16_bf16(Kf[kb][0], Qf[h][0], sv, 0, 0, 0); sv = __builtin_amdgcn_mfma_f32_32x32x16_bf16(Kf[kb][1], Qf[h][1], sv, 0, 0, 0);
#pragma unroll
                    for (int i = 0; i < 16; ++i) { const float rl = __builtin_amdgcn_fmed3f(sv[i], 0.f, __builtin_inff()); acc[kb][i] = (h == 0) ? (wh[0] * rl + 0.f) : fmaf(wh[h], rl, acc[kb][i]); } }
            const unsigned T = mode ? Tq[rr] : 0xffffffffu;
            LAS unsigned* myv = (LAS unsigned*)wscr + lane * 36;
            unsigned pm = 0u;
#pragma unroll
            for (int kb = 0; kb < 2; ++kb)
#pragma unroll
                for (int g = 0; g < 4; ++g) { u32x4 v4;
                    v4.x = sortable(acc[kb][4 * g]); v4.y = sortable(acc[kb][4 * g + 1]); v4.z = sortable(acc[kb][4 * g + 2]); v4.w = sortable(acc[kb][4 * g + 3]);
                    pm |= (v4.x > T ? 1u : 0u) << (kb * 16 + 4 * g) | (v4.y > T ? 2u : 0u) << (kb * 16 + 4 * g) | (v4.z > T ? 4u : 0u) << (kb * 16 + 4 * g) | (v4.w > T ? 8u : 0u) << (kb * 16 + 4 * g);
                    *(LAS u32x4*)(myv + kb * 16 + 4 * g) = v4;
                    if (mode == 0) { const unsigned b0 = dsa_bin(v4.x), b1 = dsa_bin(v4.y), b2 = dsa_bin(v4.z), b3 = dsa_bin(v4.w); LAS unsigned* qh = qhist + rr * QHP;
                        (void)__hip_atomic_fetch_add(qh + (b0 >> 1), 1u << (16u * (b0 & 1u)), __ATOMIC_RELAXED, __HIP_MEMORY_SCOPE_WORKGROUP); (void)__hip_atomic_fetch_add(qh + (b1 >> 1), 1u << (16u * (b1 & 1u)), __ATOMIC_RELAXED, __HIP_MEMORY_SCOPE_WORKGROUP);
                        (void)__hip_atomic_fetch_add(qh + (b2 >> 1), 1u << (16u * (b2 & 1u)), __ATOMIC_RELAXED, __HIP_MEMORY_SCOPE_WORKGROUP); (void)__hip_atomic_fetch_add(qh + (b3 >> 1), 1u << (16u * (b3 & 1u)), __ATOMIC_RELAXED, __HIP_MEMORY_SCOPE_WORKGROUP); } }
            asm volatile("s_waitcnt lgkmcnt(0)" ::: "memory");
            if (__any(pm != 0u)) {
                unsigned pos1 = 0u;
                if (pm) pos1 = __hip_atomic_fetch_add(nq + rr, (unsigned)__popc(pm), __ATOMIC_RELAXED, __HIP_MEMORY_SCOPE_WORKGROUP);
                while (__any(pm != 0u)) {
                    if (pm) { const int e = __builtin_ctz(pm); pm &= pm - 1u; const unsigned sv1 = myv[e];
                        if (mode == 1) { const unsigned bn = dsa_bin(sv1); (void)__hip_atomic_fetch_add(qhist + rr * QHP + (bn >> 1), 1u << (16u * (bn & 1u)), __ATOMIC_RELAXED, __HIP_MEMORY_SCOPE_WORKGROUP); }
                        myl[pos1++] = (u32x2){sv1, (unsigned)(j * 64 + (e >> 4) * 32 + (e & 3) + 8 * ((e & 15) >> 2) + 4 * hh)}; }
                }
            }
        }
        { const int nv = vr + 1, nrd = nv < R0 ? nrounds - R0 + nv : nv - R0; int jn = nrd * 8 + w; if (jn >= nt || nv >= nvr) jn = (j < nt ? j : 0);
#pragma unroll
          for (int kb = 0; kb < 2; ++kb)
#pragma unroll
              for (int kk = 0; kk < 2; ++kk) Kf[kb][kk] = *(const bf16x8*)(P + (size_t)(jn * 64 + kb * 32 + r) * PW + C_KI + kk * 16 + 8 * hh); }
        LAS unsigned* oflag = nq + 64;
#pragma unroll 1
        for (int qq = 0; qq < 4; ++qq) { const int q = w * 4 + qq; const unsigned n = nq[q];
            if (n > (unsigned)DSA_TRIG) { if (lane == 0) oflag[0] = 1u; continue; }
            if (mode == 1 && n < nlast[q] + 48u) continue;
            if (lane == 0) nlast[q] = n;
            const unsigned Th = dsa_hist_T(qhist + q * QHP, lane);
            if (lane == 0 && Th > Tq[q]) Tq[q] = Th; }
        __syncthreads();
        if (oflag[0]) {
            asm volatile("s_waitcnt vmcnt(0)" ::: "memory");
            __syncthreads();
#pragma unroll 1
            for (int qq = 0; qq < 4; ++qq) { const int q = w * 4 + qq; const unsigned n = nq[q];
                if (n > (unsigned)DSA_TRIG) {
                    const unsigned Th = dsa_hist_T(qhist + q * QHP, lane);
                    dsa_prune(cand + (size_t)q * DSA_CAP, nq, Tq, q, (LAS u32x2*)wscr, hist, lane, false, Th > Tq[q] ? Th : Tq[q]);
                    const int n2 = (int)nq[q]; LAS unsigned* qh = qhist + q * QHP;
                    *(LAS u32x4*)(qh + 4 * lane) = (u32x4){0u, 0u, 0u, 0u};
                    asm volatile("s_waitcnt lgkmcnt(0)" ::: "memory");
#pragma unroll 1
                    for (int i = lane; i < n2; i += 64) { const unsigned bn = dsa_bin(ld_list(cand + (size_t)q * DSA_CAP + i).x); (void)__hip_atomic_fetch_add(qh + (bn >> 1), 1u << (16u * (bn & 1u)), __ATOMIC_RELAXED, __HIP_MEMORY_SCOPE_WORKGROUP); }
                    __builtin_amdgcn_fence(__ATOMIC_ACQUIRE, "agent");
                    asm volatile("s_waitcnt vmcnt(0) lgkmcnt(0)" ::: "memory");
                    if (lane == 0) nlast[q] = (unsigned)n2;
                } }
            __syncthreads();
            if (F.tid == 0) oflag[0] = 0u;
            __syncthreads();
        }
    }
    asm volatile("s_waitcnt vmcnt(0)" ::: "memory");
    __syncthreads();
#pragma unroll 1
    for (int qq = 0; qq < 4; ++qq) { const int q = w * 4 + qq; const unsigned Th = dsa_hist_T(qhist + q * QHP, lane); if (lane == 0 && Th > Tq[q]) Tq[q] = Th; }
    __syncthreads();
#pragma unroll 1
    for (int qq = 0; qq < 4; ++qq) {
        const int q = w * 4 + qq, qrow = q0 + q; const int n0 = (int)nq[q];
        LAS unsigned* bmp = (LAS unsigned*)(F.lds + 107008 + w * 2048);
        *(LAS u32x4*)(bmp + 8 * lane) = (u32x4){0u, 0u, 0u, 0u}; *(LAS u32x4*)(bmp + 8 * lane + 4) = (u32x4){0u, 0u, 0u, 0u};
        asm volatile("s_waitcnt lgkmcnt(0)" ::: "memory");
        const int n = dsa_final(cand + (size_t)q * DSA_CAP, n0, n0 > 256 ? Tq[q] : 0u, (LAS u32x2*)wscr, hist, bmp, lane);
        unsigned short* srow = (unsigned short*)(F.ws + WS_SEL) + (size_t)qrow * 256;
        { const u32x4 b0 = *(LAS u32x4*)(bmp + 8 * lane), b1 = *(LAS u32x4*)(bmp + 8 * lane + 4); const unsigned wd[8] = {b0.x, b0.y, b0.z, b0.w, b1.x, b1.y, b1.z, b1.w};
          unsigned cnt = 0u;
#pragma unroll
          for (int i = 0; i < 8; ++i) cnt += (unsigned)__popc(wd[i]);
          unsigned pos = wave_prefix_incl(cnt) - cnt;
#pragma unroll
          for (int i = 0; i < 8; ++i) { unsigned wv = wd[i]; while (wv) { const int bpos = __builtin_ctz(wv); srow[pos++] = (unsigned short)(lane * 256 + i * 32 + bpos); wv &= wv - 1u; } } }
        if (lane == 0) ((int*)(F.ws + WS_NSEL))[qrow] = n;
    }
    asm volatile("s_waitcnt vmcnt(0)" ::: "memory");
}
__device__ __forceinline__ void dsa_pack_phase(Frame& F) {
    const bf16* P = (const bf16*)(F.ws + WS_PU); unsigned char* T8 = F.ws + WS_KV8;
    for (int t = F.bid * 512 + F.tid; t < S * 32; t += F.G * 512) {
        const int row = t >> 5, ch = t & 31;
        const bf16* src = P + (size_t)row * PW + C_KA + ch * 16;
        const u32x4 a0 = *(const u32x4*)src, a1 = *(const u32x4*)(src + 8);
        u32x4 o; int v;
        v = __builtin_amdgcn_cvt_pk_fp8_f32(bflo(a0.x), bfhi(a0.x), 0, false); v = __builtin_amdgcn_cvt_pk_fp8_f32(bflo(a0.y), bfhi(a0.y), v, true); o.x = (unsigned)v;
        v = __builtin_amdgcn_cvt_pk_fp8_f32(bflo(a0.z), bfhi(a0.z), 0, false); v = __builtin_amdgcn_cvt_pk_fp8_f32(bflo(a0.w), bfhi(a0.w), v, true); o.y = (unsigned)v;
        v = __builtin_amdgcn_cvt_pk_fp8_f32(bflo(a1.x), bfhi(a1.x), 0, false); v = __builtin_amdgcn_cvt_pk_fp8_f32(bflo(a1.y), bfhi(a1.y), v, true); o.z = (unsigned)v;
        v = __builtin_amdgcn_cvt_pk_fp8_f32(bflo(a1.z), bfhi(a1.z), 0, false); v = __builtin_amdgcn_cvt_pk_fp8_f32(bflo(a1.w), bfhi(a1.w), v, true); o.w = (unsigned)v;
        *(u32x4*)(T8 + (size_t)row * 512 + ch * 16) = o;
    }
}
__device__ __forceinline__ void dsa_sparse_unit(Frame& F, int G32) {
    const bf16* P = (const bf16*)(F.ws + WS_PU); bf16* Y = (bf16*)(F.ws + WS_Y);
    const int lane = F.lane, w = F.wave, q0 = G32 * 32;
#pragma unroll 1
    for (int qq = 0; qq < 4; ++qq) {
        int l2 = lane; asm volatile("" : "+v"(l2)); const int ks = l2 >> 4, dg = l2 & 15;
        const int q = w * 4 + qq, qrow = q0 + q; const int n = ((const int*)(F.ws + WS_NSEL))[qrow];
        LAS unsigned short* srt = (LAS unsigned short*)(F.lds + w * 1024 + (qq & 1) * 512);
        { const unsigned long long* g8 = (const unsigned long long*)((const unsigned short*)(F.ws + WS_SEL) + (size_t)qrow * 256); ((LAS unsigned long long*)srt)[lane] = g8[lane]; }
        asm volatile("s_waitcnt vmcnt(0) lgkmcnt(0)" ::: "memory");
        float qv[16];
        { const u32x4 a0 = *(const u32x4*)(P + (size_t)qrow * PW + C_QA + dg * 16), a1 = *(const u32x4*)(P + (size_t)qrow * PW + C_QA + dg * 16 + 8); const float sc = 0.125f * 1.4426950408889634f;
          qv[0] = bflo(a0.x) * sc; qv[1] = bfhi(a0.x) * sc; qv[2] = bflo(a0.y) * sc; qv[3] = bfhi(a0.y) * sc; qv[4] = bflo(a0.z) * sc; qv[5] = bfhi(a0.z) * sc; qv[6] = bflo(a0.w) * sc; qv[7] = bfhi(a0.w) * sc;
          qv[8] = bflo(a1.x) * sc; qv[9] = bfhi(a1.x) * sc; qv[10] = bflo(a1.y) * sc; qv[11] = bfhi(a1.y) * sc; qv[12] = bflo(a1.z) * sc; qv[13] = bfhi(a1.z) * sc; qv[14] = bflo(a1.w) * sc; qv[15] = bfhi(a1.w) * sc; }
        float mrun = -1e30f, lrun = 0.f, o[16];
#pragma unroll
        for (int i = 0; i < 16; ++i) o[i] = 0.f;
        const int nb = (n + 31) >> 5;
        const unsigned char* T8 = F.ws + WS_KV8 + dg * 16;
#pragma unroll 1
        for (int bt = 0; bt < nb; ++bt) {
            u32x4 kk[8], vv[8]; bool val[8];
#pragma unroll
            for (int t = 0; t < 8; ++t) { const int jn = bt * 32 + t * 4 + ks; val[t] = jn < n; const unsigned idx = val[t] ? (unsigned)srt[jn] : 0u;
                const unsigned char* kp = T8 + (size_t)idx * 512; kk[t] = *(const u32x4*)kp; vv[t] = *(const u32x4*)(kp + 256); }
#pragma unroll
            for (int t = 0; t < 8; ++t) {
                float d = 0.f;
#pragma unroll
                for (int c4 = 0; c4 < 4; ++c4) { const int wd = (int)kk[t][c4]; const f32x2 lo = __builtin_amdgcn_cvt_pk_f32_fp8(wd, false), hi = __builtin_amdgcn_cvt_pk_f32_fp8(wd, true);
                    d = fmaf(qv[4 * c4], lo.x, d); d = fmaf(qv[4 * c4 + 1], lo.y, d); d = fmaf(qv[4 * c4 + 2], hi.x, d); d = fmaf(qv[4 * c4 + 3], hi.y, d); }
                d += __builtin_bit_cast(float, __builtin_amdgcn_update_dpp(0, __builtin_bit_cast(int, d), 0xB1, 0xf, 0xf, false));
                d += __builtin_bit_cast(float, __builtin_amdgcn_update_dpp(0, __builtin_bit_cast(int, d), 0x4E, 0xf, 0xf, false));
                if (!val[t]) d = -1e30f;
                if (__any(d > mrun + 8.f)) { const float mn = fmaxf(mrun, d), al = __builtin_amdgcn_exp2f(mrun - mn); mrun = mn; lrun *= al;
#pragma unroll
                    for (int i = 0; i < 16; ++i) o[i] *= al; }
                const float p = val[t] ? __builtin_amdgcn_exp2f(d - mrun) : 0.f; lrun += p;
#pragma unroll
                for (int c4 = 0; c4 < 4; ++c4) { const int wd = (int)vv[t][c4]; const f32x2 lo = __builtin_amdgcn_cvt_pk_f32_fp8(wd, false), hi = __builtin_amdgcn_cvt_pk_f32_fp8(wd, true);
                    o[4 * c4] = fmaf(p, lo.x, o[4 * c4]); o[4 * c4 + 1] = fmaf(p, lo.y, o[4 * c4 + 1]); o[4 * c4 + 2] = fmaf(p, hi.x, o[4 * c4 + 2]); o[4 * c4 + 3] = fmaf(p, hi.y, o[4 * c4 + 3]); }
            }
        }
        { float ma = fmaxf(mrun, __shfl_xor(mrun, 16)); ma = fmaxf(ma, __shfl_xor(ma, 32)); const float al = __builtin_amdgcn_exp2f(mrun - ma);
          lrun *= al; lrun += __shfl_xor(lrun, 16); lrun += __shfl_xor(lrun, 32); const float iv = 1.f / lrun;
#pragma unroll
          for (int i = 0; i < 16; ++i) { float t = o[i] * al; t += __shfl_xor(t, 16); t += __shfl_xor(t, 32); o[i] = t * iv; } }
        if (ks == 0) { u32x4 y0, y1; y0.x = pk2(o[0], o[1]); y0.y = pk2(o[2], o[3]); y0.z = pk2(o[4], o[5]); y0.w = pk2(o[6], o[7]); y1.x = pk2(o[8], o[9]); y1.y = pk2(o[10], o[11]); y1.z = pk2(o[12], o[13]); y1.w = pk2(o[14], o[15]);
            *(u32x4*)(Y + (size_t)qrow * 256 + dg * 16) = y0; *(u32x4*)(Y + (size_t)qrow * 256 + dg * 16 + 8) = y1; }
    }
}
__device__ __forceinline__ void dsa_phase(Frame& F) {
#pragma unroll 1
    for (int i2 = F.bid * 2; i2 < 512; i2 += F.G * 2)
#pragma unroll 1
        for (int rep = 0; rep < 2; ++rep) dsa_unit(F, rep ? 511 - (i2 >> 1) : (i2 >> 1));
    __syncthreads();
}
__device__ __forceinline__ void dsa_sparse_phase(Frame& F) {
#pragma unroll 1
    for (int i2 = F.bid * 2; i2 < 512; i2 += F.G * 2)
#pragma unroll 1
        for (int rep = 0; rep < 2; ++rep) dsa_sparse_unit(F, rep ? 511 - (i2 >> 1) : (i2 >> 1));
}

__device__ __forceinline__ void phase_mixers_stub(Frame& F) {
    u32x4* y = (u32x4*)(F.ws + WS_Y); const size_t n = (size_t)1 * S * 256 * 2 / 16;
    for (size_t i = (size_t)F.bid * 512 + F.tid; i < n; i += (size_t)F.G * 512) y[i] = (u32x4){0u, 0u, 0u, 0u};
}

__device__ __forceinline__ Frame mkframe() {
    Frame F; int t = threadIdx.x; asm volatile("" : "+v"(t));
    extern __shared__ __attribute__((aligned(16))) unsigned char lds_raw[];
    F.lds = (LAS unsigned char*)lds_raw; F.ws = kargs()->ws; F.ctl = (unsigned*)(F.ws + WS_CTL);
    F.tid = t; F.lane = t & 63; F.wave = __builtin_amdgcn_readfirstlane(t >> 6); F.G = gridDim.x; F.bid = blockIdx.x;
    return F;
}
__device__ __forceinline__ void grid_barrier() {
    extern __shared__ __attribute__((aligned(16))) unsigned char lds_raw[];
    XcdBarrier b; b.bar = (unsigned*)(kargs()->ws + WS_CTL) + CW_BAR; b.x = xb_xcc_id(); b.st = (volatile LAS unsigned*)((LAS unsigned char*)lds_raw + MISC_OFF) + 8;
    xcd_barrier(b);
}
constexpr int NSEG = 14;
#ifndef SEGMASK
#define SEGMASK 0xffff
#endif
template <int l> __device__ __forceinline__ void layer_body() {
#if MK_MULTI
#define RUN(k) (((SEGMASK >> (k)) & 1) && (l * NSEG + (k)) >= kargs()->seg_lo && (l * NSEG + (k)) < kargs()->seg_hi)
#define SEAM(k) do { } while (0)
#else
#define RUN(k) ((SEGMASK >> (k)) & 1)
#define SEAM(k) grid_barrier()
#endif
    {
        if (RUN(0) && l == 0) {
            Frame F = mkframe();
            phase_convert(F, l);
            if (l == 0) { const int gw = F.bid * 8 + F.wave, NGW = F.G * 8; const float* x0 = kargs()->in[0]; const float* g0 = kargs()->in[1];
#pragma unroll 2
                for (int m = gw; m < S; m += NGW) rms_row_to_bf16(x0 + (size_t)m * D, g0, (bf16*)(F.ws + WS_H) + (size_t)m * D, F.lane); }
        }
        if (l == 0) SEAM(0);
        if (RUN(1)) {
            Frame F = mkframe();
            pg8::Gemm g{(const bf16*)(F.ws + WS_H), (const bf16*)(F.ws + WS_WIN), S, PW, 1024}; pg8::StaticOrder So; So.init(S, PW, F.G, F.bid);
            pg8::EpiStore E{(bf16*)(F.ws + WS_PU), PW, 0x7fffffff, F.ws + WS_KV8};
            pg8::gemm_phase<pg8::EpiStore, pg8::StaticOrder, true, true>(F.lds, g, So, E, F.tid);
        }
        SEAM(1);
        if (RUN(2)) { Frame F = mkframe(); ml_phase1(F, l); }
        if (RUN(2)) { Frame F = mkframe(); attn_phase<0>(F, l); }
        SEAM(2);
        if (RUN(3)) { Frame F = mkframe(); ml_phase3(F, l); }
        if (RUN(3)) { Frame F = mkframe(); attnD_phase(F, l); }
        SEAM(3);
        if (RUN(4)) { Frame F = mkframe(); ml_phase4(F); }
        if (RUN(4)) { Frame F = mkframe(); dsa_phase(F); }
        if (RUN(4)) { Frame F = mkframe(); dsa_sparse_phase(F); }
        SEAM(4);
        if (RUN(5)) { Frame F = mkframe(); ml_phase5(F, l); }
        SEAM(5);
        if (RUN(6)) {
            Frame F = mkframe();
            pg8::Gemm g{(const bf16*)(F.ws + WS_Y), (const bf16*)(F.ws + WS_WBR), 4 * S, 4096, 256}; pg8::SchedUp Su{F.G, F.bid};
            pg8::EpiStore E{(bf16*)(F.ws + WS_PU), 4096, 63, nullptr};
            pg8::gemm_phase<pg8::EpiStore, pg8::SchedUp, true, true>(F.lds, g, Su, E, F.tid);
        }
        SEAM(6);
        if (RUN(7)) {
            Frame F = mkframe();
            pg8::Gemm g{(const bf16*)(F.ws + WS_H), (const bf16*)(F.ws + WS_WGATE), S, 4096, 1024}; pg8::StaticOrder So; So.init(S, 4096, F.G, F.bid);
            pg8::EpiGateMix E{(const bf16*)(F.ws + WS_PU), (bf16*)(F.ws + WS_MIXED)};
            pg8::gemm_phase<pg8::EpiGateMix, pg8::StaticOrder, true, true>(F.lds, g, So, E, F.tid);
        }
        SEAM(7);
        if (RUN(8)) {
            Frame F = mkframe();
            pg8::Gemm g{(const bf16*)(F.ws + WS_MIXED), (const bf16*)(F.ws + WS_WOUT), S, 1024, 1024}; pg8::StaticOrder So; So.init(S, 1024, F.G, F.bid);
            float* xo = kargs()->out;
            pg8::EpiResid E{(l == 0) ? kargs()->in[0] : (const float*)xo, xo};
            pg8::gemm_phase<pg8::EpiResid, pg8::StaticOrder, true, true>(F.lds, g, So, E, F.tid);
        }
        SEAM(8);
        if (RUN(9)) { Frame F = mkframe(); phase_router(F, l, kargs()->out); }
        SEAM(9);
        if (RUN(10)) { Frame F = mkframe(); phase_scatter(F, l); }
        SEAM(10);
        if (RUN(11)) {
            Frame F = mkframe();
            moe_table(F, l); const LAS int* tab = (const LAS int*)(F.lds + LDSCTL_OFF);
            pg8::Gemm g{(const bf16*)(F.ws + WS_XS), (const bf16*)(F.ws + WS_W13), NRMAX, NE * 1024, 1024}; pg8::SchedMoe Sm{F.G, F.bid, __builtin_amdgcn_readfirstlane(tab[224]) * 4, tab};
            pg8::EpiSwiglu E{(bf16*)(F.ws + WS_ACT)};
            pg8::gemm_phase<pg8::EpiSwiglu, pg8::SchedMoe, true, true>(F.lds, g, Sm, E, F.tid);
        }
        SEAM(11);
        if (RUN(12)) {
            Frame F = mkframe();
            moe_table(F, l); const LAS int* tab = (const LAS int*)(F.lds + LDSCTL_OFF);
            pg8::Gemm g{(const bf16*)(F.ws + WS_ACT), (const bf16*)(F.ws + WS_W2), NRMAX, NE * 1024, FE}; pg8::SchedMoe Sm{F.G, F.bid, __builtin_amdgcn_readfirstlane(tab[224]) * 4, tab};
            pg8::EpiDown E{(bf16*)(F.ws + WS_YE), (const float*)(F.ws + WS_RT + 393216)};
            pg8::gemm_phase<pg8::EpiDown, pg8::SchedMoe, true, true>(F.lds, g, Sm, E, F.tid);
        }
        SEAM(12);
        if (RUN(13)) { Frame F = mkframe(); phase_combine(F, l, kargs()->out); }
        if (RUN(13) && l + 1 < NL) { Frame F = mkframe(); phase_convert(F, l + 1); }
        if (l + 1 < NL) SEAM(13);
    }
#undef RUN
#undef SEAM
}
__global__ void __launch_bounds__(512, 2) fwd_kernel(Args args) {
    extern __shared__ __attribute__((aligned(16))) unsigned char lds_raw[];
    {
        LAS unsigned char* lds = (LAS unsigned char*)lds_raw;
        for (int u = threadIdx.x; u < (LDS_BYTES - LDSCTL_OFF) / 4; u += 512) ((LAS unsigned*)(lds + LDSCTL_OFF))[u] = 0u;
        __syncthreads();
        if (!MK_MULTI) (void)xcd_barrier_post((unsigned*)(kargs()->ws + WS_CTL) + CW_BAR, (volatile LAS unsigned*)(lds + MISC_OFF) + 8);
    }
    layer_body<0>();
    layer_body<1>();
}

extern "C" void kernel_launch(void* const* d_in, const int* in_sizes, int n_in, void* d_out, int out_size, void* d_ws, size_t ws_size, hipStream_t stream) {
    static int grid = 0;
    if (grid == 0) {
        if (n_in != 23 || out_size != S * D || ws_size < WS_END) { fprintf(stderr, "kernel_launch: unexpected shapes (n_in %d out %d ws %zu need %zu)\n", n_in, out_size, ws_size, (size_t)WS_END); grid = -1; return; }
        int dev = 0, cus = 0, per_cu = 0;
        if (hipGetDevice(&dev) != hipSuccess || hipDeviceGetAttribute(&cus, hipDeviceAttributeMultiprocessorCount, dev) != hipSuccess) { grid = -1; return; }
        if (hipFuncSetAttribute((const void*)fwd_kernel, hipFuncAttributeMaxDynamicSharedMemorySize, LDS_BYTES) != hipSuccess) { fprintf(stderr, "kernel_launch: hipFuncSetAttribute failed\n"); grid = -1; return; }
        if (hipOccupancyMaxActiveBlocksPerMultiprocessor(&per_cu, (const void*)fwd_kernel, 512, LDS_BYTES) != hipSuccess || per_cu < 1) fprintf(stderr, "kernel_launch: occupancy query says %d\n", per_cu);
        (void)hipGetLastError();
        grid = cus;
    }
    if (grid < 0) return;
    if (hipMemsetAsync((char*)d_ws + WS_CTL, 0, CTL_ZERO_BYTES, stream) != hipSuccess) return;
    Args a{};
    for (int i = 0; i < 23; ++i) a.in[i] = (const float*)d_in[i];
    a.out = (float*)d_out; a.ws = (unsigned char*)d_ws;
#if MK_MULTI
    for (int s = 0; s < NL * NSEG; ++s) { a.seg_lo = s; a.seg_hi = s + 1; hipLaunchKernelGGL(fwd_kernel, dim3(grid), dim3(512), LDS_BYTES, stream, a); }
#else
    a.seg_lo = 0; a.seg_hi = NL * NSEG;
    hipLaunchKernelGGL(fwd_kernel, dim3(grid), dim3(512), LDS_BYTES, stream, a);
#endif
}
```

```cpp
#include <hip/hip_runtime.h>
#include <cstdio>
#include <cstdint>

#define GAS __attribute__((address_space(1)))
#define LAS __attribute__((address_space(3)))
typedef unsigned short bf16;
typedef short bf16x8 __attribute__((ext_vector_type(8)));
typedef short s16x4 __attribute__((ext_vector_type(4)));
typedef float f32x2 __attribute__((ext_vector_type(2)));
typedef float f32x4 __attribute__((ext_vector_type(4)));
typedef float f32x16 __attribute__((ext_vector_type(16)));
typedef unsigned u32x2 __attribute__((ext_vector_type(2)));
typedef unsigned u32x4 __attribute__((ext_vector_type(4)));

#ifndef MK_MULTI
#define MK_MULTI 0
#endif

constexpr int S = 16384, D = 1024, NL = 2, NCH = 256;
constexpr int PW = 3584;
constexpr int C_QA = 0, C_KA = 256, C_VA = 512, C_QI = 768, C_KI = 896, C_WI = 928, C_IB = 932, C_FB = 936, C_QB = 960, C_KB = 1216,
              C_VB = 1472, C_OB = 1728, C_QC = 1984, C_KC = 2240, C_VC = 2496, C_QD = 2752, C_KD = 3008, C_VD = 3264;
constexpr int CIN = 3500;
constexpr int NE = 32, FE = 512, NRMAX = 40960, NBMAX = 160;
constexpr float RMS_EPS = 1e-6f;

constexpr size_t MiB = 1u << 20;
constexpr size_t WS_CTL = 0, CTL_ZERO_BYTES = 1 * MiB;
constexpr size_t WS_WIN = 1 * MiB;
constexpr size_t WS_WBR = WS_WIN + 7 * MiB;
constexpr size_t WS_WGATE = WS_WBR + 2 * MiB;
constexpr size_t WS_WOUT = WS_WGATE + 8 * MiB;
constexpr size_t WS_W13 = WS_WOUT + 2 * MiB;
constexpr size_t WS_W2 = WS_W13 + 64 * MiB;
constexpr size_t WS_H = WS_W2 + 32 * MiB;
constexpr size_t WS_PU = WS_H + 32 * MiB;
constexpr size_t WS_XS = WS_PU;
constexpr size_t WS_ACT = WS_PU + 80 * MiB;
constexpr size_t WS_Y = WS_PU + 128 * MiB;
constexpr size_t WS_MIXED = WS_Y + 32 * MiB;
constexpr size_t WS_CAND = WS_MIXED + 32 * MiB;
constexpr size_t WS_YE = WS_Y;
constexpr size_t WS_MLC = WS_CAND + 128 * MiB;
constexpr size_t WS_MLN = WS_MLC + 16 * MiB;
constexpr size_t WS_MLS = WS_MLN + 256 * 1024;
constexpr size_t WS_RT = WS_MLS + 64 * 1024;
constexpr size_t WS_SEL = WS_RT + 1 * MiB;
constexpr size_t WS_NSEL = WS_SEL + 8 * MiB;
constexpr size_t WS_KV8 = WS_NSEL + 1 * MiB;
constexpr size_t WS_END = WS_KV8 + 8 * MiB;
static_assert(WS_YE + (size_t)NRMAX * 1024 * 2 <= WS_MLC, "ye overlay");
static_assert(WS_ACT + (size_t)NRMAX * 512 * 2 <= WS_Y, "act overlay");
constexpr int CW_BAR = 4096;
constexpr int CW_CNT = 16384;
constexpr int CW_FILL = 16384 + 64;

constexpr int RING_BYTES = 131072;
constexpr int LDS_BYTES = 163840;
constexpr int LDSCTL_OFF = LDS_BYTES - 2048;
constexpr int MISC_OFF = LDSCTL_OFF + 1024;

__device__ __forceinline__ unsigned f2bf(float f) { unsigned u = __builtin_bit_cast(unsigned, f); return (u + 0x7fffu + ((u >> 16) & 1u)) >> 16; }
__device__ __forceinline__ unsigned pk2(float lo, float hi) { return f2bf(lo) | (f2bf(hi) << 16); }
__device__ __forceinline__ float bflo(unsigned w) { return __builtin_bit_cast(float, w << 16); }
__device__ __forceinline__ float bfhi(unsigned w) { return __builtin_bit_cast(float, w & 0xffff0000u); }
__device__ __forceinline__ float bf2f(bf16 b) { return __builtin_bit_cast(float, (unsigned)b << 16); }
#define LDS_WAIT() asm volatile("s_waitcnt lgkmcnt(0)" ::: "memory")
#define VM_WAIT() asm volatile("s_waitcnt vmcnt(0)" ::: "memory")
__device__ __forceinline__ float wave_sum(float v) {
#pragma unroll
    for (int o = 1; o < 64; o <<= 1) v += __shfl_xor(v, o);
    return v;
}
__device__ __forceinline__ float wave_max(float v) {
#pragma unroll
    for (int o = 1; o < 64; o <<= 1) v = fmaxf(v, __shfl_xor(v, o));
    return v;
}

namespace pg8 {
#define PG8_LAS __attribute__((address_space(3)))
typedef unsigned short bf16_t;
constexpr int BM = 256, BK = 64, HALF = 128, HTB = HALF * BK * 2, STAGE_BYTES = 8 * HTB, NXCD = 8, WGM = 8;
__host__ __device__ __forceinline__ int lds_byte(int r, int c) { const int st = (r >> 4) * 2 + (c >> 5), rr = r & 15, cc = c & 31, ob = rr * 64 + cc * 2; return st * 1024 + (ob ^ (((ob >> 9) & 1) << 5)); }
__host__ __device__ __forceinline__ void stage_rc(int b, int& R, int& C) { const int st = b / 1024, sb = b % 1024, swz = sb ^ (((sb >> 9) & 1) << 5); R = (st >> 1) * 16 + swz / 64; C = (st & 1) * 32 + (swz % 64) / 2; }
__host__ __device__ __forceinline__ int perm32(int rho) { const int n = rho >> 4, i = rho & 15; return 8 * (i >> 2) + 4 * n + (i & 3); }
struct Unit { int pm, pn; };
struct Gemm { const bf16_t* A; const bf16_t* Bt; int M, N, K; };
struct StaticOrder {
    int nM, nN, nwg, G, c;
    __host__ __device__ void init(int M, int N, int G_, int c_) { nM = M / BM; nN = N / BM; nwg = nM * nN; G = G_; c = c_; }
    __host__ __device__ bool next(int i, Unit& u) const {
        const long L = (long)i * G + c; if (L >= nwg) return false;
        int wgid = (int)L; { const int q = nwg / NXCD, r = nwg % NXCD, xcd = wgid % NXCD, off = wgid / NXCD; wgid = (xcd < r ? xcd * (q + 1) : r * (q + 1) + (xcd - r) * q) + off; }
        const int nig = WGM * nN, gid = wgid / nig, fm = gid * WGM, gsz = (nM - fm) < WGM ? (nM - fm) : WGM;
        u.pm = fm + ((wgid % nig) % gsz); u.pn = (wgid % nig) / gsz; return true;
    }
    __device__ __forceinline__ void a_ready(const Unit&) const {}
    __device__ __forceinline__ void done(const Unit&) const {}
};
__device__ __forceinline__ unsigned cvt_pk_bf16(float lo, float hi) { unsigned r; asm volatile("v_cvt_pk_bf16_f32 %0, %1, %2" : "=v"(r) : "v"(lo), "v"(hi)); return r; }

template <class Epi, class Sched, bool ALIGN_EPI = false, bool SP2 = false>
__device__ __forceinline__ void gemm_phase(PG8_LAS unsigned char* lds, const Gemm g, const Sched& S, const Epi& E, const int tid) {
    const int wid = __builtin_amdgcn_readfirstlane(tid >> 6), lane = tid & 63, wr = wid >> 2, wc = wid & 3, fr = lane & 15, fq = lane >> 4;
    int Kl_ = g.K; asm volatile("" : "+s"(Kl_));
    const int K = Kl_, nt = K / BK;
    unsigned voffA[2], voffB[2];
#pragma unroll
    for (int i = 0; i < 2; ++i) { int R, C; stage_rc(tid * 16 + i * 8192, R, C); const int Rb = Epi::PERM ? ((R & ~31) + perm32(R & 31)) : R;
        voffA[i] = (unsigned)(R * K + C) * 2u; voffB[i] = (unsigned)(Rb * K + C) * 2u; }
    const size_t kstep = (size_t)(BK * 2);
    const size_t hstep = (size_t)HALF * K * 2;
    const size_t tstep = 2 * hstep;
    const unsigned ldsw = (unsigned)wid * 1024u;
    const int aoff = lds_byte(wr * 64 + fr, fq * 8), boff = lds_byte(wc * 32 + fr, fq * 8);
#define PG8_SA(b, h) (((b) * 2 + (h)) * HTB)
#define PG8_SB(b, h) ((4 + (b) * 2 + (h)) * HTB)
#define PG8_STAGE(bufoff, gbase, voff) do { _Pragma("unroll") for (int _i = 0; _i < 2; ++_i) \
        __builtin_amdgcn_global_load_lds((const unsigned*)((const char*)(gbase) + (voff)[_i]), (PG8_LAS unsigned*)(lds + (bufoff) + ldsw + _i * 8192), 16, 0, 0); } while (0)
#define PG8_LDA(dst, b, h) do { _Pragma("unroll") for (int m = 0; m < 4; ++m) _Pragma("unroll") for (int k = 0; k < 2; ++k) dst[m][k] = *(const PG8_LAS bf16x8*)(lds + PG8_SA(b, h) + aoff + m * 2048 + k * 1024); } while (0)
#define PG8_LDB(dst, b, h) do { _Pragma("unroll") for (int n = 0; n < 2; ++n) _Pragma("unroll") for (int k = 0; k < 2; ++k) dst[n][k] = *(const PG8_LAS bf16x8*)(lds + PG8_SB(b, h) + boff + n * 2048 + k * 1024); } while (0)
#define PG8_MMA(ai, bj, At, Bt) do { __builtin_amdgcn_s_setprio(1); _Pragma("unroll") for (int m = 0; m < 4; ++m) _Pragma("unroll") for (int n = 0; n < 2; ++n) _Pragma("unroll") for (int k = 0; k < 2; ++k) \
        acc[ai][bj][m][n] = __builtin_amdgcn_mfma_f32_16x16x32_bf16(Bt[n][k], At[m][k], acc[ai][bj][m][n], 0, 0, 0); __builtin_amdgcn_s_setprio(0); } while (0)
#define PG8_WAIT_V(n) asm volatile("s_waitcnt vmcnt(" #n ")" ::: "memory")
#define PG8_WAIT_L(n) asm volatile("s_waitcnt lgkmcnt(" #n ")" ::: "memory")
#define PG8_BAR __builtin_amdgcn_s_barrier()
#define PG8_SCHED __builtin_amdgcn_sched_barrier(0)
    Unit cur, nxt; int ui = 0;
    if (!S.next(0, cur)) return;
    f32x4 acc[2][2][4][2];
#pragma unroll
    for (int a = 0; a < 2; ++a)
#pragma unroll
        for (int b = 0; b < 2; ++b)
#pragma unroll
            for (int m = 0; m < 4; ++m)
#pragma unroll
                for (int n = 0; n < 2; ++n) acc[a][b][m][n] = (f32x4){0.f, 0.f, 0.f, 0.f};
    bf16x8 At[4][2], B0[2][2], B1[2][2];
    const char* cA = (const char*)g.A + (size_t)cur.pm * tstep; const char* cB = (const char*)g.Bt + (size_t)cur.pn * tstep;
    S.a_ready(cur);
    if constexpr (SP2) {
        PG8_STAGE(PG8_SB(0, 0), cB, voffB); PG8_STAGE(PG8_SB(0, 1), cB + hstep, voffB); PG8_STAGE(PG8_SA(0, 0), cA, voffA); PG8_STAGE(PG8_SA(0, 1), cA + hstep, voffA);
        if (wr == 1) PG8_BAR;
        PG8_WAIT_V(2); PG8_BAR;
        PG8_STAGE(PG8_SB(1, 0), cB + kstep, voffB); PG8_STAGE(PG8_SA(1, 0), cA + kstep, voffA); PG8_STAGE(PG8_SB(1, 1), cB + hstep + kstep, voffB);
        PG8_WAIT_V(6); PG8_BAR;
    } else {
        PG8_STAGE(PG8_SB(0, 0), cB, voffB); PG8_STAGE(PG8_SA(0, 0), cA, voffA); PG8_STAGE(PG8_SB(0, 1), cB + hstep, voffB); PG8_STAGE(PG8_SA(0, 1), cA + hstep, voffA);
        if (wr == 1) PG8_BAR;
        PG8_WAIT_V(4); PG8_BAR;
        PG8_STAGE(PG8_SB(1, 0), cB + kstep, voffB); PG8_STAGE(PG8_SA(1, 0), cA + kstep, voffA); PG8_STAGE(PG8_SB(1, 1), cB + hstep + kstep, voffB);
        PG8_WAIT_V(6); PG8_BAR;
    }
    for (;;) {
        const bool has_next = S.next(ui + 1, nxt);
        const char* nA = has_next ? (const char*)g.A + (size_t)nxt.pm * tstep : cA; const char* nB = has_next ? (const char*)g.Bt + (size_t)nxt.pn * tstep : cB;
        for (int t = 0; t < nt; t += 2) {
            const bool last = (t == nt - 2);
            const char* a1 = cA + (size_t)(t + 1) * kstep;
            const char* a2 = last ? nA : cA + (size_t)(t + 2) * kstep; const char* b2 = last ? nB : cB + (size_t)(t + 2) * kstep;
            const char* a3 = a2 + kstep; const char* b3 = b2 + kstep;
            if (last && has_next) S.a_ready(nxt);
            if constexpr (SP2) {
            PG8_LDB(B0, 0, 0); PG8_LDB(B1, 0, 1); PG8_SCHED; PG8_LDA(At, 0, 0); PG8_STAGE(PG8_SA(1, 1), a1 + hstep, voffA);
            PG8_WAIT_V(8); PG8_WAIT_L(0); PG8_BAR; PG8_MMA(0, 0, At, B0); PG8_MMA(0, 1, At, B1); PG8_BAR; PG8_SCHED;
            PG8_LDA(At, 0, 1); PG8_STAGE(PG8_SB(0, 0), b2, voffB); PG8_STAGE(PG8_SB(0, 1), b2 + hstep, voffB); PG8_STAGE(PG8_SA(0, 0), a2, voffA);
            PG8_WAIT_V(8); PG8_WAIT_L(0); PG8_BAR; PG8_MMA(1, 0, At, B0); PG8_MMA(1, 1, At, B1); PG8_BAR; PG8_SCHED;
            PG8_LDB(B0, 1, 0); PG8_LDB(B1, 1, 1); PG8_SCHED; PG8_LDA(At, 1, 0); PG8_STAGE(PG8_SA(0, 1), a2 + hstep, voffA);
            PG8_WAIT_V(8); PG8_WAIT_L(0); PG8_BAR; PG8_MMA(0, 0, At, B0); PG8_MMA(0, 1, At, B1); PG8_BAR; PG8_SCHED;
            PG8_LDA(At, 1, 1); PG8_STAGE(PG8_SB(1, 0), b3, voffB); PG8_STAGE(PG8_SB(1, 1), b3 + hstep, voffB); PG8_STAGE(PG8_SA(1, 0), a3, voffA);
            PG8_WAIT_V(8); PG8_WAIT_L(0); PG8_BAR; PG8_MMA(1, 0, At, B0); PG8_MMA(1, 1, At, B1); PG8_BAR; PG8_SCHED;
            } else {
            PG8_LDB(B0, 0, 0); PG8_SCHED; PG8_LDA(At, 0, 0); PG8_STAGE(PG8_SA(1, 1), a1 + hstep, voffA);
            PG8_WAIT_L(8); PG8_BAR; PG8_WAIT_L(0); PG8_MMA(0, 0, At, B0); PG8_BAR; PG8_SCHED;
            PG8_LDB(B1, 0, 1); PG8_STAGE(PG8_SB(0, 0), b2, voffB);
            PG8_BAR; PG8_WAIT_L(0); PG8_MMA(0, 1, At, B1); PG8_BAR;
            PG8_LDA(At, 0, 1); PG8_STAGE(PG8_SA(0, 0), a2, voffA);
            PG8_BAR; PG8_WAIT_L(0); PG8_MMA(1, 0, At, B0); PG8_BAR; PG8_SCHED;
            PG8_STAGE(PG8_SB(0, 1), b2 + hstep, voffB);
            PG8_WAIT_V(6); PG8_BAR; PG8_MMA(1, 1, At, B1); PG8_BAR;
            PG8_LDB(B0, 1, 0); PG8_SCHED; PG8_LDA(At, 1, 0); PG8_STAGE(PG8_SA(0, 1), a2 + hstep, voffA);
            PG8_WAIT_L(8); PG8_BAR; PG8_WAIT_L(0); PG8_MMA(0, 0, At, B0); PG8_BAR; PG8_SCHED;
            PG8_LDB(B1, 1, 1); PG8_STAGE(PG8_SB(1, 0), b3, voffB);
            PG8_BAR; PG8_WAIT_L(0); PG8_MMA(0, 1, At, B1); PG8_BAR;
            PG8_LDA(At, 1, 1); PG8_STAGE(PG8_SA(1, 0), a3, voffA);
            PG8_BAR; PG8_WAIT_L(0); PG8_MMA(1, 0, At, B0); PG8_BAR; PG8_SCHED;
            PG8_STAGE(PG8_SB(1, 1), b3 + hstep, voffB);
            PG8_WAIT_V(6); PG8_BAR; PG8_MMA(1, 1, At, B1); PG8_BAR;
            }
        }
        if constexpr (ALIGN_EPI) { if (wr == 0) PG8_BAR; }
        E(acc, cur, wr, wc, fr, fq); S.done(cur);
        if (!has_next) break;
#pragma unroll
        for (int a = 0; a < 2; ++a)
#pragma unroll
            for (int b = 0; b < 2; ++b)
#pragma unroll
                for (int m = 0; m < 4; ++m)
#pragma unroll
                    for (int n = 0; n < 2; ++n) acc[a][b][m][n] = (f32x4){0.f, 0.f, 0.f, 0.f};
        cur = nxt; cA = nA; cB = nB; ++ui;
        if constexpr (ALIGN_EPI) { if (wr == 1) PG8_BAR; }
    }
    PG8_WAIT_V(0);
    if constexpr (!ALIGN_EPI) { if (wr == 0) PG8_BAR; }
    PG8_BAR;
#undef PG8_SA
#undef PG8_SB
#undef PG8_STAGE
#undef PG8_LDA
#undef PG8_LDB
#undef PG8_MMA
#undef PG8_WAIT_V
#undef PG8_WAIT_L
#undef PG8_BAR
#undef PG8_SCHED
}

struct EpiStore {
    static constexpr bool PERM = true;
    bf16_t* O; int ldc; int rowmask; unsigned char* T8;
    __device__ __forceinline__ void operator()(const f32x4 (&acc)[2][2][4][2], const Unit& u, int wr, int wc, int fr, int fq) const {
        const int row0 = (u.pm & rowmask) * BM + wr * 64 + fr, col0 = u.pn * BM + wc * 32 + 8 * fq;
        const bool side = T8 != nullptr && (u.pn == 1 || u.pn == 2);
#pragma unroll
        for (int ai = 0; ai < 2; ++ai)
#pragma unroll
            for (int m = 0; m < 4; ++m) { int row = row0 + ai * HALF + m * 16; asm volatile("" : "+v"(row)); bf16_t* rowp = O + (size_t)row * ldc + col0;
#pragma unroll
                for (int bj = 0; bj < 2; ++bj) { const f32x4 v0 = acc[ai][bj][m][0], v1 = acc[ai][bj][m][1];
                    u32x4 w; w.x = cvt_pk_bf16(v0[0], v0[1]); w.y = cvt_pk_bf16(v0[2], v0[3]); w.z = cvt_pk_bf16(v1[0], v1[1]); w.w = cvt_pk_bf16(v1[2], v1[3]);
                    *(u32x4*)(rowp + bj * HALF) = w;
                    if (side) { int q0 = __builtin_amdgcn_cvt_pk_fp8_f32(v0[0], v0[1], 0, false); q0 = __builtin_amdgcn_cvt_pk_fp8_f32(v0[2], v0[3], q0, true);
                        int q1 = __builtin_amdgcn_cvt_pk_fp8_f32(v1[0], v1[1], 0, false); q1 = __builtin_amdgcn_cvt_pk_fp8_f32(v1[2], v1[3], q1, true);
                        *(u32x2*)(T8 + (size_t)row * 512 + (col0 + bj * HALF - 256)) = (u32x2){(unsigned)q0, (unsigned)q1}; } } }
    }
};
__device__ __forceinline__ float sigmoidf_(float x) { return 1.f / (1.f + __expf(-x)); }
struct EpiGateMix {
    static constexpr bool PERM = true;
    const bf16_t* U; bf16_t* MX;
    __device__ __forceinline__ void operator()(const f32x4 (&acc)[2][2][4][2], const Unit& u, int wr, int wc, int fr, int fq) const {
        const int row0 = u.pm * BM + wr * 64 + fr, dcol = u.pn * 64 + wc * 16 + fq * 4;
        u32x2 un[4];
        { int row = row0; asm volatile("" : "+v"(row)); const bf16_t* up = U + (size_t)row * 4096 + dcol;
#pragma unroll
          for (int b4 = 0; b4 < 4; ++b4) un[b4] = *(const u32x2*)(up + b4 * 1024); }
#pragma unroll
        for (int it = 0; it < 8; ++it) { const int ai = it >> 2, m = it & 3;
            u32x2 uc[4];
#pragma unroll
            for (int b4 = 0; b4 < 4; ++b4) uc[b4] = un[b4];
            if (it < 7) { int rown = row0 + ((it + 1) >> 2) * HALF + ((it + 1) & 3) * 16; asm volatile("" : "+v"(rown)); const bf16_t* up = U + (size_t)rown * 4096 + dcol;
#pragma unroll
                for (int b4 = 0; b4 < 4; ++b4) un[b4] = *(const u32x2*)(up + b4 * 1024); }
            int row = row0 + ai * HALF + m * 16; asm volatile("" : "+v"(row));
            float o0 = 0.f, o1 = 0.f, o2 = 0.f, o3 = 0.f;
#pragma unroll
            for (int bj = 0; bj < 2; ++bj)
#pragma unroll
                for (int n = 0; n < 2; ++n) { const u32x2 uu = uc[2 * bj + n]; const f32x4 a = acc[ai][bj][m][n];
                    o0 += sigmoidf_(a[0]) * bflo(uu.x); o1 += sigmoidf_(a[1]) * bfhi(uu.x); o2 += sigmoidf_(a[2]) * bflo(uu.y); o3 += sigmoidf_(a[3]) * bfhi(uu.y); }
            u32x2 w; w.x = cvt_pk_bf16(o0, o1); w.y = cvt_pk_bf16(o2, o3);
            *(u32x2*)(MX + (size_t)row * 1024 + dcol) = w; }
    }
};
struct EpiResid {
    static constexpr bool PERM = true;
    const float* xin; float* xout;
    __device__ __forceinline__ void operator()(const f32x4 (&acc)[2][2][4][2], const Unit& u, int wr, int wc, int fr, int fq) const {
        const int row0 = u.pm * BM + wr * 64 + fr, col0 = u.pn * BM + wc * 32 + 8 * fq;
        f32x4 xn[4];
        { int row = row0; asm volatile("" : "+v"(row)); const float* xp = xin + (size_t)row * 1024 + col0;
#pragma unroll
          for (int q4 = 0; q4 < 4; ++q4) xn[q4] = *(const f32x4*)(xp + (q4 >> 1) * HALF + 4 * (q4 & 1)); }
#pragma unroll
        for (int it = 0; it < 8; ++it) { const int ai = it >> 2, m = it & 3;
            f32x4 xc[4];
#pragma unroll
            for (int q4 = 0; q4 < 4; ++q4) xc[q4] = xn[q4];
            if (it < 7) { int rown = row0 + ((it + 1) >> 2) * HALF + ((it + 1) & 3) * 16; asm volatile("" : "+v"(rown)); const float* xp = xin + (size_t)rown * 1024 + col0;
#pragma unroll
                for (int q4 = 0; q4 < 4; ++q4) xn[q4] = *(const f32x4*)(xp + (q4 >> 1) * HALF + 4 * (q4 & 1)); }
            int row = row0 + ai * HALF + m * 16; asm volatile("" : "+v"(row)); const size_t ro = (size_t)row * 1024 + col0;
#pragma unroll
            for (int bj = 0; bj < 2; ++bj)
#pragma unroll
                for (int n = 0; n < 2; ++n) *(f32x4*)(xout + ro + bj * HALF + 4 * n) = xc[2 * bj + n] + acc[ai][bj][m][n]; }
    }
};
struct EpiSwiglu {
    static constexpr bool PERM = true;
    bf16_t* ACT;
    __device__ __forceinline__ void operator()(const f32x4 (&acc)[2][2][4][2], const Unit& u, int wr, int wc, int fr, int fq) const {
        const int row0 = u.pm * BM + wr * 64 + fr, col0 = (u.pn & 3) * 128 + wc * 32 + 8 * fq;
#pragma unroll
        for (int ai = 0; ai < 2; ++ai)
#pragma unroll
            for (int m = 0; m < 4; ++m) { int row = row0 + ai * HALF + m * 16; asm volatile("" : "+v"(row)); float v[8];
#pragma unroll
                for (int n = 0; n < 2; ++n)
#pragma unroll
                    for (int i = 0; i < 4; ++i) { const float a = acc[ai][0][m][n][i], b = acc[ai][1][m][n][i]; v[4 * n + i] = a * sigmoidf_(a) * b; }
                u32x4 w; w.x = cvt_pk_bf16(v[0], v[1]); w.y = cvt_pk_bf16(v[2], v[3]); w.z = cvt_pk_bf16(v[4], v[5]); w.w = cvt_pk_bf16(v[6], v[7]);
                *(u32x4*)(ACT + (size_t)row * 512 + col0) = w; }
    }
};
struct EpiDown {
    static constexpr bool PERM = true;
    bf16_t* YE; const float* roww;
    __device__ __forceinline__ void operator()(const f32x4 (&acc)[2][2][4][2], const Unit& u, int wr, int wc, int fr, int fq) const {
        const int row0 = u.pm * BM + wr * 64 + fr, col0 = (u.pn & 3) * BM + wc * 32 + 8 * fq;
        float sw[8];
#pragma unroll
        for (int it = 0; it < 8; ++it) sw[it] = roww[row0 + (it >> 2) * HALF + (it & 3) * 16];
#pragma unroll
        for (int ai = 0; ai < 2; ++ai)
#pragma unroll
            for (int m = 0; m < 4; ++m) { int row = row0 + ai * HALF + m * 16; asm volatile("" : "+v"(row)); const float s = sw[ai * 4 + m]; bf16_t* rowp = YE + (size_t)row * 1024 + col0;
#pragma unroll
                for (int bj = 0; bj < 2; ++bj) { const f32x4 v0 = acc[ai][bj][m][0] * s, v1 = acc[ai][bj][m][1] * s;
                    u32x4 w; w.x = cvt_pk_bf16(v0[0], v0[1]); w.y = cvt_pk_bf16(v0[2], v0[3]); w.z = cvt_pk_bf16(v1[0], v1[1]); w.w = cvt_pk_bf16(v1[2], v1[3]);
                    *(u32x4*)(rowp + bj * HALF) = w; } }
    }
};
struct SchedUp {
    int G, c;
    __device__ __forceinline__ bool next(int i, Unit& u) const { const int L = i * G + c; if (L >= 1024) return false; const int n = L >> 8, pm = (L >> 2) & 63, pn = L & 3; u.pm = n * 64 + pm; u.pn = n * 4 + pn; return true; }
    __device__ __forceinline__ void a_ready(const Unit&) const {}
    __device__ __forceinline__ void done(const Unit&) const {}
};
struct SchedMoe {
    int G, c, nunits; const PG8_LAS int* tab;
    __device__ __forceinline__ bool next(int i, Unit& u) const { const int L = i * G + c; if (L >= nunits) return false; const int b = L >> 2, t = L & 3; const int e = __builtin_amdgcn_readfirstlane(tab[b]); u.pm = b; u.pn = e * 4 + t; return true; }
    __device__ __forceinline__ void a_ready(const Unit&) const {}
    __device__ __forceinline__ void done(const Unit&) const {}
};
}

#define XB_TMO      128
#define XB_XCNT(j)  (256  + 64 * (j))
#define XB_XSUB(j)  (1280 + 64 * (j))
#define XB_XGEN(j)  (2304 + 64 * (j))
#define XB_TOP      3328
#define XB_TOPGEN   3392
#define XCD_BAR_WORDS 3456
#define XB_SPIN_CAP (1u << 18)
__device__ __forceinline__ unsigned xb_ld(unsigned* p)              { return __hip_atomic_load(p, __ATOMIC_RELAXED, __HIP_MEMORY_SCOPE_AGENT); }
__device__ __forceinline__ unsigned xb_add(unsigned* p, unsigned v) { return __hip_atomic_fetch_add(p, v, __ATOMIC_RELAXED, __HIP_MEMORY_SCOPE_AGENT); }
__device__ __forceinline__ unsigned xb_xcc_id() { return (unsigned)__builtin_amdgcn_s_getreg((3 << 11) | 20) & 0xFu; }
#define XB_SPIN(cond, bar) do { unsigned _sp = 0; while (cond) { __builtin_amdgcn_s_sleep(1); \
    if ((++_sp & 255u) == 0u) { if (xb_ld(&(bar)[XB_TMO])) break; if (_sp > XB_SPIN_CAP) { atomicAdd(&(bar)[XB_TMO], 1u); break; } } } } while (0)
struct XcdBarrier { unsigned* bar; unsigned x; volatile LAS unsigned* st; };
__device__ __forceinline__ XcdBarrier xcd_barrier_post(unsigned* bar, volatile LAS unsigned* st) {
    XcdBarrier b; b.bar = bar; b.x = xb_xcc_id(); b.st = st;
    if (threadIdx.x == 0) (void)xb_add(&bar[XB_XCNT(b.x)], 1u);
    return b;
}
__device__ __forceinline__ void xcd_barrier_complete(unsigned* bar, unsigned x, unsigned& nloc, unsigned& nx) {
    const unsigned G = gridDim.x * gridDim.y * gridDim.z;
    unsigned sum, cnt, mine, sp = 0u;
    for (;;) {
        sum = 0u; cnt = 0u; mine = 0u;
#pragma unroll
        for (unsigned j = 0; j < 16; ++j) { const unsigned c = xb_ld(&bar[XB_XCNT(j)]); sum += c; cnt += (c > 0u) ? 1u : 0u; mine = (j == x) ? c : mine; }
        if (sum == G) break;
        __builtin_amdgcn_s_sleep(1);
        if ((++sp & 255u) == 0u) { if (xb_ld(&bar[XB_TMO])) break; if (sp > XB_SPIN_CAP) { atomicAdd(&bar[XB_TMO], 1u); break; } }
    }
    nloc = mine > 0u ? mine : 1u; nx = cnt > 0u ? cnt : 1u;
}
__device__ __forceinline__ void xcd_barrier(const XcdBarrier& b) {
    asm volatile("s_waitcnt vmcnt(0)" ::: "memory");
    __syncthreads();
    if (threadIdx.x == 0) {
        unsigned* bar = b.bar;
        __builtin_amdgcn_s_waitcnt(0);
        unsigned nloc = b.st[0], nx = b.st[1];
        if (nloc == 0u) { xcd_barrier_complete(bar, b.x, nloc, nx); b.st[0] = nloc; b.st[1] = nx; }
        const unsigned old = xb_add(&bar[XB_XSUB(b.x)], 1u);
        const unsigned gen = old / nloc;
        if (old + 1u == (gen + 1u) * nloc) {
            __builtin_amdgcn_fence(__ATOMIC_RELEASE, "agent");
            asm volatile("s_waitcnt vmcnt(0)" ::: "memory");
            const unsigned og = xb_add(&bar[XB_TOP], 1u);
            const unsigned tg = og / nx;
            if (og + 1u == (tg + 1u) * nx) xb_add(&bar[XB_TOPGEN], 1u);
            else XB_SPIN(xb_ld(&bar[XB_TOPGEN]) == tg, bar);
            __builtin_amdgcn_fence(__ATOMIC_ACQUIRE, "agent");
            xb_add(&bar[XB_XGEN(b.x)], 1u);
            asm volatile("s_waitcnt vmcnt(0)" ::: "memory");
        } else {
            XB_SPIN(xb_ld(&bar[XB_XGEN(b.x)]) == gen, bar);
            __builtin_amdgcn_fence(__ATOMIC_ACQUIRE, "agent");
            asm volatile("s_waitcnt vmcnt(0)" ::: "memory");
        }
    }
    __syncthreads();
}

struct Args {
    const float* in[23]; float* out; unsigned char* ws; int seg_lo, seg_hi;
};
typedef const __attribute__((address_space(4))) Args* ArgsP;
__device__ __forceinline__ ArgsP kargs() { unsigned long long v = (unsigned long long)__builtin_amdgcn_kernarg_segment_ptr(); asm volatile("" : "+s"(v)); return (ArgsP)v; }
struct Frame {
    LAS unsigned char* lds; unsigned char* ws; unsigned* ctl;
    int tid, lane, wave, G, bid;
};

template <class SC>
__device__ __forceinline__ void cvt_item(const float* W, int ldw, int K, bf16* WT, int k0, int n0, SC sc, LAS float* scr, int lane) {
    const int nl = lane & 31; const int scol = sc(n0 + nl);
    float wv[32];
    const float* wp = W + (size_t)(k0 + (lane >> 5)) * ldw + (scol >= 0 ? scol : 0);
#pragma unroll
    for (int i = 0; i < 32; ++i) wv[i] = wp[(size_t)(2 * i) * ldw];
#pragma unroll
    for (int i = 0; i < 32; ++i) { const int kk = 2 * i + (lane >> 5); scr[kk * 33 + nl] = scol >= 0 ? wv[i] : 0.f; }
    LDS_WAIT(); asm volatile("" ::: "memory");
    const int c = lane & 7;
#pragma unroll
    for (int j = 0; j < 4; ++j) { const int n = (lane >> 3) + 8 * j; const LAS float* s = scr + (8 * c) * 33 + n;
        u32x4 o; o.x = pk2(s[0 * 33], s[1 * 33]); o.y = pk2(s[2 * 33], s[3 * 33]); o.z = pk2(s[4 * 33], s[5 * 33]); o.w = pk2(s[6 * 33], s[7 * 33]);
        *(u32x4*)(WT + (size_t)(n0 + n) * K + k0 + 8 * c) = o; }
    LDS_WAIT(); asm volatile("" ::: "memory");
}
__device__ __forceinline__ int src_col_win(int dc) {
    if (dc < 932) return dc;
    if (dc < 936) return 1700 + (dc - 932);
    if (dc < 940) return 1704 + (dc - 936);
    if (dc < 960) return -1;
    if (dc < 1728) return 932 + (dc - 960);
    if (dc < 1984) return 1708 + (dc - 1728);
    if (dc < 3520) return 1964 + (dc - 1984);
    return -1;
}
__device__ __forceinline__ void phase_convert(Frame& F, int l) {
    ArgsP a = kargs();
    LAS float* scr = (LAS float*)(F.lds + F.wave * 16384);
    const int gw = F.bid * 8 + F.wave, NGW = F.G * 8;
    constexpr int I_WIN = 16 * 112, I_WBR = 4 * 4 * 32, I_WG = 16 * 128, I_WO = 16 * 32, I_W13 = 32 * 16 * 32, I_W2 = 32 * 8 * 32;
    constexpr int NIT = I_WIN + I_WBR + I_WG + I_WO + I_W13 + I_W2;
    const float* w_in = a->in[2] + (size_t)l * 1024 * CIN;
    const float* w_br = a->in[11] + (size_t)l * 4 * 256 * 1024;
    const float* w_gate = a->in[12] + (size_t)l * 1024 * 4096;
    const float* w_out = a->in[13] + (size_t)l * 1024 * 1024;
    const float* w1 = a->in[19] + (size_t)l * NE * 1024 * FE;
    const float* w3 = a->in[20] + (size_t)l * NE * 1024 * FE;
    const float* w2 = a->in[21] + (size_t)l * NE * FE * 1024;
    for (int it = gw; it < NIT; it += NGW) {
        int r = it;
        if (r < I_WIN) { const int kb = r / 112, nb = r % 112; cvt_item(w_in, CIN, 1024, (bf16*)(F.ws + WS_WIN), kb * 64, nb * 32, [](int n) { return src_col_win(n); }, scr, F.lane); continue; } r -= I_WIN;
        if (r < I_WBR) { const int n = r / 128, q = r % 128, kb = q / 32, nb = q % 32; cvt_item(w_br + (size_t)n * 256 * 1024, 1024, 256, (bf16*)(F.ws + WS_WBR) + (size_t)n * 1024 * 256, kb * 64, nb * 32, [](int c) { return c; }, scr, F.lane); continue; } r -= I_WBR;
        if (r < I_WG) { const int kb = r / 128, nb = r % 128;
            cvt_item(w_gate, 4096, 1024, (bf16*)(F.ws + WS_WGATE), kb * 64, nb * 32, [](int np) { const int pn = np >> 8, L = np & 255, bj = L >> 7, wc = (L >> 5) & 3, fq = (L >> 3) & 3, n = (L >> 2) & 1, i = L & 3;
                return (2 * bj + n) * 1024 + pn * 64 + wc * 16 + fq * 4 + i; }, scr, F.lane); continue; } r -= I_WG;
        if (r < I_WO) { const int kb = r / 32, nb = r % 32; cvt_item(w_out, 1024, 1024, (bf16*)(F.ws + WS_WOUT), kb * 64, nb * 32, [](int c) { return c; }, scr, F.lane); continue; } r -= I_WO;
        if (r < I_W13) { const int e = r / 512, q = r % 512, kb = q / 32, nb = q % 32;
            const int t = (nb * 32) >> 8, L0 = (nb * 32) & 255; const float* src = (L0 < 128 ? w1 : w3) + (size_t)e * 1024 * FE; const int cbase = t * 128 + (L0 & 127) - nb * 32;
            cvt_item(src, FE, 1024, (bf16*)(F.ws + WS_W13) + (size_t)e * 1024 * 1024, kb * 64, nb * 32, [cbase](int np) { return np + cbase; }, scr, F.lane); continue; } r -= I_W13;
        { const int e = r / 256, q = r % 256, kb = q / 32, nb = q % 32; cvt_item(w2 + (size_t)e * FE * 1024, 1024, FE, (bf16*)(F.ws + WS_W2) + (size_t)e * 1024 * FE, kb * 64, nb * 32, [](int c) { return c; }, scr, F.lane); }
    }
}
__device__ __forceinline__ void rms_row_to_bf16(const float* xrow, const float* g, bf16* orow, int lane) {
    const f32x4* xr = (const f32x4*)xrow + lane; const f32x4* gr = (const f32x4*)g + lane;
    f32x4 v[4]; float s = 0.f;
#pragma unroll
    for (int j = 0; j < 4; ++j) { v[j] = xr[64 * j]; s += (v[j].x * v[j].x + v[j].y * v[j].y) + (v[j].z * v[j].z + v[j].w * v[j].w); }
    const float rstd = rsqrtf(wave_sum(s) * (1.f / D) + RMS_EPS);
    unsigned long long* o8 = (unsigned long long*)orow + lane;
#pragma unroll
    for (int j = 0; j < 4; ++j) { const f32x4 gg = gr[64 * j]; o8[64 * j] = (unsigned long long)pk2(v[j].x * rstd * gg.x, v[j].y * rstd * gg.y) | ((unsigned long long)pk2(v[j].z * rstd * gg.z, v[j].w * rstd * gg.w) << 32); }
}

#ifndef MFMA_F32
#define MFMA_F32(av, bv, cv) __builtin_amdgcn_mfma_f32_16x16x4f32((av), (bv), (cv), 0, 0, 0)
#endif
__device__ __forceinline__ void phase_router(Frame& F, int l, const float* xcur) {
    ArgsP a = kargs();
    LAS float* xs = (LAS float*)F.lds;
    LAS float* wsm = xs + 64 * 65;
    LAS float* lg = wsm + 64 * 48;
    LAS float* rs = lg + 64 * 37;
    const float* g = a->in[14] + (size_t)l * D;
    const float* rgw = a->in[15] + (size_t)l * D * 4; const float* rgb = a->in[16] + (size_t)l * 4;
    const float* rew = a->in[17] + (size_t)l * D * 32; const float* reb = a->in[18] + (size_t)l * 32;
    bf16* h2 = (bf16*)(F.ws + WS_H);
    int* tok_e = (int*)(F.ws + WS_RT); float* tok_w = (float*)(F.ws + WS_RT + 131072);
    unsigned* cnt = F.ctl + CW_CNT + l * 32;
    const int r = F.tid & 63;
    const int li = F.lane & 15, kq = F.lane >> 4, rb = F.wave & 3, cset = F.wave >> 2;
    for (int blk = F.bid; blk < S / 64; blk += F.G) {
        const int row0 = blk * 64;
        f32x4 acc0 = {0.f, 0.f, 0.f, 0.f}, acc1 = {0.f, 0.f, 0.f, 0.f}; float ss = 0.f;
        for (int kc = 0; kc < 16; ++kc) {
            __syncthreads();
            { const int rr = F.tid >> 3, kk = (F.tid & 7) * 8; const float* xp = xcur + (size_t)(row0 + rr) * D + kc * 64 + kk; const float* gp = g + kc * 64 + kk;
              const f32x4 x0 = *(const f32x4*)xp, x1 = *(const f32x4*)(xp + 4), g0 = *(const f32x4*)gp, g1 = *(const f32x4*)(gp + 4);
              LAS float* d = xs + rr * 65 + kk; d[0] = x0.x * g0.x; d[1] = x0.y * g0.y; d[2] = x0.z * g0.z; d[3] = x0.w * g0.w; d[4] = x1.x * g1.x; d[5] = x1.y * g1.y; d[6] = x1.z * g1.z; d[7] = x1.w * g1.w;
              ss += (x0.x * x0.x + x0.y * x0.y) + (x0.z * x0.z + x0.w * x0.w) + (x1.x * x1.x + x1.y * x1.y) + (x1.z * x1.z + x1.w * x1.w); }
            { const int kk = F.tid >> 3, c0 = (F.tid & 7) * 6; const size_t kg = (size_t)(kc * 64 + kk);
#pragma unroll
              for (int i = 0; i < 6; ++i) { const int c = c0 + i; wsm[kk * 48 + c] = c < 4 ? rgw[kg * 4 + c] : (c < 36 ? rew[kg * 32 + (c - 4)] : 0.f); } }
            __syncthreads();
            if (cset == 0) {
#pragma unroll 4
                for (int k0 = 0; k0 < 64; k0 += 4) { const float av = xs[(rb * 16 + li) * 65 + k0 + kq];
                    acc0 = MFMA_F32(av, wsm[(k0 + kq) * 48 + li], acc0); acc1 = MFMA_F32(av, wsm[(k0 + kq) * 48 + 16 + li], acc1); }
            } else {
#pragma unroll 4
                for (int k0 = 0; k0 < 64; k0 += 4) { const float av = xs[(rb * 16 + li) * 65 + k0 + kq]; acc0 = MFMA_F32(av, wsm[(k0 + kq) * 48 + 32 + li], acc0); }
            }
        }
        ss += __shfl_xor(ss, 1); ss += __shfl_xor(ss, 2); ss += __shfl_xor(ss, 4);
        __syncthreads();
        if ((F.tid & 7) == 0) rs[F.tid >> 3] = rsqrtf(ss * (1.f / D) + RMS_EPS);
        __syncthreads();
#pragma unroll
        for (int i = 0; i < 4; ++i) { const int rw = rb * 16 + kq * 4 + i; const float rstd = rs[rw];
            if (cset == 0) { lg[rw * 37 + li] = acc0[i] * rstd; lg[rw * 37 + 16 + li] = acc1[i] * rstd; } else if (li < 4) lg[rw * 37 + 32 + li] = acc0[i] * rstd; }
        __syncthreads();
        if (F.tid < 64) {
            const LAS float* L = lg + F.tid * 37; const int tok = row0 + F.tid;
            float gl[4]; int gs = 0; float gm = -3.0e38f;
#pragma unroll
            for (int i = 0; i < 4; ++i) { gl[i] = L[i] + rgb[i]; if (gl[i] > gm) { gm = gl[i]; gs = i; } }
            float gsum = 0.f;
#pragma unroll
            for (int i = 0; i < 4; ++i) gsum += __expf(gl[i] - gm);
            const float ggate = 1.f / gsum;
            float v0 = -3.0e38f, v1 = -3.0e38f; int i0 = 0, i1 = 0;
            for (int i = 0; i < 8; ++i) { const float v = L[4 + gs * 8 + i] + reb[gs * 8 + i]; if (v > v0) { v1 = v0; i1 = i0; v0 = v; i0 = i; } else if (v > v1) { v1 = v; i1 = i; } }
            const float e1 = __expf(v1 - v0), den = 1.f / (1.f + e1);
            const int ea = gs * 8 + i0, eb = gs * 8 + i1;
            tok_e[tok * 2] = ea; tok_e[tok * 2 + 1] = eb; tok_w[tok * 2] = den * ggate; tok_w[tok * 2 + 1] = e1 * den * ggate;
            atomicAdd(&cnt[ea], 1u); atomicAdd(&cnt[eb], 1u);
        }
        for (int i = 0; i < 8; ++i) { const int rr = F.wave * 8 + i; const float rstd = rs[rr];
            const f32x4* xr = (const f32x4*)(xcur + (size_t)(row0 + rr) * D) + F.lane; const f32x4* gr = (const f32x4*)g + F.lane; unsigned long long* o8 = (unsigned long long*)(h2 + (size_t)(row0 + rr) * D) + F.lane;
#pragma unroll
            for (int j = 0; j < 4; ++j) { const f32x4 v = xr[64 * j], gg = gr[64 * j]; o8[64 * j] = (unsigned long long)pk2(v.x * rstd * gg.x, v.y * rstd * gg.y) | ((unsigned long long)pk2(v.z * rstd * gg.z, v.w * rstd * gg.w) << 32); } }
    }
    __syncthreads();
}
__device__ __forceinline__ void moe_table(Frame& F, int l) {
    LAS int* tab = (LAS int*)(F.lds + LDSCTL_OFF);
    if (F.tid == 0) { int bo = 0;
#pragma unroll 1
        for (int e = 0; e < NE; ++e) { const int c = (int)__hip_atomic_load(F.ctl + CW_CNT + l * 32 + e, __ATOMIC_RELAXED, __HIP_MEMORY_SCOPE_AGENT); const int nb = (c + 255) >> 8; tab[192 + e] = bo * 256; for (int b = 0; b < nb; ++b) tab[bo + b] = e; bo += nb; } tab[224] = bo; }
    __syncthreads();
}
__device__ __forceinline__ void phase_scatter(Frame& F, int l) {
    moe_table(F, l);
    LAS int* tab = (LAS int*)(F.lds + LDSCTL_OFF);
    const bf16* h2 = (const bf16*)(F.ws + WS_H); bf16* xs = (bf16*)(F.ws + WS_XS);
    const int* tok_e = (const int*)(F.ws + WS_RT); const float* tok_w = (const float*)(F.ws + WS_RT + 131072);
    int* slot_row = (int*)(F.ws + WS_RT + 262144); float* row_w = (float*)(F.ws + WS_RT + 393216);
    unsigned* fill = F.ctl + CW_FILL + l * 32;
    const int gw = F.bid * 8 + F.wave, NGW = F.G * 8;
    for (int b0 = gw * 16; b0 < S * 2; b0 += NGW * 16) {
        int row = 0;
        if (F.lane < 16) { const int sl = b0 + F.lane; const int e = tok_e[sl]; const unsigned p = atomicAdd(&fill[e], 1u); row = tab[192 + e] + (int)p; slot_row[sl] = row; row_w[row] = tok_w[sl]; }
#pragma unroll 4
        for (int k = 0; k < 16; ++k) { const int rk = __builtin_amdgcn_readlane(row, k); const int sl = b0 + k;
            const u32x4* src = (const u32x4*)(h2 + (size_t)(sl >> 1) * D) + F.lane; u32x4* dst = (u32x4*)(xs + (size_t)rk * D) + F.lane;
            dst[0] = src[0]; dst[64] = src[64]; }
    }
}
__device__ __forceinline__ void phase_combine(Frame& F, int l, float* xcur) {
    ArgsP a = kargs();
    const bf16* ye = (const bf16*)(F.ws + WS_YE); const int* slot_row = (const int*)(F.ws + WS_RT + 262144);
    const bool last = (l == NL - 1);
    const float* g = last ? a->in[22] : a->in[1] + (size_t)(l + 1) * D;
    bf16* h = (bf16*)(F.ws + WS_H);
    const int gw = F.bid * 8 + F.wave, NGW = F.G * 8;
    int srl = 0; { const int k = F.lane >> 1, m = gw + k * NGW; if (F.lane < 16 && m < S) srl = slot_row[2 * m + (F.lane & 1)]; }
    const f32x4* gr = (const f32x4*)g + F.lane; f32x4 gg[4];
#pragma unroll
    for (int j = 0; j < 4; ++j) gg[j] = gr[64 * j];
    f32x4 xn[4]; u32x2 p0n[4], p1n[4];
#define CMB_LOAD(mm, kk) do { const int r0_ = __shfl(srl, 2 * (kk)), r1_ = __shfl(srl, 2 * (kk) + 1); const f32x4* xr_ = (const f32x4*)(xcur + (size_t)(mm) * D) + F.lane; \
        const u32x2* y0_ = (const u32x2*)(ye + (size_t)r0_ * D) + F.lane; const u32x2* y1_ = (const u32x2*)(ye + (size_t)r1_ * D) + F.lane; \
        _Pragma("unroll") for (int j = 0; j < 4; ++j) { xn[j] = xr_[64 * j]; p0n[j] = y0_[64 * j]; p1n[j] = y1_[64 * j]; } } while (0)
    if (gw < S) CMB_LOAD(gw, 0);
    int kk_ = 0;
    for (int m = gw; m < S; m += NGW, ++kk_) {
        f32x4 v[4]; float s = 0.f;
#pragma unroll
        for (int j = 0; j < 4; ++j) { const u32x2 p0 = p0n[j], p1 = p1n[j]; f32x4 x = xn[j];
            x.x = (x.x + bflo(p0.x)) + bflo(p1.x); x.y = (x.y + bfhi(p0.x)) + bfhi(p1.x); x.z = (x.z + bflo(p0.y)) + bflo(p1.y); x.w = (x.w + bfhi(p0.y)) + bfhi(p1.y);
            v[j] = x; s += (x.x * x.x + x.y * x.y) + (x.z * x.z + x.w * x.w); }
        if (m + NGW < S) CMB_LOAD(m + NGW, kk_ + 1);
        const float rstd = rsqrtf(wave_sum(s) * (1.f / D) + RMS_EPS);
        f32x4* xr = (f32x4*)(xcur + (size_t)m * D) + F.lane;
        if (last) {
#pragma unroll
            for (int j = 0; j < 4; ++j) xr[64 * j] = (f32x4){v[j].x * rstd * gg[j].x, v[j].y * rstd * gg[j].y, v[j].z * rstd * gg[j].z, v[j].w * rstd * gg[j].w};
        } else {
            unsigned long long* o8 = (unsigned long long*)(h + (size_t)m * D) + F.lane;
#pragma unroll
            for (int j = 0; j < 4; ++j) { xr[64 * j] = v[j];
                o8[64 * j] = (unsigned long long)pk2(v[j].x * rstd * gg[j].x, v[j].y * rstd * gg[j].y) | ((unsigned long long)pk2(v[j].z * rstd * gg[j].z, v[j].w * rstd * gg[j].w) << 32); }
        }
    }
#undef CMB_LOAD
}


typedef short v4i16_t __attribute__((ext_vector_type(4)));
__device__ __forceinline__ s16x4 ds_tr16(const LAS unsigned char* p) { return __builtin_bit_cast(s16x4, __builtin_amdgcn_ds_read_tr16_b64_v4i16((LAS v4i16_t*)p)); }
template <int MODE>
__device__ __forceinline__ void attn_phase(Frame& F, int l) {
    ArgsP a = kargs();
    constexpr int NS = MODE ? 2 : 1;
    const bf16* P = (const bf16*)(F.ws + WS_PU);
    bf16* Y = (bf16*)(F.ws + WS_Y) + (size_t)(MODE ? 3 : 2) * S * 256;
    const int colQ = MODE ? C_QD : C_QC, colK = MODE ? C_KD : C_KC, colV = MODE ? C_VD : C_VC;
    const float sc2 = (MODE ? 0.17677669529663687f : 0.125f) * 1.4426950408889634f;
    LAS unsigned char* Kb = F.lds; LAS unsigned char* Vb = F.lds + 16384; LAS float* btab = (LAS float*)(F.lds + 32768);
    const int lane = F.lane, w = F.wave, r = lane & 31, hh = lane >> 5;
    for (int u = F.bid; u < 256; u += F.G) {
        const int head = u & 3, ug = u >> 2;
        int qrow, cw, lo_w, T0, T1;
        if (MODE) { qrow = ug * 256 + w * 32; cw = ug * 4 + (w >> 1); lo_w = 0; T0 = 0; T1 = ug * 4 + 3; }
        else { cw = ug * 4 + (w >> 1); qrow = cw * 64 + (w & 1) * 32; lo_w = cw - 8 < 0 ? 0 : cw - 8; T0 = ug * 4 - 8 < 0 ? 0 : ug * 4 - 8; T1 = ug * 4 + 3; }
        if (!MODE) { __syncthreads(); if (F.tid < 192) btab[F.tid] = a->in[8][(size_t)(l * 4 + head) * 192 + F.tid] * 1.4426950408889634f; }
        bf16x8 Qf[4];
#pragma unroll
        for (int kk = 0; kk < 4; ++kk) Qf[kk] = *(const bf16x8*)(P + (size_t)(qrow + r) * PW + colQ + head * 64 + kk * 16 + 8 * hh);
        f32x16 O[NS][2]; float m[NS], lsum[NS];
#pragma unroll
        for (int s = 0; s < NS; ++s) { m[s] = -1e30f; lsum[s] = 0.f;
#pragma unroll
            for (int d = 0; d < 2; ++d)
#pragma unroll
                for (int i = 0; i < 16; ++i) O[s][d][i] = 0.f; }
        const int srow = F.tid >> 3, sch = F.tid & 7;
        const bf16* gK = P + (size_t)srow * PW + colK + head * 64 + sch * 8; const bf16* gV = P + (size_t)srow * PW + colV + head * 64 + sch * 8;
        const int kwoff = srow * 128 + ((sch ^ (srow & 7)) << 4), vwoff = srow * 128 + sch * 16;
        u32x4 kreg = *(const u32x4*)(gK + (size_t)T0 * 64 * PW), vreg = *(const u32x4*)(gV + (size_t)T0 * 64 * PW);
        __syncthreads();
        *(LAS u32x4*)(Kb + kwoff) = kreg; *(LAS u32x4*)(Vb + vwoff) = vreg;
        __syncthreads();
        for (int j = T0; j <= T1; ++j) {
            const int buf = (j - T0) & 1;
            if (j < T1) { kreg = *(const u32x4*)(gK + (size_t)(j + 1) * 64 * PW); vreg = *(const u32x4*)(gV + (size_t)(j + 1) * 64 * PW); }
            if (j >= lo_w && j <= cw) {
                const LAS unsigned char* Kt = Kb + buf * 8192; const LAS unsigned char* Vt = Vb + buf * 8192;
                bf16x8 pf[NS][4];
#pragma unroll
                for (int s = 0; s < NS; ++s) {
                    f32x16 Sq[2];
#pragma unroll
                    for (int kb = 0; kb < 2; ++kb) {
#pragma unroll
                        for (int i = 0; i < 16; ++i) Sq[kb][i] = 0.f;
#pragma unroll
                        for (int k2 = 0; k2 < (MODE ? 2 : 4); ++k2) { const int kk = MODE ? 2 * s + k2 : k2; const int row = kb * 32 + r;
                            const bf16x8 kf = *(const LAS bf16x8*)(Kt + row * 128 + (((kk * 2 + hh) ^ (row & 7)) << 4));
                            Sq[kb] = __builtin_amdgcn_mfma_f32_32x32x16_bf16(kf, Qf[kk], Sq[kb], 0, 0, 0); }
                    }
                    float mx = -1e30f;
                    if (!MODE) {
                        const int dj = cw - j;
                        if (dj >= 3) { const float bc = btab[191];
#pragma unroll
                            for (int kb = 0; kb < 2; ++kb)
#pragma unroll
                                for (int i = 0; i < 16; ++i) { const float t = Sq[kb][i] * sc2 + bc; Sq[kb][i] = t; mx = fmaxf(mx, t); } }
                        else { const int base = dj * 64 + (w & 1) * 32 + r - 4 * hh + 63;
#pragma unroll
                            for (int kb = 0; kb < 2; ++kb)
#pragma unroll
                                for (int i = 0; i < 16; ++i) { int rid = base - (kb * 32 + (i & 3) + 8 * (i >> 2)); rid = rid < 0 ? 0 : (rid > 191 ? 191 : rid);
                                    const float t = Sq[kb][i] * sc2 + btab[rid]; Sq[kb][i] = t; mx = fmaxf(mx, t); } }
                    } else {
#pragma unroll
                        for (int kb = 0; kb < 2; ++kb)
#pragma unroll
                            for (int i = 0; i < 16; ++i) { const float t = Sq[kb][i] * sc2; Sq[kb][i] = t; mx = fmaxf(mx, t); }
                    }
                    mx = fmaxf(mx, __shfl_xor(mx, 32));
                    const float mn = fmaxf(m[s], mx), alpha = __builtin_amdgcn_exp2f(m[s] - mn); m[s] = mn;
                    float rs = 0.f;
#pragma unroll
                    for (int kb = 0; kb < 2; ++kb)
#pragma unroll
                        for (int i = 0; i < 16; ++i) { const float p = __builtin_amdgcn_exp2f(Sq[kb][i] - mn); Sq[kb][i] = p; rs += p; }
                    lsum[s] = lsum[s] * alpha + rs;
#pragma unroll
                    for (int d = 0; d < 2; ++d)
#pragma unroll
                        for (int i = 0; i < 16; ++i) O[s][d][i] *= alpha;
#pragma unroll
                    for (int kb = 0; kb < 2; ++kb)
#pragma unroll
                        for (int ss = 0; ss < 2; ++ss) { u32x4 pw;
                            pw.x = pg8::cvt_pk_bf16(Sq[kb][8 * ss + 0], Sq[kb][8 * ss + 1]); pw.y = pg8::cvt_pk_bf16(Sq[kb][8 * ss + 2], Sq[kb][8 * ss + 3]);
                            pw.z = pg8::cvt_pk_bf16(Sq[kb][8 * ss + 4], Sq[kb][8 * ss + 5]); pw.w = pg8::cvt_pk_bf16(Sq[kb][8 * ss + 6], Sq[kb][8 * ss + 7]);
                            pf[s][kb * 2 + ss] = __builtin_bit_cast(bf16x8, pw); }
                    __builtin_amdgcn_sched_barrier(0);
                }
                const int li = lane & 15, lg = lane >> 4;
                const LAS unsigned char* vbase = Vt + (4 * (lg >> 1) + (li >> 2)) * 128 + (16 * (lg & 1) + 4 * (li & 3)) * 2;
#pragma unroll
                for (int d = 0; d < 2; ++d)
#pragma unroll
                    for (int st = 0; st < 4; ++st) {
                        const s16x4 v0 = ds_tr16(vbase + (st * 16) * 128 + d * 64), v1 = ds_tr16(vbase + (st * 16 + 8) * 128 + d * 64);
                        const bf16x8 vf = (bf16x8){v0[0], v0[1], v0[2], v0[3], v1[0], v1[1], v1[2], v1[3]};
#pragma unroll
                        for (int s = 0; s < NS; ++s) O[s][d] = __builtin_amdgcn_mfma_f32_32x32x16_bf16(vf, pf[s][st], O[s][d], 0, 0, 0);
                        if (st & 1) __builtin_amdgcn_sched_barrier(0);
                    }
            }
            if (j < T1) { *(LAS u32x4*)(Kb + (buf ^ 1) * 8192 + kwoff) = kreg; *(LAS u32x4*)(Vb + (buf ^ 1) * 8192 + vwoff) = vreg; }
            __syncthreads();
        }
        float inv[NS];
#pragma unroll
        for (int s = 0; s < NS; ++s) { const float lt = lsum[s] + __shfl_xor(lsum[s], 32); inv[s] = 1.f / lt; }
        bf16* yrow = Y + (size_t)(qrow + r) * 256 + head * 64 + 4 * hh;
        if (MODE) {
            const float* lp = a->in[9] + (size_t)l * 128 + (lane & 31); float s1 = (lane < 32) ? lp[0] * lp[32] : 0.f, s2 = (lane < 32) ? lp[64] * lp[96] : 0.f;
            s1 = wave_sum(s1); s2 = wave_sum(s2);
            const float lam_init = 0.8f - 0.6f * __expf(-0.3f * (float)l), lam = __expf(s1) - __expf(s2) + lam_init;
            const float* gn = a->in[10] + (size_t)l * 256 + head * 64 + 4 * hh;
            float ss = 0.f;
#pragma unroll
            for (int d = 0; d < 2; ++d)
#pragma unroll
                for (int i = 0; i < 16; ++i) { const float o = O[0][d][i] * inv[0] - lam * (O[NS - 1][d][i] * inv[NS - 1]); O[0][d][i] = o; ss += o * o; }
            ss += __shfl_xor(ss, 32);
            const float rstd = rsqrtf(ss * (1.f / 64.f) + RMS_EPS) * (1.f - lam_init);
#pragma unroll
            for (int d = 0; d < 2; ++d)
#pragma unroll
                for (int g = 0; g < 4; ++g) { const f32x4 gg = *(const f32x4*)(gn + d * 32 + 8 * g); u32x2 o2;
                    o2.x = pk2(O[0][d][4 * g + 0] * rstd * gg.x, O[0][d][4 * g + 1] * rstd * gg.y); o2.y = pk2(O[0][d][4 * g + 2] * rstd * gg.z, O[0][d][4 * g + 3] * rstd * gg.w);
                    *(u32x2*)(yrow + d * 32 + 8 * g) = o2; }
        } else {
#pragma unroll
            for (int d = 0; d < 2; ++d)
#pragma unroll
                for (int g = 0; g < 4; ++g) { u32x2 o2;
                    o2.x = pk2(O[0][d][4 * g + 0] * inv[0], O[0][d][4 * g + 1] * inv[0]); o2.y = pk2(O[0][d][4 * g + 2] * inv[0], O[0][d][4 * g + 3] * inv[0]);
                    *(u32x2*)(yrow + d * 32 + 8 * g) = o2; }
        }
    }
    __syncthreads();
}


__device__ __forceinline__ float vmax3_(float a, float b, float c) { float r; asm("v_max3_f32 %0, %1, %2, %3" : "=v"(r) : "v"(a), "v"(b), "v"(c)); return r; }
__device__ __forceinline__ void attnD_phase(Frame& F, int l) {
    const bf16* P = (const bf16*)(F.ws + WS_PU);
    bf16* Y = (bf16*)(F.ws + WS_Y) + (size_t)3 * S * 256;
    const float sc2 = 0.17677669529663687f * 1.4426950408889634f;
    const int lane = F.lane, w = F.wave, r = lane & 31, hh = lane >> 5, rw = w & 3, ksel = w >> 2;
    const int srow = F.tid >> 3, sch = F.tid & 7;
#pragma unroll 1
    for (int pr = F.bid; pr < 256; pr += F.G) {
        const int head = pr & 3, bp = pr >> 2;
#pragma unroll 1
        for (int rep = 0; rep < 2; ++rep) {
            const int b = rep ? 127 - bp : bp;
            const int qrow = b * 128 + rw * 32, cw = 2 * b + (rw >> 1);
            LAS unsigned char* qlds = F.lds + 98304 + w * 4096 + lane * 16;
            u32x4 qs4[4];
#pragma unroll
            for (int kk = 0; kk < 4; ++kk) { const u32x4 qw = *(const u32x4*)(P + (size_t)(qrow + r) * PW + C_QD + head * 64 + kk * 16 + 8 * hh);
                qs4[kk].x = pk2(bflo(qw.x) * sc2, bfhi(qw.x) * sc2); qs4[kk].y = pk2(bflo(qw.y) * sc2, bfhi(qw.y) * sc2); qs4[kk].z = pk2(bflo(qw.z) * sc2, bfhi(qw.z) * sc2); qs4[kk].w = pk2(bflo(qw.w) * sc2, bfhi(qw.w) * sc2); }
            f32x16 O[2][2], negM[2]; float m[2], lsum[2]; bool seen = false;
#pragma unroll
            for (int s2 = 0; s2 < 2; ++s2) { m[s2] = 0.f; lsum[s2] = 0.f;
#pragma unroll
                for (int i = 0; i < 16; ++i) negM[s2][i] = 0.f;
                asm volatile("" : "+v"(negM[s2]));
#pragma unroll
                for (int d = 0; d < 2; ++d)
#pragma unroll
                    for (int i = 0; i < 16; ++i) O[s2][d][i] = 0.f; }
            int srow_ = srow, sch_ = sch; asm volatile("" : "+v"(srow_), "+v"(sch_));
            const bf16* gK = P + (size_t)srow_ * PW + C_KD + head * 64 + (sch_ ^ (srow_ & 7)) * 8; const bf16* gV = P + (size_t)srow_ * PW + C_VD + head * 64 + sch_ * 8;
            LAS unsigned char* dma0 = F.lds + w * 1024;
#define D_STAGE(bufb, go) do { __builtin_amdgcn_global_load_lds((const unsigned*)(gK + (go)), (LAS unsigned*)(dma0 + (bufb)), 16, 0, 0); \
                __builtin_amdgcn_global_load_lds((const unsigned*)(gK + (go) + (size_t)64 * PW), (LAS unsigned*)(dma0 + (bufb) + 8192), 16, 0, 0); \
                __builtin_amdgcn_global_load_lds((const unsigned*)(gV + (go)), (LAS unsigned*)(dma0 + (bufb) + 16384), 16, 0, 0); \
                __builtin_amdgcn_global_load_lds((const unsigned*)(gV + (go) + (size_t)64 * PW), (LAS unsigned*)(dma0 + (bufb) + 24576), 16, 0, 0); } while (0)
            __syncthreads();
#pragma unroll
            for (int kk = 0; kk < 4; ++kk) *(LAS u32x4*)(qlds + kk * 1024) = qs4[kk];
            D_STAGE(0, (size_t)0);
            VM_WAIT();
            __syncthreads();
#pragma unroll 1
            for (int i = 0; i <= b; ++i) {
                const int buf = i & 1, j = 2 * i + ksel;
                if (i < b) D_STAGE((buf ^ 1) * 32768, (size_t)(2 * i + 2) * 64 * PW);
                if (j <= cw) {
                    const LAS unsigned char* Kt = F.lds + buf * 32768 + ksel * 8192; const LAS unsigned char* Vt = F.lds + buf * 32768 + 16384 + ksel * 8192;
                    bf16x8 pf[2][4];
#pragma unroll
                    for (int s2 = 0; s2 < 2; ++s2) {
                        f32x16 Sq[2];
                        const bf16x8 qf2[2] = {*(const LAS bf16x8*)(qlds + (2 * s2) * 1024), *(const LAS bf16x8*)(qlds + (2 * s2 + 1) * 1024)};
#pragma unroll
                        for (int kb = 0; kb < 2; ++kb) {
#pragma unroll
                            for (int k2 = 0; k2 < 2; ++k2) { const int kk = 2 * s2 + k2; const int row = kb * 32 + r;
                                const bf16x8 kf = *(const LAS bf16x8*)(Kt + row * 128 + (((kk * 2 + hh) ^ (row & 7)) << 4));
                                Sq[kb] = __builtin_amdgcn_mfma_f32_32x32x16_bf16(kf, qf2[k2], k2 ? Sq[kb] : negM[s2], 0, 0, 0); }
                        }
                        __builtin_amdgcn_sched_barrier(0);
                        asm volatile("s_nop 15\n\ts_nop 3" ::: "memory");
                        __builtin_amdgcn_sched_barrier(0);
                        float mx = vmax3_(Sq[0][0], Sq[0][1], Sq[0][2]);
#pragma unroll
                        for (int ii = 3; ii < 15; ii += 2) mx = vmax3_(mx, Sq[0][ii], Sq[0][ii + 1]);
                        mx = vmax3_(mx, Sq[0][15], Sq[1][0]);
#pragma unroll
                        for (int ii = 1; ii < 15; ii += 2) mx = vmax3_(mx, Sq[1][ii], Sq[1][ii + 1]);
                        mx = vmax3_(mx, Sq[1][15], Sq[1][15]);
                        mx = fmaxf(mx, __shfl_xor(mx, 32));
                        if (!seen || __any(mx > 8.f)) { const float dl = seen ? fmaxf(mx, 0.f) : mx; m[s2] += dl;
                            if (seen) { const float al = __builtin_amdgcn_exp2f(-dl); lsum[s2] *= al;
#pragma unroll
                                for (int d = 0; d < 2; ++d)
#pragma unroll
                                    for (int ii = 0; ii < 16; ++ii) O[s2][d][ii] *= al; }
#pragma unroll
                            for (int kb = 0; kb < 2; ++kb)
#pragma unroll
                                for (int ii = 0; ii < 16; ++ii) Sq[kb][ii] -= dl;
                            const float nm = -m[s2];
#pragma unroll
                            for (int ii = 0; ii < 16; ++ii) negM[s2][ii] = nm; }
                        float rs = 0.f;
#pragma unroll
                        for (int kb = 0; kb < 2; ++kb)
#pragma unroll
                            for (int ii = 0; ii < 16; ++ii) { const float p = __builtin_amdgcn_exp2f(Sq[kb][ii]); Sq[kb][ii] = p; rs += p; }
                        lsum[s2] += rs;
#pragma unroll
                        for (int kb = 0; kb < 2; ++kb)
#pragma unroll
                            for (int ss = 0; ss < 2; ++ss) { u32x4 pw;
                                pw.x = pg8::cvt_pk_bf16(Sq[kb][8 * ss + 0], Sq[kb][8 * ss + 1]); pw.y = pg8::cvt_pk_bf16(Sq[kb][8 * ss + 2], Sq[kb][8 * ss + 3]);
                                pw.z = pg8::cvt_pk_bf16(Sq[kb][8 * ss + 4], Sq[kb][8 * ss + 5]); pw.w = pg8::cvt_pk_bf16(Sq[kb][8 * ss + 6], Sq[kb][8 * ss + 7]);
                                pf[s2][kb * 2 + ss] = __builtin_bit_cast(bf16x8, pw); }
                        __builtin_amdgcn_sched_barrier(0);
                    }
                    const int li = lane & 15, lg = lane >> 4;
                    const LAS unsigned char* vbase = Vt + (4 * (lg >> 1) + (li >> 2)) * 128 + (16 * (lg & 1) + 4 * (li & 3)) * 2;
#pragma unroll
                    for (int d = 0; d < 2; ++d)
#pragma unroll
                        for (int st = 0; st < 4; ++st) {
                            const s16x4 v0 = ds_tr16(vbase + (st * 16) * 128 + d * 64), v1 = ds_tr16(vbase + (st * 16 + 8) * 128 + d * 64);
                            const bf16x8 vf = (bf16x8){v0[0], v0[1], v0[2], v0[3], v1[0], v1[1], v1[2], v1[3]};
                            O[0][d] = __builtin_amdgcn_mfma_f32_32x32x16_bf16(vf, pf[0][st], O[0][d], 0, 0, 0);
                            O[1][d] = __builtin_amdgcn_mfma_f32_32x32x16_bf16(vf, pf[1][st], O[1][d], 0, 0, 0);
                            if (st & 1) __builtin_amdgcn_sched_barrier(0);
                        }
                    seen = true;
                }
                VM_WAIT();
                __syncthreads();
            }
            LAS float* xo = (LAS float*)F.lds + rw * 4096; LAS float* xm = (LAS float*)(F.lds + 65536) + rw * 256;
            if (!seen) { m[0] = -1e30f; m[1] = -1e30f; }
            if (ksel) {
#pragma unroll
                for (int s2 = 0; s2 < 2; ++s2) { xm[s2 * 64 + lane] = m[s2]; xm[128 + s2 * 64 + lane] = lsum[s2];
#pragma unroll
                    for (int d = 0; d < 2; ++d)
#pragma unroll
                        for (int ii = 0; ii < 16; ++ii) xo[((s2 * 2 + d) * 16 + ii) * 64 + lane] = O[s2][d][ii]; }
            }
            __syncthreads();
            if (!ksel) {
                float inv[2];
#pragma unroll
                for (int s2 = 0; s2 < 2; ++s2) { const float mb = xm[s2 * 64 + lane], lb = xm[128 + s2 * 64 + lane]; const float mn = fmaxf(m[s2], mb), aa = __builtin_amdgcn_exp2f(m[s2] - mn), ab = __builtin_amdgcn_exp2f(mb - mn);
                    float lt = lsum[s2] * aa + lb * ab; lt += __shfl_xor(lt, 32); inv[s2] = 1.f / lt;
#pragma unroll
                    for (int d = 0; d < 2; ++d)
#pragma unroll
                        for (int ii = 0; ii < 16; ++ii) O[s2][d][ii] = (O[s2][d][ii] * aa + xo[((s2 * 2 + d) * 16 + ii) * 64 + lane] * ab) * inv[s2]; }
                int r_ = r, hh_ = hh; asm volatile("" : "+v"(r_), "+v"(hh_));
                ArgsP a = kargs();
                const float* lp = a->in[9] + (size_t)l * 128 + r_; float s1 = (lane < 32) ? lp[0] * lp[32] : 0.f, s3 = (lane < 32) ? lp[64] * lp[96] : 0.f;
                s1 = wave_sum(s1); s3 = wave_sum(s3);
                const float lam_init = 0.8f - 0.6f * __expf(-0.3f * (float)l), lam = __expf(s1) - __expf(s3) + lam_init;
                const float* gn = a->in[10] + (size_t)l * 256 + head * 64 + 4 * hh_;
                float ss = 0.f;
#pragma unroll
                for (int d = 0; d < 2; ++d)
#pragma unroll
                    for (int ii = 0; ii < 16; ++ii) { const float o = O[0][d][ii] - lam * O[1][d][ii]; O[0][d][ii] = o; ss += o * o; }
                ss += __shfl_xor(ss, 32);
                const float rstd = rsqrtf(ss * (1.f / 64.f) + RMS_EPS) * (1.f - lam_init);
                bf16* yrow = Y + (size_t)(qrow + r_) * 256 + head * 64 + 4 * hh_;
#pragma unroll
                for (int d = 0; d < 2; ++d)
#pragma unroll
                    for (int g = 0; g < 4; ++g) { const f32x4 gg = *(const f32x4*)(gn + d * 32 + 8 * g); u32x2 o2;
                        o2.x = pk2(O[0][d][4 * g + 0] * rstd * gg.x, O[0][d][4 * g + 1] * rstd * gg.y); o2.y = pk2(O[0][d][4 * g + 2] * rstd * gg.z, O[0][d][4 * g + 3] * rstd * gg.w);
                        *(u32x2*)(yrow + d * 32 + 8 * g) = o2; }
            }
        }
    }
    __syncthreads();
}

using pg8::sigmoidf_;
constexpr int ML_CE = 0, ML_G = 1024, ML_SC = 2048;
__device__ __forceinline__ float logsigmoidf_(float f) { return f >= 0.f ? -log1pf(__expf(-f)) : f - log1pf(__expf(f)); }
__device__ __forceinline__ void ml_gates(const bf16* P, const float* ib, const float* fb, int c, int h, int lane, float& a_t, float& i_t) {
    const bf16* pr = P + (size_t)(c * 64 + lane) * PW;
    i_t = bf2f(pr[C_IB + h]) + ib[h]; a_t = logsigmoidf_(bf2f(pr[C_FB + h]) + fb[h]);
}
__device__ __forceinline__ float wave_scan_add(float v, int lane) {
#pragma unroll
    for (int o = 1; o < 64; o <<= 1) { const float u = __shfl_up(v, o); if (lane >= o) v += u; }
    return v;
}
__device__ __forceinline__ float wave_scan_max(float v, int lane) {
#pragma unroll
    for (int o = 1; o < 64; o <<= 1) { const float u = __shfl_up(v, o); if (lane >= o) v = fmaxf(v, u); }
    return v;
}
__device__ __forceinline__ void ml_phase1(Frame& F, int l) {
    ArgsP a = kargs(); const bf16* P = (const bf16*)(F.ws + WS_PU); float* mls = (float*)(F.ws + WS_MLS);
    const float* ib = a->in[5] + l * 4; const float* fb = a->in[6] + l * 4;
    for (int u = F.bid * 8 + F.wave; u < NCH * 4; u += F.G * 8) {
        const int c = u >> 2, h = u & 3; float at, it; ml_gates(P, ib, fb, c, h, F.lane, at, it);
        const float cum = wave_scan_add(at, F.lane), ce = __shfl(cum, 63), g = ce - cum + it, G = wave_max(g);
        if (F.lane == 0) { mls[ML_CE + u] = ce; mls[ML_G + u] = G; }
    }
}
__device__ __forceinline__ void ml_mscan(Frame& F, LAS float* mt, LAS float* tmp) {
    const float* mls = (const float*)(F.ws + WS_MLS);
    __syncthreads();
    for (int i = F.tid; i < 1024; i += 512) { tmp[i] = mls[ML_CE + i]; tmp[1024 + i] = mls[ML_G + i]; }
    __syncthreads();
    if (F.tid < 4) { float m = 0.f;
#pragma unroll 1
        for (int c = 0; c < NCH; ++c) { mt[F.tid * 257 + c] = m; m = fmaxf(tmp[c * 4 + F.tid] + m, tmp[1024 + c * 4 + F.tid]); }
        mt[F.tid * 257 + 256] = m; }
    __syncthreads();
}
__device__ __forceinline__ void ml_stage_conv(const bf16* P, int col0, const float* cw, const float* cb, int row0, float sc, LAS float* dst, int tid) {
    const int t = tid >> 3, d0 = (tid & 7) * 8;
    float acc[8];
#pragma unroll
    for (int i = 0; i < 8; ++i) acc[i] = cb[d0 + i];
#pragma unroll
    for (int j = 0; j < 4; ++j) { const int r = row0 + t - 3 + j;
        if (r >= 0) { const u32x4 x = *(const u32x4*)(P + (size_t)r * PW + col0 + d0); const float* w = cw + j * 512 + d0;
            acc[0] += w[0] * bflo(x.x); acc[1] += w[1] * bfhi(x.x); acc[2] += w[2] * bflo(x.y); acc[3] += w[3] * bfhi(x.y);
            acc[4] += w[4] * bflo(x.z); acc[5] += w[5] * bfhi(x.z); acc[6] += w[6] * bflo(x.w); acc[7] += w[7] * bfhi(x.w); } }
#pragma unroll
    for (int i = 0; i < 8; ++i) dst[t * 65 + d0 + i] = acc[i] * sigmoidf_(acc[i]) * sc;
}
__device__ __forceinline__ void ml_stage_plain(const bf16* P, int col0, int row0, const LAS float* rs, LAS float* dst, int tid) {
    const int t = tid >> 3, d0 = (tid & 7) * 8; const float sc = rs ? rs[t] : 1.f;
    const u32x4 x = *(const u32x4*)(P + (size_t)(row0 + t) * PW + col0 + d0); LAS float* d = dst + t * 65 + d0;
    d[0] = bflo(x.x) * sc; d[1] = bfhi(x.x) * sc; d[2] = bflo(x.y) * sc; d[3] = bfhi(x.y) * sc; d[4] = bflo(x.z) * sc; d[5] = bfhi(x.z) * sc; d[6] = bflo(x.w) * sc; d[7] = bfhi(x.w) * sc;
}
__device__ __forceinline__ void ml_phase3(Frame& F, int l) {
    ArgsP a = kargs(); const bf16* P = (const bf16*)(F.ws + WS_PU); float* mls = (float*)(F.ws + WS_MLS);
    float* dC = (float*)(F.ws + WS_MLC); float* dn = (float*)(F.ws + WS_MLN);
    const float* ib = a->in[5] + l * 4; const float* fb = a->in[6] + l * 4; const float* cw = a->in[3] + (size_t)l * 2048; const float* cb = a->in[4] + (size_t)l * 512;
    LAS float* Kl = (LAS float*)F.lds; LAS float* Vl = Kl + 64 * 65; LAS float* srcL = Vl + 64 * 65; LAS float* mt = srcL + 64; LAS float* tmp = mt + 4 * 257 + 4;
    ml_mscan(F, mt, tmp);
    const int lane = F.lane, w = F.wave, li = lane & 15, kq = lane >> 4, bi = w >> 1, bj0 = (w & 1) * 2;
    for (int u = F.bid; u < NCH * 4; u += F.G) {
        const int c = u >> 2, h = u & 3; const float m0 = mt[h * 257 + c], m1 = mt[h * 257 + c + 1];
        __syncthreads();
        if (w == 0) { float at, it; ml_gates(P, ib, fb, c, h, lane, at, it); const float cum = wave_scan_add(at, lane), ce = __shfl(cum, 63);
            srcL[lane] = __expf(ce - cum + it - m1); if (lane == 0) mls[ML_SC + u] = __expf(ce + m0 - m1); }
        ml_stage_conv(P, C_KB + h * 64, cw + 256 + h * 64, cb + 256 + h * 64, c * 64, 0.125f, Kl, F.tid);
        __syncthreads();
        ml_stage_plain(P, C_VB + h * 64, c * 64, srcL, Vl, F.tid);
        __syncthreads();
        f32x4 acc0 = {0.f, 0.f, 0.f, 0.f}, acc1 = {0.f, 0.f, 0.f, 0.f};
#pragma unroll 4
        for (int k0 = 0; k0 < 64; k0 += 4) { const float av = Vl[(k0 + kq) * 65 + bi * 16 + li];
            acc0 = MFMA_F32(av, Kl[(k0 + kq) * 65 + bj0 * 16 + li], acc0); acc1 = MFMA_F32(av, Kl[(k0 + kq) * 65 + (bj0 + 1) * 16 + li], acc1); }
        float* o = dC + (size_t)u * 4096 + (bi * 16 + kq * 4) * 64 + li;
#pragma unroll
        for (int r = 0; r < 4; ++r) { o[r * 64 + bj0 * 16] = acc0[r]; o[r * 64 + (bj0 + 1) * 16] = acc1[r]; }
        if (F.tid < 64) { float sacc = 0.f; for (int s2 = 0; s2 < 64; ++s2) sacc += srcL[s2] * Kl[s2 * 65 + F.tid]; dn[(size_t)u * 64 + F.tid] = sacc; }
    }
    __syncthreads();
}
__device__ __forceinline__ void ml_phase4(Frame& F) {
    float* dC = (float*)(F.ws + WS_MLC); float* dn = (float*)(F.ws + WS_MLN); const float* sc = (const float*)(F.ws + WS_MLS) + ML_SC;
    float* base; size_t stride; int h;
    if (F.wave == 0) { const int e = F.bid * 64 + F.lane; if (e >= 16384) return; h = e >> 12; base = dC + (size_t)h * 4096 + (e & 4095); stride = 4 * 4096; }
    else if (F.wave == 1 && F.bid < 4) { h = F.bid; base = dn + (size_t)h * 64 + F.lane; stride = 4 * 64; }
    else return;
    float st = 0.f;
    for (int c0 = 0; c0 < NCH; c0 += 8) {
        float v[8], g[8];
#pragma unroll
        for (int i = 0; i < 8; ++i) { v[i] = base[(size_t)(c0 + i) * stride]; g[i] = sc[(c0 + i) * 4 + h]; }
#pragma unroll
        for (int i = 0; i < 8; ++i) { base[(size_t)(c0 + i) * stride] = st; st = g[i] * st + v[i]; }
    }
}
__device__ __forceinline__ void ml_phase5(Frame& F, int l) {
    ArgsP a = kargs(); const bf16* P = (const bf16*)(F.ws + WS_PU);
    const float* Cst = (const float*)(F.ws + WS_MLC); const float* nst = (const float*)(F.ws + WS_MLN);
    const float* ib = a->in[5] + l * 4; const float* fb = a->in[6] + l * 4; const float* cw = a->in[3] + (size_t)l * 2048; const float* cb = a->in[4] + (size_t)l * 512;
    const float* gn = a->in[7] + (size_t)l * 256;
    bf16* Y = (bf16*)(F.ws + WS_Y) + (size_t)1 * S * 256;
    LAS float* Ql = (LAS float*)F.lds; LAS float* Kl = Ql + 64 * 65; LAS float* Vl = Kl + 64 * 65; LAS float* Cl = Vl + 64 * 65; LAS float* Wl = Cl + 64 * 65;
    LAS float* cumL = Wl + 64 * 65; LAS float* bL = cumL + 64; LAS float* mtL = bL + 64; LAS float* inL = mtL + 64; LAS float* nL = inL + 64; LAS float* denL = nL + 64;
    LAS float* mt = denL + 64; LAS float* tmp = mt + 4 * 257 + 4;
    ml_mscan(F, mt, tmp);
    const int lane = F.lane, w = F.wave, li = lane & 15, kq = lane >> 4, bi = w >> 1, bj0 = (w & 1) * 2;
    for (int u = F.bid; u < NCH * 4; u += F.G) {
        const int c = u >> 2, h = u & 3; const float m0 = mt[h * 257 + c];
        __syncthreads();
        if (w == 0) { float at, it; ml_gates(P, ib, fb, c, h, lane, at, it); const float cum = wave_scan_add(at, lane);
            const float bb = it - cum, pm = wave_scan_max(bb, lane), mtt = fmaxf(cum + m0, cum + pm);
            cumL[lane] = cum; bL[lane] = bb; mtL[lane] = mtt; inL[lane] = __expf(cum + m0 - mtt); nL[lane] = nst[(size_t)u * 64 + lane]; }
        ml_stage_conv(P, C_QB + h * 64, cw + h * 64, cb + h * 64, c * 64, 1.f, Ql, F.tid);
        ml_stage_conv(P, C_KB + h * 64, cw + 256 + h * 64, cb + 256 + h * 64, c * 64, 0.125f, Kl, F.tid);
        ml_stage_plain(P, C_VB + h * 64, c * 64, nullptr, Vl, F.tid);
        { const int t = F.tid >> 3, d0 = (F.tid & 7) * 8; const f32x4 c0 = *(const f32x4*)(Cst + (size_t)u * 4096 + t * 64 + d0), c1 = *(const f32x4*)(Cst + (size_t)u * 4096 + t * 64 + d0 + 4);
          LAS float* d = Cl + t * 65 + d0; d[0] = c0.x; d[1] = c0.y; d[2] = c0.z; d[3] = c0.w; d[4] = c1.x; d[5] = c1.y; d[6] = c1.z; d[7] = c1.w; }
        __syncthreads();
        {
            f32x4 acc0 = {0.f, 0.f, 0.f, 0.f}, acc1 = {0.f, 0.f, 0.f, 0.f};
#pragma unroll 4
            for (int k0 = 0; k0 < 64; k0 += 4) { const float av = Ql[(bi * 16 + li) * 65 + k0 + kq];
                acc0 = MFMA_F32(av, Kl[(bj0 * 16 + li) * 65 + k0 + kq], acc0); acc1 = MFMA_F32(av, Kl[((bj0 + 1) * 16 + li) * 65 + k0 + kq], acc1); }
#pragma unroll
            for (int r = 0; r < 4; ++r) { const int t = bi * 16 + kq * 4 + r; const float ct = cumL[t] - mtL[t];
                { const int s2 = bj0 * 16 + li; Wl[t * 65 + s2] = (s2 <= t) ? __expf(ct + bL[s2]) * acc0[r] : 0.f; }
                { const int s2 = (bj0 + 1) * 16 + li; Wl[t * 65 + s2] = (s2 <= t) ? __expf(ct + bL[s2]) * acc1[r] : 0.f; } }
        }
        __syncthreads();
        if (F.tid < 64) { const int t = F.tid; float qn = 0.f, sw = 0.f;
            for (int k = 0; k < 64; ++k) { qn += Ql[t * 65 + k] * nL[k]; sw += Wl[t * 65 + k]; }
            const float den = inL[t] * qn + sw; denL[t] = 1.f / fmaxf(fabsf(den), __expf(-mtL[t])); }
        f32x4 acc0 = {0.f, 0.f, 0.f, 0.f}, acc1 = {0.f, 0.f, 0.f, 0.f};
#pragma unroll 4
        for (int k0 = 0; k0 < 64; k0 += 4) { const float av = Ql[(bi * 16 + li) * 65 + k0 + kq];
            acc0 = MFMA_F32(av, Cl[(bj0 * 16 + li) * 65 + k0 + kq], acc0); acc1 = MFMA_F32(av, Cl[((bj0 + 1) * 16 + li) * 65 + k0 + kq], acc1); }
#pragma unroll
        for (int r = 0; r < 4; ++r) { const float it = inL[bi * 16 + kq * 4 + r]; acc0[r] *= it; acc1[r] *= it; }
#pragma unroll 4
        for (int k0 = 0; k0 < 64; k0 += 4) { const float av = Wl[(bi * 16 + li) * 65 + k0 + kq];
            acc0 = MFMA_F32(av, Vl[(k0 + kq) * 65 + bj0 * 16 + li], acc0); acc1 = MFMA_F32(av, Vl[(k0 + kq) * 65 + (bj0 + 1) * 16 + li], acc1); }
        __syncthreads();
#pragma unroll
        for (int r = 0; r < 4; ++r) { const int t = bi * 16 + kq * 4 + r; const float dv = denL[t]; Wl[t * 65 + bj0 * 16 + li] = acc0[r] * dv; Wl[t * 65 + (bj0 + 1) * 16 + li] = acc1[r] * dv; }
        __syncthreads();
        { const int t = F.tid >> 3, d0 = (F.tid & 7) * 8; float hv[8], ss = 0.f;
#pragma unroll
          for (int i = 0; i < 8; ++i) { hv[i] = Wl[t * 65 + d0 + i]; ss += hv[i] * hv[i]; }
          ss += __shfl_xor(ss, 1); ss += __shfl_xor(ss, 2); ss += __shfl_xor(ss, 4);
          const float rstd = rsqrtf(ss * (1.f / 64.f) + RMS_EPS);
          const u32x4 ov = *(const u32x4*)(P + (size_t)(c * 64 + t) * PW + C_OB + h * 64 + d0); const float* g = gn + h * 64 + d0;
          const float o0 = sigmoidf_(bflo(ov.x)), o1 = sigmoidf_(bfhi(ov.x)), o2 = sigmoidf_(bflo(ov.y)), o3 = sigmoidf_(bfhi(ov.y)), o4 = sigmoidf_(bflo(ov.z)), o5 = sigmoidf_(bfhi(ov.z)), o6 = sigmoidf_(bflo(ov.w)), o7 = sigmoidf_(bfhi(ov.w));
          u32x4 y; y.x = pk2(o0 * hv[0] * rstd * g[0], o1 * hv[1] * rstd * g[1]); y.y = pk2(o2 * hv[2] * rstd * g[2], o3 * hv[3] * rstd * g[3]);
          y.z = pk2(o4 * hv[4] * rstd * g[4], o5 * hv[5] * rstd * g[5]); y.w = pk2(o6 * hv[6] * rstd * g[6], o7 * hv[7] * rstd * g[7]);
          *(u32x4*)(Y + (size_t)(c * 64 + t) * 256 + h * 64 + d0) = y; }
    }
    __syncthreads();
}


constexpr int DSA_CAP = 2048, DSA_TRIG = 1024, QHP = 260, DSA_TU = 10496;
__device__ __forceinline__ u32x2 ld_list(const u32x2* p) { const unsigned long long v = __hip_atomic_load((const unsigned long long*)p, __ATOMIC_RELAXED, __HIP_MEMORY_SCOPE_AGENT); return (u32x2){(unsigned)v, (unsigned)(v >> 32)}; }

__device__ __forceinline__ unsigned wave_prefix_incl(unsigned v) {
    v += (unsigned)__builtin_amdgcn_update_dpp(0, (int)v, 0x111, 0xf, 0xf, false);
    v += (unsigned)__builtin_amdgcn_update_dpp(0, (int)v, 0x112, 0xf, 0xf, false);
    v += (unsigned)__builtin_amdgcn_update_dpp(0, (int)v, 0x114, 0xf, 0xf, false);
    v += (unsigned)__builtin_amdgcn_update_dpp(0, (int)v, 0x118, 0xf, 0xf, false);
    v += (unsigned)__builtin_amdgcn_update_dpp(0, (int)v, 0x142, 0xa, 0xf, false);
    v += (unsigned)__builtin_amdgcn_update_dpp(0, (int)v, 0x143, 0xc, 0xf, false);
    return v;
}
__device__ __forceinline__ unsigned sortable(float v) { const unsigned b = __builtin_bit_cast(unsigned, v); return (b & 0x80000000u) ? ~b : (b | 0x80000000u); }
__device__ __forceinline__ unsigned lanes_below(unsigned long long m) { return __builtin_amdgcn_mbcnt_hi((unsigned)(m >> 32), __builtin_amdgcn_mbcnt_lo((unsigned)m, 0u)); }

__device__ __forceinline__ unsigned dsa_bin(unsigned sv) {
    const bool pos = (sv >> 31) != 0u; const unsigned mag = (pos ? sv : ~sv) & 0x7fffffffu; int t = (int)(mag >> 19) - 1904; t = t < 0 ? 0 : (t > 255 ? 255 : t);
    return pos ? 256u + (unsigned)t : 255u - (unsigned)t;
}
__device__ __forceinline__ unsigned dsa_bin_T(unsigned B) {
    if (B >= 257u) return (0x80000000u | ((1904u + (B - 256u)) << 19)) - 1u;
    if (B == 256u) return 0x7fffffffu;
    if (B == 0u) return 0u;
    const unsigned t = 255u - B, mag = ((1905u + t) << 19) - 1u; return (0x7fffffffu - mag) - 1u;
}
__device__ __forceinline__ unsigned dsa_hist_T(const LAS unsigned* qh, int lane) {
    const int grp = 63 - lane;
    const u32x4 h = *(const LAS u32x4*)(qh + 4 * grp);
    const unsigned c[8] = {h.x & 0xffffu, h.x >> 16, h.y & 0xffffu, h.y >> 16, h.z & 0xffffu, h.z >> 16, h.w & 0xffffu, h.w >> 16};
    unsigned tl = 0u;
#pragma unroll
    for (int i = 0; i < 8; ++i) tl += c[i];
    const unsigned suf = wave_prefix_incl(tl);
    const unsigned above = suf - tl; const bool mine = (above < 256u) && (256u <= suf);
    unsigned B = 0u;
    if (mine) { unsigned cc = above; B = 8u * grp;
#pragma unroll
        for (int i = 7; i >= 0; --i) { cc += c[i]; if (cc >= 256u) { B = 8u * grp + i; break; } } }
    const unsigned long long mm = __ballot(mine); if (!mm) return 0u;
    B = (unsigned)__builtin_amdgcn_readlane((int)B, (int)__builtin_ctzll(mm));
    return dsa_bin_T(B);
}
__device__ __forceinline__ void dsa_hist_T4(const LAS unsigned* qh0, LAS unsigned* T4, int lane, bool want) {
    const int qq = lane >> 4, g = 15 - (lane & 15);
    const LAS unsigned* qh = qh0 + qq * QHP + 16 * g;
    const u32x4 h0 = *(const LAS u32x4*)qh, h1 = *(const LAS u32x4*)(qh + 4), h2 = *(const LAS u32x4*)(qh + 8), h3 = *(const LAS u32x4*)(qh + 12);
    const unsigned s0 = h0.x + h0.y + h0.z + h0.w, s1 = h1.x + h1.y + h1.z + h1.w, s2 = h2.x + h2.y + h2.z + h2.w, s3 = h3.x + h3.y + h3.z + h3.w;
    const unsigned t0 = (s0 & 0xffffu) + (s0 >> 16), t1 = (s1 & 0xffffu) + (s1 >> 16), t2 = (s2 & 0xffffu) + (s2 >> 16), t3 = (s3 & 0xffffu) + (s3 >> 16);
    const unsigned tl = t0 + t1 + t2 + t3;
    unsigned v = tl;
    v += (unsigned)__builtin_amdgcn_update_dpp(0, (int)v, 0x111, 0xf, 0xf, false);
    v += (unsigned)__builtin_amdgcn_update_dpp(0, (int)v, 0x112, 0xf, 0xf, false);
    v += (unsigned)__builtin_amdgcn_update_dpp(0, (int)v, 0x114, 0xf, 0xf, false);
    v += (unsigned)__builtin_amdgcn_update_dpp(0, (int)v, 0x118, 0xf, 0xf, false);
    const unsigned above = v - tl;
    if (want && above < 256u && 256u <= v) {
        unsigned cc = above, base; u32x4 hq;
        if (cc + t3 >= 256u) { hq = h3; base = 24u; } else { cc += t3;
        if (cc + t2 >= 256u) { hq = h2; base = 16u; } else { cc += t2;
        if (cc + t1 >= 256u) { hq = h1; base = 8u; } else { cc += t1; hq = h0; base = 0u; } } }
        const unsigned c[8] = {hq.x & 0xffffu, hq.x >> 16, hq.y & 0xffffu, hq.y >> 16, hq.z & 0xffffu, hq.z >> 16, hq.w & 0xffffu, hq.w >> 16};
        unsigned B = 32u * g + base;
#pragma unroll
        for (int i = 7; i >= 0; --i) { cc += c[i]; if (cc >= 256u) { B = 32u * g + base + i; break; } }
        const unsigned T = dsa_bin_T(B); if (T > T4[qq]) { T4[qq] = T; T4[DSA_TU + qq] = B >= 511u ? 0xffffffffu : dsa_bin_T(B + 1u); }
    }
}
template <int NPASS, class KF, class PF>
__device__ __forceinline__ unsigned radix_kth(int n, KF key, PF pred, unsigned& want, LAS unsigned* hist, int lane) {
    unsigned prefix = 0u, himask = 0u;
#pragma unroll 1
    for (int p = 0; p < NPASS; ++p) {
        const int shift = 8 * (NPASS - 1 - p);
        *(LAS u32x4*)(hist + 4 * lane) = (u32x4){0u, 0u, 0u, 0u};
        asm volatile("s_waitcnt lgkmcnt(0)" ::: "memory");
#pragma unroll 4
        for (int i = lane; i < n; i += 64) { const unsigned k = key(i); if (pred(i) && ((k ^ prefix) & himask) == 0u) (void)__hip_atomic_fetch_add(hist + ((k >> shift) & 255u), 1u, __ATOMIC_RELAXED, __HIP_MEMORY_SCOPE_WORKGROUP); }
        asm volatile("s_waitcnt lgkmcnt(0)" ::: "memory");
        const int grp = 63 - lane;
        const u32x4 h = *(LAS u32x4*)(hist + 4 * grp);
        const unsigned tl = h.x + h.y + h.z + h.w; const unsigned suf = wave_prefix_incl(tl);
        const unsigned above = suf - tl;
        const bool mine = (above < want) && (want <= suf);
        unsigned D = 0u, nw = 0u;
        if (mine) { unsigned c = above;
            if (c + h.w >= want) { D = 4 * grp + 3; nw = want - c; } else { c += h.w;
            if (c + h.z >= want) { D = 4 * grp + 2; nw = want - c; } else { c += h.z;
            if (c + h.y >= want) { D = 4 * grp + 1; nw = want - c; } else { c += h.y; D = 4 * grp; nw = want - c; } } } }
        const unsigned long long mm = __ballot(mine); const int src = mm ? (int)__builtin_ctzll(mm) : 0;
        D = (unsigned)__builtin_amdgcn_readlane((int)D, src); nw = (unsigned)__builtin_amdgcn_readlane((int)nw, src);
        prefix |= D << shift; himask |= 0xffu << shift; want = nw;
    }
    return prefix;
}
__device__ __forceinline__ void dsa_prune(u32x2* list, LAS unsigned* nq, LAS unsigned* Tq, int q, LAS u32x2* st, LAS unsigned* hist, int lane, bool exact, unsigned tmin) {
    const int n0 = (int)nq[q]; int n = 0;
#pragma unroll 1
    for (int i0 = 0; i0 < n0; i0 += 256) {
        u32x2 t8[4];
#pragma unroll
        for (int u = 0; u < 4; ++u) { const int i = i0 + u * 64 + lane; t8[u] = (i < n0) ? ld_list(list + i) : (u32x2){0u, 0u}; }
#pragma unroll
        for (int u = 0; u < 4; ++u) { const int i = i0 + u * 64 + lane; const bool k = (i < n0) && t8[u].x > tmin;
            const unsigned long long m = __ballot(k); if (k) st[n + (int)lanes_below(m)] = t8[u]; n += (int)__popcll(m); } }
    asm volatile("s_waitcnt vmcnt(0) lgkmcnt(0)" ::: "memory");
    if (n <= 256) {
#pragma unroll 1
        for (int i = lane; i < n; i += 64) list[i] = st[i];
        if (lane == 0) { nq[q] = (unsigned)n; if (tmin > Tq[q]) { Tq[q] = tmin; Tq[DSA_TU + q] = 0xffffffffu; } }
        asm volatile("s_waitcnt vmcnt(0)" ::: "memory");
        return;
    }
    if (!exact) {
        unsigned want = 256u;
        const unsigned Th = radix_kth<2>(n, [st](int i) { return st[i].x >> 16; }, [](int) { return true; }, want, hist, lane);
        unsigned cnt_ge = 0u;
#pragma unroll 1
        for (int i0 = 0; i0 < n; i0 += 64) { const int i = i0 + lane; cnt_ge += (unsigned)__popcll(__ballot(i < n && (st[i].x >> 16) >= Th)); }
        if (cnt_ge <= 512u && Th > 0u) {
            unsigned base = 0u;
#pragma unroll 1
            for (int i0 = 0; i0 < n; i0 += 64) { const int i = i0 + lane; const u32x2 t = (i < n) ? st[i] : (u32x2){0u, 0u};
                const bool keep = (i < n) && (t.x >> 16) >= Th;
                const unsigned long long m = __ballot(keep); if (keep) list[base + lanes_below(m)] = t; base += (unsigned)__popcll(m); }
            if (lane == 0) { nq[q] = base; const unsigned tn = (Th << 16) - 1u; Tq[q] = tn > tmin ? tn : tmin; Tq[DSA_TU + q] = 0xffffffffu; }
            asm volatile("s_waitcnt vmcnt(0)" ::: "memory");
            return;
        }
    }
    unsigned want = 256u;
    const unsigned Ts = radix_kth<4>(n, [st](int i) { return st[i].x; }, [](int) { return true; }, want, hist, lane);
    unsigned cnt_eq = 0u;
#pragma unroll 1
    for (int i0 = 0; i0 < n; i0 += 64) { const int i = i0 + lane; cnt_eq += (unsigned)__popcll(__ballot(i < n && st[i].x == Ts)); }
    unsigned Tk = 0u;
    if (cnt_eq > want) Tk = radix_kth<2>(n, [st](int i) { return 0x3fffu - st[i].y; }, [st, Ts](int i) { return st[i].x == Ts; }, want, hist, lane);
    unsigned base = 0u;
#pragma unroll 1
    for (int i0 = 0; i0 < n; i0 += 64) { const int i = i0 + lane; const u32x2 t = (i < n) ? st[i] : (u32x2){0u, 0u};
        const bool keep = (i < n) && (t.x > Ts || (t.x == Ts && (0x3fffu - t.y) >= Tk));
        const unsigned long long m = __ballot(keep); if (keep) list[base + lanes_below(m)] = t; base += (unsigned)__popcll(m); }
    if (lane == 0) { nq[q] = base; Tq[q] = Ts; Tq[DSA_TU + q] = 0xffffffffu; }
    asm volatile("s_waitcnt vmcnt(0)" ::: "memory");
}
__device__ __forceinline__ int dsa_final(const u32x2* list, int n0, unsigned tmin, unsigned tup, LAS u32x2* st, LAS unsigned* hist, LAS unsigned* bmp, int lane) {
    int n = 0, cin = 0;
#pragma unroll 1
    for (int i0 = 0; i0 < n0; i0 += 512) {
        u32x4 t4[4];
#pragma unroll
        for (int u = 0; u < 4; ++u) { const int i = i0 + u * 128 + 2 * lane; t4[u] = (i < n0) ? *(const u32x4*)(list + i) : (u32x4){0u, 0u, 0u, 0u}; }
#pragma unroll
        for (int u = 0; u < 4; ++u) { const int i = i0 + u * 128 + 2 * lane;
            { const bool in = (i < n0) && t4[u].x > tup, k = (i < n0) && t4[u].x > tmin && !in;
              if (in) (void)__hip_atomic_fetch_or(bmp + (t4[u].y >> 5), 1u << (t4[u].y & 31u), __ATOMIC_RELAXED, __HIP_MEMORY_SCOPE_WORKGROUP);
              cin += (int)__popcll(__ballot(in));
              const unsigned long long m = __ballot(k); if (k) st[n + (int)lanes_below(m)] = (u32x2){t4[u].x, t4[u].y}; n += (int)__popcll(m); }
            { const bool in = (i + 1 < n0) && t4[u].z > tup, k = (i + 1 < n0) && t4[u].z > tmin && !in;
              if (in) (void)__hip_atomic_fetch_or(bmp + (t4[u].w >> 5), 1u << (t4[u].w & 31u), __ATOMIC_RELAXED, __HIP_MEMORY_SCOPE_WORKGROUP);
              cin += (int)__popcll(__ballot(in));
              const unsigned long long m = __ballot(k); if (k) st[n + (int)lanes_below(m)] = (u32x2){t4[u].z, t4[u].w}; n += (int)__popcll(m); } }
    }
    asm volatile("s_waitcnt lgkmcnt(0)" ::: "memory");
    const int quota = cin < 256 ? 256 - cin : 0;
    unsigned Ts = 0u, Tk = 0u;
    if (n > quota) {
        unsigned want = (unsigned)quota;
        Ts = radix_kth<4>(n, [st](int i) { return st[i].x; }, [](int) { return true; }, want, hist, lane);
        unsigned cnt_eq = 0u;
#pragma unroll 1
        for (int i0 = 0; i0 < n; i0 += 64) { const int i = i0 + lane; cnt_eq += (unsigned)__popcll(__ballot(i < n && st[i].x == Ts)); }
        if (cnt_eq > want) Tk = radix_kth<2>(n, [st](int i) { return 0x3fffu - st[i].y; }, [st, Ts](int i) { return st[i].x == Ts; }, want, hist, lane);
    }
    int cnt = cin;
#pragma unroll 1
    for (int i0 = 0; i0 < n; i0 += 64) { const int i = i0 + lane; const u32x2 t = (i < n) ? st[i] : (u32x2){0u, 0u};
        const bool keep = (i < n) && (n <= quota || t.x > Ts || (t.x == Ts && (0x3fffu - t.y) >= Tk));
        if (keep) (void)__hip_atomic_fetch_or(bmp + (t.y >> 5), 1u << (t.y & 31u), __ATOMIC_RELAXED, __HIP_MEMORY_SCOPE_WORKGROUP);
        cnt += (int)__popcll(__ballot(keep)); }
    asm volatile("s_waitcnt lgkmcnt(0)" ::: "memory");
    return cnt;
}
__device__ __forceinline__ void dsa_unit(Frame& F, int G32) {
    const bf16* P = (const bf16*)(F.ws + WS_PU);
    bf16* Y = (bf16*)(F.ws + WS_Y);
    u32x2* cand = (u32x2*)(F.ws + WS_CAND) + (size_t)F.bid * 32 * DSA_CAP;
    const int lane = F.lane, w = F.wave, r = lane & 31, hh = lane >> 5;
    LAS unsigned char* wscr = F.lds + w * 12288;
    LAS unsigned* Tq = (LAS unsigned*)(F.lds + 98304); LAS unsigned* nq = Tq + 32;
    LAS unsigned* hist = (LAS unsigned*)(F.lds + 98816 + w * 1024);
    LAS unsigned* qhist = (LAS unsigned*)(F.lds + 107008);
    const int q0 = G32 * 32, c = G32 >> 1, nt = c + 1, nrounds = (nt + 7) >> 3;
    __syncthreads();
    if (F.tid < 32) { Tq[F.tid] = 0u; Tq[DSA_TU + F.tid] = 0xffffffffu; nq[F.tid] = 0u; nq[32 + F.tid] = 0u; nq[64 + F.tid] = 0u; }
#pragma unroll
    for (int k = 0; k < 4; ++k) *(LAS u32x4*)(qhist + F.tid * 4 + k * 2048) = (u32x4){0u, 0u, 0u, 0u};
    if (F.tid < 32) *(LAS u32x4*)(qhist + 8192 + F.tid * 4) = (u32x4){0u, 0u, 0u, 0u};
    bf16x8 Qf[4][2]; float wh[4];
    { const bf16* qp = P + (size_t)(q0 + r) * PW;
#pragma unroll
      for (int h = 0; h < 4; ++h) { wh[h] = bf2f(qp[C_WI + h]);
#pragma unroll
          for (int kk = 0; kk < 2; ++kk) Qf[h][kk] = *(const bf16x8*)(qp + C_QI + h * 32 + kk * 16 + 8 * hh); } }
    bf16x8 Kf[2][2];
    { const int jf = (nrounds - (nrounds < 4 ? nrounds : 4)) * 8 + w; const int j0 = jf < nt ? jf : 0;
#pragma unroll
      for (int kb = 0; kb < 2; ++kb)
#pragma unroll
          for (int kk = 0; kk < 2; ++kk) Kf[kb][kk] = *(const bf16x8*)(P + (size_t)(j0 * 64 + kb * 32 + r) * PW + C_KI + kk * 16 + 8 * hh); }
    __syncthreads();
    LAS unsigned* nlast = nq + 32;
    const int R0 = nrounds < 4 ? nrounds : 4, nvr = nrounds + R0;
    for (int vr = 0; vr < nvr; ++vr) {
        const int rd = vr < R0 ? nrounds - R0 + vr : vr - R0;
        const int mode = vr < R0 ? 0 : (rd >= nrounds - R0 ? 2 : 1);
        const int j = rd * 8 + w;
        int rr = r; asm volatile("" : "+v"(rr));
        u32x2* myl = cand + (size_t)rr * DSA_CAP;
        if (j < nt) {
            f32x16 acc[2];
#pragma unroll
            for (int h = 0; h < 4; ++h)
#pragma unroll
                for (int kb = 0; kb < 2; ++kb) { f32x16 sv;
#pragma unroll
                    for (int i = 0; i < 16; ++i) sv[i] = 0.f;
                    sv = __builtin_amdgcn_mfma_f32_32x32x16_bf16(Kf[kb][0], Qf[h][0], sv, 0, 0, 0); sv = __builtin_amdgcn_mfma_f32_32x32x16_bf16(Kf[kb][1], Qf[h][1], sv, 0, 0, 0);
#pragma unroll
                    for (int i = 0; i < 16; ++i) { const float rl = __builtin_amdgcn_fmed3f(sv[i], 0.f, __builtin_inff()); acc[kb][i] = (h == 0) ? (wh[0] * rl + 0.f) : fmaf(wh[h], rl, acc[kb][i]); } }
            const unsigned T = mode ? Tq[rr] : 0xffffffffu;
            LAS unsigned* myv = (LAS unsigned*)wscr + lane * 36;
            unsigned pm = 0u;
#pragma unroll
            for (int kb = 0; kb < 2; ++kb)
#pragma unroll
                for (int g = 0; g < 4; ++g) { u32x4 v4;
                    v4.x = sortable(acc[kb][4 * g]); v4.y = sortable(acc[kb][4 * g + 1]); v4.z = sortable(acc[kb][4 * g + 2]); v4.w = sortable(acc[kb][4 * g + 3]);
                    pm |= (v4.x > T ? 1u : 0u) << (kb * 16 + 4 * g) | (v4.y > T ? 2u : 0u) << (kb * 16 + 4 * g) | (v4.z > T ? 4u : 0u) << (kb * 16 + 4 * g) | (v4.w > T ? 8u : 0u) << (kb * 16 + 4 * g);
                    *(LAS u32x4*)(myv + kb * 16 + 4 * g) = v4;
                    if (mode == 0) { const unsigned b0 = dsa_bin(v4.x), b1 = dsa_bin(v4.y), b2 = dsa_bin(v4.z), b3 = dsa_bin(v4.w); LAS unsigned* qh = qhist + rr * QHP;
                        (void)__hip_atomic_fetch_add(qh + (b0 >> 1), 1u << (16u * (b0 & 1u)), __ATOMIC_RELAXED, __HIP_MEMORY_SCOPE_WORKGROUP); (void)__hip_atomic_fetch_add(qh + (b1 >> 1), 1u << (16u * (b1 & 1u)), __ATOMIC_RELAXED, __HIP_MEMORY_SCOPE_WORKGROUP);
                        (void)__hip_atomic_fetch_add(qh + (b2 >> 1), 1u << (16u * (b2 & 1u)), __ATOMIC_RELAXED, __HIP_MEMORY_SCOPE_WORKGROUP); (void)__hip_atomic_fetch_add(qh + (b3 >> 1), 1u << (16u * (b3 & 1u)), __ATOMIC_RELAXED, __HIP_MEMORY_SCOPE_WORKGROUP); } }
            asm volatile("s_waitcnt lgkmcnt(0)" ::: "memory");
            if (__any(pm != 0u)) {
                unsigned pos1 = 0u;
                if (pm) pos1 = __hip_atomic_fetch_add(nq + rr, (unsigned)__popc(pm), __ATOMIC_RELAXED, __HIP_MEMORY_SCOPE_WORKGROUP);
                while (__any(pm != 0u)) {
                    if (pm) { const int e = __builtin_ctz(pm); pm &= pm - 1u; const unsigned sv1 = myv[e];
                        if (mode == 1) { const unsigned bn = dsa_bin(sv1); (void)__hip_atomic_fetch_add(qhist + rr * QHP + (bn >> 1), 1u << (16u * (bn & 1u)), __ATOMIC_RELAXED, __HIP_MEMORY_SCOPE_WORKGROUP); }
                        myl[pos1++] = (u32x2){sv1, (unsigned)(j * 64 + (e >> 4) * 32 + (e & 3) + 8 * ((e & 15) >> 2) + 4 * hh)}; }
                }
            }
        }
        { const int nv = vr + 1, nrd = nv < R0 ? nrounds - R0 + nv : nv - R0; int jn = nrd * 8 + w; if (jn >= nt || nv >= nvr) jn = (j < nt ? j : 0);
#pragma unroll
          for (int kb = 0; kb < 2; ++kb)
#pragma unroll
              for (int kk = 0; kk < 2; ++kk) Kf[kb][kk] = *(const bf16x8*)(P + (size_t)(jn * 64 + kb * 32 + r) * PW + C_KI + kk * 16 + 8 * hh); }
        LAS unsigned* oflag = nq + 64;
        { const int q = w * 4 + (lane >> 4); const unsigned n = nq[q]; const bool over = n > (unsigned)DSA_TRIG;
          if (__any(over)) { if (lane == 0) oflag[0] = 1u; }
          const bool want = !over && !(mode == 1 && n < nlast[q] + 1u);
          if (__any(want)) { if (want && (lane & 15) == 0) nlast[q] = n;
              dsa_hist_T4(qhist + (w * 4) * QHP, Tq + w * 4, lane, want); } }
        __syncthreads();
        if (oflag[0]) {
            asm volatile("s_waitcnt vmcnt(0)" ::: "memory");
            __syncthreads();
#pragma unroll 1
            for (int qq = 0; qq < 4; ++qq) { const int q = w * 4 + qq; const unsigned n = nq[q];
                if (n > (unsigned)DSA_TRIG) {
                    const unsigned Th = dsa_hist_T(qhist + q * QHP, lane);
                    dsa_prune(cand + (size_t)q * DSA_CAP, nq, Tq, q, (LAS u32x2*)wscr, hist, lane, false, Th > Tq[q] ? Th : Tq[q]);
                    const int n2 = (int)nq[q]; LAS unsigned* qh = qhist + q * QHP;
                    *(LAS u32x4*)(qh + 4 * lane) = (u32x4){0u, 0u, 0u, 0u};
                    asm volatile("s_waitcnt lgkmcnt(0)" ::: "memory");
#pragma unroll 1
                    for (int i = lane; i < n2; i += 64) { const unsigned bn = dsa_bin(ld_list(cand + (size_t)q * DSA_CAP + i).x); (void)__hip_atomic_fetch_add(qh + (bn >> 1), 1u << (16u * (bn & 1u)), __ATOMIC_RELAXED, __HIP_MEMORY_SCOPE_WORKGROUP); }
                    __builtin_amdgcn_fence(__ATOMIC_ACQUIRE, "agent");
                    asm volatile("s_waitcnt vmcnt(0) lgkmcnt(0)" ::: "memory");
                    if (lane == 0) nlast[q] = (unsigned)n2;
                } }
            __syncthreads();
            if (F.tid == 0) oflag[0] = 0u;
            __syncthreads();
        }
    }
    asm volatile("s_waitcnt vmcnt(0)" ::: "memory");
    __syncthreads();
    dsa_hist_T4(qhist + (w * 4) * QHP, Tq + w * 4, lane, true);
    __syncthreads();
#pragma unroll 1
    for (int qq = 0; qq < 4; ++qq) {
        const int q = w * 4 + qq, qrow = q0 + q; const int n0 = (int)nq[q];
        LAS unsigned* bmp = (LAS unsigned*)(F.lds + 107008 + w * 2048);
        *(LAS u32x4*)(bmp + 8 * lane) = (u32x4){0u, 0u, 0u, 0u}; *(LAS u32x4*)(bmp + 8 * lane + 4) = (u32x4){0u, 0u, 0u, 0u};
        asm volatile("s_waitcnt lgkmcnt(0)" ::: "memory");
        const int n = dsa_final(cand + (size_t)q * DSA_CAP, n0, n0 > 256 ? Tq[q] : 0u, n0 > 256 ? Tq[DSA_TU + q] : 0u, (LAS u32x2*)wscr, hist, bmp, lane);
        unsigned short* srow = (unsigned short*)(F.ws + WS_SEL) + (size_t)qrow * 256;
        { const u32x4 b0 = *(LAS u32x4*)(bmp + 8 * lane), b1 = *(LAS u32x4*)(bmp + 8 * lane + 4); const unsigned wd[8] = {b0.x, b0.y, b0.z, b0.w, b1.x, b1.y, b1.z, b1.w};
          unsigned cnt = 0u;
#pragma unroll
          for (int i = 0; i < 8; ++i) cnt += (unsigned)__popc(wd[i]);
          unsigned pos = wave_prefix_incl(cnt) - cnt;
#pragma unroll
          for (int i = 0; i < 8; ++i) { unsigned wv = wd[i]; while (wv) { const int bpos = __builtin_ctz(wv); srow[pos++] = (unsigned short)(lane * 256 + i * 32 + bpos); wv &= wv - 1u; } } }
        if (lane == 0) ((int*)(F.ws + WS_NSEL))[qrow] = n;
    }
    asm volatile("s_waitcnt vmcnt(0)" ::: "memory");
}
__device__ __forceinline__ void dsa_pack_phase(Frame& F) {
    const bf16* P = (const bf16*)(F.ws + WS_PU); unsigned char* T8 = F.ws + WS_KV8;
    for (int t = F.bid * 512 + F.tid; t < S * 32; t += F.G * 512) {
        const int row = t >> 5, ch = t & 31;
        const bf16* src = P + (size_t)row * PW + C_KA + ch * 16;
        const u32x4 a0 = *(const u32x4*)src, a1 = *(const u32x4*)(src + 8);
        u32x4 o; int v;
        v = __builtin_amdgcn_cvt_pk_fp8_f32(bflo(a0.x), bfhi(a0.x), 0, false); v = __builtin_amdgcn_cvt_pk_fp8_f32(bflo(a0.y), bfhi(a0.y), v, true); o.x = (unsigned)v;
        v = __builtin_amdgcn_cvt_pk_fp8_f32(bflo(a0.z), bfhi(a0.z), 0, false); v = __builtin_amdgcn_cvt_pk_fp8_f32(bflo(a0.w), bfhi(a0.w), v, true); o.y = (unsigned)v;
        v = __builtin_amdgcn_cvt_pk_fp8_f32(bflo(a1.x), bfhi(a1.x), 0, false); v = __builtin_amdgcn_cvt_pk_fp8_f32(bflo(a1.y), bfhi(a1.y), v, true); o.z = (unsigned)v;
        v = __builtin_amdgcn_cvt_pk_fp8_f32(bflo(a1.z), bfhi(a1.z), 0, false); v = __builtin_amdgcn_cvt_pk_fp8_f32(bflo(a1.w), bfhi(a1.w), v, true); o.w = (unsigned)v;
        *(u32x4*)(T8 + (size_t)row * 512 + ch * 16) = o;
    }
}
__device__ __forceinline__ void dsa_sparse_unit(Frame& F, int G32) {
    const bf16* P = (const bf16*)(F.ws + WS_PU); bf16* Y = (bf16*)(F.ws + WS_Y);
    const int lane = F.lane, w = F.wave, q0 = G32 * 32;
#pragma unroll 1
    for (int qq = 0; qq < 4; ++qq) {
        int l2 = lane; asm volatile("" : "+v"(l2)); const int ks = l2 >> 4, dg = l2 & 15;
        const int q = w * 4 + qq, qrow = q0 + q; const int n = ((const int*)(F.ws + WS_NSEL))[qrow];
        LAS unsigned short* srt = (LAS unsigned short*)(F.lds + w * 1024 + (qq & 1) * 512);
        { const unsigned long long* g8 = (const unsigned long long*)((const unsigned short*)(F.ws + WS_SEL) + (size_t)qrow * 256); ((LAS unsigned long long*)srt)[lane] = g8[lane]; }
        asm volatile("s_waitcnt vmcnt(0) lgkmcnt(0)" ::: "memory");
        float qv[16];
        { const u32x4 a0 = *(const u32x4*)(P + (size_t)qrow * PW + C_QA + dg * 16), a1 = *(const u32x4*)(P + (size_t)qrow * PW + C_QA + dg * 16 + 8); const float sc = 0.125f * 1.4426950408889634f;
          qv[0] = bflo(a0.x) * sc; qv[1] = bfhi(a0.x) * sc; qv[2] = bflo(a0.y) * sc; qv[3] = bfhi(a0.y) * sc; qv[4] = bflo(a0.z) * sc; qv[5] = bfhi(a0.z) * sc; qv[6] = bflo(a0.w) * sc; qv[7] = bfhi(a0.w) * sc;
          qv[8] = bflo(a1.x) * sc; qv[9] = bfhi(a1.x) * sc; qv[10] = bflo(a1.y) * sc; qv[11] = bfhi(a1.y) * sc; qv[12] = bflo(a1.z) * sc; qv[13] = bfhi(a1.z) * sc; qv[14] = bflo(a1.w) * sc; qv[15] = bfhi(a1.w) * sc; }
        float mrun = -1e30f, lrun = 0.f, o[16];
#pragma unroll
        for (int i = 0; i < 16; ++i) o[i] = 0.f;
        const int nb = (n + 31) >> 5;
        const unsigned char* T8 = F.ws + WS_KV8 + dg * 16;
#pragma unroll 1
        for (int bt = 0; bt < nb; ++bt) {
            u32x4 kk[8], vv[8]; bool val[8];
#pragma unroll
            for (int t = 0; t < 8; ++t) { const int jn = bt * 32 + t * 4 + ks; val[t] = jn < n; const unsigned idx = val[t] ? (unsigned)srt[jn] : 0u;
                const unsigned char* kp = T8 + (size_t)idx * 512; kk[t] = *(const u32x4*)kp; vv[t] = *(const u32x4*)(kp + 256); }
#pragma unroll
            for (int t = 0; t < 8; ++t) {
                float d = 0.f;
#pragma unroll
                for (int c4 = 0; c4 < 4; ++c4) { const int wd = (int)kk[t][c4]; const f32x2 lo = __builtin_amdgcn_cvt_pk_f32_fp8(wd, false), hi = __builtin_amdgcn_cvt_pk_f32_fp8(wd, true);
                    d = fmaf(qv[4 * c4], lo.x, d); d = fmaf(qv[4 * c4 + 1], lo.y, d); d = fmaf(qv[4 * c4 + 2], hi.x, d); d = fmaf(qv[4 * c4 + 3], hi.y, d); }
                d += __builtin_bit_cast(float, __builtin_amdgcn_update_dpp(0, __builtin_bit_cast(int, d), 0xB1, 0xf, 0xf, false));
                d += __builtin_bit_cast(float, __builtin_amdgcn_update_dpp(0, __builtin_bit_cast(int, d), 0x4E, 0xf, 0xf, false));
                if (!val[t]) d = -1e30f;
                if (__any(d > mrun + 8.f)) { const float mn = fmaxf(mrun, d), al = __builtin_amdgcn_exp2f(mrun - mn); mrun = mn; lrun *= al;
#pragma unroll
                    for (int i = 0; i < 16; ++i) o[i] *= al; }
                const float p = val[t] ? __builtin_amdgcn_exp2f(d - mrun) : 0.f; lrun += p;
#pragma unroll
                for (int c4 = 0; c4 < 4; ++c4) { const int wd = (int)vv[t][c4]; const f32x2 lo = __builtin_amdgcn_cvt_pk_f32_fp8(wd, false), hi = __builtin_amdgcn_cvt_pk_f32_fp8(wd, true);
                    o[4 * c4] = fmaf(p, lo.x, o[4 * c4]); o[4 * c4 + 1] = fmaf(p, lo.y, o[4 * c4 + 1]); o[4 * c4 + 2] = fmaf(p, hi.x, o[4 * c4 + 2]); o[4 * c4 + 3] = fmaf(p, hi.y, o[4 * c4 + 3]); }
            }
        }
        { float ma = fmaxf(mrun, __shfl_xor(mrun, 16)); ma = fmaxf(ma, __shfl_xor(ma, 32)); const float al = __builtin_amdgcn_exp2f(mrun - ma);
          lrun *= al; lrun += __shfl_xor(lrun, 16); lrun += __shfl_xor(lrun, 32); const float iv = 1.f / lrun;
#pragma unroll
          for (int i = 0; i < 16; ++i) { float t = o[i] * al; t += __shfl_xor(t, 16); t += __shfl_xor(t, 32); o[i] = t * iv; } }
        if (ks == 0) { u32x4 y0, y1; y0.x = pk2(o[0], o[1]); y0.y = pk2(o[2], o[3]); y0.z = pk2(o[4], o[5]); y0.w = pk2(o[6], o[7]); y1.x = pk2(o[8], o[9]); y1.y = pk2(o[10], o[11]); y1.z = pk2(o[12], o[13]); y1.w = pk2(o[14], o[15]);
            *(u32x4*)(Y + (size_t)qrow * 256 + dg * 16) = y0; *(u32x4*)(Y + (size_t)qrow * 256 + dg * 16 + 8) = y1; }
    }
}
__device__ __forceinline__ void dsa_phase(Frame& F) {
#pragma unroll 1
    for (int i2 = F.bid * 2; i2 < 512; i2 += F.G * 2)
#pragma unroll 1
        for (int rep = 0; rep < 2; ++rep) dsa_unit(F, rep ? 511 - (i2 >> 1) : (i2 >> 1));
    __syncthreads();
}
__device__ __forceinline__ void dsa_sparse_phase(Frame& F) {
#pragma unroll 1
    for (int i2 = F.bid * 2; i2 < 512; i2 += F.G * 2)
#pragma unroll 1
        for (int rep = 0; rep < 2; ++rep) dsa_sparse_unit(F, rep ? 511 - (i2 >> 1) : (i2 >> 1));
}

__device__ __forceinline__ void phase_mixers_stub(Frame& F) {
    u32x4* y = (u32x4*)(F.ws + WS_Y); const size_t n = (size_t)1 * S * 256 * 2 / 16;
    for (size_t i = (size_t)F.bid * 512 + F.tid; i < n; i += (size_t)F.G * 512) y[i] = (u32x4){0u, 0u, 0u, 0u};
}

__device__ __forceinline__ Frame mkframe() {
    Frame F; int t = threadIdx.x; asm volatile("" : "+v"(t));
    extern __shared__ __attribute__((aligned(16))) unsigned char lds_raw[];
    F.lds = (LAS unsigned char*)lds_raw; F.ws = kargs()->ws; F.ctl = (unsigned*)(F.ws + WS_CTL);
    F.tid = t; F.lane = t & 63; F.wave = __builtin_amdgcn_readfirstlane(t >> 6); F.G = gridDim.x; F.bid = blockIdx.x;
    return F;
}
__device__ __forceinline__ void grid_barrier() {
    extern __shared__ __attribute__((aligned(16))) unsigned char lds_raw[];
    XcdBarrier b; b.bar = (unsigned*)(kargs()->ws + WS_CTL) + CW_BAR; b.x = xb_xcc_id(); b.st = (volatile LAS unsigned*)((LAS unsigned char*)lds_raw + MISC_OFF) + 8;
    xcd_barrier(b);
}
constexpr int NSEG = 14;
#ifndef SEGMASK
#define SEGMASK 0xffff
#endif
template <int l> __device__ __forceinline__ void layer_body() {
#if MK_MULTI
#define RUN(k) (((SEGMASK >> (k)) & 1) && (l * NSEG + (k)) >= kargs()->seg_lo && (l * NSEG + (k)) < kargs()->seg_hi)
#define SEAM(k) do { } while (0)
#else
#define RUN(k) ((SEGMASK >> (k)) & 1)
#define SEAM(k) grid_barrier()
#endif
    {
        if (RUN(0) && l == 0) {
            Frame F = mkframe();
            phase_convert(F, l);
            if (l == 0) { const int gw = F.bid * 8 + F.wave, NGW = F.G * 8; const float* x0 = kargs()->in[0]; const float* g0 = kargs()->in[1];
#pragma unroll 2
                for (int m = gw; m < S; m += NGW) rms_row_to_bf16(x0 + (size_t)m * D, g0, (bf16*)(F.ws + WS_H) + (size_t)m * D, F.lane); }
        }
        if (l == 0) SEAM(0);
        if (RUN(1)) {
            Frame F = mkframe();
            pg8::Gemm g{(const bf16*)(F.ws + WS_H), (const bf16*)(F.ws + WS_WIN), S, PW, 1024}; pg8::StaticOrder So; So.init(S, PW, F.G, F.bid);
            pg8::EpiStore E{(bf16*)(F.ws + WS_PU), PW, 0x7fffffff, F.ws + WS_KV8};
            pg8::gemm_phase<pg8::EpiStore, pg8::StaticOrder, true, true>(F.lds, g, So, E, F.tid);
        }
        SEAM(1);
        if (RUN(2)) { Frame F = mkframe(); ml_phase1(F, l); }
        if (RUN(2)) { Frame F = mkframe(); attn_phase<0>(F, l); }
        SEAM(2);
        if (RUN(3)) { Frame F = mkframe(); ml_phase3(F, l); }
        if (RUN(3)) { Frame F = mkframe(); attnD_phase(F, l); }
        SEAM(3);
        if (RUN(4)) { Frame F = mkframe(); ml_phase4(F); }
        if (RUN(4)) { Frame F = mkframe(); dsa_phase(F); }
        if (RUN(4)) { Frame F = mkframe(); dsa_sparse_phase(F); }
        SEAM(4);
        if (RUN(5)) { Frame F = mkframe(); ml_phase5(F, l); }
        SEAM(5);
        if (RUN(6)) {
            Frame F = mkframe();
            pg8::Gemm g{(const bf16*)(F.ws + WS_Y), (const bf16*)(F.ws + WS_WBR), 4 * S, 4096, 256}; pg8::SchedUp Su{F.G, F.bid};
            pg8::EpiStore E{(bf16*)(F.ws + WS_PU), 4096, 63, nullptr};
            pg8::gemm_phase<pg8::EpiStore, pg8::SchedUp, true, true>(F.lds, g, Su, E, F.tid);
        }
        SEAM(6);
        if (RUN(7)) {
            Frame F = mkframe();
            pg8::Gemm g{(const bf16*)(F.ws + WS_H), (const bf16*)(F.ws + WS_WGATE), S, 4096, 1024}; pg8::StaticOrder So; So.init(S, 4096, F.G, F.bid);
            pg8::EpiGateMix E{(const bf16*)(F.ws + WS_PU), (bf16*)(F.ws + WS_MIXED)};
            pg8::gemm_phase<pg8::EpiGateMix, pg8::StaticOrder, true, true>(F.lds, g, So, E, F.tid);
        }
        SEAM(7);
        if (RUN(8)) {
            Frame F = mkframe();
            pg8::Gemm g{(const bf16*)(F.ws + WS_MIXED), (const bf16*)(F.ws + WS_WOUT), S, 1024, 1024}; pg8::StaticOrder So; So.init(S, 1024, F.G, F.bid);
            float* xo = kargs()->out;
            pg8::EpiResid E{(l == 0) ? kargs()->in[0] : (const float*)xo, xo};
            pg8::gemm_phase<pg8::EpiResid, pg8::StaticOrder, true, true>(F.lds, g, So, E, F.tid);
        }
        SEAM(8);
        if (RUN(9)) { Frame F = mkframe(); phase_router(F, l, kargs()->out); }
        SEAM(9);
        if (RUN(10)) { Frame F = mkframe(); phase_scatter(F, l); }
        SEAM(10);
        if (RUN(11)) {
            Frame F = mkframe();
            moe_table(F, l); const LAS int* tab = (const LAS int*)(F.lds + LDSCTL_OFF);
            pg8::Gemm g{(const bf16*)(F.ws + WS_XS), (const bf16*)(F.ws + WS_W13), NRMAX, NE * 1024, 1024}; pg8::SchedMoe Sm{F.G, F.bid, __builtin_amdgcn_readfirstlane(tab[224]) * 4, tab};
            pg8::EpiSwiglu E{(bf16*)(F.ws + WS_ACT)};
            pg8::gemm_phase<pg8::EpiSwiglu, pg8::SchedMoe, true, true>(F.lds, g, Sm, E, F.tid);
        }
        SEAM(11);
        if (RUN(12)) {
            Frame F = mkframe();
            moe_table(F, l); const LAS int* tab = (const LAS int*)(F.lds + LDSCTL_OFF);
            pg8::Gemm g{(const bf16*)(F.ws + WS_ACT), (const bf16*)(F.ws + WS_W2), NRMAX, NE * 1024, FE}; pg8::SchedMoe Sm{F.G, F.bid, __builtin_amdgcn_readfirstlane(tab[224]) * 4, tab};
            pg8::EpiDown E{(bf16*)(F.ws + WS_YE), (const float*)(F.ws + WS_RT + 393216)};
            pg8::gemm_phase<pg8::EpiDown, pg8::SchedMoe, true, true>(F.lds, g, Sm, E, F.tid);
        }
        SEAM(12);
        if (RUN(13)) { Frame F = mkframe(); phase_combine(F, l, kargs()->out); }
        if (RUN(13) && l + 1 < NL) { Frame F = mkframe(); phase_convert(F, l + 1); }
        if (l + 1 < NL) SEAM(13);
    }
#undef RUN
#undef SEAM
}
__global__ void __launch_bounds__(512, 2) fwd_kernel(Args args) {
    extern __shared__ __attribute__((aligned(16))) unsigned char lds_raw[];
    {
        LAS unsigned char* lds = (LAS unsigned char*)lds_raw;
        for (int u = threadIdx.x; u < (LDS_BYTES - LDSCTL_OFF) / 4; u += 512) ((LAS unsigned*)(lds + LDSCTL_OFF))[u] = 0u;
        __syncthreads();
        if (!MK_MULTI) (void)xcd_barrier_post((unsigned*)(kargs()->ws + WS_CTL) + CW_BAR, (volatile LAS unsigned*)(lds + MISC_OFF) + 8);
    }
    layer_body<0>();
    layer_body<1>();
}

extern "C" void kernel_launch(void* const* d_in, const int* in_sizes, int n_in, void* d_out, int out_size, void* d_ws, size_t ws_size, hipStream_t stream) {
    static int grid = 0;
    if (grid == 0) {
        if (n_in != 23 || out_size != S * D || ws_size < WS_END) { fprintf(stderr, "kernel_launch: unexpected shapes (n_in %d out %d ws %zu need %zu)\n", n_in, out_size, ws_size, (size_t)WS_END); grid = -1; return; }
        int dev = 0, cus = 0, per_cu = 0;
        if (hipGetDevice(&dev) != hipSuccess || hipDeviceGetAttribute(&cus, hipDeviceAttributeMultiprocessorCount, dev) != hipSuccess) { grid = -1; return; }
        if (hipFuncSetAttribute((const void*)fwd_kernel, hipFuncAttributeMaxDynamicSharedMemorySize, LDS_BYTES) != hipSuccess) { fprintf(stderr, "kernel_launch: hipFuncSetAttribute failed\n"); grid = -1; return; }
        if (hipOccupancyMaxActiveBlocksPerMultiprocessor(&per_cu, (const void*)fwd_kernel, 512, LDS_BYTES) != hipSuccess || per_cu < 1) fprintf(stderr, "kernel_launch: occupancy query says %d\n", per_cu);
        (void)hipGetLastError();
        grid = cus;
    }
    if (grid < 0) return;
    if (hipMemsetAsync((char*)d_ws + WS_CTL, 0, CTL_ZERO_BYTES, stream) != hipSuccess) return;
    Args a{};
    for (int i = 0; i < 23; ++i) a.in[i] = (const float*)d_in[i];
    a.out = (float*)d_out; a.ws = (unsigned char*)d_ws;
#if MK_MULTI
    for (int s = 0; s < NL * NSEG; ++s) { a.seg_lo = s; a.seg_hi = s + 1; hipLaunchKernelGGL(fwd_kernel, dim3(grid), dim3(512), LDS_BYTES, stream, a); }
#else
    a.seg_lo = 0; a.seg_hi = NL * NSEG;
    hipLaunchKernelGGL(fwd_kernel, dim3(grid), dim3(512), LDS_BYTES, stream, a);
#endif
}
```

```cpp
#include <hip/hip_runtime.h>
#include <cstdio>
#include <cstdint>

#define GAS __attribute__((address_space(1)))
#define LAS __attribute__((address_space(3)))
typedef unsigned short bf16;
typedef short bf16x8 __attribute__((ext_vector_type(8)));
typedef short s16x4 __attribute__((ext_vector_type(4)));
typedef float f32x2 __attribute__((ext_vector_type(2)));
typedef float f32x4 __attribute__((ext_vector_type(4)));
typedef float f32x16 __attribute__((ext_vector_type(16)));
typedef unsigned u32x2 __attribute__((ext_vector_type(2)));
typedef unsigned u32x4 __attribute__((ext_vector_type(4)));

#ifndef MK_MULTI
#define MK_MULTI 0
#endif

constexpr int S = 16384, D = 1024, NL = 2, NCH = 256;
constexpr int PW = 3584;
constexpr int C_QA = 0, C_KA = 256, C_VA = 512, C_QI = 768, C_KI = 896, C_WI = 928, C_IB = 932, C_FB = 936, C_QB = 960, C_KB = 1216,
              C_VB = 1472, C_OB = 1728, C_QC = 1984, C_KC = 2240, C_VC = 2496, C_QD = 2752, C_KD = 3008, C_VD = 3264;
constexpr int CIN = 3500;
constexpr int NE = 32, FE = 512, NRMAX = 40960, NBMAX = 160;
constexpr float RMS_EPS = 1e-6f;

constexpr size_t MiB = 1u << 20;
constexpr size_t WS_CTL = 0, CTL_ZERO_BYTES = 1 * MiB;
constexpr size_t WS_WIN = 1 * MiB;
constexpr size_t WS_WBR = WS_WIN + 7 * MiB;
constexpr size_t WS_WGATE = WS_WBR + 2 * MiB;
constexpr size_t WS_WOUT = WS_WGATE + 8 * MiB;
constexpr size_t WS_W13 = WS_WOUT + 2 * MiB;
constexpr size_t WS_W2 = WS_W13 + 64 * MiB;
constexpr size_t WS_H = WS_W2 + 32 * MiB;
constexpr size_t WS_PU = WS_H + 32 * MiB;
constexpr size_t WS_XS = WS_PU;
constexpr size_t WS_ACT = WS_PU + 80 * MiB;
constexpr size_t WS_Y = WS_PU + 128 * MiB;
constexpr size_t WS_MIXED = WS_Y + 32 * MiB;
constexpr size_t WS_CAND = WS_MIXED + 32 * MiB;
constexpr size_t WS_YE = WS_Y;
constexpr size_t WS_MLC = WS_CAND + 128 * MiB;
constexpr size_t WS_MLN = WS_MLC + 16 * MiB;
constexpr size_t WS_MLS = WS_MLN + 256 * 1024;
constexpr size_t WS_RT = WS_MLS + 64 * 1024;
constexpr size_t WS_SEL = WS_RT + 1 * MiB;
constexpr size_t WS_NSEL = WS_SEL + 8 * MiB;
constexpr size_t WS_KV8 = WS_NSEL + 1 * MiB;
constexpr size_t WS_END = WS_KV8 + 8 * MiB;
static_assert(WS_YE + (size_t)NRMAX * 1024 * 2 <= WS_MLC, "ye overlay");
static_assert(WS_ACT + (size_t)NRMAX * 512 * 2 <= WS_Y, "act overlay");
constexpr int CW_BAR = 4096;
constexpr int CW_CNT = 16384;
constexpr int CW_FILL = 16384 + 64;

constexpr int RING_BYTES = 131072;
constexpr int LDS_BYTES = 163840;
constexpr int LDSCTL_OFF = LDS_BYTES - 2048;
constexpr int MISC_OFF = LDSCTL_OFF + 1024;

__device__ __forceinline__ unsigned f2bf(float f) { unsigned u = __builtin_bit_cast(unsigned, f); return (u + 0x7fffu + ((u >> 16) & 1u)) >> 16; }
__device__ __forceinline__ unsigned pk2(float lo, float hi) { return f2bf(lo) | (f2bf(hi) << 16); }
__device__ __forceinline__ float bflo(unsigned w) { return __builtin_bit_cast(float, w << 16); }
__device__ __forceinline__ float bfhi(unsigned w) { return __builtin_bit_cast(float, w & 0xffff0000u); }
__device__ __forceinline__ float bf2f(bf16 b) { return __builtin_bit_cast(float, (unsigned)b << 16); }
#define LDS_WAIT() asm volatile("s_waitcnt lgkmcnt(0)" ::: "memory")
#define VM_WAIT() asm volatile("s_waitcnt vmcnt(0)" ::: "memory")
__device__ __forceinline__ float wave_sum(float v) {
#pragma unroll
    for (int o = 1; o < 64; o <<= 1) v += __shfl_xor(v, o);
    return v;
}
__device__ __forceinline__ float wave_max(float v) {
#pragma unroll
    for (int o = 1; o < 64; o <<= 1) v = fmaxf(v, __shfl_xor(v, o));
    return v;
}

namespace pg8 {
#define PG8_LAS __attribute__((address_space(3)))
typedef unsigned short bf16_t;
constexpr int BM = 256, BK = 64, HALF = 128, HTB = HALF * BK * 2, STAGE_BYTES = 8 * HTB, NXCD = 8, WGM = 8;
__host__ __device__ __forceinline__ int lds_byte(int r, int c) { const int st = (r >> 4) * 2 + (c >> 5), rr = r & 15, cc = c & 31, ob = rr * 64 + cc * 2; return st * 1024 + (ob ^ (((ob >> 9) & 1) << 5)); }
__host__ __device__ __forceinline__ void stage_rc(int b, int& R, int& C) { const int st = b / 1024, sb = b % 1024, swz = sb ^ (((sb >> 9) & 1) << 5); R = (st >> 1) * 16 + swz / 64; C = (st & 1) * 32 + (swz % 64) / 2; }
__host__ __device__ __forceinline__ int perm32(int rho) { const int n = rho >> 4, i = rho & 15; return 8 * (i >> 2) + 4 * n + (i & 3); }
struct Unit { int pm, pn; };
struct Gemm { const bf16_t* A; const bf16_t* Bt; int M, N, K; };
struct StaticOrder {
    int nM, nN, nwg, G, c;
    __host__ __device__ void init(int M, int N, int G_, int c_) { nM = M / BM; nN = N / BM; nwg = nM * nN; G = G_; c = c_; }
    __host__ __device__ bool next(int i, Unit& u) const {
        const long L = (long)i * G + c; if (L >= nwg) return false;
        int wgid = (int)L; { const int q = nwg / NXCD, r = nwg % NXCD, xcd = wgid % NXCD, off = wgid / NXCD; wgid = (xcd < r ? xcd * (q + 1) : r * (q + 1) + (xcd - r) * q) + off; }
        const int nig = WGM * nN, gid = wgid / nig, fm = gid * WGM, gsz = (nM - fm) < WGM ? (nM - fm) : WGM;
        u.pm = fm + ((wgid % nig) % gsz); u.pn = (wgid % nig) / gsz; return true;
    }
    __device__ __forceinline__ void a_ready(const Unit&) const {}
    __device__ __forceinline__ void done(const Unit&) const {}
};
__device__ __forceinline__ unsigned cvt_pk_bf16(float lo, float hi) { unsigned r; asm volatile("v_cvt_pk_bf16_f32 %0, %1, %2" : "=v"(r) : "v"(lo), "v"(hi)); return r; }

template <class Epi, class Sched, bool ALIGN_EPI = false, bool SP2 = false>
__device__ __forceinline__ void gemm_phase(PG8_LAS unsigned char* lds, const Gemm g, const Sched& S, const Epi& E, const int tid) {
    const int wid = __builtin_amdgcn_readfirstlane(tid >> 6), lane = tid & 63, wr = wid >> 2, wc = wid & 3, fr = lane & 15, fq = lane >> 4;
    int Kl_ = g.K; asm volatile("" : "+s"(Kl_));
    const int K = Kl_, nt = K / BK;
    unsigned voffA[2], voffB[2];
#pragma unroll
    for (int i = 0; i < 2; ++i) { int R, C; stage_rc(tid * 16 + i * 8192, R, C); const int Rb = Epi::PERM ? ((R & ~31) + perm32(R & 31)) : R;
        voffA[i] = (unsigned)(R * K + C) * 2u; voffB[i] = (unsigned)(Rb * K + C) * 2u; }
    const size_t kstep = (size_t)(BK * 2);
    const size_t hstep = (size_t)HALF * K * 2;
    const size_t tstep = 2 * hstep;
    const unsigned ldsw = (unsigned)wid * 1024u;
    const int aoff = lds_byte(wr * 64 + fr, fq * 8), boff = lds_byte(wc * 32 + fr, fq * 8);
#define PG8_SA(b, h) (((b) * 2 + (h)) * HTB)
#define PG8_SB(b, h) ((4 + (b) * 2 + (h)) * HTB)
#define PG8_STAGE(bufoff, gbase, voff) do { _Pragma("unroll") for (int _i = 0; _i < 2; ++_i) \
        __builtin_amdgcn_global_load_lds((const unsigned*)((const char*)(gbase) + (voff)[_i]), (PG8_LAS unsigned*)(lds + (bufoff) + ldsw + _i * 8192), 16, 0, 0); } while (0)
#define PG8_LDA(dst, b, h) do { _Pragma("unroll") for (int m = 0; m < 4; ++m) _Pragma("unroll") for (int k = 0; k < 2; ++k) dst[m][k] = *(const PG8_LAS bf16x8*)(lds + PG8_SA(b, h) + aoff + m * 2048 + k * 1024); } while (0)
#define PG8_LDB(dst, b, h) do { _Pragma("unroll") for (int n = 0; n < 2; ++n) _Pragma("unroll") for (int k = 0; k < 2; ++k) dst[n][k] = *(const PG8_LAS bf16x8*)(lds + PG8_SB(b, h) + boff + n * 2048 + k * 1024); } while (0)
#define PG8_MMA(ai, bj, At, Bt) do { __builtin_amdgcn_s_setprio(1); _Pragma("unroll") for (int m = 0; m < 4; ++m) _Pragma("unroll") for (int n = 0; n < 2; ++n) _Pragma("unroll") for (int k = 0; k < 2; ++k) \
        acc[ai][bj][m][n] = __builtin_amdgcn_mfma_f32_16x16x32_bf16(Bt[n][k], At[m][k], acc[ai][bj][m][n], 0, 0, 0); __builtin_amdgcn_s_setprio(0); } while (0)
#define PG8_WAIT_V(n) asm volatile("s_waitcnt vmcnt(" #n ")" ::: "memory")
#define PG8_WAIT_L(n) asm volatile("s_waitcnt lgkmcnt(" #n ")" ::: "memory")
#define PG8_BAR __builtin_amdgcn_s_barrier()
#define PG8_SCHED __builtin_amdgcn_sched_barrier(0)
    Unit cur, nxt; int ui = 0;
    if (!S.next(0, cur)) return;
    f32x4 acc[2][2][4][2];
#pragma unroll
    for (int a = 0; a < 2; ++a)
#pragma unroll
        for (int b = 0; b < 2; ++b)
#pragma unroll
            for (int m = 0; m < 4; ++m)
#pragma unroll
                for (int n = 0; n < 2; ++n) acc[a][b][m][n] = (f32x4){0.f, 0.f, 0.f, 0.f};
    bf16x8 At[4][2], B0[2][2], B1[2][2];
    const char* cA = (const char*)g.A + (size_t)cur.pm * tstep; const char* cB = (const char*)g.Bt + (size_t)cur.pn * tstep;
    S.a_ready(cur);
    if constexpr (SP2) {
        PG8_STAGE(PG8_SB(0, 0), cB, voffB); PG8_STAGE(PG8_SB(0, 1), cB + hstep, voffB); PG8_STAGE(PG8_SA(0, 0), cA, voffA); PG8_STAGE(PG8_SA(0, 1), cA + hstep, voffA);
        if (wr == 1) PG8_BAR;
        PG8_WAIT_V(2); PG8_BAR;
        PG8_STAGE(PG8_SB(1, 0), cB + kstep, voffB); PG8_STAGE(PG8_SA(1, 0), cA + kstep, voffA); PG8_STAGE(PG8_SB(1, 1), cB + hstep + kstep, voffB);
        PG8_WAIT_V(6); PG8_BAR;
    } else {
        PG8_STAGE(PG8_SB(0, 0), cB, voffB); PG8_STAGE(PG8_SA(0, 0), cA, voffA); PG8_STAGE(PG8_SB(0, 1), cB + hstep, voffB); PG8_STAGE(PG8_SA(0, 1), cA + hstep, voffA);
        if (wr == 1) PG8_BAR;
        PG8_WAIT_V(4); PG8_BAR;
        PG8_STAGE(PG8_SB(1, 0), cB + kstep, voffB); PG8_STAGE(PG8_SA(1, 0), cA + kstep, voffA); PG8_STAGE(PG8_SB(1, 1), cB + hstep + kstep, voffB);
        PG8_WAIT_V(6); PG8_BAR;
    }
    asm volatile(".p2align 8" ::: "memory");
    for (;;) {
        const bool has_next = S.next(ui + 1, nxt);
        const char* nA = has_next ? (const char*)g.A + (size_t)nxt.pm * tstep : cA; const char* nB = has_next ? (const char*)g.Bt + (size_t)nxt.pn * tstep : cB;
        for (int t = 0; t < nt; t += 2) {
            const bool last = (t == nt - 2);
            const char* a1 = cA + (size_t)(t + 1) * kstep;
            const char* a2 = last ? nA : cA + (size_t)(t + 2) * kstep; const char* b2 = last ? nB : cB + (size_t)(t + 2) * kstep;
            const char* a3 = a2 + kstep; const char* b3 = b2 + kstep;
            if (last && has_next) S.a_ready(nxt);
            if constexpr (SP2) {
            PG8_LDB(B0, 0, 0); PG8_LDB(B1, 0, 1); PG8_SCHED; PG8_LDA(At, 0, 0); PG8_STAGE(PG8_SA(1, 1), a1 + hstep, voffA);
            PG8_WAIT_V(8); PG8_WAIT_L(0); PG8_BAR; PG8_MMA(0, 0, At, B0); PG8_MMA(0, 1, At, B1); PG8_BAR; PG8_SCHED;
            PG8_LDA(At, 0, 1); PG8_STAGE(PG8_SB(0, 0), b2, voffB); PG8_STAGE(PG8_SB(0, 1), b2 + hstep, voffB); PG8_STAGE(PG8_SA(0, 0), a2, voffA);
            PG8_WAIT_V(8); PG8_WAIT_L(0); PG8_BAR; PG8_MMA(1, 0, At, B0); PG8_MMA(1, 1, At, B1); PG8_BAR; PG8_SCHED;
            PG8_LDB(B0, 1, 0); PG8_LDB(B1, 1, 1); PG8_SCHED; PG8_LDA(At, 1, 0); PG8_STAGE(PG8_SA(0, 1), a2 + hstep, voffA);
            PG8_WAIT_V(8); PG8_WAIT_L(0); PG8_BAR; PG8_MMA(0, 0, At, B0); PG8_MMA(0, 1, At, B1); PG8_BAR; PG8_SCHED;
            PG8_LDA(At, 1, 1); PG8_STAGE(PG8_SB(1, 0), b3, voffB); PG8_STAGE(PG8_SB(1, 1), b3 + hstep, voffB); PG8_STAGE(PG8_SA(1, 0), a3, voffA);
            PG8_WAIT_V(8); PG8_WAIT_L(0); PG8_BAR; PG8_MMA(1, 0, At, B0); PG8_MMA(1, 1, At, B1); PG8_BAR; PG8_SCHED;
            } else {
            PG8_LDB(B0, 0, 0); PG8_SCHED; PG8_LDA(At, 0, 0); PG8_STAGE(PG8_SA(1, 1), a1 + hstep, voffA);
            PG8_WAIT_L(8); PG8_BAR; PG8_WAIT_L(0); PG8_MMA(0, 0, At, B0); PG8_BAR; PG8_SCHED;
            PG8_LDB(B1, 0, 1); PG8_STAGE(PG8_SB(0, 0), b2, voffB);
            PG8_BAR; PG8_WAIT_L(0); PG8_MMA(0, 1, At, B1); PG8_BAR;
            PG8_LDA(At, 0, 1); PG8_STAGE(PG8_SA(0, 0), a2, voffA);
            PG8_BAR; PG8_WAIT_L(0); PG8_MMA(1, 0, At, B0); PG8_BAR; PG8_SCHED;
            PG8_STAGE(PG8_SB(0, 1), b2 + hstep, voffB);
            PG8_WAIT_V(6); PG8_BAR; PG8_MMA(1, 1, At, B1); PG8_BAR;
            PG8_LDB(B0, 1, 0); PG8_SCHED; PG8_LDA(At, 1, 0); PG8_STAGE(PG8_SA(0, 1), a2 + hstep, voffA);
            PG8_WAIT_L(8); PG8_BAR; PG8_WAIT_L(0); PG8_MMA(0, 0, At, B0); PG8_BAR; PG8_SCHED;
            PG8_LDB(B1, 1, 1); PG8_STAGE(PG8_SB(1, 0), b3, voffB);
            PG8_BAR; PG8_WAIT_L(0); PG8_MMA(0, 1, At, B1); PG8_BAR;
            PG8_LDA(At, 1, 1); PG8_STAGE(PG8_SA(1, 0), a3, voffA);
            PG8_BAR; PG8_WAIT_L(0); PG8_MMA(1, 0, At, B0); PG8_BAR; PG8_SCHED;
            PG8_STAGE(PG8_SB(1, 1), b3 + hstep, voffB);
            PG8_WAIT_V(6); PG8_BAR; PG8_MMA(1, 1, At, B1); PG8_BAR;
            }
        }
        if constexpr (ALIGN_EPI) { if (wr == 0) PG8_BAR; }
        E(acc, cur, wr, wc, fr, fq); S.done(cur);
        if (!has_next) break;
#pragma unroll
        for (int a = 0; a < 2; ++a)
#pragma unroll
            for (int b = 0; b < 2; ++b)
#pragma unroll
                for (int m = 0; m < 4; ++m)
#pragma unroll
                    for (int n = 0; n < 2; ++n) acc[a][b][m][n] = (f32x4){0.f, 0.f, 0.f, 0.f};
        cur = nxt; cA = nA; cB = nB; ++ui;
        if constexpr (ALIGN_EPI) { if (wr == 1) PG8_BAR; }
    }
    PG8_WAIT_V(0);
    if constexpr (!ALIGN_EPI) { if (wr == 0) PG8_BAR; }
    PG8_BAR;
#undef PG8_SA
#undef PG8_SB
#undef PG8_STAGE
#undef PG8_LDA
#undef PG8_LDB
#undef PG8_MMA
#undef PG8_WAIT_V
#undef PG8_WAIT_L
#undef PG8_BAR
#undef PG8_SCHED
}

struct EpiStore {
    static constexpr bool PERM = true;
    bf16_t* O; int ldc; int rowmask; unsigned char* T8;
    __device__ __forceinline__ void operator()(const f32x4 (&acc)[2][2][4][2], const Unit& u, int wr, int wc, int fr, int fq) const {
        const int row0 = (u.pm & rowmask) * BM + wr * 64 + fr, col0 = u.pn * BM + wc * 32 + 8 * fq;
        const bool side = T8 != nullptr && (u.pn == 1 || u.pn == 2);
#pragma unroll
        for (int ai = 0; ai < 2; ++ai)
#pragma unroll
            for (int m = 0; m < 4; ++m) { int row = row0 + ai * HALF + m * 16; asm volatile("" : "+v"(row)); bf16_t* rowp = O + (size_t)row * ldc + col0;
#pragma unroll
                for (int bj = 0; bj < 2; ++bj) { const f32x4 v0 = acc[ai][bj][m][0], v1 = acc[ai][bj][m][1];
                    u32x4 w; w.x = cvt_pk_bf16(v0[0], v0[1]); w.y = cvt_pk_bf16(v0[2], v0[3]); w.z = cvt_pk_bf16(v1[0], v1[1]); w.w = cvt_pk_bf16(v1[2], v1[3]);
                    *(u32x4*)(rowp + bj * HALF) = w;
                    if (side) { int q0 = __builtin_amdgcn_cvt_pk_fp8_f32(v0[0], v0[1], 0, false); q0 = __builtin_amdgcn_cvt_pk_fp8_f32(v0[2], v0[3], q0, true);
                        int q1 = __builtin_amdgcn_cvt_pk_fp8_f32(v1[0], v1[1], 0, false); q1 = __builtin_amdgcn_cvt_pk_fp8_f32(v1[2], v1[3], q1, true);
                        *(u32x2*)(T8 + (size_t)row * 512 + (col0 + bj * HALF - 256)) = (u32x2){(unsigned)q0, (unsigned)q1}; } } }
    }
};
__device__ __forceinline__ float sigmoidf_(float x) { return 1.f / (1.f + __expf(-x)); }
struct EpiGateMix {
    static constexpr bool PERM = true;
    const bf16_t* U; bf16_t* MX;
    __device__ __forceinline__ void operator()(const f32x4 (&acc)[2][2][4][2], const Unit& u, int wr, int wc, int fr, int fq) const {
        const int row0 = u.pm * BM + wr * 64 + fr, dcol = u.pn * 64 + wc * 16 + fq * 4;
        u32x2 un[4];
        { int row = row0; asm volatile("" : "+v"(row)); const bf16_t* up = U + (size_t)row * 4096 + dcol;
#pragma unroll
          for (int b4 = 0; b4 < 4; ++b4) un[b4] = *(const u32x2*)(up + b4 * 1024); }
#pragma unroll
        for (int it = 0; it < 8; ++it) { const int ai = it >> 2, m = it & 3;
            u32x2 uc[4];
#pragma unroll
            for (int b4 = 0; b4 < 4; ++b4) uc[b4] = un[b4];
            if (it < 7) { int rown = row0 + ((it + 1) >> 2) * HALF + ((it + 1) & 3) * 16; asm volatile("" : "+v"(rown)); const bf16_t* up = U + (size_t)rown * 4096 + dcol;
#pragma unroll
                for (int b4 = 0; b4 < 4; ++b4) un[b4] = *(const u32x2*)(up + b4 * 1024); }
            int row = row0 + ai * HALF + m * 16; asm volatile("" : "+v"(row));
            float o0 = 0.f, o1 = 0.f, o2 = 0.f, o3 = 0.f;
#pragma unroll
            for (int bj = 0; bj < 2; ++bj)
#pragma unroll
                for (int n = 0; n < 2; ++n) { const u32x2 uu = uc[2 * bj + n]; const f32x4 a = acc[ai][bj][m][n];
                    o0 += sigmoidf_(a[0]) * bflo(uu.x); o1 += sigmoidf_(a[1]) * bfhi(uu.x); o2 += sigmoidf_(a[2]) * bflo(uu.y); o3 += sigmoidf_(a[3]) * bfhi(uu.y); }
            u32x2 w; w.x = cvt_pk_bf16(o0, o1); w.y = cvt_pk_bf16(o2, o3);
            *(u32x2*)(MX + (size_t)row * 1024 + dcol) = w; }
    }
};
struct EpiResid {
    static constexpr bool PERM = true;
    const float* xin; float* xout;
    __device__ __forceinline__ void operator()(const f32x4 (&acc)[2][2][4][2], const Unit& u, int wr, int wc, int fr, int fq) const {
        const int row0 = u.pm * BM + wr * 64 + fr, col0 = u.pn * BM + wc * 32 + 8 * fq;
        f32x4 xn[4];
        { int row = row0; asm volatile("" : "+v"(row)); const float* xp = xin + (size_t)row * 1024 + col0;
#pragma unroll
          for (int q4 = 0; q4 < 4; ++q4) xn[q4] = *(const f32x4*)(xp + (q4 >> 1) * HALF + 4 * (q4 & 1)); }
#pragma unroll
        for (int it = 0; it < 8; ++it) { const int ai = it >> 2, m = it & 3;
            f32x4 xc[4];
#pragma unroll
            for (int q4 = 0; q4 < 4; ++q4) xc[q4] = xn[q4];
            if (it < 7) { int rown = row0 + ((it + 1) >> 2) * HALF + ((it + 1) & 3) * 16; asm volatile("" : "+v"(rown)); const float* xp = xin + (size_t)rown * 1024 + col0;
#pragma unroll
                for (int q4 = 0; q4 < 4; ++q4) xn[q4] = *(const f32x4*)(xp + (q4 >> 1) * HALF + 4 * (q4 & 1)); }
            int row = row0 + ai * HALF + m * 16; asm volatile("" : "+v"(row)); const size_t ro = (size_t)row * 1024 + col0;
#pragma unroll
            for (int bj = 0; bj < 2; ++bj)
#pragma unroll
                for (int n = 0; n < 2; ++n) *(f32x4*)(xout + ro + bj * HALF + 4 * n) = xc[2 * bj + n] + acc[ai][bj][m][n]; }
    }
};
struct EpiSwiglu {
    static constexpr bool PERM = true;
    bf16_t* ACT;
    __device__ __forceinline__ void operator()(const f32x4 (&acc)[2][2][4][2], const Unit& u, int wr, int wc, int fr, int fq) const {
        const int row0 = u.pm * BM + wr * 64 + fr, col0 = (u.pn & 3) * 128 + wc * 32 + 8 * fq;
#pragma unroll
        for (int ai = 0; ai < 2; ++ai)
#pragma unroll
            for (int m = 0; m < 4; ++m) { int row = row0 + ai * HALF + m * 16; asm volatile("" : "+v"(row)); float v[8];
#pragma unroll
                for (int n = 0; n < 2; ++n)
#pragma unroll
                    for (int i = 0; i < 4; ++i) { const float a = acc[ai][0][m][n][i], b = acc[ai][1][m][n][i]; v[4 * n + i] = a * sigmoidf_(a) * b; }
                u32x4 w; w.x = cvt_pk_bf16(v[0], v[1]); w.y = cvt_pk_bf16(v[2], v[3]); w.z = cvt_pk_bf16(v[4], v[5]); w.w = cvt_pk_bf16(v[6], v[7]);
                *(u32x4*)(ACT + (size_t)row * 512 + col0) = w; }
    }
};
struct EpiDown {
    static constexpr bool PERM = true;
    bf16_t* YE; const float* roww;
    __device__ __forceinline__ void operator()(const f32x4 (&acc)[2][2][4][2], const Unit& u, int wr, int wc, int fr, int fq) const {
        const int row0 = u.pm * BM + wr * 64 + fr, col0 = (u.pn & 3) * BM + wc * 32 + 8 * fq;
        float sw[8];
#pragma unroll
        for (int it = 0; it < 8; ++it) sw[it] = roww[row0 + (it >> 2) * HALF + (it & 3) * 16];
#pragma unroll
        for (int ai = 0; ai < 2; ++ai)
#pragma unroll
            for (int m = 0; m < 4; ++m) { int row = row0 + ai * HALF + m * 16; asm volatile("" : "+v"(row)); const float s = sw[ai * 4 + m]; bf16_t* rowp = YE + (size_t)row * 1024 + col0;
#pragma unroll
                for (int bj = 0; bj < 2; ++bj) { const f32x4 v0 = acc[ai][bj][m][0] * s, v1 = acc[ai][bj][m][1] * s;
                    u32x4 w; w.x = cvt_pk_bf16(v0[0], v0[1]); w.y = cvt_pk_bf16(v0[2], v0[3]); w.z = cvt_pk_bf16(v1[0], v1[1]); w.w = cvt_pk_bf16(v1[2], v1[3]);
                    *(u32x4*)(rowp + bj * HALF) = w; } }
    }
};
struct SchedUp {
    int G, c;
    __device__ __forceinline__ bool next(int i, Unit& u) const { const int L = i * G + c; if (L >= 1024) return false; const int n = L >> 8, pm = (L >> 2) & 63, pn = L & 3; u.pm = n * 64 + pm; u.pn = n * 4 + pn; return true; }
    __device__ __forceinline__ void a_ready(const Unit&) const {}
    __device__ __forceinline__ void done(const Unit&) const {}
};
struct SchedMoe {
    int G, c, nunits; const PG8_LAS int* tab;
    __device__ __forceinline__ bool next(int i, Unit& u) const { const int L = i * G + c; if (L >= nunits) return false; const int b = L >> 2, t = L & 3; const int e = __builtin_amdgcn_readfirstlane(tab[b]); u.pm = b; u.pn = e * 4 + t; return true; }
    __device__ __forceinline__ void a_ready(const Unit&) const {}
    __device__ __forceinline__ void done(const Unit&) const {}
};
}

#define XB_TMO      128
#define XB_XCNT(j)  (256  + 64 * (j))
#define XB_XSUB(j)  (1280 + 64 * (j))
#define XB_XGEN(j)  (2304 + 64 * (j))
#define XB_TOP      3328
#define XB_TOPGEN   3392
#define XCD_BAR_WORDS 3456
#define XB_SPIN_CAP (1u << 18)
__device__ __forceinline__ unsigned xb_ld(unsigned* p)              { return __hip_atomic_load(p, __ATOMIC_RELAXED, __HIP_MEMORY_SCOPE_AGENT); }
__device__ __forceinline__ unsigned xb_add(unsigned* p, unsigned v) { return __hip_atomic_fetch_add(p, v, __ATOMIC_RELAXED, __HIP_MEMORY_SCOPE_AGENT); }
__device__ __forceinline__ unsigned xb_xcc_id() { return (unsigned)__builtin_amdgcn_s_getreg((3 << 11) | 20) & 0xFu; }
#define XB_SPIN(cond, bar) do { unsigned _sp = 0; while (cond) { __builtin_amdgcn_s_sleep(1); \
    if ((++_sp & 255u) == 0u) { if (xb_ld(&(bar)[XB_TMO])) break; if (_sp > XB_SPIN_CAP) { atomicAdd(&(bar)[XB_TMO], 1u); break; } } } } while (0)
struct XcdBarrier { unsigned* bar; unsigned x; volatile LAS unsigned* st; };
__device__ __forceinline__ XcdBarrier xcd_barrier_post(unsigned* bar, volatile LAS unsigned* st) {
    XcdBarrier b; b.bar = bar; b.x = xb_xcc_id(); b.st = st;
    if (threadIdx.x == 0) (void)xb_add(&bar[XB_XCNT(b.x)], 1u);
    return b;
}
__device__ __forceinline__ void xcd_barrier_complete(unsigned* bar, unsigned x, unsigned& nloc, unsigned& nx) {
    const unsigned G = gridDim.x * gridDim.y * gridDim.z;
    unsigned sum, cnt, mine, sp = 0u;
    for (;;) {
        sum = 0u; cnt = 0u; mine = 0u;
#pragma unroll
        for (unsigned j = 0; j < 16; ++j) { const unsigned c = xb_ld(&bar[XB_XCNT(j)]); sum += c; cnt += (c > 0u) ? 1u : 0u; mine = (j == x) ? c : mine; }
        if (sum == G) break;
        __builtin_amdgcn_s_sleep(1);
        if ((++sp & 255u) == 0u) { if (xb_ld(&bar[XB_TMO])) break; if (sp > XB_SPIN_CAP) { atomicAdd(&bar[XB_TMO], 1u); break; } }
    }
    nloc = mine > 0u ? mine : 1u; nx = cnt > 0u ? cnt : 1u;
}
__device__ __forceinline__ void xcd_barrier(const XcdBarrier& b) {
    asm volatile("s_waitcnt vmcnt(0)" ::: "memory");
    __syncthreads();
    if (threadIdx.x == 0) {
        unsigned* bar = b.bar;
        __builtin_amdgcn_s_waitcnt(0);
        unsigned nloc = b.st[0], nx = b.st[1];
        if (nloc == 0u) { xcd_barrier_complete(bar, b.x, nloc, nx); b.st[0] = nloc; b.st[1] = nx; }
        const unsigned old = xb_add(&bar[XB_XSUB(b.x)], 1u);
        const unsigned gen = old / nloc;
        if (old + 1u == (gen + 1u) * nloc) {
            __builtin_amdgcn_fence(__ATOMIC_RELEASE, "agent");
            asm volatile("s_waitcnt vmcnt(0)" ::: "memory");
            const unsigned og = xb_add(&bar[XB_TOP], 1u);
            const unsigned tg = og / nx;
            if (og + 1u == (tg + 1u) * nx) xb_add(&bar[XB_TOPGEN], 1u);
            else XB_SPIN(xb_ld(&bar[XB_TOPGEN]) == tg, bar);
            __builtin_amdgcn_fence(__ATOMIC_ACQUIRE, "agent");
            xb_add(&bar[XB_XGEN(b.x)], 1u);
            asm volatile("s_waitcnt vmcnt(0)" ::: "memory");
        } else {
            XB_SPIN(xb_ld(&bar[XB_XGEN(b.x)]) == gen, bar);
            __builtin_amdgcn_fence(__ATOMIC_ACQUIRE, "agent");
            asm volatile("s_waitcnt vmcnt(0)" ::: "memory");
        }
    }
    __syncthreads();
}

struct Args {
    const float* in[23]; float* out; unsigned char* ws; int seg_lo, seg_hi;
};
typedef const __attribute__((address_space(4))) Args* ArgsP;
__device__ __forceinline__ ArgsP kargs() { unsigned long long v = (unsigned long long)__builtin_amdgcn_kernarg_segment_ptr(); asm volatile("" : "+s"(v)); return (ArgsP)v; }
struct Frame {
    LAS unsigned char* lds; unsigned char* ws; unsigned* ctl;
    int tid, lane, wave, G, bid;
};

template <class SC>
__device__ __forceinline__ void cvt_item(const float* W, int ldw, int K, bf16* WT, int k0, int n0, SC sc, LAS float* scr, int lane) {
    const int nl = lane & 31; const int scol = sc(n0 + nl);
    float wv[32];
    const float* wp = W + (size_t)(k0 + (lane >> 5)) * ldw + (scol >= 0 ? scol : 0);
#pragma unroll
    for (int i = 0; i < 32; ++i) wv[i] = wp[(size_t)(2 * i) * ldw];
#pragma unroll
    for (int i = 0; i < 32; ++i) { const int kk = 2 * i + (lane >> 5); scr[kk * 33 + nl] = scol >= 0 ? wv[i] : 0.f; }
    LDS_WAIT(); asm volatile("" ::: "memory");
    const int c = lane & 7;
#pragma unroll
    for (int j = 0; j < 4; ++j) { const int n = (lane >> 3) + 8 * j; const LAS float* s = scr + (8 * c) * 33 + n;
        u32x4 o; o.x = pk2(s[0 * 33], s[1 * 33]); o.y = pk2(s[2 * 33], s[3 * 33]); o.z = pk2(s[4 * 33], s[5 * 33]); o.w = pk2(s[6 * 33], s[7 * 33]);
        *(u32x4*)(WT + (size_t)(n0 + n) * K + k0 + 8 * c) = o; }
    LDS_WAIT(); asm volatile("" ::: "memory");
}
__device__ __forceinline__ int src_col_win(int dc) {
    if (dc < 932) return dc;
    if (dc < 936) return 1700 + (dc - 932);
    if (dc < 940) return 1704 + (dc - 936);
    if (dc < 960) return -1;
    if (dc < 1728) return 932 + (dc - 960);
    if (dc < 1984) return 1708 + (dc - 1728);
    if (dc < 3520) return 1964 + (dc - 1984);
    return -1;
}
__device__ __forceinline__ void phase_convert(Frame& F, int l) {
    ArgsP a = kargs();
    LAS float* scr = (LAS float*)(F.lds + F.wave * 16384);
    const int gw = F.bid * 8 + F.wave, NGW = F.G * 8;
    constexpr int I_WIN = 16 * 112, I_WBR = 4 * 4 * 32, I_WG = 16 * 128, I_WO = 16 * 32, I_W13 = 32 * 16 * 32, I_W2 = 32 * 8 * 32;
    constexpr int NIT = I_WIN + I_WBR + I_WG + I_WO + I_W13 + I_W2;
    const float* w_in = a->in[2] + (size_t)l * 1024 * CIN;
    const float* w_br = a->in[11] + (size_t)l * 4 * 256 * 1024;
    const float* w_gate = a->in[12] + (size_t)l * 1024 * 4096;
    const float* w_out = a->in[13] + (size_t)l * 1024 * 1024;
    const float* w1 = a->in[19] + (size_t)l * NE * 1024 * FE;
    const float* w3 = a->in[20] + (size_t)l * NE * 1024 * FE;
    const float* w2 = a->in[21] + (size_t)l * NE * FE * 1024;
    for (int it = gw; it < NIT; it += NGW) {
        int r = it;
        if (r < I_WIN) { const int kb = r / 112, nb = r % 112; cvt_item(w_in, CIN, 1024, (bf16*)(F.ws + WS_WIN), kb * 64, nb * 32, [](int n) { return src_col_win(n); }, scr, F.lane); continue; } r -= I_WIN;
        if (r < I_WBR) { const int n = r / 128, q = r % 128, kb = q / 32, nb = q % 32; cvt_item(w_br + (size_t)n * 256 * 1024, 1024, 256, (bf16*)(F.ws + WS_WBR) + (size_t)n * 1024 * 256, kb * 64, nb * 32, [](int c) { return c; }, scr, F.lane); continue; } r -= I_WBR;
        if (r < I_WG) { const int kb = r / 128, nb = r % 128;
            cvt_item(w_gate, 4096, 1024, (bf16*)(F.ws + WS_WGATE), kb * 64, nb * 32, [](int np) { const int pn = np >> 8, L = np & 255, bj = L >> 7, wc = (L >> 5) & 3, fq = (L >> 3) & 3, n = (L >> 2) & 1, i = L & 3;
                return (2 * bj + n) * 1024 + pn * 64 + wc * 16 + fq * 4 + i; }, scr, F.lane); continue; } r -= I_WG;
        if (r < I_WO) { const int kb = r / 32, nb = r % 32; cvt_item(w_out, 1024, 1024, (bf16*)(F.ws + WS_WOUT), kb * 64, nb * 32, [](int c) { return c; }, scr, F.lane); continue; } r -= I_WO;
        if (r < I_W13) { const int e = r / 512, q = r % 512, kb = q / 32, nb = q % 32;
            const int t = (nb * 32) >> 8, L0 = (nb * 32) & 255; const float* src = (L0 < 128 ? w1 : w3) + (size_t)e * 1024 * FE; const int cbase = t * 128 + (L0 & 127) - nb * 32;
            cvt_item(src, FE, 1024, (bf16*)(F.ws + WS_W13) + (size_t)e * 1024 * 1024, kb * 64, nb * 32, [cbase](int np) { return np + cbase; }, scr, F.lane); continue; } r -= I_W13;
        { const int e = r / 256, q = r % 256, kb = q / 32, nb = q % 32; cvt_item(w2 + (size_t)e * FE * 1024, 1024, FE, (bf16*)(F.ws + WS_W2) + (size_t)e * 1024 * FE, kb * 64, nb * 32, [](int c) { return c; }, scr, F.lane); }
    }
}
__device__ __forceinline__ void rms_row_to_bf16(const float* xrow, const float* g, bf16* orow, int lane) {
    const f32x4* xr = (const f32x4*)xrow + lane; const f32x4* gr = (const f32x4*)g + lane;
    f32x4 v[4]; float s = 0.f;
#pragma unroll
    for (int j = 0; j < 4; ++j) { v[j] = xr[64 * j]; s += (v[j].x * v[j].x + v[j].y * v[j].y) + (v[j].z * v[j].z + v[j].w * v[j].w); }
    const float rstd = rsqrtf(wave_sum(s) * (1.f / D) + RMS_EPS);
    unsigned long long* o8 = (unsigned long long*)orow + lane;
#pragma unroll
    for (int j = 0; j < 4; ++j) { const f32x4 gg = gr[64 * j]; o8[64 * j] = (unsigned long long)pk2(v[j].x * rstd * gg.x, v[j].y * rstd * gg.y) | ((unsigned long long)pk2(v[j].z * rstd * gg.z, v[j].w * rstd * gg.w) << 32); }
}

#ifndef MFMA_F32
#define MFMA_F32(av, bv, cv) __builtin_amdgcn_mfma_f32_16x16x4f32((av), (bv), (cv), 0, 0, 0)
#endif
__device__ __forceinline__ void phase_router(Frame& F, int l, const float* xcur) {
    ArgsP a = kargs();
    LAS float* xs = (LAS float*)F.lds;
    LAS float* wsm = xs + 64 * 65;
    LAS float* lg = wsm + 64 * 48;
    LAS float* rs = lg + 64 * 37;
    const float* g = a->in[14] + (size_t)l * D;
    const float* rgw = a->in[15] + (size_t)l * D * 4; const float* rgb = a->in[16] + (size_t)l * 4;
    const float* rew = a->in[17] + (size_t)l * D * 32; const float* reb = a->in[18] + (size_t)l * 32;
    bf16* h2 = (bf16*)(F.ws + WS_H);
    int* tok_e = (int*)(F.ws + WS_RT); float* tok_w = (float*)(F.ws + WS_RT + 131072);
    unsigned* cnt = F.ctl + CW_CNT + l * 32;
    const int r = F.tid & 63;
    const int li = F.lane & 15, kq = F.lane >> 4, rb = F.wave & 3, cset = F.wave >> 2;
    for (int blk = F.bid; blk < S / 64; blk += F.G) {
        const int row0 = blk * 64;
        f32x4 acc0 = {0.f, 0.f, 0.f, 0.f}, acc1 = {0.f, 0.f, 0.f, 0.f}; float ss = 0.f;
        for (int kc = 0; kc < 16; ++kc) {
            __syncthreads();
            { const int rr = F.tid >> 3, kk = (F.tid & 7) * 8; const float* xp = xcur + (size_t)(row0 + rr) * D + kc * 64 + kk; const float* gp = g + kc * 64 + kk;
              const f32x4 x0 = *(const f32x4*)xp, x1 = *(const f32x4*)(xp + 4), g0 = *(const f32x4*)gp, g1 = *(const f32x4*)(gp + 4);
              LAS float* d = xs + rr * 65 + kk; d[0] = x0.x * g0.x; d[1] = x0.y * g0.y; d[2] = x0.z * g0.z; d[3] = x0.w * g0.w; d[4] = x1.x * g1.x; d[5] = x1.y * g1.y; d[6] = x1.z * g1.z; d[7] = x1.w * g1.w;
              ss += (x0.x * x0.x + x0.y * x0.y) + (x0.z * x0.z + x0.w * x0.w) + (x1.x * x1.x + x1.y * x1.y) + (x1.z * x1.z + x1.w * x1.w); }
            { const int kk = F.tid >> 3, c0 = (F.tid & 7) * 6; const size_t kg = (size_t)(kc * 64 + kk);
#pragma unroll
              for (int i = 0; i < 6; ++i) { const int c = c0 + i; wsm[kk * 48 + c] = c < 4 ? rgw[kg * 4 + c] : (c < 36 ? rew[kg * 32 + (c - 4)] : 0.f); } }
            __syncthreads();
            if (cset == 0) {
#pragma unroll 4
                for (int k0 = 0; k0 < 64; k0 += 4) { const float av = xs[(rb * 16 + li) * 65 + k0 + kq];
                    acc0 = MFMA_F32(av, wsm[(k0 + kq) * 48 + li], acc0); acc1 = MFMA_F32(av, wsm[(k0 + kq) * 48 + 16 + li], acc1); }
            } else {
#pragma unroll 4
                for (int k0 = 0; k0 < 64; k0 += 4) { const float av = xs[(rb * 16 + li) * 65 + k0 + kq]; acc0 = MFMA_F32(av, wsm[(k0 + kq) * 48 + 32 + li], acc0); }
            }
        }
        ss += __shfl_xor(ss, 1); ss += __shfl_xor(ss, 2); ss += __shfl_xor(ss, 4);
        __syncthreads();
        if ((F.tid & 7) == 0) rs[F.tid >> 3] = rsqrtf(ss * (1.f / D) + RMS_EPS);
        __syncthreads();
#pragma unroll
        for (int i = 0; i < 4; ++i) { const int rw = rb * 16 + kq * 4 + i; const float rstd = rs[rw];
            if (cset == 0) { lg[rw * 37 + li] = acc0[i] * rstd; lg[rw * 37 + 16 + li] = acc1[i] * rstd; } else if (li < 4) lg[rw * 37 + 32 + li] = acc0[i] * rstd; }
        __syncthreads();
        if (F.tid < 64) {
            const LAS float* L = lg + F.tid * 37; const int tok = row0 + F.tid;
            float gl[4]; int gs = 0; float gm = -3.0e38f;
#pragma unroll
            for (int i = 0; i < 4; ++i) { gl[i] = L[i] + rgb[i]; if (gl[i] > gm) { gm = gl[i]; gs = i; } }
            float gsum = 0.f;
#pragma unroll
            for (int i = 0; i < 4; ++i) gsum += __expf(gl[i] - gm);
            const float ggate = 1.f / gsum;
            float v0 = -3.0e38f, v1 = -3.0e38f; int i0 = 0, i1 = 0;
            for (int i = 0; i < 8; ++i) { const float v = L[4 + gs * 8 + i] + reb[gs * 8 + i]; if (v > v0) { v1 = v0; i1 = i0; v0 = v; i0 = i; } else if (v > v1) { v1 = v; i1 = i; } }
            const float e1 = __expf(v1 - v0), den = 1.f / (1.f + e1);
            const int ea = gs * 8 + i0, eb = gs * 8 + i1;
            tok_e[tok * 2] = ea; tok_e[tok * 2 + 1] = eb; tok_w[tok * 2] = den * ggate; tok_w[tok * 2 + 1] = e1 * den * ggate;
            atomicAdd(&cnt[ea], 1u); atomicAdd(&cnt[eb], 1u);
        }
        for (int i = 0; i < 8; ++i) { const int rr = F.wave * 8 + i; const float rstd = rs[rr];
            const f32x4* xr = (const f32x4*)(xcur + (size_t)(row0 + rr) * D) + F.lane; const f32x4* gr = (const f32x4*)g + F.lane; unsigned long long* o8 = (unsigned long long*)(h2 + (size_t)(row0 + rr) * D) + F.lane;
#pragma unroll
            for (int j = 0; j < 4; ++j) { const f32x4 v = xr[64 * j], gg = gr[64 * j]; o8[64 * j] = (unsigned long long)pk2(v.x * rstd * gg.x, v.y * rstd * gg.y) | ((unsigned long long)pk2(v.z * rstd * gg.z, v.w * rstd * gg.w) << 32); } }
    }
    __syncthreads();
}
__device__ __forceinline__ void moe_table(Frame& F, int l) {
    LAS int* tab = (LAS int*)(F.lds + LDSCTL_OFF);
    if (F.tid == 0) { int bo = 0;
#pragma unroll 1
        for (int e = 0; e < NE; ++e) { const int c = (int)__hip_atomic_load(F.ctl + CW_CNT + l * 32 + e, __ATOMIC_RELAXED, __HIP_MEMORY_SCOPE_AGENT); const int nb = (c + 255) >> 8; tab[192 + e] = bo * 256; for (int b = 0; b < nb; ++b) tab[bo + b] = e; bo += nb; } tab[224] = bo; }
    __syncthreads();
}
__device__ __forceinline__ void phase_scatter(Frame& F, int l) {
    moe_table(F, l);
    LAS int* tab = (LAS int*)(F.lds + LDSCTL_OFF);
    const bf16* h2 = (const bf16*)(F.ws + WS_H); bf16* xs = (bf16*)(F.ws + WS_XS);
    const int* tok_e = (const int*)(F.ws + WS_RT); const float* tok_w = (const float*)(F.ws + WS_RT + 131072);
    int* slot_row = (int*)(F.ws + WS_RT + 262144); float* row_w = (float*)(F.ws + WS_RT + 393216);
    unsigned* fill = F.ctl + CW_FILL + l * 32;
    const int gw = F.bid * 8 + F.wave, NGW = F.G * 8;
    for (int b0 = gw * 16; b0 < S * 2; b0 += NGW * 16) {
        int row = 0;
        if (F.lane < 16) { const int sl = b0 + F.lane; const int e = tok_e[sl]; const unsigned p = atomicAdd(&fill[e], 1u); row = tab[192 + e] + (int)p; slot_row[sl] = row; row_w[row] = tok_w[sl]; }
#pragma unroll 4
        for (int k = 0; k < 16; ++k) { const int rk = __builtin_amdgcn_readlane(row, k); const int sl = b0 + k;
            const u32x4* src = (const u32x4*)(h2 + (size_t)(sl >> 1) * D) + F.lane; u32x4* dst = (u32x4*)(xs + (size_t)rk * D) + F.lane;
            dst[0] = src[0]; dst[64] = src[64]; }
    }
}
__device__ __forceinline__ void phase_combine(Frame& F, int l, float* xcur) {
    ArgsP a = kargs();
    const bf16* ye = (const bf16*)(F.ws + WS_YE); const int* slot_row = (const int*)(F.ws + WS_RT + 262144);
    const bool last = (l == NL - 1);
    const float* g = last ? a->in[22] : a->in[1] + (size_t)(l + 1) * D;
    bf16* h = (bf16*)(F.ws + WS_H);
    const int gw = F.bid * 8 + F.wave, NGW = F.G * 8;
    int srl = 0; { const int k = F.lane >> 1, m = gw + k * NGW; if (F.lane < 16 && m < S) srl = slot_row[2 * m + (F.lane & 1)]; }
    const f32x4* gr = (const f32x4*)g + F.lane; f32x4 gg[4];
#pragma unroll
    for (int j = 0; j < 4; ++j) gg[j] = gr[64 * j];
    f32x4 xn[4]; u32x2 p0n[4], p1n[4];
#define CMB_LOAD(mm, kk) do { const int r0_ = __shfl(srl, 2 * (kk)), r1_ = __shfl(srl, 2 * (kk) + 1); const f32x4* xr_ = (const f32x4*)(xcur + (size_t)(mm) * D) + F.lane; \
        const u32x2* y0_ = (const u32x2*)(ye + (size_t)r0_ * D) + F.lane; const u32x2* y1_ = (const u32x2*)(ye + (size_t)r1_ * D) + F.lane; \
        _Pragma("unroll") for (int j = 0; j < 4; ++j) { xn[j] = xr_[64 * j]; p0n[j] = y0_[64 * j]; p1n[j] = y1_[64 * j]; } } while (0)
    if (gw < S) CMB_LOAD(gw, 0);
    int kk_ = 0;
    for (int m = gw; m < S; m += NGW, ++kk_) {
        f32x4 v[4]; float s = 0.f;
#pragma unroll
        for (int j = 0; j < 4; ++j) { const u32x2 p0 = p0n[j], p1 = p1n[j]; f32x4 x = xn[j];
            x.x = (x.x + bflo(p0.x)) + bflo(p1.x); x.y = (x.y + bfhi(p0.x)) + bfhi(p1.x); x.z = (x.z + bflo(p0.y)) + bflo(p1.y); x.w = (x.w + bfhi(p0.y)) + bfhi(p1.y);
            v[j] = x; s += (x.x * x.x + x.y * x.y) + (x.z * x.z + x.w * x.w); }
        if (m + NGW < S) CMB_LOAD(m + NGW, kk_ + 1);
        const float rstd = rsqrtf(wave_sum(s) * (1.f / D) + RMS_EPS);
        f32x4* xr = (f32x4*)(xcur + (size_t)m * D) + F.lane;
        if (last) {
#pragma unroll
            for (int j = 0; j < 4; ++j) xr[64 * j] = (f32x4){v[j].x * rstd * gg[j].x, v[j].y * rstd * gg[j].y, v[j].z * rstd * gg[j].z, v[j].w * rstd * gg[j].w};
        } else {
            unsigned long long* o8 = (unsigned long long*)(h + (size_t)m * D) + F.lane;
#pragma unroll
            for (int j = 0; j < 4; ++j) { xr[64 * j] = v[j];
                o8[64 * j] = (unsigned long long)pk2(v[j].x * rstd * gg[j].x, v[j].y * rstd * gg[j].y) | ((unsigned long long)pk2(v[j].z * rstd * gg[j].z, v[j].w * rstd * gg[j].w) << 32); }
        }
    }
#undef CMB_LOAD
}


typedef short v4i16_t __attribute__((ext_vector_type(4)));
__device__ __forceinline__ s16x4 ds_tr16(const LAS unsigned char* p) { return __builtin_bit_cast(s16x4, __builtin_amdgcn_ds_read_tr16_b64_v4i16((LAS v4i16_t*)p)); }
template <int MODE>
__device__ __forceinline__ void attn_phase(Frame& F, int l) {
    ArgsP a = kargs();
    constexpr int NS = MODE ? 2 : 1;
    const bf16* P = (const bf16*)(F.ws + WS_PU);
    bf16* Y = (bf16*)(F.ws + WS_Y) + (size_t)(MODE ? 3 : 2) * S * 256;
    const int colQ = MODE ? C_QD : C_QC, colK = MODE ? C_KD : C_KC, colV = MODE ? C_VD : C_VC;
    const float sc2 = (MODE ? 0.17677669529663687f : 0.125f) * 1.4426950408889634f;
    LAS unsigned char* Kb = F.lds; LAS unsigned char* Vb = F.lds + 16384; LAS float* btab = (LAS float*)(F.lds + 32768);
    const int lane = F.lane, w = F.wave, r = lane & 31, hh = lane >> 5;
    for (int u = F.bid; u < 256; u += F.G) {
        const int head = u & 3, ug = u >> 2;
        int qrow, cw, lo_w, T0, T1;
        if (MODE) { qrow = ug * 256 + w * 32; cw = ug * 4 + (w >> 1); lo_w = 0; T0 = 0; T1 = ug * 4 + 3; }
        else { cw = ug * 4 + (w >> 1); qrow = cw * 64 + (w & 1) * 32; lo_w = cw - 8 < 0 ? 0 : cw - 8; T0 = ug * 4 - 8 < 0 ? 0 : ug * 4 - 8; T1 = ug * 4 + 3; }
        if (!MODE) { __syncthreads(); if (F.tid < 192) btab[F.tid] = a->in[8][(size_t)(l * 4 + head) * 192 + F.tid] * 1.4426950408889634f; }
        bf16x8 Qf[4];
#pragma unroll
        for (int kk = 0; kk < 4; ++kk) Qf[kk] = *(const bf16x8*)(P + (size_t)(qrow + r) * PW + colQ + head * 64 + kk * 16 + 8 * hh);
        f32x16 O[NS][2]; float m[NS], lsum[NS];
#pragma unroll
        for (int s = 0; s < NS; ++s) { m[s] = -1e30f; lsum[s] = 0.f;
#pragma unroll
            for (int d = 0; d < 2; ++d)
#pragma unroll
                for (int i = 0; i < 16; ++i) O[s][d][i] = 0.f; }
        const int srow = F.tid >> 3, sch = F.tid & 7;
        const bf16* gK = P + (size_t)srow * PW + colK + head * 64 + sch * 8; const bf16* gV = P + (size_t)srow * PW + colV + head * 64 + sch * 8;
        const int kwoff = srow * 128 + ((sch ^ (srow & 7)) << 4), vwoff = srow * 128 + sch * 16;
        u32x4 kreg = *(const u32x4*)(gK + (size_t)T0 * 64 * PW), vreg = *(const u32x4*)(gV + (size_t)T0 * 64 * PW);
        __syncthreads();
        *(LAS u32x4*)(Kb + kwoff) = kreg; *(LAS u32x4*)(Vb + vwoff) = vreg;
        __syncthreads();
        for (int j = T0; j <= T1; ++j) {
            const int buf = (j - T0) & 1;
            if (j < T1) { kreg = *(const u32x4*)(gK + (size_t)(j + 1) * 64 * PW); vreg = *(const u32x4*)(gV + (size_t)(j + 1) * 64 * PW); }
            if (j >= lo_w && j <= cw) {
                const LAS unsigned char* Kt = Kb + buf * 8192; const LAS unsigned char* Vt = Vb + buf * 8192;
                bf16x8 pf[NS][4];
#pragma unroll
                for (int s = 0; s < NS; ++s) {
                    f32x16 Sq[2];
#pragma unroll
                    for (int kb = 0; kb < 2; ++kb) {
#pragma unroll
                        for (int i = 0; i < 16; ++i) Sq[kb][i] = 0.f;
#pragma unroll
                        for (int k2 = 0; k2 < (MODE ? 2 : 4); ++k2) { const int kk = MODE ? 2 * s + k2 : k2; const int row = kb * 32 + r;
                            const bf16x8 kf = *(const LAS bf16x8*)(Kt + row * 128 + (((kk * 2 + hh) ^ (row & 7)) << 4));
                            Sq[kb] = __builtin_amdgcn_mfma_f32_32x32x16_bf16(kf, Qf[kk], Sq[kb], 0, 0, 0); }
                    }
                    float mx = -1e30f;
                    if (!MODE) {
                        const int dj = cw - j;
                        if (dj >= 3) { const float bc = btab[191];
#pragma unroll
                            for (int kb = 0; kb < 2; ++kb)
#pragma unroll
                                for (int i = 0; i < 16; ++i) { const float t = Sq[kb][i] * sc2 + bc; Sq[kb][i] = t; mx = fmaxf(mx, t); } }
                        else { const int base = dj * 64 + (w & 1) * 32 + r - 4 * hh + 63;
#pragma unroll
                            for (int kb = 0; kb < 2; ++kb)
#pragma unroll
                                for (int i = 0; i < 16; ++i) { int rid = base - (kb * 32 + (i & 3) + 8 * (i >> 2)); rid = rid < 0 ? 0 : (rid > 191 ? 191 : rid);
                                    const float t = Sq[kb][i] * sc2 + btab[rid]; Sq[kb][i] = t; mx = fmaxf(mx, t); } }
                    } else {
#pragma unroll
                        for (int kb = 0; kb < 2; ++kb)
#pragma unroll
                            for (int i = 0; i < 16; ++i) { const float t = Sq[kb][i] * sc2; Sq[kb][i] = t; mx = fmaxf(mx, t); }
                    }
                    mx = fmaxf(mx, __shfl_xor(mx, 32));
                    const float mn = fmaxf(m[s], mx), alpha = __builtin_amdgcn_exp2f(m[s] - mn); m[s] = mn;
                    float rs = 0.f;
#pragma unroll
                    for (int kb = 0; kb < 2; ++kb)
#pragma unroll
                        for (int i = 0; i < 16; ++i) { const float p = __builtin_amdgcn_exp2f(Sq[kb][i] - mn); Sq[kb][i] = p; rs += p; }
                    lsum[s] = lsum[s] * alpha + rs;
#pragma unroll
                    for (int d = 0; d < 2; ++d)
#pragma unroll
                        for (int i = 0; i < 16; ++i) O[s][d][i] *= alpha;
#pragma unroll
                    for (int kb = 0; kb < 2; ++kb)
#pragma unroll
                        for (int ss = 0; ss < 2; ++ss) { u32x4 pw;
                            pw.x = pg8::cvt_pk_bf16(Sq[kb][8 * ss + 0], Sq[kb][8 * ss + 1]); pw.y = pg8::cvt_pk_bf16(Sq[kb][8 * ss + 2], Sq[kb][8 * ss + 3]);
                            pw.z = pg8::cvt_pk_bf16(Sq[kb][8 * ss + 4], Sq[kb][8 * ss + 5]); pw.w = pg8::cvt_pk_bf16(Sq[kb][8 * ss + 6], Sq[kb][8 * ss + 7]);
                            pf[s][kb * 2 + ss] = __builtin_bit_cast(bf16x8, pw); }
                    __builtin_amdgcn_sched_barrier(0);
                }
                const int li = lane & 15, lg = lane >> 4;
                const LAS unsigned char* vbase = Vt + (4 * (lg >> 1) + (li >> 2)) * 128 + (16 * (lg & 1) + 4 * (li & 3)) * 2;
#pragma unroll
                for (int d = 0; d < 2; ++d)
#pragma unroll
                    for (int st = 0; st < 4; ++st) {
                        const s16x4 v0 = ds_tr16(vbase + (st * 16) * 128 + d * 64), v1 = ds_tr16(vbase + (st * 16 + 8) * 128 + d * 64);
                        const bf16x8 vf = (bf16x8){v0[0], v0[1], v0[2], v0[3], v1[0], v1[1], v1[2], v1[3]};
#pragma unroll
                        for (int s = 0; s < NS; ++s) O[s][d] = __builtin_amdgcn_mfma_f32_32x32x16_bf16(vf, pf[s][st], O[s][d], 0, 0, 0);
                        if (st & 1) __builtin_amdgcn_sched_barrier(0);
                    }
            }
            if (j < T1) { *(LAS u32x4*)(Kb + (buf ^ 1) * 8192 + kwoff) = kreg; *(LAS u32x4*)(Vb + (buf ^ 1) * 8192 + vwoff) = vreg; }
            __syncthreads();
        }
        float inv[NS];
#pragma unroll
        for (int s = 0; s < NS; ++s) { const float lt = lsum[s] + __shfl_xor(lsum[s], 32); inv[s] = 1.f / lt; }
        bf16* yrow = Y + (size_t)(qrow + r) * 256 + head * 64 + 4 * hh;
        if (MODE) {
            const float* lp = a->in[9] + (size_t)l * 128 + (lane & 31); float s1 = (lane < 32) ? lp[0] * lp[32] : 0.f, s2 = (lane < 32) ? lp[64] * lp[96] : 0.f;
            s1 = wave_sum(s1); s2 = wave_sum(s2);
            const float lam_init = 0.8f - 0.6f * __expf(-0.3f * (float)l), lam = __expf(s1) - __expf(s2) + lam_init;
            const float* gn = a->in[10] + (size_t)l * 256 + head * 64 + 4 * hh;
            float ss = 0.f;
#pragma unroll
            for (int d = 0; d < 2; ++d)
#pragma unroll
                for (int i = 0; i < 16; ++i) { const float o = O[0][d][i] * inv[0] - lam * (O[NS - 1][d][i] * inv[NS - 1]); O[0][d][i] = o; ss += o * o; }
            ss += __shfl_xor(ss, 32);
            const float rstd = rsqrtf(ss * (1.f / 64.f) + RMS_EPS) * (1.f - lam_init);
#pragma unroll
            for (int d = 0; d < 2; ++d)
#pragma unroll
                for (int g = 0; g < 4; ++g) { const f32x4 gg = *(const f32x4*)(gn + d * 32 + 8 * g); u32x2 o2;
                    o2.x = pk2(O[0][d][4 * g + 0] * rstd * gg.x, O[0][d][4 * g + 1] * rstd * gg.y); o2.y = pk2(O[0][d][4 * g + 2] * rstd * gg.z, O[0][d][4 * g + 3] * rstd * gg.w);
                    *(u32x2*)(yrow + d * 32 + 8 * g) = o2; }
        } else {
#pragma unroll
            for (int d = 0; d < 2; ++d)
#pragma unroll
                for (int g = 0; g < 4; ++g) { u32x2 o2;
                    o2.x = pk2(O[0][d][4 * g + 0] * inv[0], O[0][d][4 * g + 1] * inv[0]); o2.y = pk2(O[0][d][4 * g + 2] * inv[0], O[0][d][4 * g + 3] * inv[0]);
                    *(u32x2*)(yrow + d * 32 + 8 * g) = o2; }
        }
    }
    __syncthreads();
}


__device__ __forceinline__ float vmax3_(float a, float b, float c) { float r; asm("v_max3_f32 %0, %1, %2, %3" : "=v"(r) : "v"(a), "v"(b), "v"(c)); return r; }
__device__ __forceinline__ void attnD_phase(Frame& F, int l) {
    const bf16* P = (const bf16*)(F.ws + WS_PU);
    bf16* Y = (bf16*)(F.ws + WS_Y) + (size_t)3 * S * 256;
    const float sc2 = 0.17677669529663687f * 1.4426950408889634f;
    const int lane = F.lane, w = F.wave, r = lane & 31, hh = lane >> 5, rw = w & 3, ksel = w >> 2;
    const int srow = F.tid >> 3, sch = F.tid & 7;
#pragma unroll 1
    for (int pr = F.bid; pr < 256; pr += F.G) {
        const int head = pr & 3, bp = pr >> 2;
#pragma unroll 1
        for (int rep = 0; rep < 2; ++rep) {
            const int b = rep ? 127 - bp : bp;
            const int qrow = b * 128 + rw * 32, cw = 2 * b + (rw >> 1);
            LAS unsigned char* qlds = F.lds + 98304 + w * 4096 + lane * 16;
            u32x4 qs4[4];
#pragma unroll
            for (int kk = 0; kk < 4; ++kk) { const u32x4 qw = *(const u32x4*)(P + (size_t)(qrow + r) * PW + C_QD + head * 64 + kk * 16 + 8 * hh);
                qs4[kk].x = pk2(bflo(qw.x) * sc2, bfhi(qw.x) * sc2); qs4[kk].y = pk2(bflo(qw.y) * sc2, bfhi(qw.y) * sc2); qs4[kk].z = pk2(bflo(qw.z) * sc2, bfhi(qw.z) * sc2); qs4[kk].w = pk2(bflo(qw.w) * sc2, bfhi(qw.w) * sc2); }
            f32x16 O[2][2], negM[2]; float m[2], lsum[2]; bool seen = false;
#pragma unroll
            for (int s2 = 0; s2 < 2; ++s2) { m[s2] = 0.f; lsum[s2] = 0.f;
#pragma unroll
                for (int i = 0; i < 16; ++i) negM[s2][i] = 0.f;
                asm volatile("" : "+v"(negM[s2]));
#pragma unroll
                for (int d = 0; d < 2; ++d)
#pragma unroll
                    for (int i = 0; i < 16; ++i) O[s2][d][i] = 0.f; }
            int srow_ = srow, sch_ = sch; asm volatile("" : "+v"(srow_), "+v"(sch_));
            const bf16* gK = P + (size_t)srow_ * PW + C_KD + head * 64 + (sch_ ^ (srow_ & 7)) * 8; const bf16* gV = P + (size_t)srow_ * PW + C_VD + head * 64 + sch_ * 8;
            LAS unsigned char* dma0 = F.lds + w * 1024;
#define D_STAGE(bufb, go) do { __builtin_amdgcn_global_load_lds((const unsigned*)(gK + (go)), (LAS unsigned*)(dma0 + (bufb)), 16, 0, 0); \
                __builtin_amdgcn_global_load_lds((const unsigned*)(gK + (go) + (size_t)64 * PW), (LAS unsigned*)(dma0 + (bufb) + 8192), 16, 0, 0); \
                __builtin_amdgcn_global_load_lds((const unsigned*)(gV + (go)), (LAS unsigned*)(dma0 + (bufb) + 16384), 16, 0, 0); \
                __builtin_amdgcn_global_load_lds((const unsigned*)(gV + (go) + (size_t)64 * PW), (LAS unsigned*)(dma0 + (bufb) + 24576), 16, 0, 0); } while (0)
            __syncthreads();
#pragma unroll
            for (int kk = 0; kk < 4; ++kk) *(LAS u32x4*)(qlds + kk * 1024) = qs4[kk];
            D_STAGE(0, (size_t)0);
            VM_WAIT();
            __syncthreads();
            asm volatile(".p2align 8" ::: "memory");
#pragma unroll 1
            for (int i = 0; i <= b; ++i) {
                const int buf = i & 1, j = 2 * i + ksel;
                if (i < b) D_STAGE((buf ^ 1) * 32768, (size_t)(2 * i + 2) * 64 * PW);
                if (j <= cw) {
                    const LAS unsigned char* Kt = F.lds + buf * 32768 + ksel * 8192; const LAS unsigned char* Vt = F.lds + buf * 32768 + 16384 + ksel * 8192;
                    bf16x8 pf[2][4];
#pragma unroll
                    for (int s2 = 0; s2 < 2; ++s2) {
                        f32x16 Sq[2];
                        const bf16x8 qf2[2] = {*(const LAS bf16x8*)(qlds + (2 * s2) * 1024), *(const LAS bf16x8*)(qlds + (2 * s2 + 1) * 1024)};
#pragma unroll
                        for (int kb = 0; kb < 2; ++kb) {
#pragma unroll
                            for (int k2 = 0; k2 < 2; ++k2) { const int kk = 2 * s2 + k2; const int row = kb * 32 + r;
                                const bf16x8 kf = *(const LAS bf16x8*)(Kt + row * 128 + (((kk * 2 + hh) ^ (row & 7)) << 4));
                                Sq[kb] = __builtin_amdgcn_mfma_f32_32x32x16_bf16(kf, qf2[k2], k2 ? Sq[kb] : negM[s2], 0, 0, 0); }
                        }
                        __builtin_amdgcn_sched_barrier(0);
                        asm volatile("s_nop 15\n\ts_nop 3" ::: "memory");
                        __builtin_amdgcn_sched_barrier(0);
                        float mx = vmax3_(Sq[0][0], Sq[0][1], Sq[0][2]);
#pragma unroll
                        for (int ii = 3; ii < 15; ii += 2) mx = vmax3_(mx, Sq[0][ii], Sq[0][ii + 1]);
                        mx = vmax3_(mx, Sq[0][15], Sq[1][0]);
#pragma unroll
                        for (int ii = 1; ii < 15; ii += 2) mx = vmax3_(mx, Sq[1][ii], Sq[1][ii + 1]);
                        mx = vmax3_(mx, Sq[1][15], Sq[1][15]);
                        mx = fmaxf(mx, __shfl_xor(mx, 32));
                        if (!seen || __any(mx > 8.f)) { const float dl = seen ? fmaxf(mx, 0.f) : mx; m[s2] += dl;
                            if (seen) { const float al = __builtin_amdgcn_exp2f(-dl); lsum[s2] *= al;
#pragma unroll
                                for (int d = 0; d < 2; ++d)
#pragma unroll
                                    for (int ii = 0; ii < 16; ++ii) O[s2][d][ii] *= al; }
#pragma unroll
                            for (int kb = 0; kb < 2; ++kb)
#pragma unroll
                                for (int ii = 0; ii < 16; ++ii) Sq[kb][ii] -= dl;
                            const float nm = -m[s2];
#pragma unroll
                            for (int ii = 0; ii < 16; ++ii) negM[s2][ii] = nm; }
                        float rs = 0.f;
#pragma unroll
                        for (int kb = 0; kb < 2; ++kb)
#pragma unroll
                            for (int ii = 0; ii < 16; ++ii) { const float p = __builtin_amdgcn_exp2f(Sq[kb][ii]); Sq[kb][ii] = p; rs += p; }
                        lsum[s2] += rs;
#pragma unroll
                        for (int kb = 0; kb < 2; ++kb)
#pragma unroll
                            for (int ss = 0; ss < 2; ++ss) { u32x4 pw;
                                pw.x = pg8::cvt_pk_bf16(Sq[kb][8 * ss + 0], Sq[kb][8 * ss + 1]); pw.y = pg8::cvt_pk_bf16(Sq[kb][8 * ss + 2], Sq[kb][8 * ss + 3]);
                                pw.z = pg8::cvt_pk_bf16(Sq[kb][8 * ss + 4], Sq[kb][8 * ss + 5]); pw.w = pg8::cvt_pk_bf16(Sq[kb][8 * ss + 6], Sq[kb][8 * ss + 7]);
                                pf[s2][kb * 2 + ss] = __builtin_bit_cast(bf16x8, pw); }
                        __builtin_amdgcn_sched_barrier(0);
                    }
                    const int li = lane & 15, lg = lane >> 4;
                    const LAS unsigned char* vbase = Vt + (4 * (lg >> 1) + (li >> 2)) * 128 + (16 * (lg & 1) + 4 * (li & 3)) * 2;
#pragma unroll
                    for (int d = 0; d < 2; ++d)
#pragma unroll
                        for (int st = 0; st < 4; ++st) {
                            const s16x4 v0 = ds_tr16(vbase + (st * 16) * 128 + d * 64), v1 = ds_tr16(vbase + (st * 16 + 8) * 128 + d * 64);
                            const bf16x8 vf = (bf16x8){v0[0], v0[1], v0[2], v0[3], v1[0], v1[1], v1[2], v1[3]};
                            O[0][d] = __builtin_amdgcn_mfma_f32_32x32x16_bf16(vf, pf[0][st], O[0][d], 0, 0, 0);
                            O[1][d] = __builtin_amdgcn_mfma_f32_32x32x16_bf16(vf, pf[1][st], O[1][d], 0, 0, 0);
                            if (st & 1) __builtin_amdgcn_sched_barrier(0);
                        }
                    seen = true;
                }
                VM_WAIT();
                __syncthreads();
            }
            LAS float* xo = (LAS float*)F.lds + rw * 4096; LAS float* xm = (LAS float*)(F.lds + 65536) + rw * 256;
            if (!seen) { m[0] = -1e30f; m[1] = -1e30f; }
            if (ksel) {
#pragma unroll
                for (int s2 = 0; s2 < 2; ++s2) { xm[s2 * 64 + lane] = m[s2]; xm[128 + s2 * 64 + lane] = lsum[s2];
#pragma unroll
                    for (int d = 0; d < 2; ++d)
#pragma unroll
                        for (int ii = 0; ii < 16; ++ii) xo[((s2 * 2 + d) * 16 + ii) * 64 + lane] = O[s2][d][ii]; }
            }
            __syncthreads();
            if (!ksel) {
                float inv[2];
#pragma unroll
                for (int s2 = 0; s2 < 2; ++s2) { const float mb = xm[s2 * 64 + lane], lb = xm[128 + s2 * 64 + lane]; const float mn = fmaxf(m[s2], mb), aa = __builtin_amdgcn_exp2f(m[s2] - mn), ab = __builtin_amdgcn_exp2f(mb - mn);
                    float lt = lsum[s2] * aa + lb * ab; lt += __shfl_xor(lt, 32); inv[s2] = 1.f / lt;
#pragma unroll
                    for (int d = 0; d < 2; ++d)
#pragma unroll
                        for (int ii = 0; ii < 16; ++ii) O[s2][d][ii] = (O[s2][d][ii] * aa + xo[((s2 * 2 + d) * 16 + ii) * 64 + lane] * ab) * inv[s2]; }
                int r_ = r, hh_ = hh; asm volatile("" : "+v"(r_), "+v"(hh_));
                ArgsP a = kargs();
                const float* lp = a->in[9] + (size_t)l * 128 + r_; float s1 = (lane < 32) ? lp[0] * lp[32] : 0.f, s3 = (lane < 32) ? lp[64] * lp[96] : 0.f;
                s1 = wave_sum(s1); s3 = wave_sum(s3);
                const float lam_init = 0.8f - 0.6f * __expf(-0.3f * (float)l), lam = __expf(s1) - __expf(s3) + lam_init;
                const float* gn = a->in[10] + (size_t)l * 256 + head * 64 + 4 * hh_;
                float ss = 0.f;
#pragma unroll
                for (int d = 0; d < 2; ++d)
#pragma unroll
                    for (int ii = 0; ii < 16; ++ii) { const float o = O[0][d][ii] - lam * O[1][d][ii]; O[0][d][ii] = o; ss += o * o; }
                ss += __shfl_xor(ss, 32);
                const float rstd = rsqrtf(ss * (1.f / 64.f) + RMS_EPS) * (1.f - lam_init);
                bf16* yrow = Y + (size_t)(qrow + r_) * 256 + head * 64 + 4 * hh_;
#pragma unroll
                for (int d = 0; d < 2; ++d)
#pragma unroll
                    for (int g = 0; g < 4; ++g) { const f32x4 gg = *(const f32x4*)(gn + d * 32 + 8 * g); u32x2 o2;
                        o2.x = pk2(O[0][d][4 * g + 0] * rstd * gg.x, O[0][d][4 * g + 1] * rstd * gg.y); o2.y = pk2(O[0][d][4 * g + 2] * rstd * gg.z, O[0][d][4 * g + 3] * rstd * gg.w);
                        *(u32x2*)(yrow + d * 32 + 8 * g) = o2; }
            }
        }
    }
    __syncthreads();
}

using pg8::sigmoidf_;
constexpr int ML_CE = 0, ML_G = 1024, ML_SC = 2048;
__device__ __forceinline__ float logsigmoidf_(float f) { return f >= 0.f ? -log1pf(__expf(-f)) : f - log1pf(__expf(f)); }
__device__ __forceinline__ void ml_gates(const bf16* P, const float* ib, const float* fb, int c, int h, int lane, float& a_t, float& i_t) {
    const bf16* pr = P + (size_t)(c * 64 + lane) * PW;
    i_t = bf2f(pr[C_IB + h]) + ib[h]; a_t = logsigmoidf_(bf2f(pr[C_FB + h]) + fb[h]);
}
__device__ __forceinline__ float wave_scan_add(float v, int lane) {
#pragma unroll
    for (int o = 1; o < 64; o <<= 1) { const float u = __shfl_up(v, o); if (lane >= o) v += u; }
    return v;
}
__device__ __forceinline__ float wave_scan_max(float v, int lane) {
#pragma unroll
    for (int o = 1; o < 64; o <<= 1) { const float u = __shfl_up(v, o); if (lane >= o) v = fmaxf(v, u); }
    return v;
}
__device__ __forceinline__ void ml_phase1(Frame& F, int l) {
    ArgsP a = kargs(); const bf16* P = (const bf16*)(F.ws + WS_PU); float* mls = (float*)(F.ws + WS_MLS);
    const float* ib = a->in[5] + l * 4; const float* fb = a->in[6] + l * 4;
    for (int u = F.bid * 8 + F.wave; u < NCH * 4; u += F.G * 8) {
        const int c = u >> 2, h = u & 3; float at, it; ml_gates(P, ib, fb, c, h, F.lane, at, it);
        const float cum = wave_scan_add(at, F.lane), ce = __shfl(cum, 63), g = ce - cum + it, G = wave_max(g);
        if (F.lane == 0) { mls[ML_CE + u] = ce; mls[ML_G + u] = G; }
    }
}
__device__ __forceinline__ void ml_mscan(Frame& F, LAS float* mt, LAS float* tmp) {
    const float* mls = (const float*)(F.ws + WS_MLS);
    __syncthreads();
    for (int i = F.tid; i < 1024; i += 512) { tmp[i] = mls[ML_CE + i]; tmp[1024 + i] = mls[ML_G + i]; }
    __syncthreads();
    if (F.tid < 4) { float m = 0.f;
#pragma unroll 1
        for (int c0 = 0; c0 < NCH; c0 += 16) { float ce[16], g[16];
#pragma unroll
            for (int i = 0; i < 16; ++i) { ce[i] = tmp[(c0 + i) * 4 + F.tid]; g[i] = tmp[1024 + (c0 + i) * 4 + F.tid]; }
#pragma unroll
            for (int i = 0; i < 16; ++i) { mt[F.tid * 257 + c0 + i] = m; m = fmaxf(ce[i] + m, g[i]); } }
        mt[F.tid * 257 + 256] = m; }
    __syncthreads();
}
__device__ __forceinline__ void ml_stage_conv(const bf16* P, int col0, const float* cw, const float* cb, int row0, float sc, LAS float* dst, int tid) {
    const int t = tid >> 3, d0 = (tid & 7) * 8;
    float acc[8];
#pragma unroll
    for (int i = 0; i < 8; ++i) acc[i] = cb[d0 + i];
#pragma unroll
    for (int j = 0; j < 4; ++j) { const int r = row0 + t - 3 + j;
        if (r >= 0) { const u32x4 x = *(const u32x4*)(P + (size_t)r * PW + col0 + d0); const float* w = cw + j * 512 + d0;
            acc[0] += w[0] * bflo(x.x); acc[1] += w[1] * bfhi(x.x); acc[2] += w[2] * bflo(x.y); acc[3] += w[3] * bfhi(x.y);
            acc[4] += w[4] * bflo(x.z); acc[5] += w[5] * bfhi(x.z); acc[6] += w[6] * bflo(x.w); acc[7] += w[7] * bfhi(x.w); } }
#pragma unroll
    for (int i = 0; i < 8; ++i) dst[t * 65 + d0 + i] = acc[i] * sigmoidf_(acc[i]) * sc;
}
__device__ __forceinline__ void ml_stage_plain(const bf16* P, int col0, int row0, const LAS float* rs, LAS float* dst, int tid) {
    const int t = tid >> 3, d0 = (tid & 7) * 8; const float sc = rs ? rs[t] : 1.f;
    const u32x4 x = *(const u32x4*)(P + (size_t)(row0 + t) * PW + col0 + d0); LAS float* d = dst + t * 65 + d0;
    d[0] = bflo(x.x) * sc; d[1] = bfhi(x.x) * sc; d[2] = bflo(x.y) * sc; d[3] = bfhi(x.y) * sc; d[4] = bflo(x.z) * sc; d[5] = bfhi(x.z) * sc; d[6] = bflo(x.w) * sc; d[7] = bfhi(x.w) * sc;
}
__device__ __forceinline__ void ml_phase3(Frame& F, int l) {
    ArgsP a = kargs(); const bf16* P = (const bf16*)(F.ws + WS_PU); float* mls = (float*)(F.ws + WS_MLS);
    float* dC = (float*)(F.ws + WS_MLC); float* dn = (float*)(F.ws + WS_MLN);
    const float* ib = a->in[5] + l * 4; const float* fb = a->in[6] + l * 4; const float* cw = a->in[3] + (size_t)l * 2048; const float* cb = a->in[4] + (size_t)l * 512;
    LAS float* Kl = (LAS float*)F.lds; LAS float* Vl = Kl + 64 * 65; LAS float* srcL = Vl + 64 * 65; LAS float* mt = srcL + 64; LAS float* tmp = mt + 4 * 257 + 4;
    ml_mscan(F, mt, tmp);
    const int lane = F.lane, w = F.wave, li = lane & 15, kq = lane >> 4, bi = w >> 1, bj0 = (w & 1) * 2;
    for (int u = F.bid; u < NCH * 4; u += F.G) {
        const int c = u >> 2, h = u & 3; const float m0 = mt[h * 257 + c], m1 = mt[h * 257 + c + 1];
        __syncthreads();
        if (w == 0) { float at, it; ml_gates(P, ib, fb, c, h, lane, at, it); const float cum = wave_scan_add(at, lane), ce = __shfl(cum, 63);
            srcL[lane] = __expf(ce - cum + it - m1); if (lane == 0) mls[ML_SC + u] = __expf(ce + m0 - m1); }
        const u32x4 vx = *(const u32x4*)(P + (size_t)(c * 64 + (F.tid >> 3)) * PW + C_VB + h * 64 + (F.tid & 7) * 8);
        ml_stage_conv(P, C_KB + h * 64, cw + 256 + h * 64, cb + 256 + h * 64, c * 64, 0.125f, Kl, F.tid);
        __syncthreads();
        { const int t = F.tid >> 3, d0 = (F.tid & 7) * 8; const float sc = srcL[t]; LAS float* d = Vl + t * 65 + d0;
          d[0] = bflo(vx.x) * sc; d[1] = bfhi(vx.x) * sc; d[2] = bflo(vx.y) * sc; d[3] = bfhi(vx.y) * sc; d[4] = bflo(vx.z) * sc; d[5] = bfhi(vx.z) * sc; d[6] = bflo(vx.w) * sc; d[7] = bfhi(vx.w) * sc; }
        __syncthreads();
        f32x4 acc0 = {0.f, 0.f, 0.f, 0.f}, acc1 = {0.f, 0.f, 0.f, 0.f};
#pragma unroll 4
        for (int k0 = 0; k0 < 64; k0 += 4) { const float av = Vl[(k0 + kq) * 65 + bi * 16 + li];
            acc0 = MFMA_F32(av, Kl[(k0 + kq) * 65 + bj0 * 16 + li], acc0); acc1 = MFMA_F32(av, Kl[(k0 + kq) * 65 + (bj0 + 1) * 16 + li], acc1); }
        float* o = dC + (size_t)u * 4096 + (bi * 16 + kq * 4) * 64 + li;
#pragma unroll
        for (int r = 0; r < 4; ++r) { o[r * 64 + bj0 * 16] = acc0[r]; o[r * 64 + (bj0 + 1) * 16] = acc1[r]; }
        { const int t = F.tid >> 3, s8 = (F.tid & 7) * 8; float sacc = 0.f;
#pragma unroll
          for (int i = 0; i < 8; ++i) sacc += srcL[s8 + i] * Kl[(s8 + i) * 65 + t];
          sacc += __shfl_xor(sacc, 1); sacc += __shfl_xor(sacc, 2); sacc += __shfl_xor(sacc, 4);
          if ((F.tid & 7) == 0) dn[(size_t)u * 64 + t] = sacc; }
    }
    __syncthreads();
}
__device__ __forceinline__ void ml_phase4(Frame& F) {
    float* dC = (float*)(F.ws + WS_MLC); float* dn = (float*)(F.ws + WS_MLN); const float* sc = (const float*)(F.ws + WS_MLS) + ML_SC;
    float* base; size_t stride; int h;
    if (F.wave == 0) { const int e = F.bid * 64 + F.lane; if (e >= 16384) return; h = e >> 12; base = dC + (size_t)h * 4096 + (e & 4095); stride = 4 * 4096; }
    else if (F.wave == 1 && F.bid < 4) { h = F.bid; base = dn + (size_t)h * 64 + F.lane; stride = 4 * 64; }
    else return;
    float st = 0.f;
    for (int c0 = 0; c0 < NCH; c0 += 8) {
        float v[8], g[8];
#pragma unroll
        for (int i = 0; i < 8; ++i) { v[i] = base[(size_t)(c0 + i) * stride]; g[i] = sc[(c0 + i) * 4 + h]; }
#pragma unroll
        for (int i = 0; i < 8; ++i) { base[(size_t)(c0 + i) * stride] = st; st = g[i] * st + v[i]; }
    }
}
__device__ __forceinline__ void ml_phase5(Frame& F, int l) {
    ArgsP a = kargs(); const bf16* P = (const bf16*)(F.ws + WS_PU);
    const float* Cst = (const float*)(F.ws + WS_MLC); const float* nst = (const float*)(F.ws + WS_MLN);
    const float* ib = a->in[5] + l * 4; const float* fb = a->in[6] + l * 4; const float* cw = a->in[3] + (size_t)l * 2048; const float* cb = a->in[4] + (size_t)l * 512;
    const float* gn = a->in[7] + (size_t)l * 256;
    bf16* Y = (bf16*)(F.ws + WS_Y) + (size_t)1 * S * 256;
    LAS float* Ql = (LAS float*)F.lds; LAS float* Kl = Ql + 64 * 65; LAS float* Vl = Kl + 64 * 65; LAS float* Cl = Vl + 64 * 65; LAS float* Wl = Cl + 64 * 65;
    LAS float* cumL = Wl + 64 * 65; LAS float* bL = cumL + 64; LAS float* mtL = bL + 64; LAS float* inL = mtL + 64; LAS float* nL = inL + 64; LAS float* denL = nL + 64;
    LAS float* mt = denL + 64; LAS float* tmp = mt + 4 * 257 + 4;
    ml_mscan(F, mt, tmp);
    const int lane = F.lane, w = F.wave, li = lane & 15, kq = lane >> 4, bi = w >> 1, bj0 = (w & 1) * 2;
    for (int u = F.bid; u < NCH * 4; u += F.G) {
        const int c = u >> 2, h = u & 3; const float m0 = mt[h * 257 + c];
        const u32x4 ov = *(const u32x4*)(P + (size_t)(c * 64 + (F.tid >> 3)) * PW + C_OB + h * 64 + (F.tid & 7) * 8);
        const f32x4 g0 = *(const f32x4*)(gn + h * 64 + (F.tid & 7) * 8), g1 = *(const f32x4*)(gn + h * 64 + (F.tid & 7) * 8 + 4);
        __syncthreads();
        if (w == 0) { float at, it; ml_gates(P, ib, fb, c, h, lane, at, it); const float cum = wave_scan_add(at, lane);
            const float bb = it - cum, pm = wave_scan_max(bb, lane), mtt = fmaxf(cum + m0, cum + pm);
            cumL[lane] = cum; bL[lane] = bb; mtL[lane] = mtt; inL[lane] = __expf(cum + m0 - mtt); nL[lane] = nst[(size_t)u * 64 + lane]; }
        ml_stage_conv(P, C_QB + h * 64, cw + h * 64, cb + h * 64, c * 64, 1.f, Ql, F.tid);
        ml_stage_conv(P, C_KB + h * 64, cw + 256 + h * 64, cb + 256 + h * 64, c * 64, 0.125f, Kl, F.tid);
        ml_stage_plain(P, C_VB + h * 64, c * 64, nullptr, Vl, F.tid);
        { const int t = F.tid >> 3, d0 = (F.tid & 7) * 8; const f32x4 c0 = *(const f32x4*)(Cst + (size_t)u * 4096 + t * 64 + d0), c1 = *(const f32x4*)(Cst + (size_t)u * 4096 + t * 64 + d0 + 4);
          LAS float* d = Cl + t * 65 + d0; d[0] = c0.x; d[1] = c0.y; d[2] = c0.z; d[3] = c0.w; d[4] = c1.x; d[5] = c1.y; d[6] = c1.z; d[7] = c1.w; }
        __syncthreads();
        {
            f32x4 acc0 = {0.f, 0.f, 0.f, 0.f}, acc1 = {0.f, 0.f, 0.f, 0.f};
#pragma unroll 4
            for (int k0 = 0; k0 < 64; k0 += 4) { const float av = Ql[(bi * 16 + li) * 65 + k0 + kq];
                acc0 = MFMA_F32(av, Kl[(bj0 * 16 + li) * 65 + k0 + kq], acc0); acc1 = MFMA_F32(av, Kl[((bj0 + 1) * 16 + li) * 65 + k0 + kq], acc1); }
#pragma unroll
            for (int r = 0; r < 4; ++r) { const int t = bi * 16 + kq * 4 + r; const float ct = cumL[t] - mtL[t];
                { const int s2 = bj0 * 16 + li; Wl[t * 65 + s2] = (s2 <= t) ? __expf(ct + bL[s2]) * acc0[r] : 0.f; }
                { const int s2 = (bj0 + 1) * 16 + li; Wl[t * 65 + s2] = (s2 <= t) ? __expf(ct + bL[s2]) * acc1[r] : 0.f; } }
        }
        __syncthreads();
        { const int t = F.tid >> 3, k8 = (F.tid & 7) * 8; float qn = 0.f, sw = 0.f;
#pragma unroll
            for (int k = 0; k < 8; ++k) { qn += Ql[t * 65 + k8 + k] * nL[k8 + k]; sw += Wl[t * 65 + k8 + k]; }
            qn += __shfl_xor(qn, 1); sw += __shfl_xor(sw, 1); qn += __shfl_xor(qn, 2); sw += __shfl_xor(sw, 2); qn += __shfl_xor(qn, 4); sw += __shfl_xor(sw, 4);
            if ((F.tid & 7) == 0) { const float den = inL[t] * qn + sw; denL[t] = 1.f / fmaxf(fabsf(den), __expf(-mtL[t])); } }
        f32x4 acc0 = {0.f, 0.f, 0.f, 0.f}, acc1 = {0.f, 0.f, 0.f, 0.f};
#pragma unroll 4
        for (int k0 = 0; k0 < 64; k0 += 4) { const float av = Ql[(bi * 16 + li) * 65 + k0 + kq];
            acc0 = MFMA_F32(av, Cl[(bj0 * 16 + li) * 65 + k0 + kq], acc0); acc1 = MFMA_F32(av, Cl[((bj0 + 1) * 16 + li) * 65 + k0 + kq], acc1); }
#pragma unroll
        for (int r = 0; r < 4; ++r) { const float it = inL[bi * 16 + kq * 4 + r]; acc0[r] *= it; acc1[r] *= it; }
#pragma unroll 4
        for (int k0 = 0; k0 < 64; k0 += 4) { const float av = Wl[(bi * 16 + li) * 65 + k0 + kq];
            acc0 = MFMA_F32(av, Vl[(k0 + kq) * 65 + bj0 * 16 + li], acc0); acc1 = MFMA_F32(av, Vl[(k0 + kq) * 65 + (bj0 + 1) * 16 + li], acc1); }
        __syncthreads();
#pragma unroll
        for (int r = 0; r < 4; ++r) { const int t = bi * 16 + kq * 4 + r; const float dv = denL[t]; Wl[t * 65 + bj0 * 16 + li] = acc0[r] * dv; Wl[t * 65 + (bj0 + 1) * 16 + li] = acc1[r] * dv; }
        __syncthreads();
        { const int t = F.tid >> 3, d0 = (F.tid & 7) * 8; float hv[8], ss = 0.f;
#pragma unroll
          for (int i = 0; i < 8; ++i) { hv[i] = Wl[t * 65 + d0 + i]; ss += hv[i] * hv[i]; }
          ss += __shfl_xor(ss, 1); ss += __shfl_xor(ss, 2); ss += __shfl_xor(ss, 4);
          const float rstd = rsqrtf(ss * (1.f / 64.f) + RMS_EPS);
          const float g[8] = {g0.x, g0.y, g0.z, g0.w, g1.x, g1.y, g1.z, g1.w};
          const float o0 = sigmoidf_(bflo(ov.x)), o1 = sigmoidf_(bfhi(ov.x)), o2 = sigmoidf_(bflo(ov.y)), o3 = sigmoidf_(bfhi(ov.y)), o4 = sigmoidf_(bflo(ov.z)), o5 = sigmoidf_(bfhi(ov.z)), o6 = sigmoidf_(bflo(ov.w)), o7 = sigmoidf_(bfhi(ov.w));
          u32x4 y; y.x = pk2(o0 * hv[0] * rstd * g[0], o1 * hv[1] * rstd * g[1]); y.y = pk2(o2 * hv[2] * rstd * g[2], o3 * hv[3] * rstd * g[3]);
          y.z = pk2(o4 * hv[4] * rstd * g[4], o5 * hv[5] * rstd * g[5]); y.w = pk2(o6 * hv[6] * rstd * g[6], o7 * hv[7] * rstd * g[7]);
          *(u32x4*)(Y + (size_t)(c * 64 + t) * 256 + h * 64 + d0) = y; }
    }
    __syncthreads();
}


constexpr int DSA_CAP = 2048, DSA_TRIG = 1024, QHP = 260, DSA_TU = 10496;
__device__ __forceinline__ u32x2 ld_list(const u32x2* p) { const unsigned long long v = __hip_atomic_load((const unsigned long long*)p, __ATOMIC_RELAXED, __HIP_MEMORY_SCOPE_AGENT); return (u32x2){(unsigned)v, (unsigned)(v >> 32)}; }

__device__ __forceinline__ unsigned wave_prefix_incl(unsigned v) {
    v += (unsigned)__builtin_amdgcn_update_dpp(0, (int)v, 0x111, 0xf, 0xf, false);
    v += (unsigned)__builtin_amdgcn_update_dpp(0, (int)v, 0x112, 0xf, 0xf, false);
    v += (unsigned)__builtin_amdgcn_update_dpp(0, (int)v, 0x114, 0xf, 0xf, false);
    v += (unsigned)__builtin_amdgcn_update_dpp(0, (int)v, 0x118, 0xf, 0xf, false);
    v += (unsigned)__builtin_amdgcn_update_dpp(0, (int)v, 0x142, 0xa, 0xf, false);
    v += (unsigned)__builtin_amdgcn_update_dpp(0, (int)v, 0x143, 0xc, 0xf, false);
    return v;
}
__device__ __forceinline__ unsigned sortable(float v) { const unsigned b = __builtin_bit_cast(unsigned, v); return (b & 0x80000000u) ? ~b : (b | 0x80000000u); }
__device__ __forceinline__ unsigned lanes_below(unsigned long long m) { return __builtin_amdgcn_mbcnt_hi((unsigned)(m >> 32), __builtin_amdgcn_mbcnt_lo((unsigned)m, 0u)); }

__device__ __forceinline__ unsigned dsa_bin(unsigned sv) {
    const bool pos = (sv >> 31) != 0u; const unsigned mag = (pos ? sv : ~sv) & 0x7fffffffu; int t = (int)(mag >> 19) - 1904; t = t < 0 ? 0 : (t > 255 ? 255 : t);
    return pos ? 256u + (unsigned)t : 255u - (unsigned)t;
}
__device__ __forceinline__ unsigned dsa_bin_f(float v) {
    const unsigned b = __builtin_bit_cast(unsigned, v); int t = (int)((b >> 19) & 0xfffu) - 1904; t = t < 0 ? 0 : (t > 255 ? 255 : t);
    return (unsigned)(256 + (t ^ ((int)b >> 31)));
}
__device__ __forceinline__ unsigned dsa_bin_T(unsigned B) {
    if (B >= 257u) return (0x80000000u | ((1904u + (B - 256u)) << 19)) - 1u;
    if (B == 256u) return 0x7fffffffu;
    if (B == 0u) return 0u;
    const unsigned t = 255u - B, mag = ((1905u + t) << 19) - 1u; return (0x7fffffffu - mag) - 1u;
}
__device__ __forceinline__ unsigned dsa_hist_T(const LAS unsigned* qh, int lane) {
    const int grp = 63 - lane;
    const u32x4 h = *(const LAS u32x4*)(qh + 4 * grp);
    const unsigned c[8] = {h.x & 0xffffu, h.x >> 16, h.y & 0xffffu, h.y >> 16, h.z & 0xffffu, h.z >> 16, h.w & 0xffffu, h.w >> 16};
    unsigned tl = 0u;
#pragma unroll
    for (int i = 0; i < 8; ++i) tl += c[i];
    const unsigned suf = wave_prefix_incl(tl);
    const unsigned above = suf - tl; const bool mine = (above < 256u) && (256u <= suf);
    unsigned B = 0u;
    if (mine) { unsigned cc = above; B = 8u * grp;
#pragma unroll
        for (int i = 7; i >= 0; --i) { cc += c[i]; if (cc >= 256u) { B = 8u * grp + i; break; } } }
    const unsigned long long mm = __ballot(mine); if (!mm) return 0u;
    B = (unsigned)__builtin_amdgcn_readlane((int)B, (int)__builtin_ctzll(mm));
    return dsa_bin_T(B);
}
__device__ __forceinline__ void dsa_hist_T4(const LAS unsigned* qh0, LAS unsigned* T4, int lane, bool want) {
    const int qq = lane >> 4, g = 15 - (lane & 15);
    const LAS unsigned* qh = qh0 + qq * QHP + 16 * g;
    const u32x4 h0 = *(const LAS u32x4*)qh, h1 = *(const LAS u32x4*)(qh + 4), h2 = *(const LAS u32x4*)(qh + 8), h3 = *(const LAS u32x4*)(qh + 12);
    const unsigned s0 = h0.x + h0.y + h0.z + h0.w, s1 = h1.x + h1.y + h1.z + h1.w, s2 = h2.x + h2.y + h2.z + h2.w, s3 = h3.x + h3.y + h3.z + h3.w;
    const unsigned t0 = (s0 & 0xffffu) + (s0 >> 16), t1 = (s1 & 0xffffu) + (s1 >> 16), t2 = (s2 & 0xffffu) + (s2 >> 16), t3 = (s3 & 0xffffu) + (s3 >> 16);
    const unsigned tl = t0 + t1 + t2 + t3;
    unsigned v = tl;
    v += (unsigned)__builtin_amdgcn_update_dpp(0, (int)v, 0x111, 0xf, 0xf, false);
    v += (unsigned)__builtin_amdgcn_update_dpp(0, (int)v, 0x112, 0xf, 0xf, false);
    v += (unsigned)__builtin_amdgcn_update_dpp(0, (int)v, 0x114, 0xf, 0xf, false);
    v += (unsigned)__builtin_amdgcn_update_dpp(0, (int)v, 0x118, 0xf, 0xf, false);
    const unsigned above = v - tl;
    if (want && above < 256u && 256u <= v) {
        unsigned cc = above, base; u32x4 hq;
        if (cc + t3 >= 256u) { hq = h3; base = 24u; } else { cc += t3;
        if (cc + t2 >= 256u) { hq = h2; base = 16u; } else { cc += t2;
        if (cc + t1 >= 256u) { hq = h1; base = 8u; } else { cc += t1; hq = h0; base = 0u; } } }
        const unsigned c[8] = {hq.x & 0xffffu, hq.x >> 16, hq.y & 0xffffu, hq.y >> 16, hq.z & 0xffffu, hq.z >> 16, hq.w & 0xffffu, hq.w >> 16};
        unsigned B = 32u * g + base;
#pragma unroll
        for (int i = 7; i >= 0; --i) { cc += c[i]; if (cc >= 256u) { B = 32u * g + base + i; break; } }
        const unsigned T = dsa_bin_T(B); if (T > T4[qq]) { T4[qq] = T; T4[DSA_TU + qq] = (B >= 511u || T4[DSA_TU + 32 + qq] != 0u) ? 0xffffffffu : dsa_bin_T(B + 1u); }
    }
}
template <int NPASS, class KF, class PF>
__device__ __forceinline__ unsigned radix_kth(int n, KF key, PF pred, unsigned& want, LAS unsigned* hist, int lane) {
    unsigned prefix = 0u, himask = 0u;
#pragma unroll 1
    for (int p = 0; p < NPASS; ++p) {
        const int shift = 8 * (NPASS - 1 - p);
        *(LAS u32x4*)(hist + 4 * lane) = (u32x4){0u, 0u, 0u, 0u};
        asm volatile("s_waitcnt lgkmcnt(0)" ::: "memory");
#pragma unroll 4
        for (int i = lane; i < n; i += 64) { const unsigned k = key(i); if (pred(i) && ((k ^ prefix) & himask) == 0u) (void)__hip_atomic_fetch_add(hist + ((k >> shift) & 255u), 1u, __ATOMIC_RELAXED, __HIP_MEMORY_SCOPE_WORKGROUP); }
        asm volatile("s_waitcnt lgkmcnt(0)" ::: "memory");
        const int grp = 63 - lane;
        const u32x4 h = *(LAS u32x4*)(hist + 4 * grp);
        const unsigned tl = h.x + h.y + h.z + h.w; const unsigned suf = wave_prefix_incl(tl);
        const unsigned above = suf - tl;
        const bool mine = (above < want) && (want <= suf);
        unsigned D = 0u, nw = 0u;
        if (mine) { unsigned c = above;
            if (c + h.w >= want) { D = 4 * grp + 3; nw = want - c; } else { c += h.w;
            if (c + h.z >= want) { D = 4 * grp + 2; nw = want - c; } else { c += h.z;
            if (c + h.y >= want) { D = 4 * grp + 1; nw = want - c; } else { c += h.y; D = 4 * grp; nw = want - c; } } } }
        const unsigned long long mm = __ballot(mine); const int src = mm ? (int)__builtin_ctzll(mm) : 0;
        D = (unsigned)__builtin_amdgcn_readlane((int)D, src); nw = (unsigned)__builtin_amdgcn_readlane((int)nw, src);
        prefix |= D << shift; himask |= 0xffu << shift; want = nw;
    }
    return prefix;
}
__device__ __forceinline__ void dsa_prune(u32x2* list, LAS unsigned* nq, LAS unsigned* Tq, int q, LAS u32x2* st, LAS unsigned* hist, int lane, bool exact, unsigned tmin) {
    const int n0 = (int)nq[q]; int n = 0;
#pragma unroll 1
    for (int i0 = 0; i0 < n0; i0 += 256) {
        u32x2 t8[4];
#pragma unroll
        for (int u = 0; u < 4; ++u) { const int i = i0 + u * 64 + lane; t8[u] = (i < n0) ? ld_list(list + i) : (u32x2){0u, 0u}; }
#pragma unroll
        for (int u = 0; u < 4; ++u) { const int i = i0 + u * 64 + lane; const bool k = (i < n0) && t8[u].x > tmin;
            const unsigned long long m = __ballot(k); if (k) st[n + (int)lanes_below(m)] = t8[u]; n += (int)__popcll(m); } }
    asm volatile("s_waitcnt vmcnt(0) lgkmcnt(0)" ::: "memory");
    if (n <= 256) {
#pragma unroll 1
        for (int i = lane; i < n; i += 64) list[i] = st[i];
        if (lane == 0) { nq[q] = (unsigned)n; Tq[DSA_TU + q] = 0xffffffffu; Tq[DSA_TU + 32 + q] = 1u; if (tmin > Tq[q]) Tq[q] = tmin; }
        asm volatile("s_waitcnt vmcnt(0)" ::: "memory");
        return;
    }
    if (!exact) {
        unsigned want = 256u;
        const unsigned Th = radix_kth<2>(n, [st](int i) { return st[i].x >> 16; }, [](int) { return true; }, want, hist, lane);
        unsigned cnt_ge = 0u;
#pragma unroll 1
        for (int i0 = 0; i0 < n; i0 += 64) { const int i = i0 + lane; cnt_ge += (unsigned)__popcll(__ballot(i < n && (st[i].x >> 16) >= Th)); }
        if (cnt_ge <= 512u && Th > 0u) {
            unsigned base = 0u;
#pragma unroll 1
            for (int i0 = 0; i0 < n; i0 += 64) { const int i = i0 + lane; const u32x2 t = (i < n) ? st[i] : (u32x2){0u, 0u};
                const bool keep = (i < n) && (t.x >> 16) >= Th;
                const unsigned long long m = __ballot(keep); if (keep) list[base + lanes_below(m)] = t; base += (unsigned)__popcll(m); }
            if (lane == 0) { nq[q] = base; const unsigned tn = (Th << 16) - 1u; Tq[q] = tn > tmin ? tn : tmin; Tq[DSA_TU + q] = 0xffffffffu; Tq[DSA_TU + 32 + q] = 1u; }
            asm volatile("s_waitcnt vmcnt(0)" ::: "memory");
            return;
        }
    }
    unsigned want = 256u;
    const unsigned Ts = radix_kth<4>(n, [st](int i) { return st[i].x; }, [](int) { return true; }, want, hist, lane);
    unsigned cnt_eq = 0u;
#pragma unroll 1
    for (int i0 = 0; i0 < n; i0 += 64) { const int i = i0 + lane; cnt_eq += (unsigned)__popcll(__ballot(i < n && st[i].x == Ts)); }
    unsigned Tk = 0u;
    if (cnt_eq > want) Tk = radix_kth<2>(n, [st](int i) { return 0x3fffu - st[i].y; }, [st, Ts](int i) { return st[i].x == Ts; }, want, hist, lane);
    unsigned base = 0u;
#pragma unroll 1
    for (int i0 = 0; i0 < n; i0 += 64) { const int i = i0 + lane; const u32x2 t = (i < n) ? st[i] : (u32x2){0u, 0u};
        const bool keep = (i < n) && (t.x > Ts || (t.x == Ts && (0x3fffu - t.y) >= Tk));
        const unsigned long long m = __ballot(keep); if (keep) list[base + lanes_below(m)] = t; base += (unsigned)__popcll(m); }
    if (lane == 0) { nq[q] = base; Tq[q] = Ts; Tq[DSA_TU + q] = 0xffffffffu; Tq[DSA_TU + 32 + q] = 1u; }
    asm volatile("s_waitcnt vmcnt(0)" ::: "memory");
}
__device__ __forceinline__ int dsa_final(const u32x2* list, int n0, unsigned tmin, unsigned tup, LAS u32x2* st, LAS unsigned* hist, LAS unsigned* bmp, int lane) {
    int n = 0, cin = 0;
#pragma unroll 1
    for (int i0 = 0; i0 < n0; i0 += 512) {
        u32x4 t4[4];
#pragma unroll
        for (int u = 0; u < 4; ++u) { const int i = i0 + u * 128 + 2 * lane; t4[u] = (i < n0) ? *(const u32x4*)(list + i) : (u32x4){0u, 0u, 0u, 0u}; }
#pragma unroll
        for (int u = 0; u < 4; ++u) { const int i = i0 + u * 128 + 2 * lane;
            { const bool in = (i < n0) && t4[u].x > tup, k = (i < n0) && t4[u].x > tmin && !in;
              if (in) (void)__hip_atomic_fetch_or(bmp + (t4[u].y >> 5), 1u << (t4[u].y & 31u), __ATOMIC_RELAXED, __HIP_MEMORY_SCOPE_WORKGROUP);
              cin += (int)__popcll(__ballot(in));
              const unsigned long long m = __ballot(k); if (k) st[n + (int)lanes_below(m)] = (u32x2){t4[u].x, t4[u].y}; n += (int)__popcll(m); }
            { const bool in = (i + 1 < n0) && t4[u].z > tup, k = (i + 1 < n0) && t4[u].z > tmin && !in;
              if (in) (void)__hip_atomic_fetch_or(bmp + (t4[u].w >> 5), 1u << (t4[u].w & 31u), __ATOMIC_RELAXED, __HIP_MEMORY_SCOPE_WORKGROUP);
              cin += (int)__popcll(__ballot(in));
              const unsigned long long m = __ballot(k); if (k) st[n + (int)lanes_below(m)] = (u32x2){t4[u].z, t4[u].w}; n += (int)__popcll(m); } }
    }
    asm volatile("s_waitcnt lgkmcnt(0)" ::: "memory");
    const int quota = cin < 256 ? 256 - cin : 0;
    unsigned Ts = 0u, Tk = 0u;
    if (n > quota) {
        unsigned want = (unsigned)quota;
        Ts = radix_kth<4>(n, [st](int i) { return st[i].x; }, [](int) { return true; }, want, hist, lane);
        unsigned cnt_eq = 0u;
#pragma unroll 1
        for (int i0 = 0; i0 < n; i0 += 64) { const int i = i0 + lane; cnt_eq += (unsigned)__popcll(__ballot(i < n && st[i].x == Ts)); }
        if (cnt_eq > want) Tk = radix_kth<2>(n, [st](int i) { return 0x3fffu - st[i].y; }, [st, Ts](int i) { return st[i].x == Ts; }, want, hist, lane);
    }
    int cnt = cin;
#pragma unroll 1
    for (int i0 = 0; i0 < n; i0 += 64) { const int i = i0 + lane; const u32x2 t = (i < n) ? st[i] : (u32x2){0u, 0u};
        const bool keep = (i < n) && (n <= quota || t.x > Ts || (t.x == Ts && (0x3fffu - t.y) >= Tk));
        if (keep) (void)__hip_atomic_fetch_or(bmp + (t.y >> 5), 1u << (t.y & 31u), __ATOMIC_RELAXED, __HIP_MEMORY_SCOPE_WORKGROUP);
        cnt += (int)__popcll(__ballot(keep)); }
    asm volatile("s_waitcnt lgkmcnt(0)" ::: "memory");
    return cnt;
}
__device__ __forceinline__ void dsa_unit(Frame& F, int G32) {
    const bf16* P = (const bf16*)(F.ws + WS_PU);
    bf16* Y = (bf16*)(F.ws + WS_Y);
    u32x2* cand = (u32x2*)(F.ws + WS_CAND) + (size_t)F.bid * 32 * DSA_CAP;
    const int lane = F.lane, w = F.wave, r = lane & 31, hh = lane >> 5;
    LAS unsigned char* wscr = F.lds + w * 12288;
    LAS unsigned* Tq = (LAS unsigned*)(F.lds + 98304); LAS unsigned* nq = Tq + 32;
    LAS unsigned* hist = (LAS unsigned*)(F.lds + 98816 + w * 1024);
    LAS unsigned* qhist = (LAS unsigned*)(F.lds + 107008);
    const int q0 = G32 * 32, c = G32 >> 1, nt = c + 1, nrounds = (nt + 7) >> 3;
    __syncthreads();
    if (F.tid < 32) { Tq[F.tid] = 0u; Tq[DSA_TU + F.tid] = 0xffffffffu; Tq[DSA_TU + 32 + F.tid] = 0u; nq[F.tid] = 0u; nq[32 + F.tid] = 0u; nq[64 + F.tid] = 0u; }
#pragma unroll
    for (int k = 0; k < 4; ++k) *(LAS u32x4*)(qhist + F.tid * 4 + k * 2048) = (u32x4){0u, 0u, 0u, 0u};
    if (F.tid < 32) *(LAS u32x4*)(qhist + 8192 + F.tid * 4) = (u32x4){0u, 0u, 0u, 0u};
    bf16x8 Qf[4][2]; float wh[4];
    { const bf16* qp = P + (size_t)(q0 + r) * PW;
#pragma unroll
      for (int h = 0; h < 4; ++h) { wh[h] = bf2f(qp[C_WI + h]);
#pragma unroll
          for (int kk = 0; kk < 2; ++kk) Qf[h][kk] = *(const bf16x8*)(qp + C_QI + h * 32 + kk * 16 + 8 * hh); } }
    bf16x8 Kf[2][2];
    { const int jf = (nrounds - (nrounds < 3 ? nrounds : 3)) * 8 + w; const int j0 = jf < nt ? jf : 0;
#pragma unroll
      for (int kb = 0; kb < 2; ++kb)
#pragma unroll
          for (int kk = 0; kk < 2; ++kk) Kf[kb][kk] = *(const bf16x8*)(P + (size_t)(j0 * 64 + kb * 32 + r) * PW + C_KI + kk * 16 + 8 * hh); }
    __syncthreads();
    LAS unsigned* nlast = nq + 32;
    const int R0 = nrounds < 3 ? nrounds : 3, nvr = nrounds + R0;
    asm volatile(".p2align 8" ::: "memory");
    for (int vr = 0; vr < nvr; ++vr) {
        const int rd = vr < R0 ? nrounds - R0 + vr : vr - R0;
        const int mode = vr < R0 ? 0 : (rd >= nrounds - R0 ? 2 : 1);
        const int j = rd * 8 + w;
        int rr = r; asm volatile("" : "+v"(rr));
        u32x2* myl = cand + (size_t)rr * DSA_CAP;
        if (j < nt) {
            f32x16 acc[2];
#pragma unroll
            for (int h = 0; h < 4; ++h)
#pragma unroll
                for (int kb = 0; kb < 2; ++kb) { f32x16 sv;
#pragma unroll
                    for (int i = 0; i < 16; ++i) sv[i] = 0.f;
                    sv = __builtin_amdgcn_mfma_f32_32x32x16_bf16(Kf[kb][0], Qf[h][0], sv, 0, 0, 0); sv = __builtin_amdgcn_mfma_f32_32x32x16_bf16(Kf[kb][1], Qf[h][1], sv, 0, 0, 0);
                    const f32x2 w2 = (f32x2){wh[h], wh[h]};
#pragma unroll
                    for (int i = 0; i < 16; i += 2) { const f32x2 rl = (f32x2){__builtin_amdgcn_fmed3f(sv[i], 0.f, __builtin_inff()), __builtin_amdgcn_fmed3f(sv[i + 1], 0.f, __builtin_inff())};
                        const f32x2 a2 = (h == 0) ? __builtin_elementwise_fma(w2, rl, (f32x2){0.f, 0.f}) : __builtin_elementwise_fma(w2, rl, (f32x2){acc[kb][i], acc[kb][i + 1]});
                        acc[kb][i] = a2.x; acc[kb][i + 1] = a2.y; } }
            LAS unsigned* myv = (LAS unsigned*)wscr + lane * 36;
            unsigned pm = 0u;
            if (mode == 0) {
#pragma unroll
                for (int kb = 0; kb < 2; ++kb)
#pragma unroll
                    for (int g = 0; g < 4; ++g) { const unsigned b0 = dsa_bin_f(acc[kb][4 * g]), b1 = dsa_bin_f(acc[kb][4 * g + 1]), b2 = dsa_bin_f(acc[kb][4 * g + 2]), b3 = dsa_bin_f(acc[kb][4 * g + 3]); LAS unsigned* qh = qhist + rr * QHP;
                        (void)__hip_atomic_fetch_add(qh + (b0 >> 1), 1u << (16u * (b0 & 1u)), __ATOMIC_RELAXED, __HIP_MEMORY_SCOPE_WORKGROUP); (void)__hip_atomic_fetch_add(qh + (b1 >> 1), 1u << (16u * (b1 & 1u)), __ATOMIC_RELAXED, __HIP_MEMORY_SCOPE_WORKGROUP);
                        (void)__hip_atomic_fetch_add(qh + (b2 >> 1), 1u << (16u * (b2 & 1u)), __ATOMIC_RELAXED, __HIP_MEMORY_SCOPE_WORKGROUP); (void)__hip_atomic_fetch_add(qh + (b3 >> 1), 1u << (16u * (b3 & 1u)), __ATOMIC_RELAXED, __HIP_MEMORY_SCOPE_WORKGROUP); }
            } else {
                unsigned T1 = Tq[rr]; T1 = T1 == 0xffffffffu ? T1 : T1 + 1u; T1 = T1 < 0x007fffffu ? 0x007fffffu : T1;
                const float Tf = __builtin_bit_cast(float, (T1 & 0x80000000u) ? (T1 & 0x7fffffffu) : ~T1);
#define DSA_C2(n) "v_cmp_ge_f32 vcc, %" #n ", %9\n\tv_addc_co_u32 %0, vcc, %0, %0, vcc\n\t"
#pragma unroll
                for (int e8 = 3; e8 >= 0; --e8) { const int kb = e8 >> 1, o8 = (e8 & 1) * 8;
                    asm(DSA_C2(8) DSA_C2(7) DSA_C2(6) DSA_C2(5) DSA_C2(4) DSA_C2(3) DSA_C2(2) DSA_C2(1) : "+v"(pm)
                        : "v"(acc[kb][o8]), "v"(acc[kb][o8 + 1]), "v"(acc[kb][o8 + 2]), "v"(acc[kb][o8 + 3]), "v"(acc[kb][o8 + 4]), "v"(acc[kb][o8 + 5]), "v"(acc[kb][o8 + 6]), "v"(acc[kb][o8 + 7]), "v"(Tf) : "vcc"); }
#undef DSA_C2
#pragma unroll
                for (int kb = 0; kb < 2; ++kb)
#pragma unroll
                    for (int g = 0; g < 4; ++g) *(LAS f32x4*)(myv + kb * 16 + 4 * g) = (f32x4){acc[kb][4 * g], acc[kb][4 * g + 1], acc[kb][4 * g + 2], acc[kb][4 * g + 3]};
            }
            asm volatile("s_waitcnt lgkmcnt(0)" ::: "memory");
            if (__any(pm != 0u)) {
                unsigned pos1 = 0u;
                if (pm) pos1 = __hip_atomic_fetch_add(nq + rr, (unsigned)__popc(pm), __ATOMIC_RELAXED, __HIP_MEMORY_SCOPE_WORKGROUP);
                while (__any(pm != 0u)) {
                    if (pm) { const int e = __builtin_ctz(pm); pm &= pm - 1u; const unsigned sv1 = sortable(__builtin_bit_cast(float, myv[e]));
                        if (mode == 1) { const unsigned bn = dsa_bin(sv1); (void)__hip_atomic_fetch_add(qhist + rr * QHP + (bn >> 1), 1u << (16u * (bn & 1u)), __ATOMIC_RELAXED, __HIP_MEMORY_SCOPE_WORKGROUP); }
                        myl[pos1++] = (u32x2){sv1, (unsigned)(j * 64 + (e >> 4) * 32 + (e & 3) + 8 * ((e & 15) >> 2) + 4 * hh)}; }
                }
            }
        }
        { const int nv = vr + 1, nrd = nv < R0 ? nrounds - R0 + nv : nv - R0; int jn = nrd * 8 + w; if (jn >= nt || nv >= nvr) jn = (j < nt ? j : 0);
#pragma unroll
          for (int kb = 0; kb < 2; ++kb)
#pragma unroll
              for (int kk = 0; kk < 2; ++kk) Kf[kb][kk] = *(const bf16x8*)(P + (size_t)(jn * 64 + kb * 32 + r) * PW + C_KI + kk * 16 + 8 * hh); }
        LAS unsigned* oflag = nq + 64;
        { const int q = w * 4 + (lane >> 4); const unsigned n = nq[q]; const bool over = n > (unsigned)DSA_TRIG;
          if (__any(over)) { if (lane == 0) oflag[0] = 1u; }
          const bool want = !over && !(mode == 1 && n < nlast[q] + 1u);
          if (__any(want)) { if (want && (lane & 15) == 0) nlast[q] = n;
              dsa_hist_T4(qhist + (w * 4) * QHP, Tq + w * 4, lane, want); } }
        __syncthreads();
        if (oflag[0]) {
            asm volatile("s_waitcnt vmcnt(0)" ::: "memory");
            __syncthreads();
#pragma unroll 1
            for (int qq = 0; qq < 4; ++qq) { const int q = w * 4 + qq; const unsigned n = nq[q];
                if (n > (unsigned)DSA_TRIG) {
                    const unsigned Th = dsa_hist_T(qhist + q * QHP, lane);
                    dsa_prune(cand + (size_t)q * DSA_CAP, nq, Tq, q, (LAS u32x2*)wscr, hist, lane, false, Th > Tq[q] ? Th : Tq[q]);
                    const int n2 = (int)nq[q]; LAS unsigned* qh = qhist + q * QHP;
                    *(LAS u32x4*)(qh + 4 * lane) = (u32x4){0u, 0u, 0u, 0u};
                    asm volatile("s_waitcnt lgkmcnt(0)" ::: "memory");
#pragma unroll 1
                    for (int i = lane; i < n2; i += 64) { const unsigned bn = dsa_bin(ld_list(cand + (size_t)q * DSA_CAP + i).x); (void)__hip_atomic_fetch_add(qh + (bn >> 1), 1u << (16u * (bn & 1u)), __ATOMIC_RELAXED, __HIP_MEMORY_SCOPE_WORKGROUP); }
                    __builtin_amdgcn_fence(__ATOMIC_ACQUIRE, "agent");
                    asm volatile("s_waitcnt vmcnt(0) lgkmcnt(0)" ::: "memory");
                    if (lane == 0) nlast[q] = (unsigned)n2;
                } }
            __syncthreads();
            if (F.tid == 0) oflag[0] = 0u;
            __syncthreads();
        }
    }
    asm volatile("s_waitcnt vmcnt(0)" ::: "memory");
    __syncthreads();
    dsa_hist_T4(qhist + (w * 4) * QHP, Tq + w * 4, lane, true);
    __syncthreads();
#pragma unroll 1
    for (int qq = 0; qq < 4; ++qq) {
        const int q = w * 4 + qq, qrow = q0 + q; const int n0 = (int)nq[q];
        LAS unsigned* bmp = (LAS unsigned*)(F.lds + 107008 + w * 2048);
        *(LAS u32x4*)(bmp + 8 * lane) = (u32x4){0u, 0u, 0u, 0u}; *(LAS u32x4*)(bmp + 8 * lane + 4) = (u32x4){0u, 0u, 0u, 0u};
        asm volatile("s_waitcnt lgkmcnt(0)" ::: "memory");
        const int n = dsa_final(cand + (size_t)q * DSA_CAP, n0, n0 > 256 ? Tq[q] : 0u, n0 > 256 ? Tq[DSA_TU + q] : 0u, (LAS u32x2*)wscr, hist, bmp, lane);
        unsigned short* srow = (unsigned short*)(F.ws + WS_SEL) + (size_t)qrow * 256;
        { const u32x4 b0 = *(LAS u32x4*)(bmp + 8 * lane), b1 = *(LAS u32x4*)(bmp + 8 * lane + 4); const unsigned wd[8] = {b0.x, b0.y, b0.z, b0.w, b1.x, b1.y, b1.z, b1.w};
          unsigned cnt = 0u;
#pragma unroll
          for (int i = 0; i < 8; ++i) cnt += (unsigned)__popc(wd[i]);
          unsigned pos = wave_prefix_incl(cnt) - cnt;
#pragma unroll
          for (int i = 0; i < 8; ++i) { unsigned wv = wd[i]; while (wv) { const int bpos = __builtin_ctz(wv); srow[pos < 255u ? pos : 255u] = (unsigned short)(lane * 256 + i * 32 + bpos); ++pos; wv &= wv - 1u; } } }
        if (lane == 0) ((int*)(F.ws + WS_NSEL))[qrow] = n < 256 ? n : 256;
    }
    asm volatile("s_waitcnt vmcnt(0)" ::: "memory");
}
__device__ __forceinline__ void dsa_pack_phase(Frame& F) {
    const bf16* P = (const bf16*)(F.ws + WS_PU); unsigned char* T8 = F.ws + WS_KV8;
    for (int t = F.bid * 512 + F.tid; t < S * 32; t += F.G * 512) {
        const int row = t >> 5, ch = t & 31;
        const bf16* src = P + (size_t)row * PW + C_KA + ch * 16;
        const u32x4 a0 = *(const u32x4*)src, a1 = *(const u32x4*)(src + 8);
        u32x4 o; int v;
        v = __builtin_amdgcn_cvt_pk_fp8_f32(bflo(a0.x), bfhi(a0.x), 0, false); v = __builtin_amdgcn_cvt_pk_fp8_f32(bflo(a0.y), bfhi(a0.y), v, true); o.x = (unsigned)v;
        v = __builtin_amdgcn_cvt_pk_fp8_f32(bflo(a0.z), bfhi(a0.z), 0, false); v = __builtin_amdgcn_cvt_pk_fp8_f32(bflo(a0.w), bfhi(a0.w), v, true); o.y = (unsigned)v;
        v = __builtin_amdgcn_cvt_pk_fp8_f32(bflo(a1.x), bfhi(a1.x), 0, false); v = __builtin_amdgcn_cvt_pk_fp8_f32(bflo(a1.y), bfhi(a1.y), v, true); o.z = (unsigned)v;
        v = __builtin_amdgcn_cvt_pk_fp8_f32(bflo(a1.z), bfhi(a1.z), 0, false); v = __builtin_amdgcn_cvt_pk_fp8_f32(bflo(a1.w), bfhi(a1.w), v, true); o.w = (unsigned)v;
        *(u32x4*)(T8 + (size_t)row * 512 + ch * 16) = o;
    }
}
__device__ __forceinline__ void dsa_sparse_unit(Frame& F, int G32) {
    const bf16* P = (const bf16*)(F.ws + WS_PU); bf16* Y = (bf16*)(F.ws + WS_Y);
    const int lane = F.lane, w = F.wave, q0 = G32 * 32;
#pragma unroll 1
    for (int qq = 0; qq < 4; ++qq) {
        int l2 = lane; asm volatile("" : "+v"(l2)); const int ks = l2 >> 4, dg = l2 & 15;
        const int q = w * 4 + qq, qrow = q0 + q; const int n = ((const int*)(F.ws + WS_NSEL))[qrow];
        LAS unsigned short* srt = (LAS unsigned short*)(F.lds + w * 1024 + (qq & 1) * 512);
        { const unsigned long long* g8 = (const unsigned long long*)((const unsigned short*)(F.ws + WS_SEL) + (size_t)qrow * 256); ((LAS unsigned long long*)srt)[lane] = g8[lane]; }
        asm volatile("s_waitcnt vmcnt(0) lgkmcnt(0)" ::: "memory");
        f32x2 qv[8];
        { const u32x4 a0 = *(const u32x4*)(P + (size_t)qrow * PW + C_QA + dg * 16), a1 = *(const u32x4*)(P + (size_t)qrow * PW + C_QA + dg * 16 + 8); const float sc = 0.125f * 1.4426950408889634f;
          qv[0] = (f32x2){bflo(a0.x) * sc, bfhi(a0.x) * sc}; qv[1] = (f32x2){bflo(a0.y) * sc, bfhi(a0.y) * sc}; qv[2] = (f32x2){bflo(a0.z) * sc, bfhi(a0.z) * sc}; qv[3] = (f32x2){bflo(a0.w) * sc, bfhi(a0.w) * sc};
          qv[4] = (f32x2){bflo(a1.x) * sc, bfhi(a1.x) * sc}; qv[5] = (f32x2){bflo(a1.y) * sc, bfhi(a1.y) * sc}; qv[6] = (f32x2){bflo(a1.z) * sc, bfhi(a1.z) * sc}; qv[7] = (f32x2){bflo(a1.w) * sc, bfhi(a1.w) * sc}; }
        float mrun = -1e30f, lrun = 0.f; f32x2 o[8];
#pragma unroll
        for (int i = 0; i < 8; ++i) o[i] = (f32x2){0.f, 0.f};
        const int nb = (n + 31) >> 5;
        const unsigned char* T8 = F.ws + WS_KV8 + dg * 16;
        asm volatile(".p2align 8" ::: "memory");
#pragma unroll 1
        for (int bt = 0; bt < nb; ++bt) {
            u32x4 kk[8], vv[8]; bool val[8];
#pragma unroll
            for (int t = 0; t < 8; ++t) { const int jn = bt * 32 + t * 4 + ks; val[t] = jn < n; const unsigned idx = val[t] ? (unsigned)srt[jn] : 0u;
                const unsigned char* kp = T8 + (size_t)idx * 512; kk[t] = *(const u32x4*)kp; vv[t] = *(const u32x4*)(kp + 256); }
            float d[8];
#pragma unroll
            for (int t = 0; t < 8; ++t) { f32x2 d2 = (f32x2){0.f, 0.f};
#pragma unroll
                for (int c4 = 0; c4 < 4; ++c4) { const int wd = (int)kk[t][c4]; const f32x2 lo = __builtin_amdgcn_cvt_pk_f32_fp8(wd, false), hi = __builtin_amdgcn_cvt_pk_f32_fp8(wd, true);
                    d2 = __builtin_elementwise_fma(qv[2 * c4], lo, d2); d2 = __builtin_elementwise_fma(qv[2 * c4 + 1], hi, d2); }
                float dd = d2.x + d2.y;
                dd += __builtin_bit_cast(float, __builtin_amdgcn_update_dpp(0, __builtin_bit_cast(int, dd), 0xB1, 0xf, 0xf, false));
                dd += __builtin_bit_cast(float, __builtin_amdgcn_update_dpp(0, __builtin_bit_cast(int, dd), 0x4E, 0xf, 0xf, false));
                d[t] = val[t] ? dd : -1e30f; }
            const float dm = fmaxf(fmaxf(fmaxf(d[0], d[1]), fmaxf(d[2], d[3])), fmaxf(fmaxf(d[4], d[5]), fmaxf(d[6], d[7])));
            if (__any(dm > mrun + 8.f)) { const float mn = fmaxf(mrun, dm), al = __builtin_amdgcn_exp2f(mrun - mn); mrun = mn; lrun *= al;
#pragma unroll
                for (int i = 0; i < 8; ++i) o[i] *= al; }
            float p[8];
#pragma unroll
            for (int t = 0; t < 8; ++t) { p[t] = val[t] ? __builtin_amdgcn_exp2f(d[t] - mrun) : 0.f; lrun += p[t]; }
#pragma unroll
            for (int t = 0; t < 8; ++t) { const f32x2 p2 = (f32x2){p[t], p[t]};
#pragma unroll
                for (int c4 = 0; c4 < 4; ++c4) { const int wd = (int)vv[t][c4]; const f32x2 lo = __builtin_amdgcn_cvt_pk_f32_fp8(wd, false), hi = __builtin_amdgcn_cvt_pk_f32_fp8(wd, true);
                    o[2 * c4] = __builtin_elementwise_fma(p2, lo, o[2 * c4]); o[2 * c4 + 1] = __builtin_elementwise_fma(p2, hi, o[2 * c4 + 1]); } }
        }
        { float ma = fmaxf(mrun, __shfl_xor(mrun, 16)); ma = fmaxf(ma, __shfl_xor(ma, 32)); const float al = __builtin_amdgcn_exp2f(mrun - ma);
          lrun *= al; lrun += __shfl_xor(lrun, 16); lrun += __shfl_xor(lrun, 32); const float iv = 1.f / lrun;
#pragma unroll
          for (int i = 0; i < 8; ++i) { float t = o[i].x * al; t += __shfl_xor(t, 16); t += __shfl_xor(t, 32); o[i].x = t * iv; t = o[i].y * al; t += __shfl_xor(t, 16); t += __shfl_xor(t, 32); o[i].y = t * iv; } }
        if (ks == 0) { u32x4 y0, y1; y0.x = pk2(o[0].x, o[0].y); y0.y = pk2(o[1].x, o[1].y); y0.z = pk2(o[2].x, o[2].y); y0.w = pk2(o[3].x, o[3].y); y1.x = pk2(o[4].x, o[4].y); y1.y = pk2(o[5].x, o[5].y); y1.z = pk2(o[6].x, o[6].y); y1.w = pk2(o[7].x, o[7].y);
            *(u32x4*)(Y + (size_t)qrow * 256 + dg * 16) = y0; *(u32x4*)(Y + (size_t)qrow * 256 + dg * 16 + 8) = y1; }
    }
}
__device__ __forceinline__ void dsa_phase(Frame& F) {
#pragma unroll 1
    for (int i2 = F.bid * 2; i2 < 512; i2 += F.G * 2)
#pragma unroll 1
        for (int rep = 0; rep < 2; ++rep) dsa_unit(F, rep ? 511 - (i2 >> 1) : (i2 >> 1));
    __syncthreads();
}
__device__ __forceinline__ void dsa_sparse_phase(Frame& F) {
#pragma unroll 1
    for (int i2 = F.bid * 2; i2 < 512; i2 += F.G * 2)
#pragma unroll 1
        for (int rep = 0; rep < 2; ++rep) dsa_sparse_unit(F, rep ? 511 - (i2 >> 1) : (i2 >> 1));
}

__device__ __forceinline__ void phase_mixers_stub(Frame& F) {
    u32x4* y = (u32x4*)(F.ws + WS_Y); const size_t n = (size_t)1 * S * 256 * 2 / 16;
    for (size_t i = (size_t)F.bid * 512 + F.tid; i < n; i += (size_t)F.G * 512) y[i] = (u32x4){0u, 0u, 0u, 0u};
}

__device__ __forceinline__ Frame mkframe() {
    Frame F; int t = threadIdx.x; asm volatile("" : "+v"(t));
    extern __shared__ __attribute__((aligned(16))) unsigned char lds_raw[];
    F.lds = (LAS unsigned char*)lds_raw; F.ws = kargs()->ws; F.ctl = (unsigned*)(F.ws + WS_CTL);
    F.tid = t; F.lane = t & 63; F.wave = __builtin_amdgcn_readfirstlane(t >> 6); F.G = gridDim.x; F.bid = blockIdx.x;
    return F;
}
__device__ __forceinline__ void grid_barrier() {
    extern __shared__ __attribute__((aligned(16))) unsigned char lds_raw[];
    XcdBarrier b; b.bar = (unsigned*)(kargs()->ws + WS_CTL) + CW_BAR; b.x = xb_xcc_id(); b.st = (volatile LAS unsigned*)((LAS unsigned char*)lds_raw + MISC_OFF) + 8;
    xcd_barrier(b);
}
constexpr int NSEG = 14;
#ifndef SEGMASK
#define SEGMASK 0xffff
#endif
template <int l> __device__ __forceinline__ void layer_body() {
#if MK_MULTI
#define RUN(k) (((SEGMASK >> (k)) & 1) && (l * NSEG + (k)) >= kargs()->seg_lo && (l * NSEG + (k)) < kargs()->seg_hi)
#define SEAM(k) do { } while (0)
#else
#define RUN(k) ((SEGMASK >> (k)) & 1)
#define SEAM(k) grid_barrier()
#endif
    {
        if (RUN(0) && l == 0) {
            Frame F = mkframe();
            phase_convert(F, l);
            if (l == 0) { const int gw = F.bid * 8 + F.wave, NGW = F.G * 8; const float* x0 = kargs()->in[0]; const float* g0 = kargs()->in[1];
#pragma unroll 2
                for (int m = gw; m < S; m += NGW) rms_row_to_bf16(x0 + (size_t)m * D, g0, (bf16*)(F.ws + WS_H) + (size_t)m * D, F.lane); }
        }
        if (l == 0) SEAM(0);
        if (RUN(1)) {
            Frame F = mkframe();
            pg8::Gemm g{(const bf16*)(F.ws + WS_H), (const bf16*)(F.ws + WS_WIN), S, PW, 1024}; pg8::StaticOrder So; So.init(S, PW, F.G, F.bid);
            pg8::EpiStore E{(bf16*)(F.ws + WS_PU), PW, 0x7fffffff, F.ws + WS_KV8};
            pg8::gemm_phase<pg8::EpiStore, pg8::StaticOrder, true, true>(F.lds, g, So, E, F.tid);
        }
        SEAM(1);
        if (RUN(2)) { Frame F = mkframe(); ml_phase1(F, l); }
        if (RUN(2)) { Frame F = mkframe(); attn_phase<0>(F, l); }
        SEAM(2);
        if (RUN(3)) { Frame F = mkframe(); ml_phase3(F, l); }
        if (RUN(3)) { Frame F = mkframe(); attnD_phase(F, l); }
        SEAM(3);
        if (RUN(4)) { Frame F = mkframe(); ml_phase4(F); }
        if (RUN(4)) { Frame F = mkframe(); dsa_phase(F); }
        if (RUN(4)) { Frame F = mkframe(); dsa_sparse_phase(F); }
        SEAM(4);
        if (RUN(5)) { Frame F = mkframe(); ml_phase5(F, l); }
        SEAM(5);
        if (RUN(6)) {
            Frame F = mkframe();
            pg8::Gemm g{(const bf16*)(F.ws + WS_Y), (const bf16*)(F.ws + WS_WBR), 4 * S, 4096, 256}; pg8::SchedUp Su{F.G, F.bid};
            pg8::EpiStore E{(bf16*)(F.ws + WS_PU), 4096, 63, nullptr};
            pg8::gemm_phase<pg8::EpiStore, pg8::SchedUp, true, true>(F.lds, g, Su, E, F.tid);
        }
        SEAM(6);
        if (RUN(7)) {
            Frame F = mkframe();
            pg8::Gemm g{(const bf16*)(F.ws + WS_H), (const bf16*)(F.ws + WS_WGATE), S, 4096, 1024}; pg8::StaticOrder So; So.init(S, 4096, F.G, F.bid);
            pg8::EpiGateMix E{(const bf16*)(F.ws + WS_PU), (bf16*)(F.ws + WS_MIXED)};
            pg8::gemm_phase<pg8::EpiGateMix, pg8::StaticOrder, true, true>(F.lds, g, So, E, F.tid);
        }
        SEAM(7);
        if (RUN(8)) {
            Frame F = mkframe();
            pg8::Gemm g{(const bf16*)(F.ws + WS_MIXED), (const bf16*)(F.ws + WS_WOUT), S, 1024, 1024}; pg8::StaticOrder So; So.init(S, 1024, F.G, F.bid);
            float* xo = kargs()->out;
            pg8::EpiResid E{(l == 0) ? kargs()->in[0] : (const float*)xo, xo};
            pg8::gemm_phase<pg8::EpiResid, pg8::StaticOrder, true, true>(F.lds, g, So, E, F.tid);
        }
        SEAM(8);
        if (RUN(9)) { Frame F = mkframe(); phase_router(F, l, kargs()->out); }
        SEAM(9);
        if (RUN(10)) { Frame F = mkframe(); phase_scatter(F, l); }
        SEAM(10);
        if (RUN(11)) {
            Frame F = mkframe();
            moe_table(F, l); const LAS int* tab = (const LAS int*)(F.lds + LDSCTL_OFF);
            pg8::Gemm g{(const bf16*)(F.ws + WS_XS), (const bf16*)(F.ws + WS_W13), NRMAX, NE * 1024, 1024}; pg8::SchedMoe Sm{F.G, F.bid, __builtin_amdgcn_readfirstlane(tab[224]) * 4, tab};
            pg8::EpiSwiglu E{(bf16*)(F.ws + WS_ACT)};
            pg8::gemm_phase<pg8::EpiSwiglu, pg8::SchedMoe, true, true>(F.lds, g, Sm, E, F.tid);
        }
        SEAM(11);
        if (RUN(12)) {
            Frame F = mkframe();
            moe_table(F, l); const LAS int* tab = (const LAS int*)(F.lds + LDSCTL_OFF);
            pg8::Gemm g{(const bf16*)(F.ws + WS_ACT), (const bf16*)(F.ws + WS_W2), NRMAX, NE * 1024, FE}; pg8::SchedMoe Sm{F.G, F.bid, __builtin_amdgcn_readfirstlane(tab[224]) * 4, tab};
            pg8::EpiDown E{(bf16*)(F.ws + WS_YE), (const float*)(F.ws + WS_RT + 393216)};
            pg8::gemm_phase<pg8::EpiDown, pg8::SchedMoe, true, true>(F.lds, g, Sm, E, F.tid);
        }
        SEAM(12);
        if (RUN(13)) { Frame F = mkframe(); phase_combine(F, l, kargs()->out); }
        if (RUN(13) && l + 1 < NL) { Frame F = mkframe(); phase_convert(F, l + 1); }
        if (l + 1 < NL) SEAM(13);
    }
#undef RUN
#undef SEAM
}
__global__ void __launch_bounds__(512, 2) fwd_kernel(Args args) {
    extern __shared__ __attribute__((aligned(16))) unsigned char lds_raw[];
    {
        LAS unsigned char* lds = (LAS unsigned char*)lds_raw;
        for (int u = threadIdx.x; u < (LDS_BYTES - LDSCTL_OFF) / 4; u += 512) ((LAS unsigned*)(lds + LDSCTL_OFF))[u] = 0u;
        __syncthreads();
        if (!MK_MULTI) (void)xcd_barrier_post((unsigned*)(kargs()->ws + WS_CTL) + CW_BAR, (volatile LAS unsigned*)(lds + MISC_OFF) + 8);
    }
    layer_body<0>();
    layer_body<1>();
}

extern "C" void kernel_launch(void* const* d_in, const int* in_sizes, int n_in, void* d_out, int out_size, void* d_ws, size_t ws_size, hipStream_t stream) {
    static int grid = 0;
    if (grid == 0) {
        if (n_in != 23 || out_size != S * D || ws_size < WS_END) { fprintf(stderr, "kernel_launch: unexpected shapes (n_in %d out %d ws %zu need %zu)\n", n_in, out_size, ws_size, (size_t)WS_END); grid = -1; return; }
        int dev = 0, cus = 0, per_cu = 0;
        if (hipGetDevice(&dev) != hipSuccess || hipDeviceGetAttribute(&cus, hipDeviceAttributeMultiprocessorCount, dev) != hipSuccess) { grid = -1; return; }
        if (hipFuncSetAttribute((const void*)fwd_kernel, hipFuncAttributeMaxDynamicSharedMemorySize, LDS_BYTES) != hipSuccess) { fprintf(stderr, "kernel_launch: hipFuncSetAttribute failed\n"); grid = -1; return; }
        if (hipOccupancyMaxActiveBlocksPerMultiprocessor(&per_cu, (const void*)fwd_kernel, 512, LDS_BYTES) != hipSuccess || per_cu < 1) fprintf(stderr, "kernel_launch: occupancy query says %d\n", per_cu);
        (void)hipGetLastError();
        grid = cus;
    }
    if (grid < 0) return;
    if (hipMemsetAsync((char*)d_ws + WS_CTL, 0, CTL_ZERO_BYTES, stream) != hipSuccess) return;
    Args a{};
    for (int i = 0; i < 23; ++i) a.in[i] = (const float*)d_in[i];
    a.out = (float*)d_out; a.ws = (unsigned char*)d_ws;
#if MK_MULTI
    for (int s = 0; s < NL * NSEG; ++s) { a.seg_lo = s; a.seg_hi = s + 1; hipLaunchKernelGGL(fwd_kernel, dim3(grid), dim3(512), LDS_BYTES, stream, a); }
#else
    a.seg_lo = 0; a.seg_hi = NL * NSEG;
    hipLaunchKernelGGL(fwd_kernel, dim3(grid), dim3(512), LDS_BYTES, stream, a);
#endif
}
```

```cpp
#include <hip/hip_runtime.h>
#include <cstdio>
#include <cstdint>

#define GAS __attribute__((address_space(1)))
#define LAS __attribute__((address_space(3)))
typedef unsigned short bf16;
typedef short bf16x8 __attribute__((ext_vector_type(8)));
typedef short s16x4 __attribute__((ext_vector_type(4)));
typedef float f32x2 __attribute__((ext_vector_type(2)));
typedef float f32x4 __attribute__((ext_vector_type(4)));
typedef float f32x16 __attribute__((ext_vector_type(16)));
typedef unsigned u32x2 __attribute__((ext_vector_type(2)));
typedef unsigned u32x4 __attribute__((ext_vector_type(4)));

#ifndef MK_MULTI
#define MK_MULTI 0
#endif

constexpr int S = 16384, D = 1024, NL = 2, NCH = 256;
constexpr int PW = 3584;
constexpr int C_QA = 0, C_KA = 256, C_VA = 512, C_QI = 768, C_KI = 896, C_WI = 928, C_IB = 932, C_FB = 936, C_QB = 960, C_KB = 1216,
              C_VB = 1472, C_OB = 1728, C_QC = 1984, C_KC = 2240, C_VC = 2496, C_QD = 2752, C_KD = 3008, C_VD = 3264;
constexpr int CIN = 3500;
constexpr int NE = 32, FE = 512, NRMAX = 40960, NBMAX = 160;
constexpr float RMS_EPS = 1e-6f;

constexpr size_t MiB = 1u << 20;
constexpr size_t WS_CTL = 0, CTL_ZERO_BYTES = 1 * MiB;
constexpr size_t WS_WIN = 1 * MiB;
constexpr size_t WS_WBR = WS_WIN + 7 * MiB;
constexpr size_t WS_WGATE = WS_WBR + 2 * MiB;
constexpr size_t WS_WOUT = WS_WGATE + 8 * MiB;
constexpr size_t WS_W13 = WS_WOUT + 2 * MiB;
constexpr size_t WS_W2 = WS_W13 + 64 * MiB;
constexpr size_t WS_H = WS_W2 + 32 * MiB;
constexpr size_t WS_PU = WS_H + 32 * MiB;
constexpr size_t WS_XS = WS_PU;
constexpr size_t WS_ACT = WS_PU + 80 * MiB;
constexpr size_t WS_Y = WS_PU + 128 * MiB;
constexpr size_t WS_MIXED = WS_Y + 32 * MiB;
constexpr size_t WS_CAND = WS_MIXED + 32 * MiB;
constexpr size_t WS_YE = WS_Y;
constexpr size_t WS_MLC = WS_CAND + 128 * MiB;
constexpr size_t WS_MLN = WS_MLC + 16 * MiB;
constexpr size_t WS_MLS = WS_MLN + 256 * 1024;
constexpr size_t WS_RT = WS_MLS + 64 * 1024;
constexpr size_t WS_SEL = WS_RT + 1 * MiB;
constexpr size_t WS_NSEL = WS_SEL + 8 * MiB;
constexpr size_t WS_KV8 = WS_NSEL + 1 * MiB;
constexpr size_t WS_END = WS_KV8 + 8 * MiB;
static_assert(WS_YE + (size_t)NRMAX * 1024 * 2 <= WS_MLC, "ye overlay");
static_assert(WS_ACT + (size_t)NRMAX * 512 * 2 <= WS_Y, "act overlay");
constexpr int CW_BAR = 4096;
constexpr int CW_CNT = 16384;
constexpr int CW_FILL = 16384 + 64;

constexpr int RING_BYTES = 131072;
constexpr int LDS_BYTES = 163840;
constexpr int LDSCTL_OFF = LDS_BYTES - 2048;
constexpr int MISC_OFF = LDSCTL_OFF + 1024;

__device__ __forceinline__ unsigned f2bf(float f) { unsigned u = __builtin_bit_cast(unsigned, f); return (u + 0x7fffu + ((u >> 16) & 1u)) >> 16; }
__device__ __forceinline__ unsigned pk2(float lo, float hi) { return f2bf(lo) | (f2bf(hi) << 16); }
__device__ __forceinline__ float bflo(unsigned w) { return __builtin_bit_cast(float, w << 16); }
__device__ __forceinline__ float bfhi(unsigned w) { return __builtin_bit_cast(float, w & 0xffff0000u); }
__device__ __forceinline__ float bf2f(bf16 b) { return __builtin_bit_cast(float, (unsigned)b << 16); }
#define LDS_WAIT() asm volatile("s_waitcnt lgkmcnt(0)" ::: "memory")
#define VM_WAIT() asm volatile("s_waitcnt vmcnt(0)" ::: "memory")
__device__ __forceinline__ float wave_sum(float v) {
#pragma unroll
    for (int o = 1; o < 64; o <<= 1) v += __shfl_xor(v, o);
    return v;
}
__device__ __forceinline__ float wave_max(float v) {
#pragma unroll
    for (int o = 1; o < 64; o <<= 1) v = fmaxf(v, __shfl_xor(v, o));
    return v;
}

namespace pg8 {
#define PG8_LAS __attribute__((address_space(3)))
typedef unsigned short bf16_t;
constexpr int BM = 256, BK = 64, HALF = 128, HTB = HALF * BK * 2, STAGE_BYTES = 8 * HTB, NXCD = 8, WGM = 8;
__host__ __device__ __forceinline__ int lds_byte(int r, int c) { const int st = (r >> 4) * 2 + (c >> 5), rr = r & 15, cc = c & 31, ob = rr * 64 + cc * 2; return st * 1024 + (ob ^ (((ob >> 9) & 1) << 5)); }
__host__ __device__ __forceinline__ void stage_rc(int b, int& R, int& C) { const int st = b / 1024, sb = b % 1024, swz = sb ^ (((sb >> 9) & 1) << 5); R = (st >> 1) * 16 + swz / 64; C = (st & 1) * 32 + (swz % 64) / 2; }
__host__ __device__ __forceinline__ int perm32(int rho) { const int n = rho >> 4, i = rho & 15; return 8 * (i >> 2) + 4 * n + (i & 3); }
struct Unit { int pm, pn; };
struct Gemm { const bf16_t* A; const bf16_t* Bt; int M, N, K; };
struct StaticOrder {
    int nM, nN, nwg, G, c;
    __host__ __device__ void init(int M, int N, int G_, int c_) { nM = M / BM; nN = N / BM; nwg = nM * nN; G = G_; c = c_; }
    __host__ __device__ bool next(int i, Unit& u) const {
        const long L = (long)i * G + c; if (L >= nwg) return false;
        int wgid = (int)L; { const int q = nwg / NXCD, r = nwg % NXCD, xcd = wgid % NXCD, off = wgid / NXCD; wgid = (xcd < r ? xcd * (q + 1) : r * (q + 1) + (xcd - r) * q) + off; }
        const int nig = WGM * nN, gid = wgid / nig, fm = gid * WGM, gsz = (nM - fm) < WGM ? (nM - fm) : WGM;
        u.pm = fm + ((wgid % nig) % gsz); u.pn = (wgid % nig) / gsz; return true;
    }
    __device__ __forceinline__ void a_ready(const Unit&) const {}
    __device__ __forceinline__ void done(const Unit&) const {}
};
__device__ __forceinline__ unsigned cvt_pk_bf16(float lo, float hi) { unsigned r; asm volatile("v_cvt_pk_bf16_f32 %0, %1, %2" : "=v"(r) : "v"(lo), "v"(hi)); return r; }

template <class Epi, class Sched, bool ALIGN_EPI = false, bool SP2 = false>
__device__ __forceinline__ void gemm_phase(PG8_LAS unsigned char* lds, const Gemm g, const Sched& S, const Epi& E, const int tid) {
    const int wid = __builtin_amdgcn_readfirstlane(tid >> 6), lane = tid & 63, wr = wid >> 2, wc = wid & 3, fr = lane & 15, fq = lane >> 4;
    int Kl_ = g.K; asm volatile("" : "+s"(Kl_));
    const int K = Kl_, nt = K / BK;
    unsigned voffA[2], voffB[2];
#pragma unroll
    for (int i = 0; i < 2; ++i) { int R, C; stage_rc(tid * 16 + i * 8192, R, C); const int Rb = Epi::PERM ? ((R & ~31) + perm32(R & 31)) : R;
        voffA[i] = (unsigned)(R * K + C) * 2u; voffB[i] = (unsigned)(Rb * K + C) * 2u; }
    const size_t kstep = (size_t)(BK * 2);
    const size_t hstep = (size_t)HALF * K * 2;
    const size_t tstep = 2 * hstep;
    const unsigned ldsw = (unsigned)wid * 1024u;
    const int aoff = lds_byte(wr * 64 + fr, fq * 8), boff = lds_byte(wc * 32 + fr, fq * 8);
#define PG8_SA(b, h) (((b) * 2 + (h)) * HTB)
#define PG8_SB(b, h) ((4 + (b) * 2 + (h)) * HTB)
#define PG8_STAGE(bufoff, gbase, voff) do { _Pragma("unroll") for (int _i = 0; _i < 2; ++_i) \
        __builtin_amdgcn_global_load_lds((const unsigned*)((const char*)(gbase) + (voff)[_i]), (PG8_LAS unsigned*)(lds + (bufoff) + ldsw + _i * 8192), 16, 0, 0); } while (0)
#define PG8_LDA(dst, b, h) do { _Pragma("unroll") for (int m = 0; m < 4; ++m) _Pragma("unroll") for (int k = 0; k < 2; ++k) dst[m][k] = *(const PG8_LAS bf16x8*)(lds + PG8_SA(b, h) + aoff + m * 2048 + k * 1024); } while (0)
#define PG8_LDB(dst, b, h) do { _Pragma("unroll") for (int n = 0; n < 2; ++n) _Pragma("unroll") for (int k = 0; k < 2; ++k) dst[n][k] = *(const PG8_LAS bf16x8*)(lds + PG8_SB(b, h) + boff + n * 2048 + k * 1024); } while (0)
#define PG8_MMA(ai, bj, At, Bt) do { __builtin_amdgcn_s_setprio(1); _Pragma("unroll") for (int m = 0; m < 4; ++m) _Pragma("unroll") for (int n = 0; n < 2; ++n) _Pragma("unroll") for (int k = 0; k < 2; ++k) \
        acc[ai][bj][m][n] = __builtin_amdgcn_mfma_f32_16x16x32_bf16(Bt[n][k], At[m][k], acc[ai][bj][m][n], 0, 0, 0); __builtin_amdgcn_s_setprio(0); } while (0)
#define PG8_WAIT_V(n) asm volatile("s_waitcnt vmcnt(" #n ")" ::: "memory")
#define PG8_WAIT_L(n) asm volatile("s_waitcnt lgkmcnt(" #n ")" ::: "memory")
#define PG8_BAR __builtin_amdgcn_s_barrier()
#define PG8_SCHED __builtin_amdgcn_sched_barrier(0)
    Unit cur, nxt; int ui = 0;
    if (!S.next(0, cur)) return;
    f32x4 acc[2][2][4][2];
#pragma unroll
    for (int a = 0; a < 2; ++a)
#pragma unroll
        for (int b = 0; b < 2; ++b)
#pragma unroll
            for (int m = 0; m < 4; ++m)
#pragma unroll
                for (int n = 0; n < 2; ++n) acc[a][b][m][n] = (f32x4){0.f, 0.f, 0.f, 0.f};
    bf16x8 At[4][2], B0[2][2], B1[2][2];
    const char* cA = (const char*)g.A + (size_t)cur.pm * tstep; const char* cB = (const char*)g.Bt + (size_t)cur.pn * tstep;
    S.a_ready(cur);
    if constexpr (SP2) {
        PG8_STAGE(PG8_SB(0, 0), cB, voffB); PG8_STAGE(PG8_SB(0, 1), cB + hstep, voffB); PG8_STAGE(PG8_SA(0, 0), cA, voffA); PG8_STAGE(PG8_SA(0, 1), cA + hstep, voffA);
        if (wr == 1) PG8_BAR;
        PG8_WAIT_V(2); PG8_BAR;
        PG8_STAGE(PG8_SB(1, 0), cB + kstep, voffB); PG8_STAGE(PG8_SA(1, 0), cA + kstep, voffA); PG8_STAGE(PG8_SB(1, 1), cB + hstep + kstep, voffB);
        PG8_WAIT_V(6); PG8_BAR;
    } else {
        PG8_STAGE(PG8_SB(0, 0), cB, voffB); PG8_STAGE(PG8_SA(0, 0), cA, voffA); PG8_STAGE(PG8_SB(0, 1), cB + hstep, voffB); PG8_STAGE(PG8_SA(0, 1), cA + hstep, voffA);
        if (wr == 1) PG8_BAR;
        PG8_WAIT_V(4); PG8_BAR;
        PG8_STAGE(PG8_SB(1, 0), cB + kstep, voffB); PG8_STAGE(PG8_SA(1, 0), cA + kstep, voffA); PG8_STAGE(PG8_SB(1, 1), cB + hstep + kstep, voffB);
        PG8_WAIT_V(6); PG8_BAR;
    }
    asm volatile(".p2align 8" ::: "memory");
    for (;;) {
        const bool has_next = S.next(ui + 1, nxt);
        const char* nA = has_next ? (const char*)g.A + (size_t)nxt.pm * tstep : cA; const char* nB = has_next ? (const char*)g.Bt + (size_t)nxt.pn * tstep : cB;
        for (int t = 0; t < nt; t += 2) {
            const bool last = (t == nt - 2);
            const char* a1 = cA + (size_t)(t + 1) * kstep;
            const char* a2 = last ? nA : cA + (size_t)(t + 2) * kstep; const char* b2 = last ? nB : cB + (size_t)(t + 2) * kstep;
            const char* a3 = a2 + kstep; const char* b3 = b2 + kstep;
            if (last && has_next) S.a_ready(nxt);
            if constexpr (SP2) {
            PG8_LDB(B0, 0, 0); PG8_LDB(B1, 0, 1); PG8_SCHED; PG8_LDA(At, 0, 0); PG8_STAGE(PG8_SA(1, 1), a1 + hstep, voffA);
            PG8_WAIT_V(8); PG8_WAIT_L(0); PG8_BAR; PG8_MMA(0, 0, At, B0); PG8_MMA(0, 1, At, B1); PG8_BAR; PG8_SCHED;
            PG8_LDA(At, 0, 1); PG8_STAGE(PG8_SB(0, 0), b2, voffB); PG8_STAGE(PG8_SB(0, 1), b2 + hstep, voffB); PG8_STAGE(PG8_SA(0, 0), a2, voffA);
            PG8_WAIT_V(8); PG8_WAIT_L(0); PG8_BAR; PG8_MMA(1, 0, At, B0); PG8_MMA(1, 1, At, B1); PG8_BAR; PG8_SCHED;
            PG8_LDB(B0, 1, 0); PG8_LDB(B1, 1, 1); PG8_SCHED; PG8_LDA(At, 1, 0); PG8_STAGE(PG8_SA(0, 1), a2 + hstep, voffA);
            PG8_WAIT_V(8); PG8_WAIT_L(0); PG8_BAR; PG8_MMA(0, 0, At, B0); PG8_MMA(0, 1, At, B1); PG8_BAR; PG8_SCHED;
            PG8_LDA(At, 1, 1); PG8_STAGE(PG8_SB(1, 0), b3, voffB); PG8_STAGE(PG8_SB(1, 1), b3 + hstep, voffB); PG8_STAGE(PG8_SA(1, 0), a3, voffA);
            PG8_WAIT_V(8); PG8_WAIT_L(0); PG8_BAR; PG8_MMA(1, 0, At, B0); PG8_MMA(1, 1, At, B1); PG8_BAR; PG8_SCHED;
            } else {
            PG8_LDB(B0, 0, 0); PG8_SCHED; PG8_LDA(At, 0, 0); PG8_STAGE(PG8_SA(1, 1), a1 + hstep, voffA);
            PG8_WAIT_L(8); PG8_BAR; PG8_WAIT_L(0); PG8_MMA(0, 0, At, B0); PG8_BAR; PG8_SCHED;
            PG8_LDB(B1, 0, 1); PG8_STAGE(PG8_SB(0, 0), b2, voffB);
            PG8_BAR; PG8_WAIT_L(0); PG8_MMA(0, 1, At, B1); PG8_BAR;
            PG8_LDA(At, 0, 1); PG8_STAGE(PG8_SA(0, 0), a2, voffA);
            PG8_BAR; PG8_WAIT_L(0); PG8_MMA(1, 0, At, B0); PG8_BAR; PG8_SCHED;
            PG8_STAGE(PG8_SB(0, 1), b2 + hstep, voffB);
            PG8_WAIT_V(6); PG8_BAR; PG8_MMA(1, 1, At, B1); PG8_BAR;
            PG8_LDB(B0, 1, 0); PG8_SCHED; PG8_LDA(At, 1, 0); PG8_STAGE(PG8_SA(0, 1), a2 + hstep, voffA);
            PG8_WAIT_L(8); PG8_BAR; PG8_WAIT_L(0); PG8_MMA(0, 0, At, B0); PG8_BAR; PG8_SCHED;
            PG8_LDB(B1, 1, 1); PG8_STAGE(PG8_SB(1, 0), b3, voffB);
            PG8_BAR; PG8_WAIT_L(0); PG8_MMA(0, 1, At, B1); PG8_BAR;
            PG8_LDA(At, 1, 1); PG8_STAGE(PG8_SA(1, 0), a3, voffA);
            PG8_BAR; PG8_WAIT_L(0); PG8_MMA(1, 0, At, B0); PG8_BAR; PG8_SCHED;
            PG8_STAGE(PG8_SB(1, 1), b3 + hstep, voffB);
            PG8_WAIT_V(6); PG8_BAR; PG8_MMA(1, 1, At, B1); PG8_BAR;
            }
        }
        if constexpr (ALIGN_EPI) { if (wr == 0) PG8_BAR; }
        E(acc, cur, wr, wc, fr, fq); S.done(cur);
        if (!has_next) break;
#pragma unroll
        for (int a = 0; a < 2; ++a)
#pragma unroll
            for (int b = 0; b < 2; ++b)
#pragma unroll
                for (int m = 0; m < 4; ++m)
#pragma unroll
                    for (int n = 0; n < 2; ++n) acc[a][b][m][n] = (f32x4){0.f, 0.f, 0.f, 0.f};
        cur = nxt; cA = nA; cB = nB; ++ui;
        if constexpr (ALIGN_EPI) { if (wr == 1) PG8_BAR; }
    }
    PG8_WAIT_V(0);
    if constexpr (!ALIGN_EPI) { if (wr == 0) PG8_BAR; }
    PG8_BAR;
#undef PG8_SA
#undef PG8_SB
#undef PG8_STAGE
#undef PG8_LDA
#undef PG8_LDB
#undef PG8_MMA
#undef PG8_WAIT_V
#undef PG8_WAIT_L
#undef PG8_BAR
#undef PG8_SCHED
}

struct EpiStore {
    static constexpr bool PERM = true;
    bf16_t* O; int ldc; int rowmask; unsigned char* T8;
    __device__ __forceinline__ void operator()(const f32x4 (&acc)[2][2][4][2], const Unit& u, int wr, int wc, int fr, int fq) const {
        const int row0 = (u.pm & rowmask) * BM + wr * 64 + fr, col0 = u.pn * BM + wc * 32 + 8 * fq;
        const bool side = T8 != nullptr && (u.pn == 1 || u.pn == 2);
#pragma unroll
        for (int ai = 0; ai < 2; ++ai)
#pragma unroll
            for (int m = 0; m < 4; ++m) { int row = row0 + ai * HALF + m * 16; asm volatile("" : "+v"(row)); bf16_t* rowp = O + (size_t)row * ldc + col0;
#pragma unroll
                for (int bj = 0; bj < 2; ++bj) { const f32x4 v0 = acc[ai][bj][m][0], v1 = acc[ai][bj][m][1];
                    u32x4 w; w.x = cvt_pk_bf16(v0[0], v0[1]); w.y = cvt_pk_bf16(v0[2], v0[3]); w.z = cvt_pk_bf16(v1[0], v1[1]); w.w = cvt_pk_bf16(v1[2], v1[3]);
                    *(u32x4*)(rowp + bj * HALF) = w;
                    if (side) { int q0 = __builtin_amdgcn_cvt_pk_fp8_f32(v0[0], v0[1], 0, false); q0 = __builtin_amdgcn_cvt_pk_fp8_f32(v0[2], v0[3], q0, true);
                        int q1 = __builtin_amdgcn_cvt_pk_fp8_f32(v1[0], v1[1], 0, false); q1 = __builtin_amdgcn_cvt_pk_fp8_f32(v1[2], v1[3], q1, true);
                        *(u32x2*)(T8 + (size_t)row * 512 + (col0 + bj * HALF - 256)) = (u32x2){(unsigned)q0, (unsigned)q1}; } } }
    }
};
__device__ __forceinline__ float sigmoidf_(float x) { return 1.f / (1.f + __expf(-x)); }
struct EpiGateMix {
    static constexpr bool PERM = true;
    const bf16_t* U; bf16_t* MX;
    __device__ __forceinline__ void operator()(const f32x4 (&acc)[2][2][4][2], const Unit& u, int wr, int wc, int fr, int fq) const {
        const int row0 = u.pm * BM + wr * 64 + fr, dcol = u.pn * 64 + wc * 16 + fq * 4;
        u32x2 un[4];
        { int row = row0; asm volatile("" : "+v"(row)); const bf16_t* up = U + (size_t)row * 4096 + dcol;
#pragma unroll
          for (int b4 = 0; b4 < 4; ++b4) un[b4] = *(const u32x2*)(up + b4 * 1024); }
#pragma unroll
        for (int it = 0; it < 8; ++it) { const int ai = it >> 2, m = it & 3;
            u32x2 uc[4];
#pragma unroll
            for (int b4 = 0; b4 < 4; ++b4) uc[b4] = un[b4];
            if (it < 7) { int rown = row0 + ((it + 1) >> 2) * HALF + ((it + 1) & 3) * 16; asm volatile("" : "+v"(rown)); const bf16_t* up = U + (size_t)rown * 4096 + dcol;
#pragma unroll
                for (int b4 = 0; b4 < 4; ++b4) un[b4] = *(const u32x2*)(up + b4 * 1024); }
            int row = row0 + ai * HALF + m * 16; asm volatile("" : "+v"(row));
            float o0 = 0.f, o1 = 0.f, o2 = 0.f, o3 = 0.f;
#pragma unroll
            for (int bj = 0; bj < 2; ++bj)
#pragma unroll
                for (int n = 0; n < 2; ++n) { const u32x2 uu = uc[2 * bj + n]; const f32x4 a = acc[ai][bj][m][n];
                    o0 += sigmoidf_(a[0]) * bflo(uu.x); o1 += sigmoidf_(a[1]) * bfhi(uu.x); o2 += sigmoidf_(a[2]) * bflo(uu.y); o3 += sigmoidf_(a[3]) * bfhi(uu.y); }
            u32x2 w; w.x = cvt_pk_bf16(o0, o1); w.y = cvt_pk_bf16(o2, o3);
            *(u32x2*)(MX + (size_t)row * 1024 + dcol) = w; }
    }
};
struct EpiResid {
    static constexpr bool PERM = true;
    const float* xin; float* xout;
    __device__ __forceinline__ void operator()(const f32x4 (&acc)[2][2][4][2], const Unit& u, int wr, int wc, int fr, int fq) const {
        const int row0 = u.pm * BM + wr * 64 + fr, col0 = u.pn * BM + wc * 32 + 8 * fq;
        f32x4 xn[4];
        { int row = row0; asm volatile("" : "+v"(row)); const float* xp = xin + (size_t)row * 1024 + col0;
#pragma unroll
          for (int q4 = 0; q4 < 4; ++q4) xn[q4] = *(const f32x4*)(xp + (q4 >> 1) * HALF + 4 * (q4 & 1)); }
#pragma unroll
        for (int it = 0; it < 8; ++it) { const int ai = it >> 2, m = it & 3;
            f32x4 xc[4];
#pragma unroll
            for (int q4 = 0; q4 < 4; ++q4) xc[q4] = xn[q4];
            if (it < 7) { int rown = row0 + ((it + 1) >> 2) * HALF + ((it + 1) & 3) * 16; asm volatile("" : "+v"(rown)); const float* xp = xin + (size_t)rown * 1024 + col0;
#pragma unroll
                for (int q4 = 0; q4 < 4; ++q4) xn[q4] = *(const f32x4*)(xp + (q4 >> 1) * HALF + 4 * (q4 & 1)); }
            int row = row0 + ai * HALF + m * 16; asm volatile("" : "+v"(row)); const size_t ro = (size_t)row * 1024 + col0;
#pragma unroll
            for (int bj = 0; bj < 2; ++bj)
#pragma unroll
                for (int n = 0; n < 2; ++n) *(f32x4*)(xout + ro + bj * HALF + 4 * n) = xc[2 * bj + n] + acc[ai][bj][m][n]; }
    }
};
struct EpiSwiglu {
    static constexpr bool PERM = true;
    bf16_t* ACT;
    __device__ __forceinline__ void operator()(const f32x4 (&acc)[2][2][4][2], const Unit& u, int wr, int wc, int fr, int fq) const {
        const int row0 = u.pm * BM + wr * 64 + fr, col0 = (u.pn & 3) * 128 + wc * 32 + 8 * fq;
#pragma unroll
        for (int ai = 0; ai < 2; ++ai)
#pragma unroll
            for (int m = 0; m < 4; ++m) { int row = row0 + ai * HALF + m * 16; asm volatile("" : "+v"(row)); float v[8];
#pragma unroll
                for (int n = 0; n < 2; ++n)
#pragma unroll
                    for (int i = 0; i < 4; ++i) { const float a = acc[ai][0][m][n][i], b = acc[ai][1][m][n][i]; v[4 * n + i] = a * sigmoidf_(a) * b; }
                u32x4 w; w.x = cvt_pk_bf16(v[0], v[1]); w.y = cvt_pk_bf16(v[2], v[3]); w.z = cvt_pk_bf16(v[4], v[5]); w.w = cvt_pk_bf16(v[6], v[7]);
                *(u32x4*)(ACT + (size_t)row * 512 + col0) = w; }
    }
};
struct EpiDown {
    static constexpr bool PERM = true;
    bf16_t* YE; const float* roww;
    __device__ __forceinline__ void operator()(const f32x4 (&acc)[2][2][4][2], const Unit& u, int wr, int wc, int fr, int fq) const {
        const int row0 = u.pm * BM + wr * 64 + fr, col0 = (u.pn & 3) * BM + wc * 32 + 8 * fq;
        float sw[8];
#pragma unroll
        for (int it = 0; it < 8; ++it) sw[it] = roww[row0 + (it >> 2) * HALF + (it & 3) * 16];
#pragma unroll
        for (int ai = 0; ai < 2; ++ai)
#pragma unroll
            for (int m = 0; m < 4; ++m) { int row = row0 + ai * HALF + m * 16; asm volatile("" : "+v"(row)); const float s = sw[ai * 4 + m]; bf16_t* rowp = YE + (size_t)row * 1024 + col0;
#pragma unroll
                for (int bj = 0; bj < 2; ++bj) { const f32x4 v0 = acc[ai][bj][m][0] * s, v1 = acc[ai][bj][m][1] * s;
                    u32x4 w; w.x = cvt_pk_bf16(v0[0], v0[1]); w.y = cvt_pk_bf16(v0[2], v0[3]); w.z = cvt_pk_bf16(v1[0], v1[1]); w.w = cvt_pk_bf16(v1[2], v1[3]);
                    *(u32x4*)(rowp + bj * HALF) = w; } }
    }
};
struct SchedUp {
    int G, c;
    __device__ __forceinline__ bool next(int i, Unit& u) const { const int L = i * G + c; if (L >= 1024) return false; const int n = L >> 8, pm = (L >> 2) & 63, pn = L & 3; u.pm = n * 64 + pm; u.pn = n * 4 + pn; return true; }
    __device__ __forceinline__ void a_ready(const Unit&) const {}
    __device__ __forceinline__ void done(const Unit&) const {}
};
struct SchedMoe {
    int G, c, nunits; const PG8_LAS int* tab;
    __device__ __forceinline__ bool next(int i, Unit& u) const { const int L = i * G + c; if (L >= nunits) return false; const int b = L >> 2, t = L & 3; const int e = __builtin_amdgcn_readfirstlane(tab[b]); u.pm = b; u.pn = e * 4 + t; return true; }
    __device__ __forceinline__ void a_ready(const Unit&) const {}
    __device__ __forceinline__ void done(const Unit&) const {}
};
}

#define XB_TMO      128
#define XB_XCNT(j)  (256  + 64 * (j))
#define XB_XSUB(j)  (1280 + 64 * (j))
#define XB_XGEN(j)  (2304 + 64 * (j))
#define XB_TOP      3328
#define XB_TOPGEN   3392
#define XCD_BAR_WORDS 3456
#define XB_SPIN_CAP (1u << 18)
__device__ __forceinline__ unsigned xb_ld(unsigned* p)              { return __hip_atomic_load(p, __ATOMIC_RELAXED, __HIP_MEMORY_SCOPE_AGENT); }
__device__ __forceinline__ unsigned xb_add(unsigned* p, unsigned v) { return __hip_atomic_fetch_add(p, v, __ATOMIC_RELAXED, __HIP_MEMORY_SCOPE_AGENT); }
__device__ __forceinline__ unsigned xb_xcc_id() { return (unsigned)__builtin_amdgcn_s_getreg((3 << 11) | 20) & 0xFu; }
#define XB_SPIN(cond, bar) do { unsigned _sp = 0; while (cond) { __builtin_amdgcn_s_sleep(1); \
    if ((++_sp & 255u) == 0u) { if (xb_ld(&(bar)[XB_TMO])) break; if (_sp > XB_SPIN_CAP) { atomicAdd(&(bar)[XB_TMO], 1u); break; } } } } while (0)
struct XcdBarrier { unsigned* bar; unsigned x; volatile LAS unsigned* st; };
__device__ __forceinline__ XcdBarrier xcd_barrier_post(unsigned* bar, volatile LAS unsigned* st) {
    XcdBarrier b; b.bar = bar; b.x = xb_xcc_id(); b.st = st;
    if (threadIdx.x == 0) (void)xb_add(&bar[XB_XCNT(b.x)], 1u);
    return b;
}
__device__ __forceinline__ void xcd_barrier_complete(unsigned* bar, unsigned x, unsigned& nloc, unsigned& nx) {
    const unsigned G = gridDim.x * gridDim.y * gridDim.z;
    unsigned sum, cnt, mine, sp = 0u;
    for (;;) {
        sum = 0u; cnt = 0u; mine = 0u;
#pragma unroll
        for (unsigned j = 0; j < 16; ++j) { const unsigned c = xb_ld(&bar[XB_XCNT(j)]); sum += c; cnt += (c > 0u) ? 1u : 0u; mine = (j == x) ? c : mine; }
        if (sum == G) break;
        __builtin_amdgcn_s_sleep(1);
        if ((++sp & 255u) == 0u) { if (xb_ld(&bar[XB_TMO])) break; if (sp > XB_SPIN_CAP) { atomicAdd(&bar[XB_TMO], 1u); break; } }
    }
    nloc = mine > 0u ? mine : 1u; nx = cnt > 0u ? cnt : 1u;
}
__device__ __forceinline__ void xcd_barrier(const XcdBarrier& b) {
    asm volatile("s_waitcnt vmcnt(0)" ::: "memory");
    __syncthreads();
    if (threadIdx.x == 0) {
        unsigned* bar = b.bar;
        __builtin_amdgcn_s_waitcnt(0);
        unsigned nloc = b.st[0], nx = b.st[1];
        if (nloc == 0u) { xcd_barrier_complete(bar, b.x, nloc, nx); b.st[0] = nloc; b.st[1] = nx; }
        const unsigned old = xb_add(&bar[XB_XSUB(b.x)], 1u);
        const unsigned gen = old / nloc;
        if (old + 1u == (gen + 1u) * nloc) {
            __builtin_amdgcn_fence(__ATOMIC_RELEASE, "agent");
            asm volatile("s_waitcnt vmcnt(0)" ::: "memory");
            const unsigned og = xb_add(&bar[XB_TOP], 1u);
            const unsigned tg = og / nx;
            if (og + 1u == (tg + 1u) * nx) xb_add(&bar[XB_TOPGEN], 1u);
            else XB_SPIN(xb_ld(&bar[XB_TOPGEN]) == tg, bar);
            __builtin_amdgcn_fence(__ATOMIC_ACQUIRE, "agent");
            xb_add(&bar[XB_XGEN(b.x)], 1u);
            asm volatile("s_waitcnt vmcnt(0)" ::: "memory");
        } else {
            XB_SPIN(xb_ld(&bar[XB_XGEN(b.x)]) == gen, bar);
            __builtin_amdgcn_fence(__ATOMIC_ACQUIRE, "agent");
            asm volatile("s_waitcnt vmcnt(0)" ::: "memory");
        }
    }
    __syncthreads();
}

struct Args {
    const float* in[23]; float* out; unsigned char* ws; int seg_lo, seg_hi;
};
typedef const __attribute__((address_space(4))) Args* ArgsP;
__device__ __forceinline__ ArgsP kargs() { unsigned long long v = (unsigned long long)__builtin_amdgcn_kernarg_segment_ptr(); asm volatile("" : "+s"(v)); return (ArgsP)v; }
struct Frame {
    LAS unsigned char* lds; unsigned char* ws; unsigned* ctl;
    int tid, lane, wave, G, bid;
};

struct CvtItem { const float* wp; bf16* dst; int ldw, K; bool valid; };
__device__ __forceinline__ int src_col_win(int dc) {
    if (dc < 932) return dc;
    if (dc < 936) return 1700 + (dc - 932);
    if (dc < 940) return 1704 + (dc - 936);
    if (dc < 960) return -1;
    if (dc < 1728) return 932 + (dc - 960);
    if (dc < 1984) return 1708 + (dc - 1728);
    if (dc < 3520) return 1964 + (dc - 1984);
    return -1;
}
__device__ __forceinline__ CvtItem cvt_decode(int it, int l, int lane, unsigned char* ws) {
    ArgsP a = kargs();
    constexpr int I_WIN = 16 * 112, I_WBR = 4 * 4 * 32, I_WG = 16 * 128, I_WO = 16 * 32, I_W13 = 32 * 16 * 32;
    const int nl = lane & 31; int r = it;
    const float* W; bf16* WT; int ldw, K, k0, n0, scol;
    if (r < I_WIN) { const int kb = r / 112, nb = r % 112; W = a->in[2] + (size_t)l * 1024 * CIN; ldw = CIN; K = 1024; WT = (bf16*)(ws + WS_WIN); k0 = kb * 64; n0 = nb * 32; scol = src_col_win(n0 + nl); }
    else if ((r -= I_WIN) < I_WBR) { const int n = r / 128, q = r % 128, kb = q / 32, nb = q % 32; W = a->in[11] + (size_t)l * 4 * 256 * 1024 + (size_t)n * 256 * 1024; ldw = 1024; K = 256; WT = (bf16*)(ws + WS_WBR) + (size_t)n * 1024 * 256; k0 = kb * 64; n0 = nb * 32; scol = n0 + nl; }
    else if ((r -= I_WBR) < I_WG) { const int kb = r / 128, nb = r % 128; W = a->in[12] + (size_t)l * 1024 * 4096; ldw = 4096; K = 1024; WT = (bf16*)(ws + WS_WGATE); k0 = kb * 64; n0 = nb * 32;
        const int np = n0 + nl, pn = np >> 8, L = np & 255, bj = L >> 7, wc = (L >> 5) & 3, fq = (L >> 3) & 3, n = (L >> 2) & 1, i = L & 3; scol = (2 * bj + n) * 1024 + pn * 64 + wc * 16 + fq * 4 + i; }
    else if ((r -= I_WG) < I_WO) { const int kb = r / 32, nb = r % 32; W = a->in[13] + (size_t)l * 1024 * 1024; ldw = 1024; K = 1024; WT = (bf16*)(ws + WS_WOUT); k0 = kb * 64; n0 = nb * 32; scol = n0 + nl; }
    else if ((r -= I_WO) < I_W13) { const int e = r / 512, q = r % 512, kb = q / 32, nb = q % 32;
        const int t = (nb * 32) >> 8, L0 = (nb * 32) & 255; W = (L0 < 128 ? a->in[19] : a->in[20]) + (size_t)l * NE * 1024 * FE + (size_t)e * 1024 * FE; ldw = FE; K = 1024;
        WT = (bf16*)(ws + WS_W13) + (size_t)e * 1024 * 1024; k0 = kb * 64; n0 = nb * 32; scol = t * 128 + (L0 & 127) + nl; }
    else { r -= I_W13; const int e = r / 256, q = r % 256, kb = q / 32, nb = q % 32; W = a->in[21] + (size_t)l * NE * FE * 1024 + (size_t)e * FE * 1024; ldw = 1024; K = FE; WT = (bf16*)(ws + WS_W2) + (size_t)e * 1024 * FE; k0 = kb * 64; n0 = nb * 32; scol = n0 + nl; }
    CvtItem c; c.valid = scol >= 0; c.wp = W + (size_t)(k0 + (lane >> 5)) * ldw + (scol >= 0 ? scol : 0); c.dst = WT + (size_t)n0 * K + k0; c.ldw = ldw; c.K = K;
    return c;
}
__device__ __forceinline__ void phase_convert(Frame& F, int l) {
    LAS float* scr = (LAS float*)(F.lds + F.wave * 16384);
    const int gw = F.bid * 8 + F.wave, NGW = F.G * 8, lane = F.lane;
    constexpr int NIT = 16 * 112 + 4 * 4 * 32 + 16 * 128 + 16 * 32 + 32 * 16 * 32 + 32 * 8 * 32;
    int it = gw; if (it >= NIT) return;
    CvtItem cur = cvt_decode(it, l, lane, F.ws);
    float wv[32];
#pragma unroll
    for (int i = 0; i < 32; ++i) wv[i] = cur.wp[(size_t)(2 * i) * cur.ldw];
#pragma unroll 1
    for (;;) {
        const int itn = it + NGW; const bool more = itn < NIT;
        CvtItem nxt = cvt_decode(more ? itn : it, l, lane, F.ws);
        float wn[32];
#pragma unroll
        for (int i = 0; i < 32; ++i) wn[i] = nxt.wp[(size_t)(2 * i) * nxt.ldw];
        const int nl = lane & 31;
#pragma unroll
        for (int i = 0; i < 32; ++i) { const int kk = 2 * i + (lane >> 5); scr[kk * 33 + nl] = cur.valid ? wv[i] : 0.f; }
        LDS_WAIT(); asm volatile("" ::: "memory");
        const int c = lane & 7;
#pragma unroll
        for (int j = 0; j < 4; ++j) { const int n = (lane >> 3) + 8 * j; const LAS float* sp = scr + (8 * c) * 33 + n;
            u32x4 o; o.x = pk2(sp[0 * 33], sp[1 * 33]); o.y = pk2(sp[2 * 33], sp[3 * 33]); o.z = pk2(sp[4 * 33], sp[5 * 33]); o.w = pk2(sp[6 * 33], sp[7 * 33]);
            *(u32x4*)(cur.dst + (size_t)n * cur.K + 8 * c) = o; }
        LDS_WAIT(); asm volatile("" ::: "memory");
        if (!more) break;
        it = itn; cur = nxt;
#pragma unroll
        for (int i = 0; i < 32; ++i) wv[i] = wn[i];
    }
}
__device__ __forceinline__ void rms_row_to_bf16(const float* xrow, const float* g, bf16* orow, int lane) {
    const f32x4* xr = (const f32x4*)xrow + lane; const f32x4* gr = (const f32x4*)g + lane;
    f32x4 v[4]; float s = 0.f;
#pragma unroll
    for (int j = 0; j < 4; ++j) { v[j] = xr[64 * j]; s += (v[j].x * v[j].x + v[j].y * v[j].y) + (v[j].z * v[j].z + v[j].w * v[j].w); }
    const float rstd = rsqrtf(wave_sum(s) * (1.f / D) + RMS_EPS);
    unsigned long long* o8 = (unsigned long long*)orow + lane;
#pragma unroll
    for (int j = 0; j < 4; ++j) { const f32x4 gg = gr[64 * j]; o8[64 * j] = (unsigned long long)pk2(v[j].x * rstd * gg.x, v[j].y * rstd * gg.y) | ((unsigned long long)pk2(v[j].z * rstd * gg.z, v[j].w * rstd * gg.w) << 32); }
}

#ifndef MFMA_F32
#define MFMA_F32(av, bv, cv) __builtin_amdgcn_mfma_f32_16x16x4f32((av), (bv), (cv), 0, 0, 0)
#endif
__device__ __forceinline__ void phase_router(Frame& F, int l, const float* xcur) {
    ArgsP a = kargs();
    LAS float* xs = (LAS float*)F.lds;
    LAS float* wsm = xs + 64 * 65;
    LAS float* lg = wsm + 64 * 48;
    LAS float* rs = lg + 64 * 37;
    const float* g = a->in[14] + (size_t)l * D;
    const float* rgw = a->in[15] + (size_t)l * D * 4; const float* rgb = a->in[16] + (size_t)l * 4;
    const float* rew = a->in[17] + (size_t)l * D * 32; const float* reb = a->in[18] + (size_t)l * 32;
    bf16* h2 = (bf16*)(F.ws + WS_H);
    int* tok_e = (int*)(F.ws + WS_RT); float* tok_w = (float*)(F.ws + WS_RT + 131072);
    unsigned* cnt = F.ctl + CW_CNT + l * 32;
    const int r = F.tid & 63;
    const int li = F.lane & 15, kq = F.lane >> 4, rb = F.wave & 3, cset = F.wave >> 2;
    for (int blk = F.bid; blk < S / 64; blk += F.G) {
        const int row0 = blk * 64;
        f32x4 acc0 = {0.f, 0.f, 0.f, 0.f}, acc1 = {0.f, 0.f, 0.f, 0.f}; float ss = 0.f;
        const int rr = F.tid >> 3, kk = (F.tid & 7) * 8, wk = F.tid >> 3, c0 = (F.tid & 7) * 6;
        f32x4 x0, x1, g0, g1; float wv[6];
#define RT_LOAD(kc_) do { const float* xp = xcur + (size_t)(row0 + rr) * D + (kc_) * 64 + kk; const float* gp = g + (kc_) * 64 + kk; \
            x0 = *(const f32x4*)xp; x1 = *(const f32x4*)(xp + 4); g0 = *(const f32x4*)gp; g1 = *(const f32x4*)(gp + 4); const size_t kg = (size_t)((kc_) * 64 + wk); \
            _Pragma("unroll") for (int i = 0; i < 6; ++i) { const int c = c0 + i; wv[i] = c < 4 ? rgw[kg * 4 + c] : (c < 36 ? rew[kg * 32 + (c - 4)] : 0.f); } } while (0)
        RT_LOAD(0);
        for (int kc = 0; kc < 16; ++kc) {
            __syncthreads();
            { LAS float* d = xs + rr * 65 + kk; d[0] = x0.x * g0.x; d[1] = x0.y * g0.y; d[2] = x0.z * g0.z; d[3] = x0.w * g0.w; d[4] = x1.x * g1.x; d[5] = x1.y * g1.y; d[6] = x1.z * g1.z; d[7] = x1.w * g1.w;
              ss += (x0.x * x0.x + x0.y * x0.y) + (x0.z * x0.z + x0.w * x0.w) + (x1.x * x1.x + x1.y * x1.y) + (x1.z * x1.z + x1.w * x1.w);
#pragma unroll
              for (int i = 0; i < 6; ++i) wsm[wk * 48 + c0 + i] = wv[i]; }
            if (kc + 1 < 16) RT_LOAD(kc + 1);
            __syncthreads();
            if (cset == 0) {
#pragma unroll 4
                for (int k0 = 0; k0 < 64; k0 += 4) { const float av = xs[(rb * 16 + li) * 65 + k0 + kq];
                    acc0 = MFMA_F32(av, wsm[(k0 + kq) * 48 + li], acc0); acc1 = MFMA_F32(av, wsm[(k0 + kq) * 48 + 16 + li], acc1); }
            } else {
#pragma unroll 4
                for (int k0 = 0; k0 < 64; k0 += 4) { const float av = xs[(rb * 16 + li) * 65 + k0 + kq]; acc0 = MFMA_F32(av, wsm[(k0 + kq) * 48 + 32 + li], acc0); }
            }
        }
#undef RT_LOAD
        ss += __shfl_xor(ss, 1); ss += __shfl_xor(ss, 2); ss += __shfl_xor(ss, 4);
        __syncthreads();
        if ((F.tid & 7) == 0) rs[F.tid >> 3] = rsqrtf(ss * (1.f / D) + RMS_EPS);
        __syncthreads();
#pragma unroll
        for (int i = 0; i < 4; ++i) { const int rw = rb * 16 + kq * 4 + i; const float rstd = rs[rw];
            if (cset == 0) { lg[rw * 37 + li] = acc0[i] * rstd; lg[rw * 37 + 16 + li] = acc1[i] * rstd; } else if (li < 4) lg[rw * 37 + 32 + li] = acc0[i] * rstd; }
        __syncthreads();
        if (F.tid < 64) {
            const LAS float* L = lg + F.tid * 37; const int tok = row0 + F.tid;
            float gl[4]; int gs = 0; float gm = -3.0e38f;
#pragma unroll
            for (int i = 0; i < 4; ++i) { gl[i] = L[i] + rgb[i]; if (gl[i] > gm) { gm = gl[i]; gs = i; } }
            float gsum = 0.f;
#pragma unroll
            for (int i = 0; i < 4; ++i) gsum += __expf(gl[i] - gm);
            const float ggate = 1.f / gsum;
            float v0 = -3.0e38f, v1 = -3.0e38f; int i0 = 0, i1 = 0;
            for (int i = 0; i < 8; ++i) { const float v = L[4 + gs * 8 + i] + reb[gs * 8 + i]; if (v > v0) { v1 = v0; i1 = i0; v0 = v; i0 = i; } else if (v > v1) { v1 = v; i1 = i; } }
            const float e1 = __expf(v1 - v0), den = 1.f / (1.f + e1);
            const int ea = gs * 8 + i0, eb = gs * 8 + i1;
            tok_e[tok * 2] = ea; tok_e[tok * 2 + 1] = eb; tok_w[tok * 2] = den * ggate; tok_w[tok * 2 + 1] = e1 * den * ggate;
            atomicAdd(&cnt[ea], 1u); atomicAdd(&cnt[eb], 1u);
        }
#pragma unroll 1
        for (int i4 = 0; i4 < 8; i4 += 4) { f32x4 xv[4][4];
#pragma unroll
            for (int i = 0; i < 4; ++i) { const f32x4* xr = (const f32x4*)(xcur + (size_t)(row0 + F.wave * 8 + i4 + i) * D) + F.lane;
#pragma unroll
                for (int j = 0; j < 4; ++j) xv[i][j] = xr[64 * j]; }
#pragma unroll
            for (int i = 0; i < 4; ++i) { const int r2 = F.wave * 8 + i4 + i; const float rstd = rs[r2]; const f32x4* gr = (const f32x4*)g + F.lane; unsigned long long* o8 = (unsigned long long*)(h2 + (size_t)(row0 + r2) * D) + F.lane;
#pragma unroll
                for (int j = 0; j < 4; ++j) { const f32x4 v = xv[i][j], gg = gr[64 * j]; o8[64 * j] = (unsigned long long)pk2(v.x * rstd * gg.x, v.y * rstd * gg.y) | ((unsigned long long)pk2(v.z * rstd * gg.z, v.w * rstd * gg.w) << 32); } } }
    }
    __syncthreads();
}
__device__ __forceinline__ void moe_table(Frame& F, int l) {
    LAS int* tab = (LAS int*)(F.lds + LDSCTL_OFF);
    if (F.tid < 64) {
        const int e = F.lane & 31; const int c = (int)__hip_atomic_load(F.ctl + CW_CNT + l * 32 + e, __ATOMIC_RELAXED, __HIP_MEMORY_SCOPE_AGENT);
        const int nb = F.lane < 32 ? (c + 255) >> 8 : 0; int incl = nb;
#pragma unroll
        for (int o = 1; o < 32; o <<= 1) { const int t = __shfl_up(incl, o); if (F.lane >= o) incl += t; }
        const int bo = incl - nb;
        if (F.lane < 32) { tab[192 + e] = bo * 256;
#pragma unroll 1
            for (int b2 = 0; b2 < nb; ++b2) tab[bo + b2] = e; }
        if (F.lane == 31) tab[224] = incl; }
    __syncthreads();
}
__device__ __forceinline__ void phase_scatter(Frame& F, int l) {
    moe_table(F, l);
    LAS int* tab = (LAS int*)(F.lds + LDSCTL_OFF);
    const bf16* h2 = (const bf16*)(F.ws + WS_H); bf16* xs = (bf16*)(F.ws + WS_XS);
    const int* tok_e = (const int*)(F.ws + WS_RT); const float* tok_w = (const float*)(F.ws + WS_RT + 131072);
    int* slot_row = (int*)(F.ws + WS_RT + 262144); float* row_w = (float*)(F.ws + WS_RT + 393216);
    unsigned* fill = F.ctl + CW_FILL + l * 32;
    const int gw = F.bid * 8 + F.wave, NGW = F.G * 8;
    for (int b0 = gw * 16; b0 < S * 2; b0 += NGW * 16) {
        int row = 0;
        if (F.lane < 16) { const int sl = b0 + F.lane; const int e = tok_e[sl]; const unsigned p = atomicAdd(&fill[e], 1u); row = tab[192 + e] + (int)p; slot_row[sl] = row; row_w[row] = tok_w[sl]; }
#pragma unroll 4
        for (int k = 0; k < 16; ++k) { const int rk = __builtin_amdgcn_readlane(row, k); const int sl = b0 + k;
            const u32x4* src = (const u32x4*)(h2 + (size_t)(sl >> 1) * D) + F.lane; u32x4* dst = (u32x4*)(xs + (size_t)rk * D) + F.lane;
            dst[0] = src[0]; dst[64] = src[64]; }
    }
}
__device__ __forceinline__ void phase_combine(Frame& F, int l, float* xcur) {
    ArgsP a = kargs();
    const bf16* ye = (const bf16*)(F.ws + WS_YE); const int* slot_row = (const int*)(F.ws + WS_RT + 262144);
    const bool last = (l == NL - 1);
    const float* g = last ? a->in[22] : a->in[1] + (size_t)(l + 1) * D;
    bf16* h = (bf16*)(F.ws + WS_H);
    const int gw = F.bid * 8 + F.wave, NGW = F.G * 8;
    int srl = 0; { const int k = F.lane >> 1, m = gw + k * NGW; if (F.lane < 16 && m < S) srl = slot_row[2 * m + (F.lane & 1)]; }
    const f32x4* gr = (const f32x4*)g + F.lane; f32x4 gg[4];
#pragma unroll
    for (int j = 0; j < 4; ++j) gg[j] = gr[64 * j];
    f32x4 xn[4]; u32x2 p0n[4], p1n[4];
#define CMB_LOAD(mm, kk) do { const int r0_ = __shfl(srl, 2 * (kk)), r1_ = __shfl(srl, 2 * (kk) + 1); const f32x4* xr_ = (const f32x4*)(xcur + (size_t)(mm) * D) + F.lane; \
        const u32x2* y0_ = (const u32x2*)(ye + (size_t)r0_ * D) + F.lane; const u32x2* y1_ = (const u32x2*)(ye + (size_t)r1_ * D) + F.lane; \
        _Pragma("unroll") for (int j = 0; j < 4; ++j) { xn[j] = xr_[64 * j]; p0n[j] = y0_[64 * j]; p1n[j] = y1_[64 * j]; } } while (0)
    if (gw < S) CMB_LOAD(gw, 0);
    int kk_ = 0;
    for (int m = gw; m < S; m += NGW, ++kk_) {
        f32x4 v[4]; float s = 0.f;
#pragma unroll
        for (int j = 0; j < 4; ++j) { const u32x2 p0 = p0n[j], p1 = p1n[j]; f32x4 x = xn[j];
            x.x = (x.x + bflo(p0.x)) + bflo(p1.x); x.y = (x.y + bfhi(p0.x)) + bfhi(p1.x); x.z = (x.z + bflo(p0.y)) + bflo(p1.y); x.w = (x.w + bfhi(p0.y)) + bfhi(p1.y);
            v[j] = x; s += (x.x * x.x + x.y * x.y) + (x.z * x.z + x.w * x.w); }
        if (m + NGW < S) CMB_LOAD(m + NGW, kk_ + 1);
        const float rstd = rsqrtf(wave_sum(s) * (1.f / D) + RMS_EPS);
        f32x4* xr = (f32x4*)(xcur + (size_t)m * D) + F.lane;
        if (last) {
#pragma unroll
            for (int j = 0; j < 4; ++j) xr[64 * j] = (f32x4){v[j].x * rstd * gg[j].x, v[j].y * rstd * gg[j].y, v[j].z * rstd * gg[j].z, v[j].w * rstd * gg[j].w};
        } else {
            unsigned long long* o8 = (unsigned long long*)(h + (size_t)m * D) + F.lane;
#pragma unroll
            for (int j = 0; j < 4; ++j) { xr[64 * j] = v[j];
                o8[64 * j] = (unsigned long long)pk2(v[j].x * rstd * gg[j].x, v[j].y * rstd * gg[j].y) | ((unsigned long long)pk2(v[j].z * rstd * gg[j].z, v[j].w * rstd * gg[j].w) << 32); }
        }
    }
#undef CMB_LOAD
}


typedef short v4i16_t __attribute__((ext_vector_type(4)));
__device__ __forceinline__ s16x4 ds_tr16(const LAS unsigned char* p) { return __builtin_bit_cast(s16x4, __builtin_amdgcn_ds_read_tr16_b64_v4i16((LAS v4i16_t*)p)); }
template <int MODE>
__device__ __forceinline__ void attn_phase(Frame& F, int l) {
    ArgsP a = kargs();
    constexpr int NS = MODE ? 2 : 1;
    const bf16* P = (const bf16*)(F.ws + WS_PU);
    bf16* Y = (bf16*)(F.ws + WS_Y) + (size_t)(MODE ? 3 : 2) * S * 256;
    const int colQ = MODE ? C_QD : C_QC, colK = MODE ? C_KD : C_KC, colV = MODE ? C_VD : C_VC;
    const float sc2 = (MODE ? 0.17677669529663687f : 0.125f) * 1.4426950408889634f;
    LAS unsigned char* Kb = F.lds; LAS unsigned char* Vb = F.lds + 16384; LAS float* btab = (LAS float*)(F.lds + 32768);
    const int lane = F.lane, w = F.wave, r = lane & 31, hh = lane >> 5;
    for (int u = F.bid; u < 256; u += F.G) {
        const int head = u & 3, ug = u >> 2;
        int qrow, cw, lo_w, T0, T1;
        if (MODE) { qrow = ug * 256 + w * 32; cw = ug * 4 + (w >> 1); lo_w = 0; T0 = 0; T1 = ug * 4 + 3; }
        else { cw = ug * 4 + (w >> 1); qrow = cw * 64 + (w & 1) * 32; lo_w = cw - 8 < 0 ? 0 : cw - 8; T0 = ug * 4 - 8 < 0 ? 0 : ug * 4 - 8; T1 = ug * 4 + 3; }
        if (!MODE) { __syncthreads(); if (F.tid < 192) btab[F.tid] = a->in[8][(size_t)(l * 4 + head) * 192 + F.tid] * 1.4426950408889634f; }
        bf16x8 Qf[4];
#pragma unroll
        for (int kk = 0; kk < 4; ++kk) Qf[kk] = *(const bf16x8*)(P + (size_t)(qrow + r) * PW + colQ + head * 64 + kk * 16 + 8 * hh);
        f32x16 O[NS][2]; float m[NS], lsum[NS];
#pragma unroll
        for (int s = 0; s < NS; ++s) { m[s] = -1e30f; lsum[s] = 0.f;
#pragma unroll
            for (int d = 0; d < 2; ++d)
#pragma unroll
                for (int i = 0; i < 16; ++i) O[s][d][i] = 0.f; }
        const int srow = F.tid >> 3, sch = F.tid & 7;
        const bf16* gK = P + (size_t)srow * PW + colK + head * 64 + sch * 8; const bf16* gV = P + (size_t)srow * PW + colV + head * 64 + sch * 8;
        const int kwoff = srow * 128 + ((sch ^ (srow & 7)) << 4), vwoff = srow * 128 + sch * 16;
        u32x4 kreg = *(const u32x4*)(gK + (size_t)T0 * 64 * PW), vreg = *(const u32x4*)(gV + (size_t)T0 * 64 * PW);
        __syncthreads();
        *(LAS u32x4*)(Kb + kwoff) = kreg; *(LAS u32x4*)(Vb + vwoff) = vreg;
        __syncthreads();
        for (int j = T0; j <= T1; ++j) {
            const int buf = (j - T0) & 1;
            if (j < T1) { kreg = *(const u32x4*)(gK + (size_t)(j + 1) * 64 * PW); vreg = *(const u32x4*)(gV + (size_t)(j + 1) * 64 * PW); }
            if (j >= lo_w && j <= cw) {
                const LAS unsigned char* Kt = Kb + buf * 8192; const LAS unsigned char* Vt = Vb + buf * 8192;
                bf16x8 pf[NS][4];
#pragma unroll
                for (int s = 0; s < NS; ++s) {
                    f32x16 Sq[2];
#pragma unroll
                    for (int kb = 0; kb < 2; ++kb) {
#pragma unroll
                        for (int i = 0; i < 16; ++i) Sq[kb][i] = 0.f;
#pragma unroll
                        for (int k2 = 0; k2 < (MODE ? 2 : 4); ++k2) { const int kk = MODE ? 2 * s + k2 : k2; const int row = kb * 32 + r;
                            const bf16x8 kf = *(const LAS bf16x8*)(Kt + row * 128 + (((kk * 2 + hh) ^ (row & 7)) << 4));
                            Sq[kb] = __builtin_amdgcn_mfma_f32_32x32x16_bf16(kf, Qf[kk], Sq[kb], 0, 0, 0); }
                    }
                    float mx = -1e30f;
                    if (!MODE) {
                        const int dj = cw - j;
                        if (dj >= 3) { const float bc = btab[191];
#pragma unroll
                            for (int kb = 0; kb < 2; ++kb)
#pragma unroll
                                for (int i = 0; i < 16; ++i) { const float t = Sq[kb][i] * sc2 + bc; Sq[kb][i] = t; mx = fmaxf(mx, t); } }
                        else { const int base = dj * 64 + (w & 1) * 32 + r - 4 * hh + 63;
#pragma unroll
                            for (int kb = 0; kb < 2; ++kb)
#pragma unroll
                                for (int i = 0; i < 16; ++i) { int rid = base - (kb * 32 + (i & 3) + 8 * (i >> 2)); rid = rid < 0 ? 0 : (rid > 191 ? 191 : rid);
                                    const float t = Sq[kb][i] * sc2 + btab[rid]; Sq[kb][i] = t; mx = fmaxf(mx, t); } }
                    } else {
#pragma unroll
                        for (int kb = 0; kb < 2; ++kb)
#pragma unroll
                            for (int i = 0; i < 16; ++i) { const float t = Sq[kb][i] * sc2; Sq[kb][i] = t; mx = fmaxf(mx, t); }
                    }
                    mx = fmaxf(mx, __shfl_xor(mx, 32));
                    const float mn = fmaxf(m[s], mx), alpha = __builtin_amdgcn_exp2f(m[s] - mn); m[s] = mn;
                    float rs = 0.f;
#pragma unroll
                    for (int kb = 0; kb < 2; ++kb)
#pragma unroll
                        for (int i = 0; i < 16; ++i) { const float p = __builtin_amdgcn_exp2f(Sq[kb][i] - mn); Sq[kb][i] = p; rs += p; }
                    lsum[s] = lsum[s] * alpha + rs;
#pragma unroll
                    for (int d = 0; d < 2; ++d)
#pragma unroll
                        for (int i = 0; i < 16; ++i) O[s][d][i] *= alpha;
#pragma unroll
                    for (int kb = 0; kb < 2; ++kb)
#pragma unroll
                        for (int ss = 0; ss < 2; ++ss) { u32x4 pw;
                            pw.x = pg8::cvt_pk_bf16(Sq[kb][8 * ss + 0], Sq[kb][8 * ss + 1]); pw.y = pg8::cvt_pk_bf16(Sq[kb][8 * ss + 2], Sq[kb][8 * ss + 3]);
                            pw.z = pg8::cvt_pk_bf16(Sq[kb][8 * ss + 4], Sq[kb][8 * ss + 5]); pw.w = pg8::cvt_pk_bf16(Sq[kb][8 * ss + 6], Sq[kb][8 * ss + 7]);
                            pf[s][kb * 2 + ss] = __builtin_bit_cast(bf16x8, pw); }
                    __builtin_amdgcn_sched_barrier(0);
                }
                const int li = lane & 15, lg = lane >> 4;
                const LAS unsigned char* vbase = Vt + (4 * (lg >> 1) + (li >> 2)) * 128 + (16 * (lg & 1) + 4 * (li & 3)) * 2;
#pragma unroll
                for (int d = 0; d < 2; ++d)
#pragma unroll
                    for (int st = 0; st < 4; ++st) {
                        const s16x4 v0 = ds_tr16(vbase + (st * 16) * 128 + d * 64), v1 = ds_tr16(vbase + (st * 16 + 8) * 128 + d * 64);
                        const bf16x8 vf = (bf16x8){v0[0], v0[1], v0[2], v0[3], v1[0], v1[1], v1[2], v1[3]};
#pragma unroll
                        for (int s = 0; s < NS; ++s) O[s][d] = __builtin_amdgcn_mfma_f32_32x32x16_bf16(vf, pf[s][st], O[s][d], 0, 0, 0);
                        if (st & 1) __builtin_amdgcn_sched_barrier(0);
                    }
            }
            if (j < T1) { *(LAS u32x4*)(Kb + (buf ^ 1) * 8192 + kwoff) = kreg; *(LAS u32x4*)(Vb + (buf ^ 1) * 8192 + vwoff) = vreg; }
            __syncthreads();
        }
        float inv[NS];
#pragma unroll
        for (int s = 0; s < NS; ++s) { const float lt = lsum[s] + __shfl_xor(lsum[s], 32); inv[s] = 1.f / lt; }
        bf16* yrow = Y + (size_t)(qrow + r) * 256 + head * 64 + 4 * hh;
        if (MODE) {
            const float* lp = a->in[9] + (size_t)l * 128 + (lane & 31); float s1 = (lane < 32) ? lp[0] * lp[32] : 0.f, s2 = (lane < 32) ? lp[64] * lp[96] : 0.f;
            s1 = wave_sum(s1); s2 = wave_sum(s2);
            const float lam_init = 0.8f - 0.6f * __expf(-0.3f * (float)l), lam = __expf(s1) - __expf(s2) + lam_init;
            const float* gn = a->in[10] + (size_t)l * 256 + head * 64 + 4 * hh;
            float ss = 0.f;
#pragma unroll
            for (int d = 0; d < 2; ++d)
#pragma unroll
                for (int i = 0; i < 16; ++i) { const float o = O[0][d][i] * inv[0] - lam * (O[NS - 1][d][i] * inv[NS - 1]); O[0][d][i] = o; ss += o * o; }
            ss += __shfl_xor(ss, 32);
            const float rstd = rsqrtf(ss * (1.f / 64.f) + RMS_EPS) * (1.f - lam_init);
#pragma unroll
            for (int d = 0; d < 2; ++d)
#pragma unroll
                for (int g = 0; g < 4; ++g) { const f32x4 gg = *(const f32x4*)(gn + d * 32 + 8 * g); u32x2 o2;
                    o2.x = pk2(O[0][d][4 * g + 0] * rstd * gg.x, O[0][d][4 * g + 1] * rstd * gg.y); o2.y = pk2(O[0][d][4 * g + 2] * rstd * gg.z, O[0][d][4 * g + 3] * rstd * gg.w);
                    *(u32x2*)(yrow + d * 32 + 8 * g) = o2; }
        } else {
#pragma unroll
            for (int d = 0; d < 2; ++d)
#pragma unroll
                for (int g = 0; g < 4; ++g) { u32x2 o2;
                    o2.x = pk2(O[0][d][4 * g + 0] * inv[0], O[0][d][4 * g + 1] * inv[0]); o2.y = pk2(O[0][d][4 * g + 2] * inv[0], O[0][d][4 * g + 3] * inv[0]);
                    *(u32x2*)(yrow + d * 32 + 8 * g) = o2; }
        }
    }
    __syncthreads();
}


__device__ __forceinline__ float vmax3_(float a, float b, float c) { float r; asm("v_max3_f32 %0, %1, %2, %3" : "=v"(r) : "v"(a), "v"(b), "v"(c)); return r; }
__device__ __forceinline__ void attnD_phase(Frame& F, int l) {
    const bf16* P = (const bf16*)(F.ws + WS_PU);
    bf16* Y = (bf16*)(F.ws + WS_Y) + (size_t)3 * S * 256;
    const float sc2 = 0.17677669529663687f * 1.4426950408889634f;
    const int lane = F.lane, w = F.wave, r = lane & 31, hh = lane >> 5, rw = w & 3, ksel = w >> 2;
    const int srow = F.tid >> 3, sch = F.tid & 7;
#pragma unroll 1
    for (int pr = F.bid; pr < 256; pr += F.G) {
        const int head = pr & 3, bp = pr >> 2;
#pragma unroll 1
        for (int rep = 0; rep < 2; ++rep) {
            const int b = rep ? 127 - bp : bp;
            const int qrow = b * 128 + rw * 32, cw = 2 * b + (rw >> 1);
            LAS unsigned char* qlds = F.lds + 98304 + w * 4096 + lane * 16;
            u32x4 qs4[4];
#pragma unroll
            for (int kk = 0; kk < 4; ++kk) { const u32x4 qw = *(const u32x4*)(P + (size_t)(qrow + r) * PW + C_QD + head * 64 + kk * 16 + 8 * hh);
                qs4[kk].x = pk2(bflo(qw.x) * sc2, bfhi(qw.x) * sc2); qs4[kk].y = pk2(bflo(qw.y) * sc2, bfhi(qw.y) * sc2); qs4[kk].z = pk2(bflo(qw.z) * sc2, bfhi(qw.z) * sc2); qs4[kk].w = pk2(bflo(qw.w) * sc2, bfhi(qw.w) * sc2); }
            f32x16 O[2][2], negM[2]; float m[2], lsum[2]; bool seen = false;
#pragma unroll
            for (int s2 = 0; s2 < 2; ++s2) { m[s2] = 0.f; lsum[s2] = 0.f;
#pragma unroll
                for (int i = 0; i < 16; ++i) negM[s2][i] = 0.f;
                asm volatile("" : "+v"(negM[s2]));
#pragma unroll
                for (int d = 0; d < 2; ++d)
#pragma unroll
                    for (int i = 0; i < 16; ++i) O[s2][d][i] = 0.f; }
            int srow_ = srow, sch_ = sch; asm volatile("" : "+v"(srow_), "+v"(sch_));
            const bf16* gK = P + (size_t)srow_ * PW + C_KD + head * 64 + (sch_ ^ (srow_ & 7)) * 8; const bf16* gV = P + (size_t)srow_ * PW + C_VD + head * 64 + sch_ * 8;
            LAS unsigned char* dma0 = F.lds + w * 1024;
#define D_STAGE(bufb, go) do { __builtin_amdgcn_global_load_lds((const unsigned*)(gK + (go)), (LAS unsigned*)(dma0 + (bufb)), 16, 0, 0); \
                __builtin_amdgcn_global_load_lds((const unsigned*)(gK + (go) + (size_t)64 * PW), (LAS unsigned*)(dma0 + (bufb) + 8192), 16, 0, 0); \
                __builtin_amdgcn_global_load_lds((const unsigned*)(gV + (go)), (LAS unsigned*)(dma0 + (bufb) + 16384), 16, 0, 0); \
                __builtin_amdgcn_global_load_lds((const unsigned*)(gV + (go) + (size_t)64 * PW), (LAS unsigned*)(dma0 + (bufb) + 24576), 16, 0, 0); } while (0)
            __syncthreads();
#pragma unroll
            for (int kk = 0; kk < 4; ++kk) *(LAS u32x4*)(qlds + kk * 1024) = qs4[kk];
            D_STAGE(0, (size_t)0);
            VM_WAIT();
            __syncthreads();
            asm volatile(".p2align 8" ::: "memory");
#pragma unroll 1
            for (int i = 0; i <= b; ++i) {
                const int buf = i & 1, j = 2 * i + ksel;
                if (i < b) D_STAGE((buf ^ 1) * 32768, (size_t)(2 * i + 2) * 64 * PW);
                if (j <= cw) {
                    const LAS unsigned char* Kt = F.lds + buf * 32768 + ksel * 8192; const LAS unsigned char* Vt = F.lds + buf * 32768 + 16384 + ksel * 8192;
                    bf16x8 pf[2][4];
#pragma unroll
                    for (int s2 = 0; s2 < 2; ++s2) {
                        f32x16 Sq[2];
                        const bf16x8 qf2[2] = {*(const LAS bf16x8*)(qlds + (2 * s2) * 1024), *(const LAS bf16x8*)(qlds + (2 * s2 + 1) * 1024)};
#pragma unroll
                        for (int kb = 0; kb < 2; ++kb) {
#pragma unroll
                            for (int k2 = 0; k2 < 2; ++k2) { const int kk = 2 * s2 + k2; const int row = kb * 32 + r;
                                const bf16x8 kf = *(const LAS bf16x8*)(Kt + row * 128 + (((kk * 2 + hh) ^ (row & 7)) << 4));
                                Sq[kb] = __builtin_amdgcn_mfma_f32_32x32x16_bf16(kf, qf2[k2], k2 ? Sq[kb] : negM[s2], 0, 0, 0); }
                        }
                        __builtin_amdgcn_sched_barrier(0);
                        asm volatile("s_nop 15\n\ts_nop 3" ::: "memory");
                        __builtin_amdgcn_sched_barrier(0);
                        float mx = vmax3_(Sq[0][0], Sq[0][1], Sq[0][2]);
#pragma unroll
                        for (int ii = 3; ii < 15; ii += 2) mx = vmax3_(mx, Sq[0][ii], Sq[0][ii + 1]);
                        mx = vmax3_(mx, Sq[0][15], Sq[1][0]);
#pragma unroll
                        for (int ii = 1; ii < 15; ii += 2) mx = vmax3_(mx, Sq[1][ii], Sq[1][ii + 1]);
                        mx = vmax3_(mx, Sq[1][15], Sq[1][15]);
                        mx = fmaxf(mx, __shfl_xor(mx, 32));
                        if (!seen || __any(mx > 8.f)) { const float dl = seen ? fmaxf(mx, 0.f) : mx; m[s2] += dl;
                            if (seen) { const float al = __builtin_amdgcn_exp2f(-dl); lsum[s2] *= al;
#pragma unroll
                                for (int d = 0; d < 2; ++d)
#pragma unroll
                                    for (int ii = 0; ii < 16; ++ii) O[s2][d][ii] *= al; }
#pragma unroll
                            for (int kb = 0; kb < 2; ++kb)
#pragma unroll
                                for (int ii = 0; ii < 16; ++ii) Sq[kb][ii] -= dl;
                            const float nm = -m[s2];
#pragma unroll
                            for (int ii = 0; ii < 16; ++ii) negM[s2][ii] = nm; }
                        float rs = 0.f;
#pragma unroll
                        for (int kb = 0; kb < 2; ++kb)
#pragma unroll
                            for (int ii = 0; ii < 16; ++ii) { const float p = __builtin_amdgcn_exp2f(Sq[kb][ii]); Sq[kb][ii] = p; rs += p; }
                        lsum[s2] += rs;
#pragma unroll
                        for (int kb = 0; kb < 2; ++kb)
#pragma unroll
                            for (int ss = 0; ss < 2; ++ss) { u32x4 pw;
                                pw.x = pg8::cvt_pk_bf16(Sq[kb][8 * ss + 0], Sq[kb][8 * ss + 1]); pw.y = pg8::cvt_pk_bf16(Sq[kb][8 * ss + 2], Sq[kb][8 * ss + 3]);
                                pw.z = pg8::cvt_pk_bf16(Sq[kb][8 * ss + 4], Sq[kb][8 * ss + 5]); pw.w = pg8::cvt_pk_bf16(Sq[kb][8 * ss + 6], Sq[kb][8 * ss + 7]);
                                pf[s2][kb * 2 + ss] = __builtin_bit_cast(bf16x8, pw); }
                        __builtin_amdgcn_sched_barrier(0);
                    }
                    const int li = lane & 15, lg = lane >> 4;
                    const LAS unsigned char* vbase = Vt + (4 * (lg >> 1) + (li >> 2)) * 128 + (16 * (lg & 1) + 4 * (li & 3)) * 2;
#pragma unroll
                    for (int d = 0; d < 2; ++d)
#pragma unroll
                        for (int st = 0; st < 4; ++st) {
                            const s16x4 v0 = ds_tr16(vbase + (st * 16) * 128 + d * 64), v1 = ds_tr16(vbase + (st * 16 + 8) * 128 + d * 64);
                            const bf16x8 vf = (bf16x8){v0[0], v0[1], v0[2], v0[3], v1[0], v1[1], v1[2], v1[3]};
                            O[0][d] = __builtin_amdgcn_mfma_f32_32x32x16_bf16(vf, pf[0][st], O[0][d], 0, 0, 0);
                            O[1][d] = __builtin_amdgcn_mfma_f32_32x32x16_bf16(vf, pf[1][st], O[1][d], 0, 0, 0);
                            if (st & 1) __builtin_amdgcn_sched_barrier(0);
                        }
                    seen = true;
                }
                VM_WAIT();
                __syncthreads();
            }
            LAS float* xo = (LAS float*)F.lds + rw * 4096; LAS float* xm = (LAS float*)(F.lds + 65536) + rw * 256;
            if (!seen) { m[0] = -1e30f; m[1] = -1e30f; }
            if (ksel) {
#pragma unroll
                for (int s2 = 0; s2 < 2; ++s2) { xm[s2 * 64 + lane] = m[s2]; xm[128 + s2 * 64 + lane] = lsum[s2];
#pragma unroll
                    for (int d = 0; d < 2; ++d)
#pragma unroll
                        for (int ii = 0; ii < 16; ++ii) xo[((s2 * 2 + d) * 16 + ii) * 64 + lane] = O[s2][d][ii]; }
            }
            __syncthreads();
            if (!ksel) {
                float inv[2];
#pragma unroll
                for (int s2 = 0; s2 < 2; ++s2) { const float mb = xm[s2 * 64 + lane], lb = xm[128 + s2 * 64 + lane]; const float mn = fmaxf(m[s2], mb), aa = __builtin_amdgcn_exp2f(m[s2] - mn), ab = __builtin_amdgcn_exp2f(mb - mn);
                    float lt = lsum[s2] * aa + lb * ab; lt += __shfl_xor(lt, 32); inv[s2] = 1.f / lt;
#pragma unroll
                    for (int d = 0; d < 2; ++d)
#pragma unroll
                        for (int ii = 0; ii < 16; ++ii) O[s2][d][ii] = (O[s2][d][ii] * aa + xo[((s2 * 2 + d) * 16 + ii) * 64 + lane] * ab) * inv[s2]; }
                int r_ = r, hh_ = hh; asm volatile("" : "+v"(r_), "+v"(hh_));
                ArgsP a = kargs();
                const float* lp = a->in[9] + (size_t)l * 128 + r_; float s1 = (lane < 32) ? lp[0] * lp[32] : 0.f, s3 = (lane < 32) ? lp[64] * lp[96] : 0.f;
                s1 = wave_sum(s1); s3 = wave_sum(s3);
                const float lam_init = 0.8f - 0.6f * __expf(-0.3f * (float)l), lam = __expf(s1) - __expf(s3) + lam_init;
                const float* gn = a->in[10] + (size_t)l * 256 + head * 64 + 4 * hh_;
                float ss = 0.f;
#pragma unroll
                for (int d = 0; d < 2; ++d)
#pragma unroll
                    for (int ii = 0; ii < 16; ++ii) { const float o = O[0][d][ii] - lam * O[1][d][ii]; O[0][d][ii] = o; ss += o * o; }
                ss += __shfl_xor(ss, 32);
                const float rstd = rsqrtf(ss * (1.f / 64.f) + RMS_EPS) * (1.f - lam_init);
                bf16* yrow = Y + (size_t)(qrow + r_) * 256 + head * 64 + 4 * hh_;
#pragma unroll
                for (int d = 0; d < 2; ++d)
#pragma unroll
                    for (int g = 0; g < 4; ++g) { const f32x4 gg = *(const f32x4*)(gn + d * 32 + 8 * g); u32x2 o2;
                        o2.x = pk2(O[0][d][4 * g + 0] * rstd * gg.x, O[0][d][4 * g + 1] * rstd * gg.y); o2.y = pk2(O[0][d][4 * g + 2] * rstd * gg.z, O[0][d][4 * g + 3] * rstd * gg.w);
                        *(u32x2*)(yrow + d * 32 + 8 * g) = o2; }
            }
        }
    }
    __syncthreads();
}

using pg8::sigmoidf_;
constexpr int ML_CE = 0, ML_G = 1024, ML_SC = 2048;
__device__ __forceinline__ float logsigmoidf_(float f) { return f >= 0.f ? -log1pf(__expf(-f)) : f - log1pf(__expf(f)); }
__device__ __forceinline__ void ml_gates(const bf16* P, const float* ib, const float* fb, int c, int h, int lane, float& a_t, float& i_t) {
    const bf16* pr = P + (size_t)(c * 64 + lane) * PW;
    i_t = bf2f(pr[C_IB + h]) + ib[h]; a_t = logsigmoidf_(bf2f(pr[C_FB + h]) + fb[h]);
}
__device__ __forceinline__ float wave_scan_add(float v, int lane) {
#pragma unroll
    for (int o = 1; o < 64; o <<= 1) { const float u = __shfl_up(v, o); if (lane >= o) v += u; }
    return v;
}
__device__ __forceinline__ float wave_scan_max(float v, int lane) {
#pragma unroll
    for (int o = 1; o < 64; o <<= 1) { const float u = __shfl_up(v, o); if (lane >= o) v = fmaxf(v, u); }
    return v;
}
__device__ __forceinline__ void ml_phase1(Frame& F, int l) {
    ArgsP a = kargs(); const bf16* P = (const bf16*)(F.ws + WS_PU); float* mls = (float*)(F.ws + WS_MLS);
    const float* ib = a->in[5] + l * 4; const float* fb = a->in[6] + l * 4;
    for (int u = F.bid * 8 + F.wave; u < NCH * 4; u += F.G * 8) {
        const int c = u >> 2, h = u & 3; float at, it; ml_gates(P, ib, fb, c, h, F.lane, at, it);
        const float cum = wave_scan_add(at, F.lane), ce = __shfl(cum, 63), g = ce - cum + it, G = wave_max(g);
        if (F.lane == 0) { mls[ML_CE + u] = ce; mls[ML_G + u] = G; }
    }
}
__device__ __forceinline__ void ml_mscan(Frame& F, LAS float* mt, LAS float* tmp) {
    const float* mls = (const float*)(F.ws + WS_MLS);
    __syncthreads();
    for (int i = F.tid; i < 1024; i += 512) { tmp[i] = mls[ML_CE + i]; tmp[1024 + i] = mls[ML_G + i]; }
    __syncthreads();
    if (F.tid < 4) { float m = 0.f;
#pragma unroll 1
        for (int c0 = 0; c0 < NCH; c0 += 16) { float ce[16], g[16];
#pragma unroll
            for (int i = 0; i < 16; ++i) { ce[i] = tmp[(c0 + i) * 4 + F.tid]; g[i] = tmp[1024 + (c0 + i) * 4 + F.tid]; }
#pragma unroll
            for (int i = 0; i < 16; ++i) { mt[F.tid * 257 + c0 + i] = m; m = fmaxf(ce[i] + m, g[i]); } }
        mt[F.tid * 257 + 256] = m; }
    __syncthreads();
}
__device__ __forceinline__ void ml_stage_conv(const bf16* P, int col0, const float* cw, const float* cb, int row0, float sc, LAS float* dst, int tid) {
    const int t = tid >> 3, d0 = (tid & 7) * 8;
    float acc[8];
#pragma unroll
    for (int i = 0; i < 8; ++i) acc[i] = cb[d0 + i];
#pragma unroll
    for (int j = 0; j < 4; ++j) { const int r = row0 + t - 3 + j;
        if (r >= 0) { const u32x4 x = *(const u32x4*)(P + (size_t)r * PW + col0 + d0); const float* w = cw + j * 512 + d0;
            acc[0] += w[0] * bflo(x.x); acc[1] += w[1] * bfhi(x.x); acc[2] += w[2] * bflo(x.y); acc[3] += w[3] * bfhi(x.y);
            acc[4] += w[4] * bflo(x.z); acc[5] += w[5] * bfhi(x.z); acc[6] += w[6] * bflo(x.w); acc[7] += w[7] * bfhi(x.w); } }
#pragma unroll
    for (int i = 0; i < 8; ++i) dst[t * 65 + d0 + i] = acc[i] * sigmoidf_(acc[i]) * sc;
}
__device__ __forceinline__ void ml_stage_plain(const bf16* P, int col0, int row0, const LAS float* rs, LAS float* dst, int tid) {
    const int t = tid >> 3, d0 = (tid & 7) * 8; const float sc = rs ? rs[t] : 1.f;
    const u32x4 x = *(const u32x4*)(P + (size_t)(row0 + t) * PW + col0 + d0); LAS float* d = dst + t * 65 + d0;
    d[0] = bflo(x.x) * sc; d[1] = bfhi(x.x) * sc; d[2] = bflo(x.y) * sc; d[3] = bfhi(x.y) * sc; d[4] = bflo(x.z) * sc; d[5] = bfhi(x.z) * sc; d[6] = bflo(x.w) * sc; d[7] = bfhi(x.w) * sc;
}
__device__ __forceinline__ void ml_phase3(Frame& F, int l) {
    ArgsP a = kargs(); const bf16* P = (const bf16*)(F.ws + WS_PU); float* mls = (float*)(F.ws + WS_MLS);
    float* dC = (float*)(F.ws + WS_MLC); float* dn = (float*)(F.ws + WS_MLN);
    const float* ib = a->in[5] + l * 4; const float* fb = a->in[6] + l * 4; const float* cw = a->in[3] + (size_t)l * 2048; const float* cb = a->in[4] + (size_t)l * 512;
    LAS float* Kl = (LAS float*)F.lds; LAS float* Vl = Kl + 64 * 65; LAS float* srcL = Vl + 64 * 65; LAS float* mt = srcL + 64; LAS float* tmp = mt + 4 * 257 + 4;
    ml_mscan(F, mt, tmp);
    const int lane = F.lane, w = F.wave, li = lane & 15, kq = lane >> 4, bi = w >> 1, bj0 = (w & 1) * 2;
    for (int u = F.bid; u < NCH * 4; u += F.G) {
        const int c = u >> 2, h = u & 3; const float m0 = mt[h * 257 + c], m1 = mt[h * 257 + c + 1];
        __syncthreads();
        if (w == 0) { float at, it; ml_gates(P, ib, fb, c, h, lane, at, it); const float cum = wave_scan_add(at, lane), ce = __shfl(cum, 63);
            srcL[lane] = __expf(ce - cum + it - m1); if (lane == 0) mls[ML_SC + u] = __expf(ce + m0 - m1); }
        const u32x4 vx = *(const u32x4*)(P + (size_t)(c * 64 + (F.tid >> 3)) * PW + C_VB + h * 64 + (F.tid & 7) * 8);
        ml_stage_conv(P, C_KB + h * 64, cw + 256 + h * 64, cb + 256 + h * 64, c * 64, 0.125f, Kl, F.tid);
        __syncthreads();
        { const int t = F.tid >> 3, d0 = (F.tid & 7) * 8; const float sc = srcL[t]; LAS float* d = Vl + t * 65 + d0;
          d[0] = bflo(vx.x) * sc; d[1] = bfhi(vx.x) * sc; d[2] = bflo(vx.y) * sc; d[3] = bfhi(vx.y) * sc; d[4] = bflo(vx.z) * sc; d[5] = bfhi(vx.z) * sc; d[6] = bflo(vx.w) * sc; d[7] = bfhi(vx.w) * sc; }
        __syncthreads();
        f32x4 acc0 = {0.f, 0.f, 0.f, 0.f}, acc1 = {0.f, 0.f, 0.f, 0.f};
#pragma unroll 4
        for (int k0 = 0; k0 < 64; k0 += 4) { const float av = Vl[(k0 + kq) * 65 + bi * 16 + li];
            acc0 = MFMA_F32(av, Kl[(k0 + kq) * 65 + bj0 * 16 + li], acc0); acc1 = MFMA_F32(av, Kl[(k0 + kq) * 65 + (bj0 + 1) * 16 + li], acc1); }
        float* o = dC + (size_t)u * 4096 + (bi * 16 + kq * 4) * 64 + li;
#pragma unroll
        for (int r = 0; r < 4; ++r) { o[r * 64 + bj0 * 16] = acc0[r]; o[r * 64 + (bj0 + 1) * 16] = acc1[r]; }
        { const int t = F.tid >> 3, s8 = (F.tid & 7) * 8; float sacc = 0.f;
#pragma unroll
          for (int i = 0; i < 8; ++i) sacc += srcL[s8 + i] * Kl[(s8 + i) * 65 + t];
          sacc += __shfl_xor(sacc, 1); sacc += __shfl_xor(sacc, 2); sacc += __shfl_xor(sacc, 4);
          if ((F.tid & 7) == 0) dn[(size_t)u * 64 + t] = sacc; }
    }
    __syncthreads();
}
__device__ __forceinline__ void ml_phase4(Frame& F) {
    float* dC = (float*)(F.ws + WS_MLC); float* dn = (float*)(F.ws + WS_MLN); const float* sc = (const float*)(F.ws + WS_MLS) + ML_SC;
    float* base; size_t stride; int h;
    if (F.wave == 0) { const int e = F.bid * 64 + F.lane; if (e >= 16384) return; h = e >> 12; base = dC + (size_t)h * 4096 + (e & 4095); stride = 4 * 4096; }
    else if (F.wave == 1 && F.bid < 4) { h = F.bid; base = dn + (size_t)h * 64 + F.lane; stride = 4 * 64; }
    else return;
    float st = 0.f;
    for (int c0 = 0; c0 < NCH; c0 += 8) {
        float v[8], g[8];
#pragma unroll
        for (int i = 0; i < 8; ++i) { v[i] = base[(size_t)(c0 + i) * stride]; g[i] = sc[(c0 + i) * 4 + h]; }
#pragma unroll
        for (int i = 0; i < 8; ++i) { base[(size_t)(c0 + i) * stride] = st; st = g[i] * st + v[i]; }
    }
}
__device__ __forceinline__ void ml_phase5(Frame& F, int l) {
    ArgsP a = kargs(); const bf16* P = (const bf16*)(F.ws + WS_PU);
    const float* Cst = (const float*)(F.ws + WS_MLC); const float* nst = (const float*)(F.ws + WS_MLN);
    const float* ib = a->in[5] + l * 4; const float* fb = a->in[6] + l * 4; const float* cw = a->in[3] + (size_t)l * 2048; const float* cb = a->in[4] + (size_t)l * 512;
    const float* gn = a->in[7] + (size_t)l * 256;
    bf16* Y = (bf16*)(F.ws + WS_Y) + (size_t)1 * S * 256;
    LAS float* Ql = (LAS float*)F.lds; LAS float* Kl = Ql + 64 * 65; LAS float* Vl = Kl + 64 * 65; LAS float* Cl = Vl + 64 * 65; LAS float* Wl = Cl + 64 * 65;
    LAS float* cumL = Wl + 64 * 65; LAS float* bL = cumL + 64; LAS float* mtL = bL + 64; LAS float* inL = mtL + 64; LAS float* nL = inL + 64; LAS float* denL = nL + 64;
    LAS float* mt = denL + 64; LAS float* tmp = mt + 4 * 257 + 4;
    ml_mscan(F, mt, tmp);
    const int lane = F.lane, w = F.wave, li = lane & 15, kq = lane >> 4, bi = w >> 1, bj0 = (w & 1) * 2;
    for (int u = F.bid; u < NCH * 4; u += F.G) {
        const int c = u >> 2, h = u & 3; const float m0 = mt[h * 257 + c];
        const u32x4 ov = *(const u32x4*)(P + (size_t)(c * 64 + (F.tid >> 3)) * PW + C_OB + h * 64 + (F.tid & 7) * 8);
        const f32x4 g0 = *(const f32x4*)(gn + h * 64 + (F.tid & 7) * 8), g1 = *(const f32x4*)(gn + h * 64 + (F.tid & 7) * 8 + 4);
        __syncthreads();
        if (w == 0) { float at, it; ml_gates(P, ib, fb, c, h, lane, at, it); const float cum = wave_scan_add(at, lane);
            const float bb = it - cum, pm = wave_scan_max(bb, lane), mtt = fmaxf(cum + m0, cum + pm);
            cumL[lane] = cum; bL[lane] = bb; mtL[lane] = mtt; inL[lane] = __expf(cum + m0 - mtt); nL[lane] = nst[(size_t)u * 64 + lane]; }
        ml_stage_conv(P, C_QB + h * 64, cw + h * 64, cb + h * 64, c * 64, 1.f, Ql, F.tid);
        ml_stage_conv(P, C_KB + h * 64, cw + 256 + h * 64, cb + 256 + h * 64, c * 64, 0.125f, Kl, F.tid);
        ml_stage_plain(P, C_VB + h * 64, c * 64, nullptr, Vl, F.tid);
        { const int t = F.tid >> 3, d0 = (F.tid & 7) * 8; const f32x4 c0 = *(const f32x4*)(Cst + (size_t)u * 4096 + t * 64 + d0), c1 = *(const f32x4*)(Cst + (size_t)u * 4096 + t * 64 + d0 + 4);
          LAS float* d = Cl + t * 65 + d0; d[0] = c0.x; d[1] = c0.y; d[2] = c0.z; d[3] = c0.w; d[4] = c1.x; d[5] = c1.y; d[6] = c1.z; d[7] = c1.w; }
        __syncthreads();
        {
            f32x4 acc0 = {0.f, 0.f, 0.f, 0.f}, acc1 = {0.f, 0.f, 0.f, 0.f};
#pragma unroll 4
            for (int k0 = 0; k0 < 64; k0 += 4) { const float av = Ql[(bi * 16 + li) * 65 + k0 + kq];
                acc0 = MFMA_F32(av, Kl[(bj0 * 16 + li) * 65 + k0 + kq], acc0); acc1 = MFMA_F32(av, Kl[((bj0 + 1) * 16 + li) * 65 + k0 + kq], acc1); }
#pragma unroll
            for (int r = 0; r < 4; ++r) { const int t = bi * 16 + kq * 4 + r; const float ct = cumL[t] - mtL[t];
                { const int s2 = bj0 * 16 + li; Wl[t * 65 + s2] = (s2 <= t) ? __expf(ct + bL[s2]) * acc0[r] : 0.f; }
                { const int s2 = (bj0 + 1) * 16 + li; Wl[t * 65 + s2] = (s2 <= t) ? __expf(ct + bL[s2]) * acc1[r] : 0.f; } }
        }
        __syncthreads();
        { const int t = F.tid >> 3, k8 = (F.tid & 7) * 8; float qn = 0.f, sw = 0.f;
#pragma unroll
            for (int k = 0; k < 8; ++k) { qn += Ql[t * 65 + k8 + k] * nL[k8 + k]; sw += Wl[t * 65 + k8 + k]; }
            qn += __shfl_xor(qn, 1); sw += __shfl_xor(sw, 1); qn += __shfl_xor(qn, 2); sw += __shfl_xor(sw, 2); qn += __shfl_xor(qn, 4); sw += __shfl_xor(sw, 4);
            if ((F.tid & 7) == 0) { const float den = inL[t] * qn + sw; denL[t] = 1.f / fmaxf(fabsf(den), __expf(-mtL[t])); } }
        f32x4 acc0 = {0.f, 0.f, 0.f, 0.f}, acc1 = {0.f, 0.f, 0.f, 0.f};
#pragma unroll 4
        for (int k0 = 0; k0 < 64; k0 += 4) { const float av = Ql[(bi * 16 + li) * 65 + k0 + kq];
            acc0 = MFMA_F32(av, Cl[(bj0 * 16 + li) * 65 + k0 + kq], acc0); acc1 = MFMA_F32(av, Cl[((bj0 + 1) * 16 + li) * 65 + k0 + kq], acc1); }
#pragma unroll
        for (int r = 0; r < 4; ++r) { const float it = inL[bi * 16 + kq * 4 + r]; acc0[r] *= it; acc1[r] *= it; }
#pragma unroll 4
        for (int k0 = 0; k0 < 64; k0 += 4) { const float av = Wl[(bi * 16 + li) * 65 + k0 + kq];
            acc0 = MFMA_F32(av, Vl[(k0 + kq) * 65 + bj0 * 16 + li], acc0); acc1 = MFMA_F32(av, Vl[(k0 + kq) * 65 + (bj0 + 1) * 16 + li], acc1); }
        __syncthreads();
#pragma unroll
        for (int r = 0; r < 4; ++r) { const int t = bi * 16 + kq * 4 + r; const float dv = denL[t]; Wl[t * 65 + bj0 * 16 + li] = acc0[r] * dv; Wl[t * 65 + (bj0 + 1) * 16 + li] = acc1[r] * dv; }
        __syncthreads();
        { const int t = F.tid >> 3, d0 = (F.tid & 7) * 8; float hv[8], ss = 0.f;
#pragma unroll
          for (int i = 0; i < 8; ++i) { hv[i] = Wl[t * 65 + d0 + i]; ss += hv[i] * hv[i]; }
          ss += __shfl_xor(ss, 1); ss += __shfl_xor(ss, 2); ss += __shfl_xor(ss, 4);
          const float rstd = rsqrtf(ss * (1.f / 64.f) + RMS_EPS);
          const float g[8] = {g0.x, g0.y, g0.z, g0.w, g1.x, g1.y, g1.z, g1.w};
          const float o0 = sigmoidf_(bflo(ov.x)), o1 = sigmoidf_(bfhi(ov.x)), o2 = sigmoidf_(bflo(ov.y)), o3 = sigmoidf_(bfhi(ov.y)), o4 = sigmoidf_(bflo(ov.z)), o5 = sigmoidf_(bfhi(ov.z)), o6 = sigmoidf_(bflo(ov.w)), o7 = sigmoidf_(bfhi(ov.w));
          u32x4 y; y.x = pk2(o0 * hv[0] * rstd * g[0], o1 * hv[1] * rstd * g[1]); y.y = pk2(o2 * hv[2] * rstd * g[2], o3 * hv[3] * rstd * g[3]);
          y.z = pk2(o4 * hv[4] * rstd * g[4], o5 * hv[5] * rstd * g[5]); y.w = pk2(o6 * hv[6] * rstd * g[6], o7 * hv[7] * rstd * g[7]);
          *(u32x4*)(Y + (size_t)(c * 64 + t) * 256 + h * 64 + d0) = y; }
    }
    __syncthreads();
}


constexpr int DSA_CAP = 2048, DSA_TRIG = 1024, QHP = 260, DSA_TU = 10496;
__device__ __forceinline__ u32x2 ld_list(const u32x2* p) { const unsigned long long v = __hip_atomic_load((const unsigned long long*)p, __ATOMIC_RELAXED, __HIP_MEMORY_SCOPE_AGENT); return (u32x2){(unsigned)v, (unsigned)(v >> 32)}; }

__device__ __forceinline__ unsigned wave_prefix_incl(unsigned v) {
    v += (unsigned)__builtin_amdgcn_update_dpp(0, (int)v, 0x111, 0xf, 0xf, false);
    v += (unsigned)__builtin_amdgcn_update_dpp(0, (int)v, 0x112, 0xf, 0xf, false);
    v += (unsigned)__builtin_amdgcn_update_dpp(0, (int)v, 0x114, 0xf, 0xf, false);
    v += (unsigned)__builtin_amdgcn_update_dpp(0, (int)v, 0x118, 0xf, 0xf, false);
    v += (unsigned)__builtin_amdgcn_update_dpp(0, (int)v, 0x142, 0xa, 0xf, false);
    v += (unsigned)__builtin_amdgcn_update_dpp(0, (int)v, 0x143, 0xc, 0xf, false);
    return v;
}
__device__ __forceinline__ unsigned sortable(float v) { const unsigned b = __builtin_bit_cast(unsigned, v); return (b & 0x80000000u) ? ~b : (b | 0x80000000u); }
__device__ __forceinline__ unsigned lanes_below(unsigned long long m) { return __builtin_amdgcn_mbcnt_hi((unsigned)(m >> 32), __builtin_amdgcn_mbcnt_lo((unsigned)m, 0u)); }

__device__ __forceinline__ unsigned dsa_bin(unsigned sv) {
    const bool pos = (sv >> 31) != 0u; const unsigned mag = (pos ? sv : ~sv) & 0x7fffffffu; int t = (int)(mag >> 19) - 1904; t = t < 0 ? 0 : (t > 255 ? 255 : t);
    return pos ? 256u + (unsigned)t : 255u - (unsigned)t;
}
__device__ __forceinline__ unsigned dsa_bin_f(float v) {
    const unsigned b = __builtin_bit_cast(unsigned, v); int t = (int)((b >> 19) & 0xfffu) - 1904; t = t < 0 ? 0 : (t > 255 ? 255 : t);
    return (unsigned)(256 + (t ^ ((int)b >> 31)));
}
__device__ __forceinline__ unsigned dsa_bin_T(unsigned B) {
    if (B >= 257u) return (0x80000000u | ((1904u + (B - 256u)) << 19)) - 1u;
    if (B == 256u) return 0x7fffffffu;
    if (B == 0u) return 0u;
    const unsigned t = 255u - B, mag = ((1905u + t) << 19) - 1u; return (0x7fffffffu - mag) - 1u;
}
__device__ __forceinline__ unsigned dsa_hist_T(const LAS unsigned* qh, int lane) {
    const int grp = 63 - lane;
    const u32x4 h = *(const LAS u32x4*)(qh + 4 * grp);
    const unsigned c[8] = {h.x & 0xffffu, h.x >> 16, h.y & 0xffffu, h.y >> 16, h.z & 0xffffu, h.z >> 16, h.w & 0xffffu, h.w >> 16};
    unsigned tl = 0u;
#pragma unroll
    for (int i = 0; i < 8; ++i) tl += c[i];
    const unsigned suf = wave_prefix_incl(tl);
    const unsigned above = suf - tl; const bool mine = (above < 256u) && (256u <= suf);
    unsigned B = 0u;
    if (mine) { unsigned cc = above; B = 8u * grp;
#pragma unroll
        for (int i = 7; i >= 0; --i) { cc += c[i]; if (cc >= 256u) { B = 8u * grp + i; break; } } }
    const unsigned long long mm = __ballot(mine); if (!mm) return 0u;
    B = (unsigned)__builtin_amdgcn_readlane((int)B, (int)__builtin_ctzll(mm));
    return dsa_bin_T(B);
}
__device__ __forceinline__ void dsa_hist_T4(const LAS unsigned* qh0, LAS unsigned* T4, int lane, bool want) {
    const int qq = lane >> 4, g = 15 - (lane & 15);
    const LAS unsigned* qh = qh0 + qq * QHP + 16 * g;
    const u32x4 h0 = *(const LAS u32x4*)qh, h1 = *(const LAS u32x4*)(qh + 4), h2 = *(const LAS u32x4*)(qh + 8), h3 = *(const LAS u32x4*)(qh + 12);
    const unsigned s0 = h0.x + h0.y + h0.z + h0.w, s1 = h1.x + h1.y + h1.z + h1.w, s2 = h2.x + h2.y + h2.z + h2.w, s3 = h3.x + h3.y + h3.z + h3.w;
    const unsigned t0 = (s0 & 0xffffu) + (s0 >> 16), t1 = (s1 & 0xffffu) + (s1 >> 16), t2 = (s2 & 0xffffu) + (s2 >> 16), t3 = (s3 & 0xffffu) + (s3 >> 16);
    const unsigned tl = t0 + t1 + t2 + t3;
    unsigned v = tl;
    v += (unsigned)__builtin_amdgcn_update_dpp(0, (int)v, 0x111, 0xf, 0xf, false);
    v += (unsigned)__builtin_amdgcn_update_dpp(0, (int)v, 0x112, 0xf, 0xf, false);
    v += (unsigned)__builtin_amdgcn_update_dpp(0, (int)v, 0x114, 0xf, 0xf, false);
    v += (unsigned)__builtin_amdgcn_update_dpp(0, (int)v, 0x118, 0xf, 0xf, false);
    const unsigned above = v - tl;
    if (want && above < 256u && 256u <= v) {
        unsigned cc = above, base; u32x4 hq;
        if (cc + t3 >= 256u) { hq = h3; base = 24u; } else { cc += t3;
        if (cc + t2 >= 256u) { hq = h2; base = 16u; } else { cc += t2;
        if (cc + t1 >= 256u) { hq = h1; base = 8u; } else { cc += t1; hq = h0; base = 0u; } } }
        const unsigned c[8] = {hq.x & 0xffffu, hq.x >> 16, hq.y & 0xffffu, hq.y >> 16, hq.z & 0xffffu, hq.z >> 16, hq.w & 0xffffu, hq.w >> 16};
        unsigned B = 32u * g + base;
#pragma unroll
        for (int i = 7; i >= 0; --i) { cc += c[i]; if (cc >= 256u) { B = 32u * g + base + i; break; } }
        const unsigned T = dsa_bin_T(B); if (T > T4[qq]) { T4[qq] = T; T4[DSA_TU + qq] = (B >= 511u || T4[DSA_TU + 32 + qq] != 0u) ? 0xffffffffu : dsa_bin_T(B + 1u); }
    }
}
template <int NPASS, class KF, class PF>
__device__ __forceinline__ unsigned radix_kth(int n, KF key, PF pred, unsigned& want, LAS unsigned* hist, int lane) {
    unsigned prefix = 0u, himask = 0u;
#pragma unroll 1
    for (int p = 0; p < NPASS; ++p) {
        const int shift = 8 * (NPASS - 1 - p);
        *(LAS u32x4*)(hist + 4 * lane) = (u32x4){0u, 0u, 0u, 0u};
        asm volatile("s_waitcnt lgkmcnt(0)" ::: "memory");
#pragma unroll 4
        for (int i = lane; i < n; i += 64) { const unsigned k = key(i); if (pred(i) && ((k ^ prefix) & himask) == 0u) (void)__hip_atomic_fetch_add(hist + ((k >> shift) & 255u), 1u, __ATOMIC_RELAXED, __HIP_MEMORY_SCOPE_WORKGROUP); }
        asm volatile("s_waitcnt lgkmcnt(0)" ::: "memory");
        const int grp = 63 - lane;
        const u32x4 h = *(LAS u32x4*)(hist + 4 * grp);
        const unsigned tl = h.x + h.y + h.z + h.w; const unsigned suf = wave_prefix_incl(tl);
        const unsigned above = suf - tl;
        const bool mine = (above < want) && (want <= suf);
        unsigned D = 0u, nw = 0u;
        if (mine) { unsigned c = above;
            if (c + h.w >= want) { D = 4 * grp + 3; nw = want - c; } else { c += h.w;
            if (c + h.z >= want) { D = 4 * grp + 2; nw = want - c; } else { c += h.z;
            if (c + h.y >= want) { D = 4 * grp + 1; nw = want - c; } else { c += h.y; D = 4 * grp; nw = want - c; } } } }
        const unsigned long long mm = __ballot(mine); const int src = mm ? (int)__builtin_ctzll(mm) : 0;
        D = (unsigned)__builtin_amdgcn_readlane((int)D, src); nw = (unsigned)__builtin_amdgcn_readlane((int)nw, src);
        prefix |= D << shift; himask |= 0xffu << shift; want = nw;
    }
    return prefix;
}
__device__ __forceinline__ void dsa_prune(u32x2* list, LAS unsigned* nq, LAS unsigned* Tq, int q, LAS u32x2* st, LAS unsigned* hist, int lane, bool exact, unsigned tmin) {
    const int n0 = (int)nq[q]; int n = 0;
#pragma unroll 1
    for (int i0 = 0; i0 < n0; i0 += 256) {
        u32x2 t8[4];
#pragma unroll
        for (int u = 0; u < 4; ++u) { const int i = i0 + u * 64 + lane; t8[u] = (i < n0) ? ld_list(list + i) : (u32x2){0u, 0u}; }
#pragma unroll
        for (int u = 0; u < 4; ++u) { const int i = i0 + u * 64 + lane; const bool k = (i < n0) && t8[u].x > tmin;
            const unsigned long long m = __ballot(k); if (k) st[n + (int)lanes_below(m)] = t8[u]; n += (int)__popcll(m); } }
    asm volatile("s_waitcnt vmcnt(0) lgkmcnt(0)" ::: "memory");
    if (n <= 256) {
#pragma unroll 1
        for (int i = lane; i < n; i += 64) list[i] = st[i];
        if (lane == 0) { nq[q] = (unsigned)n; Tq[DSA_TU + q] = 0xffffffffu; Tq[DSA_TU + 32 + q] = 1u; if (tmin > Tq[q]) Tq[q] = tmin; }
        asm volatile("s_waitcnt vmcnt(0)" ::: "memory");
        return;
    }
    if (!exact) {
        unsigned want = 256u;
        const unsigned Th = radix_kth<2>(n, [st](int i) { return st[i].x >> 16; }, [](int) { return true; }, want, hist, lane);
        unsigned cnt_ge = 0u;
#pragma unroll 1
        for (int i0 = 0; i0 < n; i0 += 64) { const int i = i0 + lane; cnt_ge += (unsigned)__popcll(__ballot(i < n && (st[i].x >> 16) >= Th)); }
        if (cnt_ge <= 512u && Th > 0u) {
            unsigned base = 0u;
#pragma unroll 1
            for (int i0 = 0; i0 < n; i0 += 64) { const int i = i0 + lane; const u32x2 t = (i < n) ? st[i] : (u32x2){0u, 0u};
                const bool keep = (i < n) && (t.x >> 16) >= Th;
                const unsigned long long m = __ballot(keep); if (keep) list[base + lanes_below(m)] = t; base += (unsigned)__popcll(m); }
            if (lane == 0) { nq[q] = base; const unsigned tn = (Th << 16) - 1u; Tq[q] = tn > tmin ? tn : tmin; Tq[DSA_TU + q] = 0xffffffffu; Tq[DSA_TU + 32 + q] = 1u; }
            asm volatile("s_waitcnt vmcnt(0)" ::: "memory");
            return;
        }
    }
    unsigned want = 256u;
    const unsigned Ts = radix_kth<4>(n, [st](int i) { return st[i].x; }, [](int) { return true; }, want, hist, lane);
    unsigned cnt_eq = 0u;
#pragma unroll 1
    for (int i0 = 0; i0 < n; i0 += 64) { const int i = i0 + lane; cnt_eq += (unsigned)__popcll(__ballot(i < n && st[i].x == Ts)); }
    unsigned Tk = 0u;
    if (cnt_eq > want) Tk = radix_kth<2>(n, [st](int i) { return 0x3fffu - st[i].y; }, [st, Ts](int i) { return st[i].x == Ts; }, want, hist, lane);
    unsigned base = 0u;
#pragma unroll 1
    for (int i0 = 0; i0 < n; i0 += 64) { const int i = i0 + lane; const u32x2 t = (i < n) ? st[i] : (u32x2){0u, 0u};
        const bool keep = (i < n) && (t.x > Ts || (t.x == Ts && (0x3fffu - t.y) >= Tk));
        const unsigned long long m = __ballot(keep); if (keep) list[base + lanes_below(m)] = t; base += (unsigned)__popcll(m); }
    if (lane == 0) { nq[q] = base; Tq[q] = Ts; Tq[DSA_TU + q] = 0xffffffffu; Tq[DSA_TU + 32 + q] = 1u; }
    asm volatile("s_waitcnt vmcnt(0)" ::: "memory");
}
__device__ __forceinline__ int dsa_final(const u32x2* list, int n0, unsigned tmin, unsigned tup, LAS u32x2* st, LAS unsigned* hist, LAS unsigned* bmp, int lane) {
    int n = 0, cin = 0;
#pragma unroll 1
    for (int i0 = 0; i0 < n0; i0 += 512) {
        u32x4 t4[4];
#pragma unroll
        for (int u = 0; u < 4; ++u) { const int i = i0 + u * 128 + 2 * lane; t4[u] = (i < n0) ? *(const u32x4*)(list + i) : (u32x4){0u, 0u, 0u, 0u}; }
#pragma unroll
        for (int u = 0; u < 4; ++u) { const int i = i0 + u * 128 + 2 * lane;
            { const bool in = (i < n0) && t4[u].x > tup, k = (i < n0) && t4[u].x > tmin && !in;
              if (in) (void)__hip_atomic_fetch_or(bmp + (t4[u].y >> 5), 1u << (t4[u].y & 31u), __ATOMIC_RELAXED, __HIP_MEMORY_SCOPE_WORKGROUP);
              cin += (int)__popcll(__ballot(in));
              const unsigned long long m = __ballot(k); if (k) st[n + (int)lanes_below(m)] = (u32x2){t4[u].x, t4[u].y}; n += (int)__popcll(m); }
            { const bool in = (i + 1 < n0) && t4[u].z > tup, k = (i + 1 < n0) && t4[u].z > tmin && !in;
              if (in) (void)__hip_atomic_fetch_or(bmp + (t4[u].w >> 5), 1u << (t4[u].w & 31u), __ATOMIC_RELAXED, __HIP_MEMORY_SCOPE_WORKGROUP);
              cin += (int)__popcll(__ballot(in));
              const unsigned long long m = __ballot(k); if (k) st[n + (int)lanes_below(m)] = (u32x2){t4[u].z, t4[u].w}; n += (int)__popcll(m); } }
    }
    asm volatile("s_waitcnt lgkmcnt(0)" ::: "memory");
    const int quota = cin < 256 ? 256 - cin : 0;
    unsigned Ts = 0u, Tk = 0u;
    if (n > quota) {
        unsigned want = (unsigned)quota;
        Ts = radix_kth<4>(n, [st](int i) { return st[i].x; }, [](int) { return true; }, want, hist, lane);
        unsigned cnt_eq = 0u;
#pragma unroll 1
        for (int i0 = 0; i0 < n; i0 += 64) { const int i = i0 + lane; cnt_eq += (unsigned)__popcll(__ballot(i < n && st[i].x == Ts)); }
        if (cnt_eq > want) Tk = radix_kth<2>(n, [st](int i) { return 0x3fffu - st[i].y; }, [st, Ts](int i) { return st[i].x == Ts; }, want, hist, lane);
    }
    int cnt = cin;
#pragma unroll 1
    for (int i0 = 0; i0 < n; i0 += 64) { const int i = i0 + lane; const u32x2 t = (i < n) ? st[i] : (u32x2){0u, 0u};
        const bool keep = (i < n) && (n <= quota || t.x > Ts || (t.x == Ts && (0x3fffu - t.y) >= Tk));
        if (keep) (void)__hip_atomic_fetch_or(bmp + (t.y >> 5), 1u << (t.y & 31u), __ATOMIC_RELAXED, __HIP_MEMORY_SCOPE_WORKGROUP);
        cnt += (int)__popcll(__ballot(keep)); }
    asm volatile("s_waitcnt lgkmcnt(0)" ::: "memory");
    return cnt;
}
__device__ __forceinline__ void dsa_unit(Frame& F, int G32) {
    const bf16* P = (const bf16*)(F.ws + WS_PU);
    bf16* Y = (bf16*)(F.ws + WS_Y);
    u32x2* cand = (u32x2*)(F.ws + WS_CAND) + (size_t)F.bid * 32 * DSA_CAP;
    const int lane = F.lane, w = F.wave, r = lane & 31, hh = lane >> 5;
    LAS unsigned char* wscr = F.lds + w * 12288;
    LAS unsigned* Tq = (LAS unsigned*)(F.lds + 98304); LAS unsigned* nq = Tq + 32;
    LAS unsigned* hist = (LAS unsigned*)(F.lds + 98816 + w * 1024);
    LAS unsigned* qhist = (LAS unsigned*)(F.lds + 107008);
    const int q0 = G32 * 32, c = G32 >> 1, nt = c + 1, nrounds = (nt + 7) >> 3;
    __syncthreads();
    if (F.tid < 32) { Tq[F.tid] = 0u; Tq[DSA_TU + F.tid] = 0xffffffffu; Tq[DSA_TU + 32 + F.tid] = 0u; nq[F.tid] = 0u; nq[32 + F.tid] = 0u; nq[64 + F.tid] = 0u; }
#pragma unroll
    for (int k = 0; k < 4; ++k) *(LAS u32x4*)(qhist + F.tid * 4 + k * 2048) = (u32x4){0u, 0u, 0u, 0u};
    if (F.tid < 32) *(LAS u32x4*)(qhist + 8192 + F.tid * 4) = (u32x4){0u, 0u, 0u, 0u};
    bf16x8 Qf[4][2]; float wh[4];
    { const bf16* qp = P + (size_t)(q0 + r) * PW;
#pragma unroll
      for (int h = 0; h < 4; ++h) { wh[h] = bf2f(qp[C_WI + h]);
#pragma unroll
          for (int kk = 0; kk < 2; ++kk) Qf[h][kk] = *(const bf16x8*)(qp + C_QI + h * 32 + kk * 16 + 8 * hh); } }
    bf16x8 Kf[2][2];
    { const int jf = (nrounds - (nrounds < 3 ? nrounds : 3)) * 8 + w; const int j0 = jf < nt ? jf : 0;
#pragma unroll
      for (int kb = 0; kb < 2; ++kb)
#pragma unroll
          for (int kk = 0; kk < 2; ++kk) Kf[kb][kk] = *(const bf16x8*)(P + (size_t)(j0 * 64 + kb * 32 + r) * PW + C_KI + kk * 16 + 8 * hh); }
    __syncthreads();
    LAS unsigned* nlast = nq + 32;
    const int R0 = nrounds < 3 ? nrounds : 3, nvr = nrounds + R0;
    asm volatile(".p2align 8" ::: "memory");
    for (int vr = 0; vr < nvr; ++vr) {
        const int rd = vr < R0 ? nrounds - R0 + vr : vr - R0;
        const int mode = vr < R0 ? 0 : (rd >= nrounds - R0 ? 2 : 1);
        const int j = rd * 8 + w;
        int rr = r; asm volatile("" : "+v"(rr));
        u32x2* myl = cand + (size_t)rr * DSA_CAP;
        if (j < nt) {
            f32x16 acc[2];
#pragma unroll
            for (int h = 0; h < 4; ++h)
#pragma unroll
                for (int kb = 0; kb < 2; ++kb) { f32x16 sv;
#pragma unroll
                    for (int i = 0; i < 16; ++i) sv[i] = 0.f;
                    sv = __builtin_amdgcn_mfma_f32_32x32x16_bf16(Kf[kb][0], Qf[h][0], sv, 0, 0, 0); sv = __builtin_amdgcn_mfma_f32_32x32x16_bf16(Kf[kb][1], Qf[h][1], sv, 0, 0, 0);
                    const f32x2 w2 = (f32x2){wh[h], wh[h]};
#pragma unroll
                    for (int i = 0; i < 16; i += 2) { const f32x2 rl = (f32x2){__builtin_amdgcn_fmed3f(sv[i], 0.f, __builtin_inff()), __builtin_amdgcn_fmed3f(sv[i + 1], 0.f, __builtin_inff())};
                        const f32x2 a2 = (h == 0) ? __builtin_elementwise_fma(w2, rl, (f32x2){0.f, 0.f}) : __builtin_elementwise_fma(w2, rl, (f32x2){acc[kb][i], acc[kb][i + 1]});
                        acc[kb][i] = a2.x; acc[kb][i + 1] = a2.y; } }
            LAS unsigned* myv = (LAS unsigned*)wscr + lane * 36;
            unsigned pm = 0u;
            if (mode == 0) {
#pragma unroll
                for (int kb = 0; kb < 2; ++kb)
#pragma unroll
                    for (int g = 0; g < 4; ++g) { const unsigned b0 = dsa_bin_f(acc[kb][4 * g]), b1 = dsa_bin_f(acc[kb][4 * g + 1]), b2 = dsa_bin_f(acc[kb][4 * g + 2]), b3 = dsa_bin_f(acc[kb][4 * g + 3]); LAS unsigned* qh = qhist + rr * QHP;
                        (void)__hip_atomic_fetch_add(qh + (b0 >> 1), 1u << (16u * (b0 & 1u)), __ATOMIC_RELAXED, __HIP_MEMORY_SCOPE_WORKGROUP); (void)__hip_atomic_fetch_add(qh + (b1 >> 1), 1u << (16u * (b1 & 1u)), __ATOMIC_RELAXED, __HIP_MEMORY_SCOPE_WORKGROUP);
                        (void)__hip_atomic_fetch_add(qh + (b2 >> 1), 1u << (16u * (b2 & 1u)), __ATOMIC_RELAXED, __HIP_MEMORY_SCOPE_WORKGROUP); (void)__hip_atomic_fetch_add(qh + (b3 >> 1), 1u << (16u * (b3 & 1u)), __ATOMIC_RELAXED, __HIP_MEMORY_SCOPE_WORKGROUP); }
            } else {
                unsigned T1 = Tq[rr]; T1 = T1 == 0xffffffffu ? T1 : T1 + 1u; T1 = T1 < 0x007fffffu ? 0x007fffffu : T1;
                const float Tf = __builtin_bit_cast(float, (T1 & 0x80000000u) ? (T1 & 0x7fffffffu) : ~T1);
#define DSA_C2(n) "v_cmp_ge_f32 vcc, %" #n ", %9\n\tv_addc_co_u32 %0, vcc, %0, %0, vcc\n\t"
#pragma unroll
                for (int e8 = 3; e8 >= 0; --e8) { const int kb = e8 >> 1, o8 = (e8 & 1) * 8;
                    asm(DSA_C2(8) DSA_C2(7) DSA_C2(6) DSA_C2(5) DSA_C2(4) DSA_C2(3) DSA_C2(2) DSA_C2(1) : "+v"(pm)
                        : "v"(acc[kb][o8]), "v"(acc[kb][o8 + 1]), "v"(acc[kb][o8 + 2]), "v"(acc[kb][o8 + 3]), "v"(acc[kb][o8 + 4]), "v"(acc[kb][o8 + 5]), "v"(acc[kb][o8 + 6]), "v"(acc[kb][o8 + 7]), "v"(Tf) : "vcc"); }
#undef DSA_C2
#pragma unroll
                for (int kb = 0; kb < 2; ++kb)
#pragma unroll
                    for (int g = 0; g < 4; ++g) *(LAS f32x4*)(myv + kb * 16 + 4 * g) = (f32x4){acc[kb][4 * g], acc[kb][4 * g + 1], acc[kb][4 * g + 2], acc[kb][4 * g + 3]};
            }
            asm volatile("s_waitcnt lgkmcnt(0)" ::: "memory");
            if (__any(pm != 0u)) {
                unsigned pos1 = 0u;
                if (pm) pos1 = __hip_atomic_fetch_add(nq + rr, (unsigned)__popc(pm), __ATOMIC_RELAXED, __HIP_MEMORY_SCOPE_WORKGROUP);
                while (__any(pm != 0u)) {
                    if (pm) { const int e = __builtin_ctz(pm); pm &= pm - 1u; const unsigned sv1 = sortable(__builtin_bit_cast(float, myv[e]));
                        if (mode == 1) { const unsigned bn = dsa_bin(sv1); (void)__hip_atomic_fetch_add(qhist + rr * QHP + (bn >> 1), 1u << (16u * (bn & 1u)), __ATOMIC_RELAXED, __HIP_MEMORY_SCOPE_WORKGROUP); }
                        myl[pos1++] = (u32x2){sv1, (unsigned)(j * 64 + (e >> 4) * 32 + (e & 3) + 8 * ((e & 15) >> 2) + 4 * hh)}; }
                }
            }
        }
        { const int nv = vr + 1, nrd = nv < R0 ? nrounds - R0 + nv : nv - R0; int jn = nrd * 8 + w; if (jn >= nt || nv >= nvr) jn = (j < nt ? j : 0);
#pragma unroll
          for (int kb = 0; kb < 2; ++kb)
#pragma unroll
              for (int kk = 0; kk < 2; ++kk) Kf[kb][kk] = *(const bf16x8*)(P + (size_t)(jn * 64 + kb * 32 + r) * PW + C_KI + kk * 16 + 8 * hh); }
        LAS unsigned* oflag = nq + 64;
        { const int q = w * 4 + (lane >> 4); const unsigned n = nq[q]; const bool over = n > (unsigned)DSA_TRIG;
          if (__any(over)) { if (lane == 0) oflag[0] = 1u; }
          const bool want = !over && !(mode == 1 && n < nlast[q] + 1u);
          if (__any(want)) { if (want && (lane & 15) == 0) nlast[q] = n;
              dsa_hist_T4(qhist + (w * 4) * QHP, Tq + w * 4, lane, want); } }
        __syncthreads();
        if (oflag[0]) {
            asm volatile("s_waitcnt vmcnt(0)" ::: "memory");
            __syncthreads();
#pragma unroll 1
            for (int qq = 0; qq < 4; ++qq) { const int q = w * 4 + qq; const unsigned n = nq[q];
                if (n > (unsigned)DSA_TRIG) {
                    const unsigned Th = dsa_hist_T(qhist + q * QHP, lane);
                    dsa_prune(cand + (size_t)q * DSA_CAP, nq, Tq, q, (LAS u32x2*)wscr, hist, lane, false, Th > Tq[q] ? Th : Tq[q]);
                    const int n2 = (int)nq[q]; LAS unsigned* qh = qhist + q * QHP;
                    *(LAS u32x4*)(qh + 4 * lane) = (u32x4){0u, 0u, 0u, 0u};
                    asm volatile("s_waitcnt lgkmcnt(0)" ::: "memory");
#pragma unroll 1
                    for (int i = lane; i < n2; i += 64) { const unsigned bn = dsa_bin(ld_list(cand + (size_t)q * DSA_CAP + i).x); (void)__hip_atomic_fetch_add(qh + (bn >> 1), 1u << (16u * (bn & 1u)), __ATOMIC_RELAXED, __HIP_MEMORY_SCOPE_WORKGROUP); }
                    __builtin_amdgcn_fence(__ATOMIC_ACQUIRE, "agent");
                    asm volatile("s_waitcnt vmcnt(0) lgkmcnt(0)" ::: "memory");
                    if (lane == 0) nlast[q] = (unsigned)n2;
                } }
            __syncthreads();
            if (F.tid == 0) oflag[0] = 0u;
            __syncthreads();
        }
    }
    asm volatile("s_waitcnt vmcnt(0)" ::: "memory");
    __syncthreads();
    dsa_hist_T4(qhist + (w * 4) * QHP, Tq + w * 4, lane, true);
    __syncthreads();
#pragma unroll 1
    for (int qq = 0; qq < 4; ++qq) {
        const int q = w * 4 + qq, qrow = q0 + q; const int n0 = (int)nq[q];
        LAS unsigned* bmp = (LAS unsigned*)(F.lds + 107008 + w * 2048);
        *(LAS u32x4*)(bmp + 8 * lane) = (u32x4){0u, 0u, 0u, 0u}; *(LAS u32x4*)(bmp + 8 * lane + 4) = (u32x4){0u, 0u, 0u, 0u};
        asm volatile("s_waitcnt lgkmcnt(0)" ::: "memory");
        const int n = dsa_final(cand + (size_t)q * DSA_CAP, n0, n0 > 256 ? Tq[q] : 0u, n0 > 256 ? Tq[DSA_TU + q] : 0u, (LAS u32x2*)wscr, hist, bmp, lane);
        unsigned short* srow = (unsigned short*)(F.ws + WS_SEL) + (size_t)qrow * 256;
        { const u32x4 b0 = *(LAS u32x4*)(bmp + 8 * lane), b1 = *(LAS u32x4*)(bmp + 8 * lane + 4); const unsigned wd[8] = {b0.x, b0.y, b0.z, b0.w, b1.x, b1.y, b1.z, b1.w};
          unsigned cnt = 0u;
#pragma unroll
          for (int i = 0; i < 8; ++i) cnt += (unsigned)__popc(wd[i]);
          unsigned pos = wave_prefix_incl(cnt) - cnt;
#pragma unroll
          for (int i = 0; i < 8; ++i) { unsigned wv = wd[i]; while (wv) { const int bpos = __builtin_ctz(wv); srow[pos < 255u ? pos : 255u] = (unsigned short)(lane * 256 + i * 32 + bpos); ++pos; wv &= wv - 1u; } } }
        if (lane == 0) ((int*)(F.ws + WS_NSEL))[qrow] = n < 256 ? n : 256;
    }
    asm volatile("s_waitcnt vmcnt(0)" ::: "memory");
}
__device__ __forceinline__ void dsa_pack_phase(Frame& F) {
    const bf16* P = (const bf16*)(F.ws + WS_PU); unsigned char* T8 = F.ws + WS_KV8;
    for (int t = F.bid * 512 + F.tid; t < S * 32; t += F.G * 512) {
        const int row = t >> 5, ch = t & 31;
        const bf16* src = P + (size_t)row * PW + C_KA + ch * 16;
        const u32x4 a0 = *(const u32x4*)src, a1 = *(const u32x4*)(src + 8);
        u32x4 o; int v;
        v = __builtin_amdgcn_cvt_pk_fp8_f32(bflo(a0.x), bfhi(a0.x), 0, false); v = __builtin_amdgcn_cvt_pk_fp8_f32(bflo(a0.y), bfhi(a0.y), v, true); o.x = (unsigned)v;
        v = __builtin_amdgcn_cvt_pk_fp8_f32(bflo(a0.z), bfhi(a0.z), 0, false); v = __builtin_amdgcn_cvt_pk_fp8_f32(bflo(a0.w), bfhi(a0.w), v, true); o.y = (unsigned)v;
        v = __builtin_amdgcn_cvt_pk_fp8_f32(bflo(a1.x), bfhi(a1.x), 0, false); v = __builtin_amdgcn_cvt_pk_fp8_f32(bflo(a1.y), bfhi(a1.y), v, true); o.z = (unsigned)v;
        v = __builtin_amdgcn_cvt_pk_fp8_f32(bflo(a1.z), bfhi(a1.z), 0, false); v = __builtin_amdgcn_cvt_pk_fp8_f32(bflo(a1.w), bfhi(a1.w), v, true); o.w = (unsigned)v;
        *(u32x4*)(T8 + (size_t)row * 512 + ch * 16) = o;
    }
}
__device__ __forceinline__ void dsa_sparse_unit(Frame& F, int G32) {
    const bf16* P = (const bf16*)(F.ws + WS_PU); bf16* Y = (bf16*)(F.ws + WS_Y);
    const int lane = F.lane, w = F.wave, q0 = G32 * 32;
    int n_nx; unsigned long long id_nx; u32x4 a0_nx, a1_nx;
#define SP_PREF(qrow_) do { int l3 = lane; asm volatile("" : "+v"(l3)); n_nx = ((const int*)(F.ws + WS_NSEL))[qrow_]; id_nx = ((const unsigned long long*)((const unsigned short*)(F.ws + WS_SEL) + (size_t)(qrow_) * 256))[l3]; \
        a0_nx = *(const u32x4*)(P + (size_t)(qrow_) * PW + C_QA + (l3 & 15) * 16); a1_nx = *(const u32x4*)(P + (size_t)(qrow_) * PW + C_QA + (l3 & 15) * 16 + 8); } while (0)
    SP_PREF(q0 + w * 4);
#pragma unroll 1
    for (int qq = 0; qq < 4; ++qq) {
        int l2 = lane; asm volatile("" : "+v"(l2)); const int ks = l2 >> 4, dg = l2 & 15;
        const int q = w * 4 + qq, qrow = q0 + q; const int n = n_nx;
        LAS unsigned short* srt = (LAS unsigned short*)(F.lds + w * 1024 + (qq & 1) * 512);
        ((LAS unsigned long long*)srt)[lane] = id_nx;
        const u32x4 a0 = a0_nx, a1 = a1_nx;
        if (qq < 3) SP_PREF(qrow + 1);
        asm volatile("s_waitcnt lgkmcnt(0)" ::: "memory");
        f32x2 qv[8];
        { const float sc = 0.125f * 1.4426950408889634f;
          qv[0] = (f32x2){bflo(a0.x) * sc, bfhi(a0.x) * sc}; qv[1] = (f32x2){bflo(a0.y) * sc, bfhi(a0.y) * sc}; qv[2] = (f32x2){bflo(a0.z) * sc, bfhi(a0.z) * sc}; qv[3] = (f32x2){bflo(a0.w) * sc, bfhi(a0.w) * sc};
          qv[4] = (f32x2){bflo(a1.x) * sc, bfhi(a1.x) * sc}; qv[5] = (f32x2){bflo(a1.y) * sc, bfhi(a1.y) * sc}; qv[6] = (f32x2){bflo(a1.z) * sc, bfhi(a1.z) * sc}; qv[7] = (f32x2){bflo(a1.w) * sc, bfhi(a1.w) * sc}; }
        float mrun = -1e30f, lrun = 0.f; f32x2 o[8];
#pragma unroll
        for (int i = 0; i < 8; ++i) o[i] = (f32x2){0.f, 0.f};
        const int nb = (n + 31) >> 5;
        const unsigned char* T8 = F.ws + WS_KV8 + dg * 16;
        asm volatile(".p2align 8" ::: "memory");
#pragma unroll 1
        for (int bt = 0; bt < nb; ++bt) {
            u32x4 kk[8], vv[8]; bool val[8];
#pragma unroll
            for (int t = 0; t < 8; ++t) { const int jn = bt * 32 + t * 4 + ks; val[t] = jn < n; const unsigned idx = val[t] ? (unsigned)srt[jn] : 0u;
                const unsigned char* kp = T8 + (size_t)idx * 512; kk[t] = *(const u32x4*)kp; vv[t] = *(const u32x4*)(kp + 256); }
            float d[8];
#pragma unroll
            for (int t = 0; t < 8; ++t) { f32x2 d2 = (f32x2){0.f, 0.f};
#pragma unroll
                for (int c4 = 0; c4 < 4; ++c4) { const int wd = (int)kk[t][c4]; const f32x2 lo = __builtin_amdgcn_cvt_pk_f32_fp8(wd, false), hi = __builtin_amdgcn_cvt_pk_f32_fp8(wd, true);
                    d2 = __builtin_elementwise_fma(qv[2 * c4], lo, d2); d2 = __builtin_elementwise_fma(qv[2 * c4 + 1], hi, d2); }
                float dd = d2.x + d2.y;
                dd += __builtin_bit_cast(float, __builtin_amdgcn_update_dpp(0, __builtin_bit_cast(int, dd), 0xB1, 0xf, 0xf, false));
                dd += __builtin_bit_cast(float, __builtin_amdgcn_update_dpp(0, __builtin_bit_cast(int, dd), 0x4E, 0xf, 0xf, false));
                d[t] = val[t] ? dd : -1e30f; }
            const float dm = fmaxf(fmaxf(fmaxf(d[0], d[1]), fmaxf(d[2], d[3])), fmaxf(fmaxf(d[4], d[5]), fmaxf(d[6], d[7])));
            if (__any(dm > mrun + 8.f)) { const float mn = fmaxf(mrun, dm), al = __builtin_amdgcn_exp2f(mrun - mn); mrun = mn; lrun *= al;
#pragma unroll
                for (int i = 0; i < 8; ++i) o[i] *= al; }
            float p[8];
#pragma unroll
            for (int t = 0; t < 8; ++t) { p[t] = val[t] ? __builtin_amdgcn_exp2f(d[t] - mrun) : 0.f; lrun += p[t]; }
#pragma unroll
            for (int t = 0; t < 8; ++t) { const f32x2 p2 = (f32x2){p[t], p[t]};
#pragma unroll
                for (int c4 = 0; c4 < 4; ++c4) { const int wd = (int)vv[t][c4]; const f32x2 lo = __builtin_amdgcn_cvt_pk_f32_fp8(wd, false), hi = __builtin_amdgcn_cvt_pk_f32_fp8(wd, true);
                    o[2 * c4] = __builtin_elementwise_fma(p2, lo, o[2 * c4]); o[2 * c4 + 1] = __builtin_elementwise_fma(p2, hi, o[2 * c4 + 1]); } }
        }
        { float ma = fmaxf(mrun, __shfl_xor(mrun, 16)); ma = fmaxf(ma, __shfl_xor(ma, 32)); const float al = __builtin_amdgcn_exp2f(mrun - ma);
          lrun *= al; lrun += __shfl_xor(lrun, 16); lrun += __shfl_xor(lrun, 32); const float iv = 1.f / lrun;
#pragma unroll
          for (int i = 0; i < 8; ++i) { float t = o[i].x * al; t += __shfl_xor(t, 16); t += __shfl_xor(t, 32); o[i].x = t * iv; t = o[i].y * al; t += __shfl_xor(t, 16); t += __shfl_xor(t, 32); o[i].y = t * iv; } }
        if (ks == 0) { u32x4 y0, y1; y0.x = pk2(o[0].x, o[0].y); y0.y = pk2(o[1].x, o[1].y); y0.z = pk2(o[2].x, o[2].y); y0.w = pk2(o[3].x, o[3].y); y1.x = pk2(o[4].x, o[4].y); y1.y = pk2(o[5].x, o[5].y); y1.z = pk2(o[6].x, o[6].y); y1.w = pk2(o[7].x, o[7].y);
            *(u32x4*)(Y + (size_t)qrow * 256 + dg * 16) = y0; *(u32x4*)(Y + (size_t)qrow * 256 + dg * 16 + 8) = y1; }
    }
}
__device__ __forceinline__ void dsa_phase(Frame& F) {
#pragma unroll 1
    for (int i2 = F.bid * 2; i2 < 512; i2 += F.G * 2)
#pragma unroll 1
        for (int rep = 0; rep < 2; ++rep) dsa_unit(F, rep ? 511 - (i2 >> 1) : (i2 >> 1));
    __syncthreads();
}
__device__ __forceinline__ void dsa_sparse_phase(Frame& F) {
#pragma unroll 1
    for (int i2 = F.bid * 2; i2 < 512; i2 += F.G * 2)
#pragma unroll 1
        for (int rep = 0; rep < 2; ++rep) dsa_sparse_unit(F, rep ? 511 - (i2 >> 1) : (i2 >> 1));
}

__device__ __forceinline__ void phase_mixers_stub(Frame& F) {
    u32x4* y = (u32x4*)(F.ws + WS_Y); const size_t n = (size_t)1 * S * 256 * 2 / 16;
    for (size_t i = (size_t)F.bid * 512 + F.tid; i < n; i += (size_t)F.G * 512) y[i] = (u32x4){0u, 0u, 0u, 0u};
}

__device__ __forceinline__ Frame mkframe() {
    Frame F; int t = threadIdx.x; asm volatile("" : "+v"(t));
    extern __shared__ __attribute__((aligned(16))) unsigned char lds_raw[];
    F.lds = (LAS unsigned char*)lds_raw; F.ws = kargs()->ws; F.ctl = (unsigned*)(F.ws + WS_CTL);
    F.tid = t; F.lane = t & 63; F.wave = __builtin_amdgcn_readfirstlane(t >> 6); F.G = gridDim.x; F.bid = blockIdx.x;
    return F;
}
__device__ __forceinline__ void grid_barrier() {
    extern __shared__ __attribute__((aligned(16))) unsigned char lds_raw[];
    XcdBarrier b; b.bar = (unsigned*)(kargs()->ws + WS_CTL) + CW_BAR; b.x = xb_xcc_id(); b.st = (volatile LAS unsigned*)((LAS unsigned char*)lds_raw + MISC_OFF) + 8;
    xcd_barrier(b);
}
constexpr int NSEG = 14;
#ifndef SEGMASK
#define SEGMASK 0xffff
#endif
template <int l> __device__ __forceinline__ void layer_body() {
#if MK_MULTI
#define RUN(k) (((SEGMASK >> (k)) & 1) && (l * NSEG + (k)) >= kargs()->seg_lo && (l * NSEG + (k)) < kargs()->seg_hi)
#define SEAM(k) do { } while (0)
#else
#define RUN(k) ((SEGMASK >> (k)) & 1)
#define SEAM(k) grid_barrier()
#endif
    {
        if (RUN(0) && l == 0) {
            Frame F = mkframe();
            phase_convert(F, l);
            if (l == 0) { const int gw = F.bid * 8 + F.wave, NGW = F.G * 8; const float* x0 = kargs()->in[0]; const float* g0 = kargs()->in[1];
#pragma unroll 2
                for (int m = gw; m < S; m += NGW) rms_row_to_bf16(x0 + (size_t)m * D, g0, (bf16*)(F.ws + WS_H) + (size_t)m * D, F.lane); }
        }
        if (l == 0) SEAM(0);
        if (RUN(1)) {
            Frame F = mkframe();
            pg8::Gemm g{(const bf16*)(F.ws + WS_H), (const bf16*)(F.ws + WS_WIN), S, PW, 1024}; pg8::StaticOrder So; So.init(S, PW, F.G, F.bid);
            pg8::EpiStore E{(bf16*)(F.ws + WS_PU), PW, 0x7fffffff, F.ws + WS_KV8};
            pg8::gemm_phase<pg8::EpiStore, pg8::StaticOrder, true, true>(F.lds, g, So, E, F.tid);
        }
        SEAM(1);
        if (RUN(2)) { Frame F = mkframe(); ml_phase1(F, l); }
        if (RUN(2)) { Frame F = mkframe(); attn_phase<0>(F, l); }
        SEAM(2);
        if (RUN(3)) { Frame F = mkframe(); ml_phase3(F, l); }
        if (RUN(3)) { Frame F = mkframe(); attnD_phase(F, l); }
        SEAM(3);
        if (RUN(4)) { Frame F = mkframe(); ml_phase4(F); }
        if (RUN(4)) { Frame F = mkframe(); dsa_phase(F); }
        if (RUN(4)) { Frame F = mkframe(); dsa_sparse_phase(F); }
        SEAM(4);
        if (RUN(5)) { Frame F = mkframe(); ml_phase5(F, l); }
        SEAM(5);
        if (RUN(6)) {
            Frame F = mkframe();
            pg8::Gemm g{(const bf16*)(F.ws + WS_Y), (const bf16*)(F.ws + WS_WBR), 4 * S, 4096, 256}; pg8::SchedUp Su{F.G, F.bid};
            pg8::EpiStore E{(bf16*)(F.ws + WS_PU), 4096, 63, nullptr};
            pg8::gemm_phase<pg8::EpiStore, pg8::SchedUp, true, true>(F.lds, g, Su, E, F.tid);
        }
        SEAM(6);
        if (RUN(7)) {
            Frame F = mkframe();
            pg8::Gemm g{(const bf16*)(F.ws + WS_H), (const bf16*)(F.ws + WS_WGATE), S, 4096, 1024}; pg8::StaticOrder So; So.init(S, 4096, F.G, F.bid);
            pg8::EpiGateMix E{(const bf16*)(F.ws + WS_PU), (bf16*)(F.ws + WS_MIXED)};
            pg8::gemm_phase<pg8::EpiGateMix, pg8::StaticOrder, true, true>(F.lds, g, So, E, F.tid);
        }
        SEAM(7);
        if (RUN(8)) {
            Frame F = mkframe();
            pg8::Gemm g{(const bf16*)(F.ws + WS_MIXED), (const bf16*)(F.ws + WS_WOUT), S, 1024, 1024}; pg8::StaticOrder So; So.init(S, 1024, F.G, F.bid);
            float* xo = kargs()->out;
            pg8::EpiResid E{(l == 0) ? kargs()->in[0] : (const float*)xo, xo};
            pg8::gemm_phase<pg8::EpiResid, pg8::StaticOrder, true, true>(F.lds, g, So, E, F.tid);
        }
        SEAM(8);
        if (RUN(9)) { Frame F = mkframe(); phase_router(F, l, kargs()->out); }
        SEAM(9);
        if (RUN(10)) { Frame F = mkframe(); phase_scatter(F, l); }
        SEAM(10);
        if (RUN(11)) {
            Frame F = mkframe();
            moe_table(F, l); const LAS int* tab = (const LAS int*)(F.lds + LDSCTL_OFF);
            pg8::Gemm g{(const bf16*)(F.ws + WS_XS), (const bf16*)(F.ws + WS_W13), NRMAX, NE * 1024, 1024}; pg8::SchedMoe Sm{F.G, F.bid, __builtin_amdgcn_readfirstlane(tab[224]) * 4, tab};
            pg8::EpiSwiglu E{(bf16*)(F.ws + WS_ACT)};
            pg8::gemm_phase<pg8::EpiSwiglu, pg8::SchedMoe, true, true>(F.lds, g, Sm, E, F.tid);
        }
        SEAM(11);
        if (RUN(12)) {
            Frame F = mkframe();
            moe_table(F, l); const LAS int* tab = (const LAS int*)(F.lds + LDSCTL_OFF);
            pg8::Gemm g{(const bf16*)(F.ws + WS_ACT), (const bf16*)(F.ws + WS_W2), NRMAX, NE * 1024, FE}; pg8::SchedMoe Sm{F.G, F.bid, __builtin_amdgcn_readfirstlane(tab[224]) * 4, tab};
            pg8::EpiDown E{(bf16*)(F.ws + WS_YE), (const float*)(F.ws + WS_RT + 393216)};
            pg8::gemm_phase<pg8::EpiDown, pg8::SchedMoe, true, true>(F.lds, g, Sm, E, F.tid);
        }
        SEAM(12);
        if (RUN(13)) { Frame F = mkframe(); phase_combine(F, l, kargs()->out); }
        if (RUN(13) && l + 1 < NL) { Frame F = mkframe(); phase_convert(F, l + 1); }
        if (l + 1 < NL) SEAM(13);
    }
#undef RUN
#undef SEAM
}
__global__ void __launch_bounds__(512, 2) fwd_kernel(Args args) {
    extern __shared__ __attribute__((aligned(16))) unsigned char lds_raw[];
    {
        LAS unsigned char* lds = (LAS unsigned char*)lds_raw;
        for (int u = threadIdx.x; u < (LDS_BYTES - LDSCTL_OFF) / 4; u += 512) ((LAS unsigned*)(lds + LDSCTL_OFF))[u] = 0u;
        __syncthreads();
        if (!MK_MULTI) (void)xcd_barrier_post((unsigned*)(kargs()->ws + WS_CTL) + CW_BAR, (volatile LAS unsigned*)(lds + MISC_OFF) + 8);
    }
    layer_body<0>();
    layer_body<1>();
}

extern "C" void kernel_launch(void* const* d_in, const int* in_sizes, int n_in, void* d_out, int out_size, void* d_ws, size_t ws_size, hipStream_t stream) {
    static int grid = 0;
    if (grid == 0) {
        if (n_in != 23 || out_size != S * D || ws_size < WS_END) { fprintf(stderr, "kernel_launch: unexpected shapes (n_in %d out %d ws %zu need %zu)\n", n_in, out_size, ws_size, (size_t)WS_END); grid = -1; return; }
        int dev = 0, cus = 0, per_cu = 0;
        if (hipGetDevice(&dev) != hipSuccess || hipDeviceGetAttribute(&cus, hipDeviceAttributeMultiprocessorCount, dev) != hipSuccess) { grid = -1; return; }
        if (hipFuncSetAttribute((const void*)fwd_kernel, hipFuncAttributeMaxDynamicSharedMemorySize, LDS_BYTES) != hipSuccess) { fprintf(stderr, "kernel_launch: hipFuncSetAttribute failed\n"); grid = -1; return; }
        if (hipOccupancyMaxActiveBlocksPerMultiprocessor(&per_cu, (const void*)fwd_kernel, 512, LDS_BYTES) != hipSuccess || per_cu < 1) fprintf(stderr, "kernel_launch: occupancy query says %d\n", per_cu);
        (void)hipGetLastError();
        grid = cus;
    }
    if (grid < 0) return;
    if (hipMemsetAsync((char*)d_ws + WS_CTL, 0, CTL_ZERO_BYTES, stream) != hipSuccess) return;
    Args a{};
    for (int i = 0; i < 23; ++i) a.in[i] = (const float*)d_in[i];
    a.out = (float*)d_out; a.ws = (unsigned char*)d_ws;
#if MK_MULTI
    for (int s = 0; s < NL * NSEG; ++s) { a.seg_lo = s; a.seg_hi = s + 1; hipLaunchKernelGGL(fwd_kernel, dim3(grid), dim3(512), LDS_BYTES, stream, a); }
#else
    a.seg_lo = 0; a.seg_hi = NL * NSEG;
    hipLaunchKernelGGL(fwd_kernel, dim3(grid), dim3(512), LDS_BYTES, stream, a);
#endif
}
```

```cpp
#include <hip/hip_runtime.h>
#include <cstdio>
#include <cstdint>

#define GAS __attribute__((address_space(1)))
#define LAS __attribute__((address_space(3)))
typedef unsigned short bf16;
typedef short bf16x8 __attribute__((ext_vector_type(8)));
typedef short s16x4 __attribute__((ext_vector_type(4)));
typedef float f32x2 __attribute__((ext_vector_type(2)));
typedef float f32x4 __attribute__((ext_vector_type(4)));
typedef float f32x16 __attribute__((ext_vector_type(16)));
typedef unsigned u32x2 __attribute__((ext_vector_type(2)));
typedef unsigned u32x4 __attribute__((ext_vector_type(4)));

#ifndef MK_MULTI
#define MK_MULTI 0
#endif

constexpr int S = 16384, D = 1024, NL = 2, NCH = 256;
constexpr int PW = 3584;
constexpr int C_QA = 0, C_KA = 256, C_VA = 512, C_QI = 768, C_KI = 896, C_WI = 928, C_IB = 932, C_FB = 936, C_QB = 960, C_KB = 1216,
              C_VB = 1472, C_OB = 1728, C_QC = 1984, C_KC = 2240, C_VC = 2496, C_QD = 2752, C_KD = 3008, C_VD = 3264;
constexpr int CIN = 3500;
constexpr int NE = 32, FE = 512, NRMAX = 40960, NBMAX = 160;
constexpr float RMS_EPS = 1e-6f;

constexpr size_t MiB = 1u << 20;
constexpr size_t WS_CTL = 0, CTL_ZERO_BYTES = 1 * MiB;
constexpr size_t WS_WIN = 1 * MiB;
constexpr size_t WS_WBR = WS_WIN + 7 * MiB;
constexpr size_t WS_WGATE = WS_WBR + 2 * MiB;
constexpr size_t WS_WOUT = WS_WGATE + 8 * MiB;
constexpr size_t WS_W13 = WS_WOUT + 2 * MiB;
constexpr size_t WS_W2 = WS_W13 + 64 * MiB;
constexpr size_t WS_H = WS_W2 + 32 * MiB;
constexpr size_t WS_PU = WS_H + 32 * MiB;
constexpr size_t WS_XS = WS_PU;
constexpr size_t WS_ACT = WS_PU + 80 * MiB;
constexpr size_t WS_Y = WS_PU + 128 * MiB;
constexpr size_t WS_MIXED = WS_Y + 32 * MiB;
constexpr size_t WS_CAND = WS_MIXED + 32 * MiB;
constexpr size_t WS_YE = WS_Y;
constexpr size_t WS_MLC = WS_CAND + 128 * MiB;
constexpr size_t WS_MLN = WS_MLC + 16 * MiB;
constexpr size_t WS_MLS = WS_MLN + 256 * 1024;
constexpr size_t WS_RT = WS_MLS + 64 * 1024;
constexpr size_t WS_SEL = WS_RT + 1 * MiB;
constexpr size_t WS_NSEL = WS_SEL + 8 * MiB;
constexpr size_t WS_KV8 = WS_NSEL + 1 * MiB;
constexpr size_t WS_END = WS_KV8 + 8 * MiB;
static_assert(WS_YE + (size_t)NRMAX * 1024 * 2 <= WS_MLC, "ye overlay");
static_assert(WS_ACT + (size_t)NRMAX * 512 * 2 <= WS_Y, "act overlay");
constexpr int CW_BAR = 4096;
constexpr int CW_CNT = 16384;
constexpr int CW_FILL = 16384 + 64;

constexpr int RING_BYTES = 131072;
constexpr int LDS_BYTES = 163840;
constexpr int LDSCTL_OFF = LDS_BYTES - 2048;
constexpr int MISC_OFF = LDSCTL_OFF + 1024;

__device__ __forceinline__ unsigned f2bf(float f) { unsigned u = __builtin_bit_cast(unsigned, f); return (u + 0x7fffu + ((u >> 16) & 1u)) >> 16; }
typedef __bf16 bf16v2_t __attribute__((ext_vector_type(2)));
__device__ __forceinline__ unsigned pk2(float lo, float hi) { return __builtin_bit_cast(unsigned, __builtin_convertvector((f32x2){lo, hi}, bf16v2_t)); }
__device__ __forceinline__ float bflo(unsigned w) { return __builtin_bit_cast(float, w << 16); }
__device__ __forceinline__ float bfhi(unsigned w) { return __builtin_bit_cast(float, w & 0xffff0000u); }
__device__ __forceinline__ float bf2f(bf16 b) { return __builtin_bit_cast(float, (unsigned)b << 16); }
#define LDS_WAIT() asm volatile("s_waitcnt lgkmcnt(0)" ::: "memory")
#define VM_WAIT() asm volatile("s_waitcnt vmcnt(0)" ::: "memory")
__device__ __forceinline__ float wave_sum(float v) {
#pragma unroll
    for (int o = 1; o < 64; o <<= 1) v += __shfl_xor(v, o);
    return v;
}
__device__ __forceinline__ float wave_max(float v) {
#pragma unroll
    for (int o = 1; o < 64; o <<= 1) v = fmaxf(v, __shfl_xor(v, o));
    return v;
}

namespace pg8 {
#define PG8_LAS __attribute__((address_space(3)))
typedef unsigned short bf16_t;
constexpr int BM = 256, BK = 64, HALF = 128, HTB = HALF * BK * 2, STAGE_BYTES = 8 * HTB, NXCD = 8, WGM = 8;
__host__ __device__ __forceinline__ int lds_byte(int r, int c) { const int st = (r >> 4) * 2 + (c >> 5), rr = r & 15, cc = c & 31, ob = rr * 64 + cc * 2; return st * 1024 + (ob ^ (((ob >> 9) & 1) << 5)); }
__host__ __device__ __forceinline__ void stage_rc(int b, int& R, int& C) { const int st = b / 1024, sb = b % 1024, swz = sb ^ (((sb >> 9) & 1) << 5); R = (st >> 1) * 16 + swz / 64; C = (st & 1) * 32 + (swz % 64) / 2; }
__host__ __device__ __forceinline__ int perm32(int rho) { const int n = rho >> 4, i = rho & 15; return 8 * (i >> 2) + 4 * n + (i & 3); }
struct Unit { int pm, pn; };
struct Gemm { const bf16_t* A; const bf16_t* Bt; int M, N, K; const int* rt; };
struct StaticOrder {
    int nM, nN, nwg, G, c;
    __host__ __device__ void init(int M, int N, int G_, int c_) { nM = M / BM; nN = N / BM; nwg = nM * nN; G = G_; c = c_; }
    __host__ __device__ bool next(int i, Unit& u) const {
        const long L = (long)i * G + c; if (L >= nwg) return false;
        int wgid = (int)L; { const int q = nwg / NXCD, r = nwg % NXCD, xcd = wgid % NXCD, off = wgid / NXCD; wgid = (xcd < r ? xcd * (q + 1) : r * (q + 1) + (xcd - r) * q) + off; }
        const int nig = WGM * nN, gid = wgid / nig, fm = gid * WGM, gsz = (nM - fm) < WGM ? (nM - fm) : WGM;
        u.pm = fm + ((wgid % nig) % gsz); u.pn = (wgid % nig) / gsz; return true;
    }
    __device__ __forceinline__ void a_ready(const Unit&) const {}
    __device__ __forceinline__ void done(const Unit&) const {}
};
__device__ __forceinline__ unsigned cvt_pk_bf16(float lo, float hi) { unsigned r; asm volatile("v_cvt_pk_bf16_f32 %0, %1, %2" : "=v"(r) : "v"(lo), "v"(hi)); return r; }

template <class Epi, class Sched, bool ALIGN_EPI = false, bool SP2 = false, bool GATHER = false>
__device__ __forceinline__ void gemm_phase(PG8_LAS unsigned char* lds, const Gemm g, const Sched& S, const Epi& E, const int tid) {
    const int wid = __builtin_amdgcn_readfirstlane(tid >> 6), lane = tid & 63, wr = wid >> 2, wc = wid & 3, fr = lane & 15, fq = lane >> 4;
    int Kl_ = g.K; asm volatile("" : "+s"(Kl_));
    const int K = Kl_, nt = K / BK;
    unsigned voffA[2], voffB[2];
#pragma unroll
    for (int i = 0; i < 2; ++i) { int R, C; stage_rc(tid * 16 + i * 8192, R, C); const int Rb = Epi::PERM ? ((R & ~31) + perm32(R & 31)) : R;
        voffA[i] = (unsigned)(R * K + C) * 2u; voffB[i] = (unsigned)(Rb * K + C) * 2u; }
    unsigned vA[2][2] = {{0u, 0u}, {0u, 0u}}, nvA[2][2] = {{0u, 0u}, {0u, 0u}};
#define PG8_ROWS(dst, pm_) do { _Pragma("unroll") for (int h_ = 0; h_ < 2; ++h_) _Pragma("unroll") for (int i_ = 0; i_ < 2; ++i_) { int R_, C_; stage_rc(tid * 16 + i_ * 8192, R_, C_); \
        int src_ = g.rt[(pm_) * BM + h_ * HALF + R_]; src_ = (unsigned)src_ < (unsigned)g.M ? src_ : 0; dst[h_][i_] = (unsigned)(src_ * K + C_) * 2u; } \
        asm volatile("" : "+v"(dst[0][0]), "+v"(dst[0][1]), "+v"(dst[1][0]), "+v"(dst[1][1])); } while (0)
    const size_t kstep = (size_t)(BK * 2);
    const size_t hstep = (size_t)HALF * K * 2;
    const size_t tstep = 2 * hstep;
    const unsigned ldsw = (unsigned)wid * 1024u;
    const int aoff = lds_byte(wr * 64 + fr, fq * 8), boff = lds_byte(wc * 32 + fr, fq * 8);
#define PG8_SA(b, h) (((b) * 2 + (h)) * HTB)
#define PG8_SB(b, h) ((4 + (b) * 2 + (h)) * HTB)
#define PG8_STAGE(bufoff, gbase, voff) do { _Pragma("unroll") for (int _i = 0; _i < 2; ++_i) \
        __builtin_amdgcn_global_load_lds((const unsigned*)((const char*)(gbase) + (voff)[_i]), (PG8_LAS unsigned*)(lds + (bufoff) + ldsw + _i * 8192), 16, 0, 0); } while (0)
#define PG8_LDA(dst, b, h) do { _Pragma("unroll") for (int m = 0; m < 4; ++m) _Pragma("unroll") for (int k = 0; k < 2; ++k) dst[m][k] = *(const PG8_LAS bf16x8*)(lds + PG8_SA(b, h) + aoff + m * 2048 + k * 1024); } while (0)
#define PG8_LDB(dst, b, h) do { _Pragma("unroll") for (int n = 0; n < 2; ++n) _Pragma("unroll") for (int k = 0; k < 2; ++k) dst[n][k] = *(const PG8_LAS bf16x8*)(lds + PG8_SB(b, h) + boff + n * 2048 + k * 1024); } while (0)
#define PG8_MMA(ai, bj, At, Bt) do { __builtin_amdgcn_s_setprio(1); _Pragma("unroll") for (int m = 0; m < 4; ++m) _Pragma("unroll") for (int n = 0; n < 2; ++n) _Pragma("unroll") for (int k = 0; k < 2; ++k) \
        acc[ai][bj][m][n] = __builtin_amdgcn_mfma_f32_16x16x32_bf16(Bt[n][k], At[m][k], acc[ai][bj][m][n], 0, 0, 0); __builtin_amdgcn_s_setprio(0); } while (0)
#define PG8_WAIT_V(n) asm volatile("s_waitcnt vmcnt(" #n ")" ::: "memory")
#define PG8_WAIT_L(n) asm volatile("s_waitcnt lgkmcnt(" #n ")" ::: "memory")
#define PG8_BAR __builtin_amdgcn_s_barrier()
#define PG8_SCHED __builtin_amdgcn_sched_barrier(0)
    Unit cur, nxt; int ui = 0;
    if (!S.next(0, cur)) return;
    f32x4 acc[2][2][4][2];
#pragma unroll
    for (int a = 0; a < 2; ++a)
#pragma unroll
        for (int b = 0; b < 2; ++b)
#pragma unroll
            for (int m = 0; m < 4; ++m)
#pragma unroll
                for (int n = 0; n < 2; ++n) acc[a][b][m][n] = (f32x4){0.f, 0.f, 0.f, 0.f};
    bf16x8 At[4][2], B0[2][2], B1[2][2];
    const char* cA = GATHER ? (const char*)g.A : (const char*)g.A + (size_t)cur.pm * tstep; const char* cB = (const char*)g.Bt + (size_t)cur.pn * tstep;
    S.a_ready(cur);
    if constexpr (GATHER) PG8_ROWS(vA, cur.pm);
    if constexpr (SP2) {
        PG8_STAGE(PG8_SB(0, 0), cB, voffB); PG8_STAGE(PG8_SB(0, 1), cB + hstep, voffB);
        if constexpr (GATHER) { PG8_STAGE(PG8_SA(0, 0), cA, vA[0]); PG8_STAGE(PG8_SA(0, 1), cA, vA[1]); } else { PG8_STAGE(PG8_SA(0, 0), cA, voffA); PG8_STAGE(PG8_SA(0, 1), cA + hstep, voffA); }
        if (wr == 1) PG8_BAR;
        PG8_WAIT_V(2); PG8_BAR;
        PG8_STAGE(PG8_SB(1, 0), cB + kstep, voffB);
        if constexpr (GATHER) PG8_STAGE(PG8_SA(1, 0), cA + kstep, vA[0]); else PG8_STAGE(PG8_SA(1, 0), cA + kstep, voffA);
        PG8_STAGE(PG8_SB(1, 1), cB + hstep + kstep, voffB);
        PG8_WAIT_V(6); PG8_BAR;
    } else {
        PG8_STAGE(PG8_SB(0, 0), cB, voffB); PG8_STAGE(PG8_SA(0, 0), cA, voffA); PG8_STAGE(PG8_SB(0, 1), cB + hstep, voffB); PG8_STAGE(PG8_SA(0, 1), cA + hstep, voffA);
        if (wr == 1) PG8_BAR;
        PG8_WAIT_V(4); PG8_BAR;
        PG8_STAGE(PG8_SB(1, 0), cB + kstep, voffB); PG8_STAGE(PG8_SA(1, 0), cA + kstep, voffA); PG8_STAGE(PG8_SB(1, 1), cB + hstep + kstep, voffB);
        PG8_WAIT_V(6); PG8_BAR;
    }
    asm volatile(".p2align 8" ::: "memory");
    for (;;) {
        const bool has_next = S.next(ui + 1, nxt);
        const char* nA = (has_next && !GATHER) ? (const char*)g.A + (size_t)nxt.pm * tstep : cA; const char* nB = has_next ? (const char*)g.Bt + (size_t)nxt.pn * tstep : cB;
        if constexpr (GATHER) { if (has_next) PG8_ROWS(nvA, nxt.pm); }
        for (int t = 0; t < nt; t += 2) {
            const bool last = (t == nt - 2);
            const char* a1 = cA + (size_t)(t + 1) * kstep;
            const char* a2 = last ? nA : cA + (size_t)(t + 2) * kstep; const char* b2 = last ? nB : cB + (size_t)(t + 2) * kstep;
            const char* a3 = a2 + kstep; const char* b3 = b2 + kstep;
            if (last && has_next) S.a_ready(nxt);
            if constexpr (SP2) {
            PG8_LDB(B0, 0, 0); PG8_LDB(B1, 0, 1); PG8_SCHED; PG8_LDA(At, 0, 0); if constexpr (GATHER) PG8_STAGE(PG8_SA(1, 1), a1, vA[1]); else PG8_STAGE(PG8_SA(1, 1), a1 + hstep, voffA);
            PG8_WAIT_V(8); PG8_WAIT_L(0); PG8_BAR; PG8_MMA(0, 0, At, B0); PG8_MMA(0, 1, At, B1); PG8_BAR; PG8_SCHED;
            PG8_LDA(At, 0, 1); PG8_STAGE(PG8_SB(0, 0), b2, voffB); PG8_STAGE(PG8_SB(0, 1), b2 + hstep, voffB); if constexpr (GATHER) { const unsigned o_[2] = {last ? nvA[0][0] : vA[0][0], last ? nvA[0][1] : vA[0][1]}; PG8_STAGE(PG8_SA(0, 0), a2, o_); } else PG8_STAGE(PG8_SA(0, 0), a2, voffA);
            PG8_WAIT_V(8); PG8_WAIT_L(0); PG8_BAR; PG8_MMA(1, 0, At, B0); PG8_MMA(1, 1, At, B1); PG8_BAR; PG8_SCHED;
            PG8_LDB(B0, 1, 0); PG8_LDB(B1, 1, 1); PG8_SCHED; PG8_LDA(At, 1, 0); if constexpr (GATHER) { const unsigned o_[2] = {last ? nvA[1][0] : vA[1][0], last ? nvA[1][1] : vA[1][1]}; PG8_STAGE(PG8_SA(0, 1), a2, o_); } else PG8_STAGE(PG8_SA(0, 1), a2 + hstep, voffA);
            PG8_WAIT_V(8); PG8_WAIT_L(0); PG8_BAR; PG8_MMA(0, 0, At, B0); PG8_MMA(0, 1, At, B1); PG8_BAR; PG8_SCHED;
            PG8_LDA(At, 1, 1); PG8_STAGE(PG8_SB(1, 0), b3, voffB); PG8_STAGE(PG8_SB(1, 1), b3 + hstep, voffB); if constexpr (GATHER) { const unsigned o_[2] = {last ? nvA[0][0] : vA[0][0], last ? nvA[0][1] : vA[0][1]}; PG8_STAGE(PG8_SA(1, 0), a3, o_); } else PG8_STAGE(PG8_SA(1, 0), a3, voffA);
            PG8_WAIT_V(8); PG8_WAIT_L(0); PG8_BAR; PG8_MMA(1, 0, At, B0); PG8_MMA(1, 1, At, B1); PG8_BAR; PG8_SCHED;
            } else {
            PG8_LDB(B0, 0, 0); PG8_SCHED; PG8_LDA(At, 0, 0); PG8_STAGE(PG8_SA(1, 1), a1 + hstep, voffA);
            PG8_WAIT_L(8); PG8_BAR; PG8_WAIT_L(0); PG8_MMA(0, 0, At, B0); PG8_BAR; PG8_SCHED;
            PG8_LDB(B1, 0, 1); PG8_STAGE(PG8_SB(0, 0), b2, voffB);
            PG8_BAR; PG8_WAIT_L(0); PG8_MMA(0, 1, At, B1); PG8_BAR;
            PG8_LDA(At, 0, 1); PG8_STAGE(PG8_SA(0, 0), a2, voffA);
            PG8_BAR; PG8_WAIT_L(0); PG8_MMA(1, 0, At, B0); PG8_BAR; PG8_SCHED;
            PG8_STAGE(PG8_SB(0, 1), b2 + hstep, voffB);
            PG8_WAIT_V(6); PG8_BAR; PG8_MMA(1, 1, At, B1); PG8_BAR;
            PG8_LDB(B0, 1, 0); PG8_SCHED; PG8_LDA(At, 1, 0); PG8_STAGE(PG8_SA(0, 1), a2 + hstep, voffA);
            PG8_WAIT_L(8); PG8_BAR; PG8_WAIT_L(0); PG8_MMA(0, 0, At, B0); PG8_BAR; PG8_SCHED;
            PG8_LDB(B1, 1, 1); PG8_STAGE(PG8_SB(1, 0), b3, voffB);
            PG8_BAR; PG8_WAIT_L(0); PG8_MMA(0, 1, At, B1); PG8_BAR;
            PG8_LDA(At, 1, 1); PG8_STAGE(PG8_SA(1, 0), a3, voffA);
            PG8_BAR; PG8_WAIT_L(0); PG8_MMA(1, 0, At, B0); PG8_BAR; PG8_SCHED;
            PG8_STAGE(PG8_SB(1, 1), b3 + hstep, voffB);
            PG8_WAIT_V(6); PG8_BAR; PG8_MMA(1, 1, At, B1); PG8_BAR;
            }
        }
        if constexpr (ALIGN_EPI) { if (wr == 0) PG8_BAR; }
        E(acc, cur, wr, wc, fr, fq); S.done(cur);
        if (!has_next) break;
#pragma unroll
        for (int a = 0; a < 2; ++a)
#pragma unroll
            for (int b = 0; b < 2; ++b)
#pragma unroll
                for (int m = 0; m < 4; ++m)
#pragma unroll
                    for (int n = 0; n < 2; ++n) acc[a][b][m][n] = (f32x4){0.f, 0.f, 0.f, 0.f};
        cur = nxt; cA = nA; cB = nB; ++ui;
        if constexpr (GATHER) { vA[0][0] = nvA[0][0]; vA[0][1] = nvA[0][1]; vA[1][0] = nvA[1][0]; vA[1][1] = nvA[1][1]; }
        if constexpr (ALIGN_EPI) { if (wr == 1) PG8_BAR; }
    }
    PG8_WAIT_V(0);
    if constexpr (!ALIGN_EPI) { if (wr == 0) PG8_BAR; }
    PG8_BAR;
#undef PG8_ROWS
#undef PG8_SA
#undef PG8_SB
#undef PG8_STAGE
#undef PG8_LDA
#undef PG8_LDB
#undef PG8_MMA
#undef PG8_WAIT_V
#undef PG8_WAIT_L
#undef PG8_BAR
#undef PG8_SCHED
}

struct EpiStore {
    static constexpr bool PERM = true;
    bf16_t* O; int ldc; int rowmask; unsigned char* T8;
    __device__ __forceinline__ void operator()(const f32x4 (&acc)[2][2][4][2], const Unit& u, int wr, int wc, int fr, int fq) const {
        const int row0 = (u.pm & rowmask) * BM + wr * 64 + fr, col0 = u.pn * BM + wc * 32 + 8 * fq;
        const bool side = T8 != nullptr && (u.pn == 1 || u.pn == 2);
#pragma unroll
        for (int ai = 0; ai < 2; ++ai)
#pragma unroll
            for (int m = 0; m < 4; ++m) { int row = row0 + ai * HALF + m * 16; asm volatile("" : "+v"(row)); bf16_t* rowp = O + (size_t)row * ldc + col0;
#pragma unroll
                for (int bj = 0; bj < 2; ++bj) { const f32x4 v0 = acc[ai][bj][m][0], v1 = acc[ai][bj][m][1];
                    u32x4 w; w.x = cvt_pk_bf16(v0[0], v0[1]); w.y = cvt_pk_bf16(v0[2], v0[3]); w.z = cvt_pk_bf16(v1[0], v1[1]); w.w = cvt_pk_bf16(v1[2], v1[3]);
                    *(u32x4*)(rowp + bj * HALF) = w;
                    if (side) { int q0 = __builtin_amdgcn_cvt_pk_fp8_f32(v0[0], v0[1], 0, false); q0 = __builtin_amdgcn_cvt_pk_fp8_f32(v0[2], v0[3], q0, true);
                        int q1 = __builtin_amdgcn_cvt_pk_fp8_f32(v1[0], v1[1], 0, false); q1 = __builtin_amdgcn_cvt_pk_fp8_f32(v1[2], v1[3], q1, true);
                        *(u32x2*)(T8 + (size_t)row * 512 + (col0 + bj * HALF - 256)) = (u32x2){(unsigned)q0, (unsigned)q1}; } } }
    }
};
__device__ __forceinline__ float sigmoidf_(float x) { return __builtin_amdgcn_rcpf(1.f + __expf(-x)); }
struct EpiGateMix {
    static constexpr bool PERM = true;
    const bf16_t* U; bf16_t* MX;
    __device__ __forceinline__ void operator()(const f32x4 (&acc)[2][2][4][2], const Unit& u, int wr, int wc, int fr, int fq) const {
        const int row0 = u.pm * BM + wr * 64 + fr, dcol = u.pn * 64 + wc * 16 + fq * 4;
        u32x2 un[4];
        { int row = row0; asm volatile("" : "+v"(row)); const bf16_t* up = U + (size_t)row * 4096 + dcol;
#pragma unroll
          for (int b4 = 0; b4 < 4; ++b4) un[b4] = *(const u32x2*)(up + b4 * 1024); }
#pragma unroll
        for (int it = 0; it < 8; ++it) { const int ai = it >> 2, m = it & 3;
            u32x2 uc[4];
#pragma unroll
            for (int b4 = 0; b4 < 4; ++b4) uc[b4] = un[b4];
            if (it < 7) { int rown = row0 + ((it + 1) >> 2) * HALF + ((it + 1) & 3) * 16; asm volatile("" : "+v"(rown)); const bf16_t* up = U + (size_t)rown * 4096 + dcol;
#pragma unroll
                for (int b4 = 0; b4 < 4; ++b4) un[b4] = *(const u32x2*)(up + b4 * 1024); }
            int row = row0 + ai * HALF + m * 16; asm volatile("" : "+v"(row));
            float o0 = 0.f, o1 = 0.f, o2 = 0.f, o3 = 0.f;
#pragma unroll
            for (int bj = 0; bj < 2; ++bj)
#pragma unroll
                for (int n = 0; n < 2; ++n) { const u32x2 uu = uc[2 * bj + n]; const f32x4 a = acc[ai][bj][m][n];
                    o0 += sigmoidf_(a[0]) * bflo(uu.x); o1 += sigmoidf_(a[1]) * bfhi(uu.x); o2 += sigmoidf_(a[2]) * bflo(uu.y); o3 += sigmoidf_(a[3]) * bfhi(uu.y); }
            u32x2 w; w.x = cvt_pk_bf16(o0, o1); w.y = cvt_pk_bf16(o2, o3);
            *(u32x2*)(MX + (size_t)row * 1024 + dcol) = w; }
    }
};
template <bool INBF>
struct EpiResid {
    static constexpr bool PERM = true;
    const void* xin; bf16_t* xout;
    __device__ __forceinline__ f32x4 ld4(size_t off) const {
        if constexpr (INBF) { const u32x2 w = *(const u32x2*)((const bf16_t*)xin + off); return (f32x4){__builtin_bit_cast(float, w.x << 16), __builtin_bit_cast(float, w.x & 0xffff0000u), __builtin_bit_cast(float, w.y << 16), __builtin_bit_cast(float, w.y & 0xffff0000u)}; }
        else return *(const f32x4*)((const float*)xin + off);
    }
    __device__ __forceinline__ void operator()(const f32x4 (&acc)[2][2][4][2], const Unit& u, int wr, int wc, int fr, int fq) const {
        const int row0 = u.pm * BM + wr * 64 + fr, col0 = u.pn * BM + wc * 32 + 8 * fq;
        f32x4 xn[4];
        { int row = row0; asm volatile("" : "+v"(row)); const size_t xo_ = (size_t)row * 1024 + col0;
#pragma unroll
          for (int q4 = 0; q4 < 4; ++q4) xn[q4] = ld4(xo_ + (q4 >> 1) * HALF + 4 * (q4 & 1)); }
#pragma unroll
        for (int it = 0; it < 8; ++it) { const int ai = it >> 2, m = it & 3;
            f32x4 xc[4];
#pragma unroll
            for (int q4 = 0; q4 < 4; ++q4) xc[q4] = xn[q4];
            if (it < 7) { int rown = row0 + ((it + 1) >> 2) * HALF + ((it + 1) & 3) * 16; asm volatile("" : "+v"(rown)); const size_t xo_ = (size_t)rown * 1024 + col0;
#pragma unroll
                for (int q4 = 0; q4 < 4; ++q4) xn[q4] = ld4(xo_ + (q4 >> 1) * HALF + 4 * (q4 & 1)); }
            int row = row0 + ai * HALF + m * 16; asm volatile("" : "+v"(row)); const size_t ro = (size_t)row * 1024 + col0;
#pragma unroll
            for (int bj = 0; bj < 2; ++bj) { const f32x4 s0 = xc[2 * bj] + acc[ai][bj][m][0], s1 = xc[2 * bj + 1] + acc[ai][bj][m][1];
                u32x4 w; w.x = cvt_pk_bf16(s0[0], s0[1]); w.y = cvt_pk_bf16(s0[2], s0[3]); w.z = cvt_pk_bf16(s1[0], s1[1]); w.w = cvt_pk_bf16(s1[2], s1[3]);
                *(u32x4*)(xout + ro + bj * HALF) = w; } }
    }
};
struct EpiSwiglu {
    static constexpr bool PERM = true;
    bf16_t* ACT;
    __device__ __forceinline__ void operator()(const f32x4 (&acc)[2][2][4][2], const Unit& u, int wr, int wc, int fr, int fq) const {
        const int row0 = u.pm * BM + wr * 64 + fr, col0 = (u.pn & 3) * 128 + wc * 32 + 8 * fq;
#pragma unroll
        for (int ai = 0; ai < 2; ++ai)
#pragma unroll
            for (int m = 0; m < 4; ++m) { int row = row0 + ai * HALF + m * 16; asm volatile("" : "+v"(row)); float v[8];
#pragma unroll
                for (int n = 0; n < 2; ++n)
#pragma unroll
                    for (int i = 0; i < 4; ++i) { const float a = acc[ai][0][m][n][i], b = acc[ai][1][m][n][i]; v[4 * n + i] = a * sigmoidf_(a) * b; }
                u32x4 w; w.x = cvt_pk_bf16(v[0], v[1]); w.y = cvt_pk_bf16(v[2], v[3]); w.z = cvt_pk_bf16(v[4], v[5]); w.w = cvt_pk_bf16(v[6], v[7]);
                *(u32x4*)(ACT + (size_t)row * 512 + col0) = w; }
    }
};
struct EpiDown {
    static constexpr bool PERM = true;
    bf16_t* YE; const float* roww;
    __device__ __forceinline__ void operator()(const f32x4 (&acc)[2][2][4][2], const Unit& u, int wr, int wc, int fr, int fq) const {
        const int row0 = u.pm * BM + wr * 64 + fr, col0 = (u.pn & 3) * BM + wc * 32 + 8 * fq;
        float sw[8];
#pragma unroll
        for (int it = 0; it < 8; ++it) sw[it] = roww[row0 + (it >> 2) * HALF + (it & 3) * 16];
#pragma unroll
        for (int ai = 0; ai < 2; ++ai)
#pragma unroll
            for (int m = 0; m < 4; ++m) { int row = row0 + ai * HALF + m * 16; asm volatile("" : "+v"(row)); const float s = sw[ai * 4 + m]; bf16_t* rowp = YE + (size_t)row * 1024 + col0;
#pragma unroll
                for (int bj = 0; bj < 2; ++bj) { const f32x4 v0 = acc[ai][bj][m][0] * s, v1 = acc[ai][bj][m][1] * s;
                    u32x4 w; w.x = cvt_pk_bf16(v0[0], v0[1]); w.y = cvt_pk_bf16(v0[2], v0[3]); w.z = cvt_pk_bf16(v1[0], v1[1]); w.w = cvt_pk_bf16(v1[2], v1[3]);
                    *(u32x4*)(rowp + bj * HALF) = w; } }
    }
};
struct SchedUp {
    int G, c;
    __device__ __forceinline__ bool next(int i, Unit& u) const { const int Lr = i * G + c; if (Lr >= 1024) return false;
        const int L = (Lr % NXCD) * (1024 / NXCD) + Lr / NXCD;
        const int n = L >> 8, pm = (L >> 2) & 63, pn = L & 3; u.pm = n * 64 + pm; u.pn = n * 4 + pn; return true; }
    __device__ __forceinline__ void a_ready(const Unit&) const {}
    __device__ __forceinline__ void done(const Unit&) const {}
};
struct SchedMoe {
    int G, c, nunits; const PG8_LAS int* tab;
    __device__ __forceinline__ bool next(int i, Unit& u) const { const int Lr = i * G + c; if (Lr >= nunits) return false;
        const int q = nunits / NXCD, r = nunits % NXCD, xcd = Lr % NXCD, off = Lr / NXCD; const int L = (xcd < r ? xcd * (q + 1) : r * (q + 1) + (xcd - r) * q) + off;
        const int b = L >> 2, t = L & 3; const int e = __builtin_amdgcn_readfirstlane(tab[b]); u.pm = b; u.pn = e * 4 + t; return true; }
    __device__ __forceinline__ void a_ready(const Unit&) const {}
    __device__ __forceinline__ void done(const Unit&) const {}
};
}

#define XB_TMO      128
#define XB_XCNT(j)  (256  + 64 * (j))
#define XB_XSUB(j)  (1280 + 64 * (j))
#define XB_XGEN(j)  (2304 + 64 * (j))
#define XB_TOP      3328
#define XB_TOPGEN   3392
#define XCD_BAR_WORDS 3456
#define XB_SPIN_CAP (1u << 18)
__device__ __forceinline__ unsigned xb_ld(unsigned* p)              { return __hip_atomic_load(p, __ATOMIC_RELAXED, __HIP_MEMORY_SCOPE_AGENT); }
__device__ __forceinline__ unsigned xb_add(unsigned* p, unsigned v) { return __hip_atomic_fetch_add(p, v, __ATOMIC_RELAXED, __HIP_MEMORY_SCOPE_AGENT); }
__device__ __forceinline__ unsigned xb_xcc_id() { return (unsigned)__builtin_amdgcn_s_getreg((3 << 11) | 20) & 0xFu; }
#define XB_SPIN(cond, bar) do { unsigned _sp = 0; while (cond) { __builtin_amdgcn_s_sleep(1); \
    if ((++_sp & 255u) == 0u) { if (xb_ld(&(bar)[XB_TMO])) break; if (_sp > XB_SPIN_CAP) { atomicAdd(&(bar)[XB_TMO], 1u); break; } } } } while (0)
struct XcdBarrier { unsigned* bar; unsigned x; volatile LAS unsigned* st; };
__device__ __forceinline__ XcdBarrier xcd_barrier_post(unsigned* bar, volatile LAS unsigned* st) {
    XcdBarrier b; b.bar = bar; b.x = xb_xcc_id(); b.st = st;
    if (threadIdx.x == 0) (void)xb_add(&bar[XB_XCNT(b.x)], 1u);
    return b;
}
__device__ __forceinline__ void xcd_barrier_complete(unsigned* bar, unsigned x, unsigned& nloc, unsigned& nx) {
    const unsigned G = gridDim.x * gridDim.y * gridDim.z;
    unsigned sum, cnt, mine, sp = 0u;
    for (;;) {
        sum = 0u; cnt = 0u; mine = 0u;
#pragma unroll
        for (unsigned j = 0; j < 16; ++j) { const unsigned c = xb_ld(&bar[XB_XCNT(j)]); sum += c; cnt += (c > 0u) ? 1u : 0u; mine = (j == x) ? c : mine; }
        if (sum == G) break;
        __builtin_amdgcn_s_sleep(1);
        if ((++sp & 255u) == 0u) { if (xb_ld(&bar[XB_TMO])) break; if (sp > XB_SPIN_CAP) { atomicAdd(&bar[XB_TMO], 1u); break; } }
    }
    nloc = mine > 0u ? mine : 1u; nx = cnt > 0u ? cnt : 1u;
}
__device__ __forceinline__ void xcd_barrier(const XcdBarrier& b) {
    asm volatile("s_waitcnt vmcnt(0)" ::: "memory");
    __syncthreads();
    if (threadIdx.x == 0) {
        unsigned* bar = b.bar;
        __builtin_amdgcn_s_waitcnt(0);
        unsigned nloc = b.st[0], nx = b.st[1];
        if (nloc == 0u) { xcd_barrier_complete(bar, b.x, nloc, nx); b.st[0] = nloc; b.st[1] = nx; }
        const unsigned old = xb_add(&bar[XB_XSUB(b.x)], 1u);
        const unsigned gen = old / nloc;
        if (old + 1u == (gen + 1u) * nloc) {
            __builtin_amdgcn_fence(__ATOMIC_RELEASE, "agent");
            asm volatile("s_waitcnt vmcnt(0)" ::: "memory");
            const unsigned og = xb_add(&bar[XB_TOP], 1u);
            const unsigned tg = og / nx;
            if (og + 1u == (tg + 1u) * nx) xb_add(&bar[XB_TOPGEN], 1u);
            else XB_SPIN(xb_ld(&bar[XB_TOPGEN]) == tg, bar);
            __builtin_amdgcn_fence(__ATOMIC_ACQUIRE, "agent");
            xb_add(&bar[XB_XGEN(b.x)], 1u);
            asm volatile("s_waitcnt vmcnt(0)" ::: "memory");
        } else {
            XB_SPIN(xb_ld(&bar[XB_XGEN(b.x)]) == gen, bar);
            __builtin_amdgcn_fence(__ATOMIC_ACQUIRE, "agent");
            asm volatile("s_waitcnt vmcnt(0)" ::: "memory");
        }
    }
    __syncthreads();
}

struct Args {
    const float* in[23]; float* out; unsigned char* ws; int seg_lo, seg_hi;
};
typedef const __attribute__((address_space(4))) Args* ArgsP;
__device__ __forceinline__ ArgsP kargs() { unsigned long long v = (unsigned long long)__builtin_amdgcn_kernarg_segment_ptr(); asm volatile("" : "+s"(v)); return (ArgsP)v; }
struct Frame {
    LAS unsigned char* lds; unsigned char* ws; unsigned* ctl;
    int tid, lane, wave, G, bid;
};

struct CvtItem { const float* wp; bf16* dst; int ldw, K; bool valid; };
__device__ __forceinline__ int src_col_win(int dc) {
    if (dc < 932) return dc;
    if (dc < 936) return 1700 + (dc - 932);
    if (dc < 940) return 1704 + (dc - 936);
    if (dc < 960) return -1;
    if (dc < 1728) return 932 + (dc - 960);
    if (dc < 1984) return 1708 + (dc - 1728);
    if (dc < 3520) return 1964 + (dc - 1984);
    return -1;
}
__device__ __forceinline__ CvtItem cvt_decode(int it, int l, int lane, unsigned char* ws) {
    ArgsP a = kargs();
    constexpr int I_WIN = 16 * 112, I_WBR = 4 * 4 * 32, I_WG = 16 * 128, I_WO = 16 * 32, I_W13 = 32 * 16 * 32;
    const int nl = lane & 31; int r = it;
    const float* W; bf16* WT; int ldw, K, k0, n0, scol;
    if (r < I_WIN) { const int kb = r / 112, nb = r % 112; W = a->in[2] + (size_t)l * 1024 * CIN; ldw = CIN; K = 1024; WT = (bf16*)(ws + WS_WIN); k0 = kb * 64; n0 = nb * 32; scol = src_col_win(n0 + nl); }
    else if ((r -= I_WIN) < I_WBR) { const int n = r / 128, q = r % 128, kb = q / 32, nb = q % 32; W = a->in[11] + (size_t)l * 4 * 256 * 1024 + (size_t)n * 256 * 1024; ldw = 1024; K = 256; WT = (bf16*)(ws + WS_WBR) + (size_t)n * 1024 * 256; k0 = kb * 64; n0 = nb * 32; scol = n0 + nl; }
    else if ((r -= I_WBR) < I_WG) { const int kb = r / 128, nb = r % 128; W = a->in[12] + (size_t)l * 1024 * 4096; ldw = 4096; K = 1024; WT = (bf16*)(ws + WS_WGATE); k0 = kb * 64; n0 = nb * 32;
        const int np = n0 + nl, pn = np >> 8, L = np & 255, bj = L >> 7, wc = (L >> 5) & 3, fq = (L >> 3) & 3, n = (L >> 2) & 1, i = L & 3; scol = (2 * bj + n) * 1024 + pn * 64 + wc * 16 + fq * 4 + i; }
    else if ((r -= I_WG) < I_WO) { const int kb = r / 32, nb = r % 32; W = a->in[13] + (size_t)l * 1024 * 1024; ldw = 1024; K = 1024; WT = (bf16*)(ws + WS_WOUT); k0 = kb * 64; n0 = nb * 32; scol = n0 + nl; }
    else if ((r -= I_WO) < I_W13) { const int e = r / 512, q = r % 512, kb = q / 32, nb = q % 32;
        const int t = (nb * 32) >> 8, L0 = (nb * 32) & 255; W = (L0 < 128 ? a->in[19] : a->in[20]) + (size_t)l * NE * 1024 * FE + (size_t)e * 1024 * FE; ldw = FE; K = 1024;
        WT = (bf16*)(ws + WS_W13) + (size_t)e * 1024 * 1024; k0 = kb * 64; n0 = nb * 32; scol = t * 128 + (L0 & 127) + nl; }
    else { r -= I_W13; const int e = r / 256, q = r % 256, kb = q / 32, nb = q % 32; W = a->in[21] + (size_t)l * NE * FE * 1024 + (size_t)e * FE * 1024; ldw = 1024; K = FE; WT = (bf16*)(ws + WS_W2) + (size_t)e * 1024 * FE; k0 = kb * 64; n0 = nb * 32; scol = n0 + nl; }
    CvtItem c; c.valid = scol >= 0; c.wp = W + (size_t)(k0 + (lane >> 5)) * ldw + (scol >= 0 ? scol : 0); c.dst = WT + (size_t)n0 * K + k0; c.ldw = ldw; c.K = K;
    return c;
}
constexpr int CVT_A = 16 * 112 + 4 * 4 * 32 + 16 * 128 + 16 * 32, CVT_B = CVT_A + 32 * 16 * 32, CVT_N = CVT_B + 32 * 8 * 32;
__device__ __forceinline__ void phase_convert(Frame& F, int l, int lo, int NIT) {
    LAS float* scr = (LAS float*)(F.lds + F.wave * 16384);
    const int gw = F.bid * 8 + F.wave, NGW = F.G * 8, lane = F.lane;
    int it = lo + gw; if (it >= NIT) return;
    CvtItem cur = cvt_decode(it, l, lane, F.ws);
    float wv[32];
#pragma unroll
    for (int i = 0; i < 32; ++i) wv[i] = cur.wp[(size_t)(2 * i) * cur.ldw];
#pragma unroll 1
    for (;;) {
        const int itn = it + NGW; const bool more = itn < NIT;
        CvtItem nxt = cvt_decode(more ? itn : it, l, lane, F.ws);
        float wn[32];
#pragma unroll
        for (int i = 0; i < 32; ++i) wn[i] = nxt.wp[(size_t)(2 * i) * nxt.ldw];
        const int nl = lane & 31;
#pragma unroll
        for (int i = 0; i < 32; ++i) { const int kk = 2 * i + (lane >> 5); scr[kk * 33 + nl] = cur.valid ? wv[i] : 0.f; }
        LDS_WAIT(); asm volatile("" ::: "memory");
        const int c = lane & 7;
#pragma unroll
        for (int j = 0; j < 4; ++j) { const int n = (lane >> 3) + 8 * j; const LAS float* sp = scr + (8 * c) * 33 + n;
            u32x4 o; o.x = pk2(sp[0 * 33], sp[1 * 33]); o.y = pk2(sp[2 * 33], sp[3 * 33]); o.z = pk2(sp[4 * 33], sp[5 * 33]); o.w = pk2(sp[6 * 33], sp[7 * 33]);
            *(u32x4*)(cur.dst + (size_t)n * cur.K + 8 * c) = o; }
        LDS_WAIT(); asm volatile("" ::: "memory");
        if (!more) break;
        it = itn; cur = nxt;
#pragma unroll
        for (int i = 0; i < 32; ++i) wv[i] = wn[i];
    }
}
__device__ __forceinline__ void rms_row_to_bf16(const float* xrow, const float* g, bf16* orow, int lane) {
    const f32x4* xr = (const f32x4*)xrow + lane; const f32x4* gr = (const f32x4*)g + lane;
    f32x4 v[4]; float s = 0.f;
#pragma unroll
    for (int j = 0; j < 4; ++j) { v[j] = xr[64 * j]; s += (v[j].x * v[j].x + v[j].y * v[j].y) + (v[j].z * v[j].z + v[j].w * v[j].w); }
    const float rstd = rsqrtf(wave_sum(s) * (1.f / D) + RMS_EPS);
    unsigned long long* o8 = (unsigned long long*)orow + lane;
#pragma unroll
    for (int j = 0; j < 4; ++j) { const f32x4 gg = gr[64 * j]; o8[64 * j] = (unsigned long long)pk2(v[j].x * rstd * gg.x, v[j].y * rstd * gg.y) | ((unsigned long long)pk2(v[j].z * rstd * gg.z, v[j].w * rstd * gg.w) << 32); }
}

#ifndef MFMA_F32
#define MFMA_F32(av, bv, cv) __builtin_amdgcn_mfma_f32_16x16x4f32((av), (bv), (cv), 0, 0, 0)
#endif
__device__ __forceinline__ void phase_router(Frame& F, int l, const bf16* xcur) {
    ArgsP a = kargs();
    LAS float* xs = (LAS float*)F.lds;
    LAS float* wsm = xs + 64 * 65;
    LAS float* lg = wsm + 64 * 48;
    LAS float* rs = lg + 64 * 37;
    LAS unsigned* ecl = (LAS unsigned*)(rs + 64);
    if (F.tid < 32) ecl[F.tid] = 0u;
    const float* g = a->in[14] + (size_t)l * D;
    const float* rgw = a->in[15] + (size_t)l * D * 4; const float* rgb = a->in[16] + (size_t)l * 4;
    const float* rew = a->in[17] + (size_t)l * D * 32; const float* reb = a->in[18] + (size_t)l * 32;
    bf16* h2 = (bf16*)(F.ws + WS_H);
    int* tok_e = (int*)(F.ws + WS_RT); float* tok_w = (float*)(F.ws + WS_RT + 131072);
    unsigned* cnt = F.ctl + CW_CNT + l * 32;
    const int r = F.tid & 63;
    const int li = F.lane & 15, kq = F.lane >> 4, rb = F.wave & 3, cset = F.wave >> 2;
    for (int blk = F.bid; blk < S / 64; blk += F.G) {
        const int row0 = blk * 64;
        f32x4 acc0 = {0.f, 0.f, 0.f, 0.f}, acc1 = {0.f, 0.f, 0.f, 0.f}; float ss = 0.f;
        const int rr = F.tid >> 3, kk = (F.tid & 7) * 8, wk = F.tid >> 3, c0 = (F.tid & 7) * 6;
        u32x4 xw; f32x4 g0, g1; float wv[6];
#define RT_LOAD(kc_) do { const bf16* xp = xcur + (size_t)(row0 + rr) * D + (kc_) * 64 + kk; const float* gp = g + (kc_) * 64 + kk; \
            xw = *(const u32x4*)xp; g0 = *(const f32x4*)gp; g1 = *(const f32x4*)(gp + 4); const size_t kg = (size_t)((kc_) * 64 + wk); \
            _Pragma("unroll") for (int i = 0; i < 6; ++i) { const int c = c0 + i; wv[i] = c < 4 ? rgw[kg * 4 + c] : (c < 36 ? rew[kg * 32 + (c - 4)] : 0.f); } } while (0)
        RT_LOAD(0);
        for (int kc = 0; kc < 16; ++kc) {
            __syncthreads();
            { const f32x4 x0 = (f32x4){bflo(xw.x), bfhi(xw.x), bflo(xw.y), bfhi(xw.y)}, x1 = (f32x4){bflo(xw.z), bfhi(xw.z), bflo(xw.w), bfhi(xw.w)};
              LAS float* d = xs + rr * 65 + kk; d[0] = x0.x * g0.x; d[1] = x0.y * g0.y; d[2] = x0.z * g0.z; d[3] = x0.w * g0.w; d[4] = x1.x * g1.x; d[5] = x1.y * g1.y; d[6] = x1.z * g1.z; d[7] = x1.w * g1.w;
              ss += (x0.x * x0.x + x0.y * x0.y) + (x0.z * x0.z + x0.w * x0.w) + (x1.x * x1.x + x1.y * x1.y) + (x1.z * x1.z + x1.w * x1.w);
#pragma unroll
              for (int i = 0; i < 6; ++i) wsm[wk * 48 + c0 + i] = wv[i]; }
            if (kc + 1 < 16) RT_LOAD(kc + 1);
            __syncthreads();
            if (cset == 0) {
#pragma unroll 4
                for (int k0 = 0; k0 < 64; k0 += 4) { const float av = xs[(rb * 16 + li) * 65 + k0 + kq];
                    acc0 = MFMA_F32(av, wsm[(k0 + kq) * 48 + li], acc0); acc1 = MFMA_F32(av, wsm[(k0 + kq) * 48 + 16 + li], acc1); }
            } else {
#pragma unroll 4
                for (int k0 = 0; k0 < 64; k0 += 4) { const float av = xs[(rb * 16 + li) * 65 + k0 + kq]; acc0 = MFMA_F32(av, wsm[(k0 + kq) * 48 + 32 + li], acc0); }
            }
        }
#undef RT_LOAD
        ss += __shfl_xor(ss, 1); ss += __shfl_xor(ss, 2); ss += __shfl_xor(ss, 4);
        __syncthreads();
        if ((F.tid & 7) == 0) rs[F.tid >> 3] = rsqrtf(ss * (1.f / D) + RMS_EPS);
        __syncthreads();
#pragma unroll
        for (int i = 0; i < 4; ++i) { const int rw = rb * 16 + kq * 4 + i; const float rstd = rs[rw];
            if (cset == 0) { lg[rw * 37 + li] = acc0[i] * rstd; lg[rw * 37 + 16 + li] = acc1[i] * rstd; } else if (li < 4) lg[rw * 37 + 32 + li] = acc0[i] * rstd; }
        __syncthreads();
        if (F.tid < 64) {
            const LAS float* L = lg + F.tid * 37; const int tok = row0 + F.tid;
            float gl[4]; int gs = 0; float gm = -3.0e38f;
#pragma unroll
            for (int i = 0; i < 4; ++i) { gl[i] = L[i] + rgb[i]; if (gl[i] > gm) { gm = gl[i]; gs = i; } }
            float gsum = 0.f;
#pragma unroll
            for (int i = 0; i < 4; ++i) gsum += __expf(gl[i] - gm);
            const float ggate = 1.f / gsum;
            float v0 = -3.0e38f, v1 = -3.0e38f; int i0 = 0, i1 = 0;
            for (int i = 0; i < 8; ++i) { const float v = L[4 + gs * 8 + i] + reb[gs * 8 + i]; if (v > v0) { v1 = v0; i1 = i0; v0 = v; i0 = i; } else if (v > v1) { v1 = v; i1 = i; } }
            const float e1 = __expf(v1 - v0), den = 1.f / (1.f + e1);
            const int ea = gs * 8 + i0, eb = gs * 8 + i1;
            tok_e[tok * 2] = ea; tok_e[tok * 2 + 1] = eb; tok_w[tok * 2] = den * ggate; tok_w[tok * 2 + 1] = e1 * den * ggate;
            (void)__hip_atomic_fetch_add(ecl + ea, 1u, __ATOMIC_RELAXED, __HIP_MEMORY_SCOPE_WORKGROUP); (void)__hip_atomic_fetch_add(ecl + eb, 1u, __ATOMIC_RELAXED, __HIP_MEMORY_SCOPE_WORKGROUP);
        }
        __syncthreads();
        if (F.tid < 32) { const unsigned c = ecl[F.tid]; if (c) atomicAdd(&cnt[F.tid], c); ecl[F.tid] = 0u; }
#pragma unroll 1
        for (int i4 = 0; i4 < 8; i4 += 4) { u32x2 xv[4][4];
#pragma unroll
            for (int i = 0; i < 4; ++i) { const u32x2* xr = (const u32x2*)(xcur + (size_t)(row0 + F.wave * 8 + i4 + i) * D) + F.lane;
#pragma unroll
                for (int j = 0; j < 4; ++j) xv[i][j] = xr[64 * j]; }
#pragma unroll
            for (int i = 0; i < 4; ++i) { const int r2 = F.wave * 8 + i4 + i; const float rstd = rs[r2]; const f32x4* gr = (const f32x4*)g + F.lane; unsigned long long* o8 = (unsigned long long*)(h2 + (size_t)(row0 + r2) * D) + F.lane;
#pragma unroll
                for (int j = 0; j < 4; ++j) { const f32x4 v = (f32x4){bflo(xv[i][j].x), bfhi(xv[i][j].x), bflo(xv[i][j].y), bfhi(xv[i][j].y)}, gg = gr[64 * j]; o8[64 * j] = (unsigned long long)pk2(v.x * rstd * gg.x, v.y * rstd * gg.y) | ((unsigned long long)pk2(v.z * rstd * gg.z, v.w * rstd * gg.w) << 32); } } }
    }
    __syncthreads();
}
__device__ __forceinline__ void moe_table(Frame& F, int l) {
    LAS int* tab = (LAS int*)(F.lds + LDSCTL_OFF);
    if (F.tid < 64) {
        const int e = F.lane & 31; const int c = (int)__hip_atomic_load(F.ctl + CW_CNT + l * 32 + e, __ATOMIC_RELAXED, __HIP_MEMORY_SCOPE_AGENT);
        const int nb = F.lane < 32 ? (c + 255) >> 8 : 0; int incl = nb;
#pragma unroll
        for (int o = 1; o < 32; o <<= 1) { const int t = __shfl_up(incl, o); if (F.lane >= o) incl += t; }
        const int bo = incl - nb;
        if (F.lane < 32) { tab[192 + e] = bo * 256;
#pragma unroll 1
            for (int b2 = 0; b2 < nb; ++b2) tab[bo + b2] = e; }
        if (F.lane == 31) tab[224] = incl; }
    __syncthreads();
}
__device__ __forceinline__ void phase_scatter(Frame& F, int l) {
    moe_table(F, l);
    LAS int* tab = (LAS int*)(F.lds + LDSCTL_OFF);
    const bf16* h2 = (const bf16*)(F.ws + WS_H); bf16* xs = (bf16*)(F.ws + WS_XS);
    const int* tok_e = (const int*)(F.ws + WS_RT); const float* tok_w = (const float*)(F.ws + WS_RT + 131072);
    int* slot_row = (int*)(F.ws + WS_RT + 262144); float* row_w = (float*)(F.ws + WS_RT + 393216);
    unsigned* fill = F.ctl + CW_FILL + l * 32;
    const int gw = F.bid * 8 + F.wave, NGW = F.G * 8;
    LAS unsigned* ecl = (LAS unsigned*)F.lds; LAS unsigned* ebase = ecl + 32;
    for (int b0 = gw * 16; b0 < S * 2; b0 += NGW * 16) {
        __syncthreads();
        if (F.tid < 32) ecl[F.tid] = 0u;
        __syncthreads();
        int row = 0, e = 0; unsigned rank = 0u;
        if (F.lane < 16) { e = tok_e[b0 + F.lane]; rank = __hip_atomic_fetch_add(ecl + e, 1u, __ATOMIC_RELAXED, __HIP_MEMORY_SCOPE_WORKGROUP); }
        __syncthreads();
        if (F.tid < 32) { const unsigned c = ecl[F.tid]; ebase[F.tid] = c ? atomicAdd(&fill[F.tid], c) : 0u; }
        __syncthreads();
        if (F.lane < 16) { const int sl = b0 + F.lane; row = tab[192 + e] + (int)(ebase[e] + rank); slot_row[sl] = row; row_w[row] = tok_w[sl]; ((int*)(F.ws + WS_RT + 589824))[row] = sl >> 1; }
    }
}
__device__ __forceinline__ void phase_combine(Frame& F, int l, const bf16* x1, void* xnext) {
    ArgsP a = kargs();
    const bf16* ye = (const bf16*)(F.ws + WS_YE); const int* slot_row = (const int*)(F.ws + WS_RT + 262144);
    const bool last = (l == NL - 1);
    const float* g = last ? a->in[22] : a->in[1] + (size_t)(l + 1) * D;
    bf16* h = (bf16*)(F.ws + WS_H);
    const int gw = F.bid * 8 + F.wave, NGW = F.G * 8;
    int srl = 0; { const int k = F.lane >> 1, m = gw + k * NGW; if (F.lane < 16 && m < S) srl = slot_row[2 * m + (F.lane & 1)]; }
    const f32x4* gr = (const f32x4*)g + F.lane; f32x4 gg[4];
#pragma unroll
    for (int j = 0; j < 4; ++j) gg[j] = gr[64 * j];
    u32x2 xn[4], p0n[4], p1n[4];
#define CMB_LOAD(mm, kk) do { const int r0_ = __shfl(srl, 2 * (kk)), r1_ = __shfl(srl, 2 * (kk) + 1); const u32x2* xr_ = (const u32x2*)(x1 + (size_t)(mm) * D) + F.lane; \
        const u32x2* y0_ = (const u32x2*)(ye + (size_t)r0_ * D) + F.lane; const u32x2* y1_ = (const u32x2*)(ye + (size_t)r1_ * D) + F.lane; \
        _Pragma("unroll") for (int j = 0; j < 4; ++j) { xn[j] = xr_[64 * j]; p0n[j] = y0_[64 * j]; p1n[j] = y1_[64 * j]; } } while (0)
    if (gw < S) CMB_LOAD(gw, 0);
    int kk_ = 0;
    for (int m = gw; m < S; m += NGW, ++kk_) {
        f32x4 v[4]; float s = 0.f;
#pragma unroll
        for (int j = 0; j < 4; ++j) { const u32x2 p0 = p0n[j], p1 = p1n[j]; f32x4 x = (f32x4){bflo(xn[j].x), bfhi(xn[j].x), bflo(xn[j].y), bfhi(xn[j].y)};
            x.x = (x.x + bflo(p0.x)) + bflo(p1.x); x.y = (x.y + bfhi(p0.x)) + bfhi(p1.x); x.z = (x.z + bflo(p0.y)) + bflo(p1.y); x.w = (x.w + bfhi(p0.y)) + bfhi(p1.y);
            v[j] = x; s += (x.x * x.x + x.y * x.y) + (x.z * x.z + x.w * x.w); }
        if (m + NGW < S) CMB_LOAD(m + NGW, kk_ + 1);
        const float rstd = rsqrtf(wave_sum(s) * (1.f / D) + RMS_EPS);
        if (last) { f32x4* xr = (f32x4*)((float*)xnext + (size_t)m * D) + F.lane;
#pragma unroll
            for (int j = 0; j < 4; ++j) xr[64 * j] = (f32x4){v[j].x * rstd * gg[j].x, v[j].y * rstd * gg[j].y, v[j].z * rstd * gg[j].z, v[j].w * rstd * gg[j].w};
        } else {
            unsigned long long* o8 = (unsigned long long*)(h + (size_t)m * D) + F.lane; unsigned long long* x8 = (unsigned long long*)((bf16*)xnext + (size_t)m * D) + F.lane;
#pragma unroll
            for (int j = 0; j < 4; ++j) { x8[64 * j] = (unsigned long long)pk2(v[j].x, v[j].y) | ((unsigned long long)pk2(v[j].z, v[j].w) << 32);
                o8[64 * j] = (unsigned long long)pk2(v[j].x * rstd * gg[j].x, v[j].y * rstd * gg[j].y) | ((unsigned long long)pk2(v[j].z * rstd * gg[j].z, v[j].w * rstd * gg[j].w) << 32); }
        }
    }
#undef CMB_LOAD
}


typedef short v4i16_t __attribute__((ext_vector_type(4)));
__device__ __forceinline__ s16x4 ds_tr16(const LAS unsigned char* p) { return __builtin_bit_cast(s16x4, __builtin_amdgcn_ds_read_tr16_b64_v4i16((LAS v4i16_t*)p)); }
template <int MODE>
__device__ __forceinline__ void attn_phase(Frame& F, int l) {
    ArgsP a = kargs();
    constexpr int NS = MODE ? 2 : 1;
    const bf16* P = (const bf16*)(F.ws + WS_PU);
    bf16* Y = (bf16*)(F.ws + WS_Y) + (size_t)(MODE ? 3 : 2) * S * 256;
    const int colQ = MODE ? C_QD : C_QC, colK = MODE ? C_KD : C_KC, colV = MODE ? C_VD : C_VC;
    const float sc2 = (MODE ? 0.17677669529663687f : 0.125f) * 1.4426950408889634f;
    LAS unsigned char* Kb = F.lds; LAS unsigned char* Vb = F.lds + 16384; LAS float* btab = (LAS float*)(F.lds + 32768);
    const int lane = F.lane, w = F.wave, r = lane & 31, hh = lane >> 5;
    for (int u = F.bid; u < 256; u += F.G) {
        const int head = u & 3, ug = u >> 2;
        int qrow, cw, lo_w, T0, T1;
        if (MODE) { qrow = ug * 256 + w * 32; cw = ug * 4 + (w >> 1); lo_w = 0; T0 = 0; T1 = ug * 4 + 3; }
        else { cw = ug * 4 + (w >> 1); qrow = cw * 64 + (w & 1) * 32; lo_w = cw - 8 < 0 ? 0 : cw - 8; T0 = ug * 4 - 8 < 0 ? 0 : ug * 4 - 8; T1 = ug * 4 + 3; }
        if (!MODE) { __syncthreads(); if (F.tid < 192) btab[F.tid] = a->in[8][(size_t)(l * 4 + head) * 192 + F.tid] * 1.4426950408889634f; }
        bf16x8 Qf[4];
#pragma unroll
        for (int kk = 0; kk < 4; ++kk) Qf[kk] = *(const bf16x8*)(P + (size_t)(qrow + r) * PW + colQ + head * 64 + kk * 16 + 8 * hh);
        f32x16 O[NS][2]; float m[NS], lsum[NS];
#pragma unroll
        for (int s = 0; s < NS; ++s) { m[s] = -1e30f; lsum[s] = 0.f;
#pragma unroll
            for (int d = 0; d < 2; ++d)
#pragma unroll
                for (int i = 0; i < 16; ++i) O[s][d][i] = 0.f; }
        const int srow = F.tid >> 3, sch = F.tid & 7;
        const bf16* gK = P + (size_t)srow * PW + colK + head * 64 + sch * 8; const bf16* gV = P + (size_t)srow * PW + colV + head * 64 + sch * 8;
        const int kwoff = srow * 128 + ((sch ^ (srow & 7)) << 4), vwoff = srow * 128 + sch * 16;
        u32x4 kreg = *(const u32x4*)(gK + (size_t)T0 * 64 * PW), vreg = *(const u32x4*)(gV + (size_t)T0 * 64 * PW);
        __syncthreads();
        *(LAS u32x4*)(Kb + kwoff) = kreg; *(LAS u32x4*)(Vb + vwoff) = vreg;
        __syncthreads();
        for (int j = T0; j <= T1; ++j) {
            const int buf = (j - T0) & 1;
            if (j < T1) { kreg = *(const u32x4*)(gK + (size_t)(j + 1) * 64 * PW); vreg = *(const u32x4*)(gV + (size_t)(j + 1) * 64 * PW); }
            if (j >= lo_w && j <= cw) {
                const LAS unsigned char* Kt = Kb + buf * 8192; const LAS unsigned char* Vt = Vb + buf * 8192;
                bf16x8 pf[NS][4];
#pragma unroll
                for (int s = 0; s < NS; ++s) {
                    f32x16 Sq[2];
#pragma unroll
                    for (int kb = 0; kb < 2; ++kb) {
#pragma unroll
                        for (int i = 0; i < 16; ++i) Sq[kb][i] = 0.f;
#pragma unroll
                        for (int k2 = 0; k2 < (MODE ? 2 : 4); ++k2) { const int kk = MODE ? 2 * s + k2 : k2; const int row = kb * 32 + r;
                            const bf16x8 kf = *(const LAS bf16x8*)(Kt + row * 128 + (((kk * 2 + hh) ^ (row & 7)) << 4));
                            Sq[kb] = __builtin_amdgcn_mfma_f32_32x32x16_bf16(kf, Qf[kk], Sq[kb], 0, 0, 0); }
                    }
                    float mx = -1e30f;
                    if (!MODE) {
                        const int dj = cw - j;
                        if (dj >= 3) { const float bc = btab[191];
#pragma unroll
                            for (int kb = 0; kb < 2; ++kb)
#pragma unroll
                                for (int i = 0; i < 16; ++i) { const float t = Sq[kb][i] * sc2 + bc; Sq[kb][i] = t; mx = fmaxf(mx, t); } }
                        else { const int base = dj * 64 + (w & 1) * 32 + r - 4 * hh + 63;
#pragma unroll
                            for (int kb = 0; kb < 2; ++kb)
#pragma unroll
                                for (int i = 0; i < 16; ++i) { int rid = base - (kb * 32 + (i & 3) + 8 * (i >> 2)); rid = rid < 0 ? 0 : (rid > 191 ? 191 : rid);
                                    const float t = Sq[kb][i] * sc2 + btab[rid]; Sq[kb][i] = t; mx = fmaxf(mx, t); } }
                    } else {
#pragma unroll
                        for (int kb = 0; kb < 2; ++kb)
#pragma unroll
                            for (int i = 0; i < 16; ++i) { const float t = Sq[kb][i] * sc2; Sq[kb][i] = t; mx = fmaxf(mx, t); }
                    }
                    mx = fmaxf(mx, __shfl_xor(mx, 32));
                    const float mn = fmaxf(m[s], mx), alpha = __builtin_amdgcn_exp2f(m[s] - mn); m[s] = mn;
                    float rs = 0.f;
#pragma unroll
                    for (int kb = 0; kb < 2; ++kb)
#pragma unroll
                        for (int i = 0; i < 16; ++i) { const float p = __builtin_amdgcn_exp2f(Sq[kb][i] - mn); Sq[kb][i] = p; rs += p; }
                    lsum[s] = lsum[s] * alpha + rs;
#pragma unroll
                    for (int d = 0; d < 2; ++d)
#pragma unroll
                        for (int i = 0; i < 16; ++i) O[s][d][i] *= alpha;
#pragma unroll
                    for (int kb = 0; kb < 2; ++kb)
#pragma unroll
                        for (int ss = 0; ss < 2; ++ss) { u32x4 pw;
                            pw.x = pg8::cvt_pk_bf16(Sq[kb][8 * ss + 0], Sq[kb][8 * ss + 1]); pw.y = pg8::cvt_pk_bf16(Sq[kb][8 * ss + 2], Sq[kb][8 * ss + 3]);
                            pw.z = pg8::cvt_pk_bf16(Sq[kb][8 * ss + 4], Sq[kb][8 * ss + 5]); pw.w = pg8::cvt_pk_bf16(Sq[kb][8 * ss + 6], Sq[kb][8 * ss + 7]);
                            pf[s][kb * 2 + ss] = __builtin_bit_cast(bf16x8, pw); }
                    __builtin_amdgcn_sched_barrier(0);
                }
                const int li = lane & 15, lg = lane >> 4;
                const LAS unsigned char* vbase = Vt + (4 * (lg >> 1) + (li >> 2)) * 128 + (16 * (lg & 1) + 4 * (li & 3)) * 2;
#pragma unroll
                for (int d = 0; d < 2; ++d)
#pragma unroll
                    for (int st = 0; st < 4; ++st) {
                        const s16x4 v0 = ds_tr16(vbase + (st * 16) * 128 + d * 64), v1 = ds_tr16(vbase + (st * 16 + 8) * 128 + d * 64);
                        const bf16x8 vf = (bf16x8){v0[0], v0[1], v0[2], v0[3], v1[0], v1[1], v1[2], v1[3]};
#pragma unroll
                        for (int s = 0; s < NS; ++s) O[s][d] = __builtin_amdgcn_mfma_f32_32x32x16_bf16(vf, pf[s][st], O[s][d], 0, 0, 0);
                        if (st & 1) __builtin_amdgcn_sched_barrier(0);
                    }
            }
            if (j < T1) { *(LAS u32x4*)(Kb + (buf ^ 1) * 8192 + kwoff) = kreg; *(LAS u32x4*)(Vb + (buf ^ 1) * 8192 + vwoff) = vreg; }
            __syncthreads();
        }
        float inv[NS];
#pragma unroll
        for (int s = 0; s < NS; ++s) { const float lt = lsum[s] + __shfl_xor(lsum[s], 32); inv[s] = 1.f / lt; }
        bf16* yrow = Y + (size_t)(qrow + r) * 256 + head * 64 + 4 * hh;
        if (MODE) {
            const float* lp = a->in[9] + (size_t)l * 128 + (lane & 31); float s1 = (lane < 32) ? lp[0] * lp[32] : 0.f, s2 = (lane < 32) ? lp[64] * lp[96] : 0.f;
            s1 = wave_sum(s1); s2 = wave_sum(s2);
            const float lam_init = 0.8f - 0.6f * __expf(-0.3f * (float)l), lam = __expf(s1) - __expf(s2) + lam_init;
            const float* gn = a->in[10] + (size_t)l * 256 + head * 64 + 4 * hh;
            float ss = 0.f;
#pragma unroll
            for (int d = 0; d < 2; ++d)
#pragma unroll
                for (int i = 0; i < 16; ++i) { const float o = O[0][d][i] * inv[0] - lam * (O[NS - 1][d][i] * inv[NS - 1]); O[0][d][i] = o; ss += o * o; }
            ss += __shfl_xor(ss, 32);
            const float rstd = rsqrtf(ss * (1.f / 64.f) + RMS_EPS) * (1.f - lam_init);
#pragma unroll
            for (int d = 0; d < 2; ++d)
#pragma unroll
                for (int g = 0; g < 4; ++g) { const f32x4 gg = *(const f32x4*)(gn + d * 32 + 8 * g); u32x2 o2;
                    o2.x = pk2(O[0][d][4 * g + 0] * rstd * gg.x, O[0][d][4 * g + 1] * rstd * gg.y); o2.y = pk2(O[0][d][4 * g + 2] * rstd * gg.z, O[0][d][4 * g + 3] * rstd * gg.w);
                    *(u32x2*)(yrow + d * 32 + 8 * g) = o2; }
        } else {
#pragma unroll
            for (int d = 0; d < 2; ++d)
#pragma unroll
                for (int g = 0; g < 4; ++g) { u32x2 o2;
                    o2.x = pk2(O[0][d][4 * g + 0] * inv[0], O[0][d][4 * g + 1] * inv[0]); o2.y = pk2(O[0][d][4 * g + 2] * inv[0], O[0][d][4 * g + 3] * inv[0]);
                    *(u32x2*)(yrow + d * 32 + 8 * g) = o2; }
        }
    }
    __syncthreads();
}


__device__ __forceinline__ float vmax3_(float a, float b, float c) { float r; asm("v_max3_f32 %0, %1, %2, %3" : "=v"(r) : "v"(a), "v"(b), "v"(c)); return r; }
__device__ __forceinline__ void attnD_phase(Frame& F, int l) {
    const bf16* P = (const bf16*)(F.ws + WS_PU);
    bf16* Y = (bf16*)(F.ws + WS_Y) + (size_t)3 * S * 256;
    const float sc2 = 0.17677669529663687f * 1.4426950408889634f;
    const int lane = F.lane, w = F.wave, r = lane & 31, hh = lane >> 5, rw = w & 3, ksel = w >> 2;
    const int srow = F.tid >> 3, sch = F.tid & 7;
#pragma unroll 1
    for (int pr = F.bid; pr < 256; pr += F.G) {
        const int head = pr & 3, bp = pr >> 2;
#pragma unroll 1
        for (int rep = 0; rep < 2; ++rep) {
            const int b = rep ? 127 - bp : bp;
            const int qrow = b * 128 + rw * 32, cw = 2 * b + (rw >> 1);
            LAS unsigned char* qlds = F.lds + 98304 + w * 4096 + lane * 16;
            u32x4 qs4[4];
#pragma unroll
            for (int kk = 0; kk < 4; ++kk) { const u32x4 qw = *(const u32x4*)(P + (size_t)(qrow + r) * PW + C_QD + head * 64 + kk * 16 + 8 * hh);
                qs4[kk].x = pk2(bflo(qw.x) * sc2, bfhi(qw.x) * sc2); qs4[kk].y = pk2(bflo(qw.y) * sc2, bfhi(qw.y) * sc2); qs4[kk].z = pk2(bflo(qw.z) * sc2, bfhi(qw.z) * sc2); qs4[kk].w = pk2(bflo(qw.w) * sc2, bfhi(qw.w) * sc2); }
            f32x16 O[2][2], negM[2]; float m[2], lsum[2]; bool seen = false;
#pragma unroll
            for (int s2 = 0; s2 < 2; ++s2) { m[s2] = 0.f; lsum[s2] = 0.f;
#pragma unroll
                for (int i = 0; i < 16; ++i) negM[s2][i] = 0.f;
                asm volatile("" : "+v"(negM[s2]));
#pragma unroll
                for (int d = 0; d < 2; ++d)
#pragma unroll
                    for (int i = 0; i < 16; ++i) O[s2][d][i] = 0.f; }
            int srow_ = srow, sch_ = sch; asm volatile("" : "+v"(srow_), "+v"(sch_));
            const bf16* gK = P + (size_t)srow_ * PW + C_KD + head * 64 + (sch_ ^ (srow_ & 7)) * 8; const bf16* gV = P + (size_t)srow_ * PW + C_VD + head * 64 + sch_ * 8;
            LAS unsigned char* dma0 = F.lds + w * 1024;
#define D_STAGE(bufb, go) do { __builtin_amdgcn_global_load_lds((const unsigned*)(gK + (go)), (LAS unsigned*)(dma0 + (bufb)), 16, 0, 0); \
                __builtin_amdgcn_global_load_lds((const unsigned*)(gK + (go) + (size_t)64 * PW), (LAS unsigned*)(dma0 + (bufb) + 8192), 16, 0, 0); \
                __builtin_amdgcn_global_load_lds((const unsigned*)(gV + (go)), (LAS unsigned*)(dma0 + (bufb) + 16384), 16, 0, 0); \
                __builtin_amdgcn_global_load_lds((const unsigned*)(gV + (go) + (size_t)64 * PW), (LAS unsigned*)(dma0 + (bufb) + 24576), 16, 0, 0); } while (0)
            __syncthreads();
#pragma unroll
            for (int kk = 0; kk < 4; ++kk) *(LAS u32x4*)(qlds + kk * 1024) = qs4[kk];
            D_STAGE(0, (size_t)0);
            VM_WAIT();
            __syncthreads();
            asm volatile(".p2align 8" ::: "memory");
#pragma unroll 1
            for (int i = 0; i <= b; ++i) {
                const int buf = i & 1, j = 2 * i + ksel;
                if (i < b) D_STAGE((buf ^ 1) * 32768, (size_t)(2 * i + 2) * 64 * PW);
                if (j <= cw) {
                    const LAS unsigned char* Kt = F.lds + buf * 32768 + ksel * 8192; const LAS unsigned char* Vt = F.lds + buf * 32768 + 16384 + ksel * 8192;
                    bf16x8 pf[2][4];
#pragma unroll
                    for (int s2 = 0; s2 < 2; ++s2) {
                        f32x16 Sq[2];
                        const bf16x8 qf2[2] = {*(const LAS bf16x8*)(qlds + (2 * s2) * 1024), *(const LAS bf16x8*)(qlds + (2 * s2 + 1) * 1024)};
#pragma unroll
                        for (int kb = 0; kb < 2; ++kb) {
#pragma unroll
                            for (int k2 = 0; k2 < 2; ++k2) { const int kk = 2 * s2 + k2; const int row = kb * 32 + r;
                                const bf16x8 kf = *(const LAS bf16x8*)(Kt + row * 128 + (((kk * 2 + hh) ^ (row & 7)) << 4));
                                Sq[kb] = __builtin_amdgcn_mfma_f32_32x32x16_bf16(kf, qf2[k2], k2 ? Sq[kb] : negM[s2], 0, 0, 0); }
                        }
                        __builtin_amdgcn_sched_barrier(0);
                        asm volatile("s_nop 15\n\ts_nop 3" ::: "memory");
                        __builtin_amdgcn_sched_barrier(0);
                        float mx = vmax3_(Sq[0][0], Sq[0][1], Sq[0][2]);
#pragma unroll
                        for (int ii = 3; ii < 15; ii += 2) mx = vmax3_(mx, Sq[0][ii], Sq[0][ii + 1]);
                        mx = vmax3_(mx, Sq[0][15], Sq[1][0]);
#pragma unroll
                        for (int ii = 1; ii < 15; ii += 2) mx = vmax3_(mx, Sq[1][ii], Sq[1][ii + 1]);
                        mx = vmax3_(mx, Sq[1][15], Sq[1][15]);
                        mx = fmaxf(mx, __shfl_xor(mx, 32));
                        if (!seen || __any(mx > 8.f)) { const float dl = seen ? fmaxf(mx, 0.f) : mx; m[s2] += dl;
                            if (seen) { const float al = __builtin_amdgcn_exp2f(-dl); lsum[s2] *= al;
#pragma unroll
                                for (int d = 0; d < 2; ++d)
#pragma unroll
                                    for (int ii = 0; ii < 16; ++ii) O[s2][d][ii] *= al; }
#pragma unroll
                            for (int kb = 0; kb < 2; ++kb)
#pragma unroll
                                for (int ii = 0; ii < 16; ++ii) Sq[kb][ii] -= dl;
                            const float nm = -m[s2];
#pragma unroll
                            for (int ii = 0; ii < 16; ++ii) negM[s2][ii] = nm; }
                        float rs = 0.f;
#pragma unroll
                        for (int kb = 0; kb < 2; ++kb)
#pragma unroll
                            for (int ii = 0; ii < 16; ++ii) { const float p = __builtin_amdgcn_exp2f(Sq[kb][ii]); Sq[kb][ii] = p; rs += p; }
                        lsum[s2] += rs;
#pragma unroll
                        for (int kb = 0; kb < 2; ++kb)
#pragma unroll
                            for (int ss = 0; ss < 2; ++ss) { u32x4 pw;
                                pw.x = pg8::cvt_pk_bf16(Sq[kb][8 * ss + 0], Sq[kb][8 * ss + 1]); pw.y = pg8::cvt_pk_bf16(Sq[kb][8 * ss + 2], Sq[kb][8 * ss + 3]);
                                pw.z = pg8::cvt_pk_bf16(Sq[kb][8 * ss + 4], Sq[kb][8 * ss + 5]); pw.w = pg8::cvt_pk_bf16(Sq[kb][8 * ss + 6], Sq[kb][8 * ss + 7]);
                                pf[s2][kb * 2 + ss] = __builtin_bit_cast(bf16x8, pw); }
                        __builtin_amdgcn_sched_barrier(0);
                    }
                    const int li = lane & 15, lg = lane >> 4;
                    const LAS unsigned char* vbase = Vt + (4 * (lg >> 1) + (li >> 2)) * 128 + (16 * (lg & 1) + 4 * (li & 3)) * 2;
#pragma unroll
                    for (int d = 0; d < 2; ++d)
#pragma unroll
                        for (int st = 0; st < 4; ++st) {
                            const s16x4 v0 = ds_tr16(vbase + (st * 16) * 128 + d * 64), v1 = ds_tr16(vbase + (st * 16 + 8) * 128 + d * 64);
                            const bf16x8 vf = (bf16x8){v0[0], v0[1], v0[2], v0[3], v1[0], v1[1], v1[2], v1[3]};
                            O[0][d] = __builtin_amdgcn_mfma_f32_32x32x16_bf16(vf, pf[0][st], O[0][d], 0, 0, 0);
                            O[1][d] = __builtin_amdgcn_mfma_f32_32x32x16_bf16(vf, pf[1][st], O[1][d], 0, 0, 0);
                            if (st & 1) __builtin_amdgcn_sched_barrier(0);
                        }
                    seen = true;
                }
                VM_WAIT();
                __syncthreads();
            }
            LAS float* xo = (LAS float*)F.lds + rw * 4096; LAS float* xm = (LAS float*)(F.lds + 65536) + rw * 256;
            if (!seen) { m[0] = -1e30f; m[1] = -1e30f; }
            if (ksel) {
#pragma unroll
                for (int s2 = 0; s2 < 2; ++s2) { xm[s2 * 64 + lane] = m[s2]; xm[128 + s2 * 64 + lane] = lsum[s2];
#pragma unroll
                    for (int d = 0; d < 2; ++d)
#pragma unroll
                        for (int ii = 0; ii < 16; ++ii) xo[((s2 * 2 + d) * 16 + ii) * 64 + lane] = O[s2][d][ii]; }
            }
            __syncthreads();
            if (!ksel) {
                float inv[2];
#pragma unroll
                for (int s2 = 0; s2 < 2; ++s2) { const float mb = xm[s2 * 64 + lane], lb = xm[128 + s2 * 64 + lane]; const float mn = fmaxf(m[s2], mb), aa = __builtin_amdgcn_exp2f(m[s2] - mn), ab = __builtin_amdgcn_exp2f(mb - mn);
                    float lt = lsum[s2] * aa + lb * ab; lt += __shfl_xor(lt, 32); inv[s2] = 1.f / lt;
#pragma unroll
                    for (int d = 0; d < 2; ++d)
#pragma unroll
                        for (int ii = 0; ii < 16; ++ii) O[s2][d][ii] = (O[s2][d][ii] * aa + xo[((s2 * 2 + d) * 16 + ii) * 64 + lane] * ab) * inv[s2]; }
                int r_ = r, hh_ = hh; asm volatile("" : "+v"(r_), "+v"(hh_));
                ArgsP a = kargs();
                const float* lp = a->in[9] + (size_t)l * 128 + r_; float s1 = (lane < 32) ? lp[0] * lp[32] : 0.f, s3 = (lane < 32) ? lp[64] * lp[96] : 0.f;
                s1 = wave_sum(s1); s3 = wave_sum(s3);
                const float lam_init = 0.8f - 0.6f * __expf(-0.3f * (float)l), lam = __expf(s1) - __expf(s3) + lam_init;
                const float* gn = a->in[10] + (size_t)l * 256 + head * 64 + 4 * hh_;
                float ss = 0.f;
#pragma unroll
                for (int d = 0; d < 2; ++d)
#pragma unroll
                    for (int ii = 0; ii < 16; ++ii) { const float o = O[0][d][ii] - lam * O[1][d][ii]; O[0][d][ii] = o; ss += o * o; }
                ss += __shfl_xor(ss, 32);
                const float rstd = rsqrtf(ss * (1.f / 64.f) + RMS_EPS) * (1.f - lam_init);
                bf16* yrow = Y + (size_t)(qrow + r_) * 256 + head * 64 + 4 * hh_;
#pragma unroll
                for (int d = 0; d < 2; ++d)
#pragma unroll
                    for (int g = 0; g < 4; ++g) { const f32x4 gg = *(const f32x4*)(gn + d * 32 + 8 * g); u32x2 o2;
                        o2.x = pk2(O[0][d][4 * g + 0] * rstd * gg.x, O[0][d][4 * g + 1] * rstd * gg.y); o2.y = pk2(O[0][d][4 * g + 2] * rstd * gg.z, O[0][d][4 * g + 3] * rstd * gg.w);
                        *(u32x2*)(yrow + d * 32 + 8 * g) = o2; }
            }
        }
    }
    __syncthreads();
}

using pg8::sigmoidf_;
constexpr int ML_CE = 0, ML_G = 1024, ML_SC = 2048;
__device__ __forceinline__ float logsigmoidf_(float f) { return f >= 0.f ? -log1pf(__expf(-f)) : f - log1pf(__expf(f)); }
__device__ __forceinline__ void ml_gates(const bf16* P, const float* ib, const float* fb, int c, int h, int lane, float& a_t, float& i_t) {
    const bf16* pr = P + (size_t)(c * 64 + lane) * PW;
    i_t = bf2f(pr[C_IB + h]) + ib[h]; a_t = logsigmoidf_(bf2f(pr[C_FB + h]) + fb[h]);
}
__device__ __forceinline__ float wave_scan_add(float v, int lane) {
#pragma unroll
    for (int o = 1; o < 64; o <<= 1) { const float u = __shfl_up(v, o); if (lane >= o) v += u; }
    return v;
}
__device__ __forceinline__ float wave_scan_max(float v, int lane) {
#pragma unroll
    for (int o = 1; o < 64; o <<= 1) { const float u = __shfl_up(v, o); if (lane >= o) v = fmaxf(v, u); }
    return v;
}
__device__ __forceinline__ void ml_phase1(Frame& F, int l) {
    ArgsP a = kargs(); const bf16* P = (const bf16*)(F.ws + WS_PU); float* mls = (float*)(F.ws + WS_MLS);
    const float* ib = a->in[5] + l * 4; const float* fb = a->in[6] + l * 4;
    for (int u = F.bid * 8 + F.wave; u < NCH * 4; u += F.G * 8) {
        const int c = u >> 2, h = u & 3; float at, it; ml_gates(P, ib, fb, c, h, F.lane, at, it);
        const float cum = wave_scan_add(at, F.lane), ce = __shfl(cum, 63), g = ce - cum + it, G = wave_max(g);
        if (F.lane == 0) { mls[ML_CE + u] = ce; mls[ML_G + u] = G; }
    }
}
__device__ __forceinline__ void ml_mscan(Frame& F, LAS float* mt, LAS float* tmp) {
    const float* mls = (const float*)(F.ws + WS_MLS);
    __syncthreads();
    for (int i = F.tid; i < 1024; i += 512) { tmp[i] = mls[ML_CE + i]; tmp[1024 + i] = mls[ML_G + i]; }
    __syncthreads();
    if (F.tid < 4) { float m = 0.f;
#pragma unroll 1
        for (int c0 = 0; c0 < NCH; c0 += 16) { float ce[16], g[16];
#pragma unroll
            for (int i = 0; i < 16; ++i) { ce[i] = tmp[(c0 + i) * 4 + F.tid]; g[i] = tmp[1024 + (c0 + i) * 4 + F.tid]; }
#pragma unroll
            for (int i = 0; i < 16; ++i) { mt[F.tid * 257 + c0 + i] = m; m = fmaxf(ce[i] + m, g[i]); } }
        mt[F.tid * 257 + 256] = m; }
    __syncthreads();
}
__device__ __forceinline__ void ml_stage_conv(const bf16* P, int col0, const float* cw, const float* cb, int row0, float sc, LAS float* dst, int tid) {
    const int t = tid >> 3, d0 = (tid & 7) * 8;
    float acc[8];
#pragma unroll
    for (int i = 0; i < 8; ++i) acc[i] = cb[d0 + i];
#pragma unroll
    for (int j = 0; j < 4; ++j) { const int r = row0 + t - 3 + j;
        if (r >= 0) { const u32x4 x = *(const u32x4*)(P + (size_t)r * PW + col0 + d0); const float* w = cw + j * 512 + d0;
            acc[0] += w[0] * bflo(x.x); acc[1] += w[1] * bfhi(x.x); acc[2] += w[2] * bflo(x.y); acc[3] += w[3] * bfhi(x.y);
            acc[4] += w[4] * bflo(x.z); acc[5] += w[5] * bfhi(x.z); acc[6] += w[6] * bflo(x.w); acc[7] += w[7] * bfhi(x.w); } }
#pragma unroll
    for (int i = 0; i < 8; ++i) dst[t * 65 + d0 + i] = acc[i] * sigmoidf_(acc[i]) * sc;
}
__device__ __forceinline__ void ml_stage_plain(const bf16* P, int col0, int row0, const LAS float* rs, LAS float* dst, int tid) {
    const int t = tid >> 3, d0 = (tid & 7) * 8; const float sc = rs ? rs[t] : 1.f;
    const u32x4 x = *(const u32x4*)(P + (size_t)(row0 + t) * PW + col0 + d0); LAS float* d = dst + t * 65 + d0;
    d[0] = bflo(x.x) * sc; d[1] = bfhi(x.x) * sc; d[2] = bflo(x.y) * sc; d[3] = bfhi(x.y) * sc; d[4] = bflo(x.z) * sc; d[5] = bfhi(x.z) * sc; d[6] = bflo(x.w) * sc; d[7] = bfhi(x.w) * sc;
}
__device__ __forceinline__ void ml_phase3(Frame& F, int l) {
    ArgsP a = kargs(); const bf16* P = (const bf16*)(F.ws + WS_PU); float* mls = (float*)(F.ws + WS_MLS);
    float* dC = (float*)(F.ws + WS_MLC); float* dn = (float*)(F.ws + WS_MLN);
    const float* ib = a->in[5] + l * 4; const float* fb = a->in[6] + l * 4; const float* cw = a->in[3] + (size_t)l * 2048; const float* cb = a->in[4] + (size_t)l * 512;
    LAS float* Kl = (LAS float*)F.lds; LAS float* Vl = Kl + 64 * 65; LAS float* srcL = Vl + 64 * 65; LAS float* mt = srcL + 64; LAS float* tmp = mt + 4 * 257 + 4;
    ml_mscan(F, mt, tmp);
    const int lane = F.lane, w = F.wave, li = lane & 15, kq = lane >> 4, bi = w >> 1, bj0 = (w & 1) * 2;
    for (int u = F.bid; u < NCH * 4; u += F.G) {
        const int c = u >> 2, h = u & 3; const float m0 = mt[h * 257 + c], m1 = mt[h * 257 + c + 1];
        __syncthreads();
        if (w == 0) { float at, it; ml_gates(P, ib, fb, c, h, lane, at, it); const float cum = wave_scan_add(at, lane), ce = __shfl(cum, 63);
            srcL[lane] = __expf(ce - cum + it - m1); if (lane == 0) mls[ML_SC + u] = __expf(ce + m0 - m1); }
        const u32x4 vx = *(const u32x4*)(P + (size_t)(c * 64 + (F.tid >> 3)) * PW + C_VB + h * 64 + (F.tid & 7) * 8);
        ml_stage_conv(P, C_KB + h * 64, cw + 256 + h * 64, cb + 256 + h * 64, c * 64, 0.125f, Kl, F.tid);
        __syncthreads();
        { const int t = F.tid >> 3, d0 = (F.tid & 7) * 8; const float sc = srcL[t]; LAS float* d = Vl + t * 65 + d0;
          d[0] = bflo(vx.x) * sc; d[1] = bfhi(vx.x) * sc; d[2] = bflo(vx.y) * sc; d[3] = bfhi(vx.y) * sc; d[4] = bflo(vx.z) * sc; d[5] = bfhi(vx.z) * sc; d[6] = bflo(vx.w) * sc; d[7] = bfhi(vx.w) * sc; }
        __syncthreads();
        f32x4 acc0 = {0.f, 0.f, 0.f, 0.f}, acc1 = {0.f, 0.f, 0.f, 0.f};
#pragma unroll 4
        for (int k0 = 0; k0 < 64; k0 += 4) { const float av = Vl[(k0 + kq) * 65 + bi * 16 + li];
            acc0 = MFMA_F32(av, Kl[(k0 + kq) * 65 + bj0 * 16 + li], acc0); acc1 = MFMA_F32(av, Kl[(k0 + kq) * 65 + (bj0 + 1) * 16 + li], acc1); }
        float* o = dC + (size_t)u * 4096 + (bi * 16 + kq * 4) * 64 + li;
#pragma unroll
        for (int r = 0; r < 4; ++r) { o[r * 64 + bj0 * 16] = acc0[r]; o[r * 64 + (bj0 + 1) * 16] = acc1[r]; }
        { const int t = F.tid >> 3, s8 = (F.tid & 7) * 8; float sacc = 0.f;
#pragma unroll
          for (int i = 0; i < 8; ++i) sacc += srcL[s8 + i] * Kl[(s8 + i) * 65 + t];
          sacc += __shfl_xor(sacc, 1); sacc += __shfl_xor(sacc, 2); sacc += __shfl_xor(sacc, 4);
          if ((F.tid & 7) == 0) dn[(size_t)u * 64 + t] = sacc; }
    }
    __syncthreads();
}
__device__ __forceinline__ void ml_phase4(Frame& F) {
    float* dC = (float*)(F.ws + WS_MLC); float* dn = (float*)(F.ws + WS_MLN); const float* sc = (const float*)(F.ws + WS_MLS) + ML_SC;
    float* base; size_t stride; int h;
    if (F.wave == 0) { const int e = F.bid * 64 + F.lane; if (e >= 16384) return; h = e >> 12; base = dC + (size_t)h * 4096 + (e & 4095); stride = 4 * 4096; }
    else if (F.wave == 1 && F.bid < 4) { h = F.bid; base = dn + (size_t)h * 64 + F.lane; stride = 4 * 64; }
    else return;
    float st = 0.f;
    for (int c0 = 0; c0 < NCH; c0 += 8) {
        float v[8], g[8];
#pragma unroll
        for (int i = 0; i < 8; ++i) { v[i] = base[(size_t)(c0 + i) * stride]; g[i] = sc[(c0 + i) * 4 + h]; }
#pragma unroll
        for (int i = 0; i < 8; ++i) { base[(size_t)(c0 + i) * stride] = st; st = g[i] * st + v[i]; }
    }
}
__device__ __forceinline__ void ml_phase5(Frame& F, int l) {
    ArgsP a = kargs(); const bf16* P = (const bf16*)(F.ws + WS_PU);
    const float* Cst = (const float*)(F.ws + WS_MLC); const float* nst = (const float*)(F.ws + WS_MLN);
    const float* ib = a->in[5] + l * 4; const float* fb = a->in[6] + l * 4; const float* cw = a->in[3] + (size_t)l * 2048; const float* cb = a->in[4] + (size_t)l * 512;
    const float* gn = a->in[7] + (size_t)l * 256;
    bf16* Y = (bf16*)(F.ws + WS_Y) + (size_t)1 * S * 256;
    LAS float* Ql = (LAS float*)F.lds; LAS float* Kl = Ql + 64 * 65; LAS float* Vl = Kl + 64 * 65; LAS float* Cl = Vl + 64 * 65; LAS float* Wl = Cl + 64 * 65;
    LAS float* cumL = Wl + 64 * 65; LAS float* bL = cumL + 64; LAS float* mtL = bL + 64; LAS float* inL = mtL + 64; LAS float* nL = inL + 64; LAS float* denL = nL + 64;
    LAS float* mt = denL + 64; LAS float* tmp = mt + 4 * 257 + 4;
    ml_mscan(F, mt, tmp);
    const int lane = F.lane, w = F.wave, li = lane & 15, kq = lane >> 4, bi = w >> 1, bj0 = (w & 1) * 2;
    for (int u = F.bid; u < NCH * 4; u += F.G) {
        const int c = u >> 2, h = u & 3; const float m0 = mt[h * 257 + c];
        const u32x4 ov = *(const u32x4*)(P + (size_t)(c * 64 + (F.tid >> 3)) * PW + C_OB + h * 64 + (F.tid & 7) * 8);
        const f32x4 g0 = *(const f32x4*)(gn + h * 64 + (F.tid & 7) * 8), g1 = *(const f32x4*)(gn + h * 64 + (F.tid & 7) * 8 + 4);
        __syncthreads();
        if (w == 0) { float at, it; ml_gates(P, ib, fb, c, h, lane, at, it); const float cum = wave_scan_add(at, lane);
            const float bb = it - cum, pm = wave_scan_max(bb, lane), mtt = fmaxf(cum + m0, cum + pm);
            cumL[lane] = cum; bL[lane] = bb; mtL[lane] = mtt; inL[lane] = __expf(cum + m0 - mtt); nL[lane] = nst[(size_t)u * 64 + lane]; }
        ml_stage_conv(P, C_QB + h * 64, cw + h * 64, cb + h * 64, c * 64, 1.f, Ql, F.tid);
        ml_stage_conv(P, C_KB + h * 64, cw + 256 + h * 64, cb + 256 + h * 64, c * 64, 0.125f, Kl, F.tid);
        ml_stage_plain(P, C_VB + h * 64, c * 64, nullptr, Vl, F.tid);
        { const int t = F.tid >> 3, d0 = (F.tid & 7) * 8; const f32x4 c0 = *(const f32x4*)(Cst + (size_t)u * 4096 + t * 64 + d0), c1 = *(const f32x4*)(Cst + (size_t)u * 4096 + t * 64 + d0 + 4);
          LAS float* d = Cl + t * 65 + d0; d[0] = c0.x; d[1] = c0.y; d[2] = c0.z; d[3] = c0.w; d[4] = c1.x; d[5] = c1.y; d[6] = c1.z; d[7] = c1.w; }
        __syncthreads();
        {
            f32x4 acc0 = {0.f, 0.f, 0.f, 0.f}, acc1 = {0.f, 0.f, 0.f, 0.f};
#pragma unroll 4
            for (int k0 = 0; k0 < 64; k0 += 4) { const float av = Ql[(bi * 16 + li) * 65 + k0 + kq];
                acc0 = MFMA_F32(av, Kl[(bj0 * 16 + li) * 65 + k0 + kq], acc0); acc1 = MFMA_F32(av, Kl[((bj0 + 1) * 16 + li) * 65 + k0 + kq], acc1); }
#pragma unroll
            for (int r = 0; r < 4; ++r) { const int t = bi * 16 + kq * 4 + r; const float ct = cumL[t] - mtL[t];
                { const int s2 = bj0 * 16 + li; Wl[t * 65 + s2] = (s2 <= t) ? __expf(ct + bL[s2]) * acc0[r] : 0.f; }
                { const int s2 = (bj0 + 1) * 16 + li; Wl[t * 65 + s2] = (s2 <= t) ? __expf(ct + bL[s2]) * acc1[r] : 0.f; } }
        }
        __syncthreads();
        { const int t = F.tid >> 3, k8 = (F.tid & 7) * 8; float qn = 0.f, sw = 0.f;
#pragma unroll
            for (int k = 0; k < 8; ++k) { qn += Ql[t * 65 + k8 + k] * nL[k8 + k]; sw += Wl[t * 65 + k8 + k]; }
            qn += __shfl_xor(qn, 1); sw += __shfl_xor(sw, 1); qn += __shfl_xor(qn, 2); sw += __shfl_xor(sw, 2); qn += __shfl_xor(qn, 4); sw += __shfl_xor(sw, 4);
            if ((F.tid & 7) == 0) { const float den = inL[t] * qn + sw; denL[t] = 1.f / fmaxf(fabsf(den), __expf(-mtL[t])); } }
        f32x4 acc0 = {0.f, 0.f, 0.f, 0.f}, acc1 = {0.f, 0.f, 0.f, 0.f};
#pragma unroll 4
        for (int k0 = 0; k0 < 64; k0 += 4) { const float av = Ql[(bi * 16 + li) * 65 + k0 + kq];
            acc0 = MFMA_F32(av, Cl[(bj0 * 16 + li) * 65 + k0 + kq], acc0); acc1 = MFMA_F32(av, Cl[((bj0 + 1) * 16 + li) * 65 + k0 + kq], acc1); }
#pragma unroll
        for (int r = 0; r < 4; ++r) { const float it = inL[bi * 16 + kq * 4 + r]; acc0[r] *= it; acc1[r] *= it; }
#pragma unroll 4
        for (int k0 = 0; k0 < 64; k0 += 4) { const float av = Wl[(bi * 16 + li) * 65 + k0 + kq];
            acc0 = MFMA_F32(av, Vl[(k0 + kq) * 65 + bj0 * 16 + li], acc0); acc1 = MFMA_F32(av, Vl[(k0 + kq) * 65 + (bj0 + 1) * 16 + li], acc1); }
        __syncthreads();
#pragma unroll
        for (int r = 0; r < 4; ++r) { const int t = bi * 16 + kq * 4 + r; const float dv = denL[t]; Wl[t * 65 + bj0 * 16 + li] = acc0[r] * dv; Wl[t * 65 + (bj0 + 1) * 16 + li] = acc1[r] * dv; }
        __syncthreads();
        { const int t = F.tid >> 3, d0 = (F.tid & 7) * 8; float hv[8], ss = 0.f;
#pragma unroll
          for (int i = 0; i < 8; ++i) { hv[i] = Wl[t * 65 + d0 + i]; ss += hv[i] * hv[i]; }
          ss += __shfl_xor(ss, 1); ss += __shfl_xor(ss, 2); ss += __shfl_xor(ss, 4);
          const float rstd = rsqrtf(ss * (1.f / 64.f) + RMS_EPS);
          const float g[8] = {g0.x, g0.y, g0.z, g0.w, g1.x, g1.y, g1.z, g1.w};
          const float o0 = sigmoidf_(bflo(ov.x)), o1 = sigmoidf_(bfhi(ov.x)), o2 = sigmoidf_(bflo(ov.y)), o3 = sigmoidf_(bfhi(ov.y)), o4 = sigmoidf_(bflo(ov.z)), o5 = sigmoidf_(bfhi(ov.z)), o6 = sigmoidf_(bflo(ov.w)), o7 = sigmoidf_(bfhi(ov.w));
          u32x4 y; y.x = pk2(o0 * hv[0] * rstd * g[0], o1 * hv[1] * rstd * g[1]); y.y = pk2(o2 * hv[2] * rstd * g[2], o3 * hv[3] * rstd * g[3]);
          y.z = pk2(o4 * hv[4] * rstd * g[4], o5 * hv[5] * rstd * g[5]); y.w = pk2(o6 * hv[6] * rstd * g[6], o7 * hv[7] * rstd * g[7]);
          *(u32x4*)(Y + (size_t)(c * 64 + t) * 256 + h * 64 + d0) = y; }
    }
    __syncthreads();
}


constexpr int DSA_CAP = 2048, DSA_TRIG = 1024, QHP = 260, DSA_TU = 10496;
__device__ __forceinline__ u32x2 ld_list(const u32x2* p) { const unsigned long long v = __hip_atomic_load((const unsigned long long*)p, __ATOMIC_RELAXED, __HIP_MEMORY_SCOPE_AGENT); return (u32x2){(unsigned)v, (unsigned)(v >> 32)}; }

__device__ __forceinline__ unsigned wave_prefix_incl(unsigned v) {
    v += (unsigned)__builtin_amdgcn_update_dpp(0, (int)v, 0x111, 0xf, 0xf, false);
    v += (unsigned)__builtin_amdgcn_update_dpp(0, (int)v, 0x112, 0xf, 0xf, false);
    v += (unsigned)__builtin_amdgcn_update_dpp(0, (int)v, 0x114, 0xf, 0xf, false);
    v += (unsigned)__builtin_amdgcn_update_dpp(0, (int)v, 0x118, 0xf, 0xf, false);
    v += (unsigned)__builtin_amdgcn_update_dpp(0, (int)v, 0x142, 0xa, 0xf, false);
    v += (unsigned)__builtin_amdgcn_update_dpp(0, (int)v, 0x143, 0xc, 0xf, false);
    return v;
}
__device__ __forceinline__ float relu_bits(float v) { const int b = __builtin_bit_cast(int, v); return __builtin_bit_cast(float, b > 0 ? b : 0); }
__device__ __forceinline__ unsigned sortable(float v) { const unsigned b = __builtin_bit_cast(unsigned, v); return (b & 0x80000000u) ? ~b : (b | 0x80000000u); }
__device__ __forceinline__ unsigned lanes_below(unsigned long long m) { return __builtin_amdgcn_mbcnt_hi((unsigned)(m >> 32), __builtin_amdgcn_mbcnt_lo((unsigned)m, 0u)); }

__device__ __forceinline__ unsigned dsa_bin(unsigned sv) {
    const bool pos = (sv >> 31) != 0u; const unsigned mag = (pos ? sv : ~sv) & 0x7fffffffu; int t = (int)(mag >> 19) - 1904; t = t < 0 ? 0 : (t > 255 ? 255 : t);
    return pos ? 256u + (unsigned)t : 255u - (unsigned)t;
}
__device__ __forceinline__ unsigned dsa_bin_f(float v) {
    const unsigned b = __builtin_bit_cast(unsigned, v); int t = (int)((b >> 19) & 0xfffu) - 1904; t = t < 0 ? 0 : (t > 255 ? 255 : t);
    return (unsigned)(256 + (t ^ ((int)b >> 31)));
}
__device__ __forceinline__ unsigned dsa_bin_T(unsigned B) {
    if (B >= 257u) return (0x80000000u | ((1904u + (B - 256u)) << 19)) - 1u;
    if (B == 256u) return 0x7fffffffu;
    if (B == 0u) return 0u;
    const unsigned t = 255u - B, mag = ((1905u + t) << 19) - 1u; return (0x7fffffffu - mag) - 1u;
}
__device__ __forceinline__ unsigned dsa_hist_T(const LAS unsigned* qh, int lane) {
    const int grp = 63 - lane;
    const u32x4 h = *(const LAS u32x4*)(qh + 4 * grp);
    const unsigned c[8] = {h.x & 0xffffu, h.x >> 16, h.y & 0xffffu, h.y >> 16, h.z & 0xffffu, h.z >> 16, h.w & 0xffffu, h.w >> 16};
    unsigned tl = 0u;
#pragma unroll
    for (int i = 0; i < 8; ++i) tl += c[i];
    const unsigned suf = wave_prefix_incl(tl);
    const unsigned above = suf - tl; const bool mine = (above < 256u) && (256u <= suf);
    unsigned B = 0u;
    if (mine) { unsigned cc = above; B = 8u * grp;
#pragma unroll
        for (int i = 7; i >= 0; --i) { cc += c[i]; if (cc >= 256u) { B = 8u * grp + i; break; } } }
    const unsigned long long mm = __ballot(mine); if (!mm) return 0u;
    B = (unsigned)__builtin_amdgcn_readlane((int)B, (int)__builtin_ctzll(mm));
    return dsa_bin_T(B);
}
__device__ __forceinline__ void dsa_hist_T4(const LAS unsigned* qh0, LAS unsigned* T4, int lane, bool want) {
    const int qq = lane >> 4, g = 15 - (lane & 15);
    const LAS unsigned* qh = qh0 + qq * QHP + 16 * g;
    const u32x4 h0 = *(const LAS u32x4*)qh, h1 = *(const LAS u32x4*)(qh + 4), h2 = *(const LAS u32x4*)(qh + 8), h3 = *(const LAS u32x4*)(qh + 12);
    const unsigned s0 = h0.x + h0.y + h0.z + h0.w, s1 = h1.x + h1.y + h1.z + h1.w, s2 = h2.x + h2.y + h2.z + h2.w, s3 = h3.x + h3.y + h3.z + h3.w;
    const unsigned t0 = (s0 & 0xffffu) + (s0 >> 16), t1 = (s1 & 0xffffu) + (s1 >> 16), t2 = (s2 & 0xffffu) + (s2 >> 16), t3 = (s3 & 0xffffu) + (s3 >> 16);
    const unsigned tl = t0 + t1 + t2 + t3;
    unsigned v = tl;
    v += (unsigned)__builtin_amdgcn_update_dpp(0, (int)v, 0x111, 0xf, 0xf, false);
    v += (unsigned)__builtin_amdgcn_update_dpp(0, (int)v, 0x112, 0xf, 0xf, false);
    v += (unsigned)__builtin_amdgcn_update_dpp(0, (int)v, 0x114, 0xf, 0xf, false);
    v += (unsigned)__builtin_amdgcn_update_dpp(0, (int)v, 0x118, 0xf, 0xf, false);
    const unsigned above = v - tl;
    if (want && above < 256u && 256u <= v) {
        const unsigned c3 = above + t3, c2 = c3 + t2, c1 = c2 + t1;
        const bool s3 = c3 >= 256u, s2 = !s3 && c2 >= 256u, s1 = !s3 && !s2 && c1 >= 256u;
        const unsigned cc0 = s3 ? above : (s2 ? c3 : (s1 ? c2 : c1)), base = s3 ? 24u : (s2 ? 16u : (s1 ? 8u : 0u));
        u32x4 hq; hq.x = s3 ? h3.x : (s2 ? h2.x : (s1 ? h1.x : h0.x)); hq.y = s3 ? h3.y : (s2 ? h2.y : (s1 ? h1.y : h0.y)); hq.z = s3 ? h3.z : (s2 ? h2.z : (s1 ? h1.z : h0.z)); hq.w = s3 ? h3.w : (s2 ? h2.w : (s1 ? h1.w : h0.w));
        const unsigned c[8] = {hq.x & 0xffffu, hq.x >> 16, hq.y & 0xffffu, hq.y >> 16, hq.z & 0xffffu, hq.z >> 16, hq.w & 0xffffu, hq.w >> 16};
        unsigned run = cc0, B = 32u * g + base, cc = 0u, cB = 0u; bool found = false;
#pragma unroll
        for (int i = 7; i >= 0; --i) { run += c[i]; const bool hit = !found && run >= 256u; B = hit ? 32u * g + base + (unsigned)i : B; cc = hit ? run : cc; cB = hit ? c[i] : cB; found = found || hit; }
        if (!found) { cc = run; cB = 0u; }
        const unsigned T = dsa_bin_T(B); if (T > T4[qq]) { T4[qq] = T; T4[DSA_TU + qq] = (B >= 511u || T4[DSA_TU + 32 + qq] != 0u) ? 0xffffffffu : dsa_bin_T(B + 1u); }
    }
}
template <int NPASS, class KF, class PF>
__device__ __forceinline__ unsigned radix_kth(int n, KF key, PF pred, unsigned& want, LAS unsigned* hist, int lane) {
    unsigned prefix = 0u, himask = 0u;
#pragma unroll 1
    for (int p = 0; p < NPASS; ++p) {
        const int shift = 8 * (NPASS - 1 - p);
        *(LAS u32x4*)(hist + 4 * lane) = (u32x4){0u, 0u, 0u, 0u};
        asm volatile("s_waitcnt lgkmcnt(0)" ::: "memory");
#pragma unroll 4
        for (int i = lane; i < n; i += 64) { const unsigned k = key(i); if (pred(i) && ((k ^ prefix) & himask) == 0u) (void)__hip_atomic_fetch_add(hist + ((k >> shift) & 255u), 1u, __ATOMIC_RELAXED, __HIP_MEMORY_SCOPE_WORKGROUP); }
        asm volatile("s_waitcnt lgkmcnt(0)" ::: "memory");
        const int grp = 63 - lane;
        const u32x4 h = *(LAS u32x4*)(hist + 4 * grp);
        const unsigned tl = h.x + h.y + h.z + h.w; const unsigned suf = wave_prefix_incl(tl);
        const unsigned above = suf - tl;
        const bool mine = (above < want) && (want <= suf);
        unsigned D = 0u, nw = 0u;
        if (mine) { unsigned c = above;
            if (c + h.w >= want) { D = 4 * grp + 3; nw = want - c; } else { c += h.w;
            if (c + h.z >= want) { D = 4 * grp + 2; nw = want - c; } else { c += h.z;
            if (c + h.y >= want) { D = 4 * grp + 1; nw = want - c; } else { c += h.y; D = 4 * grp; nw = want - c; } } } }
        const unsigned long long mm = __ballot(mine); const int src = mm ? (int)__builtin_ctzll(mm) : 0;
        D = (unsigned)__builtin_amdgcn_readlane((int)D, src); nw = (unsigned)__builtin_amdgcn_readlane((int)nw, src);
        prefix |= D << shift; himask |= 0xffu << shift; want = nw;
    }
    return prefix;
}
__device__ __forceinline__ void dsa_prune(u32x2* list, LAS unsigned* nq, LAS unsigned* Tq, int q, LAS u32x2* st, LAS unsigned* hist, int lane, bool exact, unsigned tmin) {
    const int n0 = (int)nq[q]; int n = 0;
#pragma unroll 1
    for (int i0 = 0; i0 < n0; i0 += 256) {
        u32x2 t8[4];
#pragma unroll
        for (int u = 0; u < 4; ++u) { const int i = i0 + u * 64 + lane; t8[u] = (i < n0) ? ld_list(list + i) : (u32x2){0u, 0u}; }
#pragma unroll
        for (int u = 0; u < 4; ++u) { const int i = i0 + u * 64 + lane; const bool k = (i < n0) && t8[u].x > tmin;
            const unsigned long long m = __ballot(k); if (k) st[n + (int)lanes_below(m)] = t8[u]; n += (int)__popcll(m); } }
    asm volatile("s_waitcnt vmcnt(0) lgkmcnt(0)" ::: "memory");
    if (n <= 256) {
#pragma unroll 1
        for (int i = lane; i < n; i += 64) list[i] = st[i];
        if (lane == 0) { nq[q] = (unsigned)n; Tq[DSA_TU + q] = 0xffffffffu; Tq[DSA_TU + 32 + q] = 1u; if (tmin > Tq[q]) Tq[q] = tmin; }
        asm volatile("s_waitcnt vmcnt(0)" ::: "memory");
        return;
    }
    if (!exact) {
        unsigned want = 256u;
        const unsigned Th = radix_kth<2>(n, [st](int i) { return st[i].x >> 16; }, [](int) { return true; }, want, hist, lane);
        unsigned cnt_ge = 0u;
#pragma unroll 1
        for (int i0 = 0; i0 < n; i0 += 64) { const int i = i0 + lane; cnt_ge += (unsigned)__popcll(__ballot(i < n && (st[i].x >> 16) >= Th)); }
        if (cnt_ge <= 512u && Th > 0u) {
            unsigned base = 0u;
#pragma unroll 1
            for (int i0 = 0; i0 < n; i0 += 64) { const int i = i0 + lane; const u32x2 t = (i < n) ? st[i] : (u32x2){0u, 0u};
                const bool keep = (i < n) && (t.x >> 16) >= Th;
                const unsigned long long m = __ballot(keep); if (keep) list[base + lanes_below(m)] = t; base += (unsigned)__popcll(m); }
            if (lane == 0) { nq[q] = base; const unsigned tn = (Th << 16) - 1u; Tq[q] = tn > tmin ? tn : tmin; Tq[DSA_TU + q] = 0xffffffffu; Tq[DSA_TU + 32 + q] = 1u; }
            asm volatile("s_waitcnt vmcnt(0)" ::: "memory");
            return;
        }
    }
    unsigned want = 256u;
    const unsigned Ts = radix_kth<4>(n, [st](int i) { return st[i].x; }, [](int) { return true; }, want, hist, lane);
    unsigned cnt_eq = 0u;
#pragma unroll 1
    for (int i0 = 0; i0 < n; i0 += 64) { const int i = i0 + lane; cnt_eq += (unsigned)__popcll(__ballot(i < n && st[i].x == Ts)); }
    unsigned Tk = 0u;
    if (cnt_eq > want) Tk = radix_kth<2>(n, [st](int i) { return 0x3fffu - st[i].y; }, [st, Ts](int i) { return st[i].x == Ts; }, want, hist, lane);
    unsigned base = 0u;
#pragma unroll 1
    for (int i0 = 0; i0 < n; i0 += 64) { const int i = i0 + lane; const u32x2 t = (i < n) ? st[i] : (u32x2){0u, 0u};
        const bool keep = (i < n) && (t.x > Ts || (t.x == Ts && (0x3fffu - t.y) >= Tk));
        const unsigned long long m = __ballot(keep); if (keep) list[base + lanes_below(m)] = t; base += (unsigned)__popcll(m); }
    if (lane == 0) { nq[q] = base; Tq[q] = Ts; Tq[DSA_TU + q] = 0xffffffffu; Tq[DSA_TU + 32 + q] = 1u; }
    asm volatile("s_waitcnt vmcnt(0)" ::: "memory");
}
__device__ __forceinline__ int dsa_final(const u32x2* list, int n0, unsigned tmin, unsigned tup, LAS u32x2* st, LAS unsigned* hist, LAS unsigned* bmp, int lane) {
    int n = 0, cin = 0;
#pragma unroll 1
    for (int i0 = 0; i0 < n0; i0 += 512) {
        u32x4 t4[4];
#pragma unroll
        for (int u = 0; u < 4; ++u) { const int i = i0 + u * 128 + 2 * lane; t4[u] = (i < n0) ? *(const u32x4*)(list + i) : (u32x4){0u, 0u, 0u, 0u}; }
#pragma unroll
        for (int u = 0; u < 4; ++u) { const int i = i0 + u * 128 + 2 * lane;
            { const bool in = (i < n0) && t4[u].x > tup, k = (i < n0) && t4[u].x > tmin && !in;
              if (in) (void)__hip_atomic_fetch_or(bmp + (t4[u].y >> 5), 1u << (t4[u].y & 31u), __ATOMIC_RELAXED, __HIP_MEMORY_SCOPE_WORKGROUP);
              cin += (int)__popcll(__ballot(in));
              const unsigned long long m = __ballot(k); if (k) st[n + (int)lanes_below(m)] = (u32x2){t4[u].x, t4[u].y}; n += (int)__popcll(m); }
            { const bool in = (i + 1 < n0) && t4[u].z > tup, k = (i + 1 < n0) && t4[u].z > tmin && !in;
              if (in) (void)__hip_atomic_fetch_or(bmp + (t4[u].w >> 5), 1u << (t4[u].w & 31u), __ATOMIC_RELAXED, __HIP_MEMORY_SCOPE_WORKGROUP);
              cin += (int)__popcll(__ballot(in));
              const unsigned long long m = __ballot(k); if (k) st[n + (int)lanes_below(m)] = (u32x2){t4[u].z, t4[u].w}; n += (int)__popcll(m); } }
    }
    asm volatile("s_waitcnt lgkmcnt(0)" ::: "memory");
    const int quota = cin < 256 ? 256 - cin : 0;
    unsigned Ts = 0u, Tk = 0u;
    if (n > quota) {
        unsigned want = (unsigned)quota;
        Ts = radix_kth<4>(n, [st](int i) { return st[i].x; }, [](int) { return true; }, want, hist, lane);
        unsigned cnt_eq = 0u;
#pragma unroll 1
        for (int i0 = 0; i0 < n; i0 += 64) { const int i = i0 + lane; cnt_eq += (unsigned)__popcll(__ballot(i < n && st[i].x == Ts)); }
        if (cnt_eq > want) Tk = radix_kth<2>(n, [st](int i) { return 0x3fffu - st[i].y; }, [st, Ts](int i) { return st[i].x == Ts; }, want, hist, lane);
    }
    int cnt = cin;
#pragma unroll 1
    for (int i0 = 0; i0 < n; i0 += 64) { const int i = i0 + lane; const u32x2 t = (i < n) ? st[i] : (u32x2){0u, 0u};
        const bool keep = (i < n) && (n <= quota || t.x > Ts || (t.x == Ts && (0x3fffu - t.y) >= Tk));
        if (keep) (void)__hip_atomic_fetch_or(bmp + (t.y >> 5), 1u << (t.y & 31u), __ATOMIC_RELAXED, __HIP_MEMORY_SCOPE_WORKGROUP);
        cnt += (int)__popcll(__ballot(keep)); }
    asm volatile("s_waitcnt lgkmcnt(0)" ::: "memory");
    return cnt;
}
__device__ __forceinline__ void dsa_unit(Frame& F, int G32) {
    const bf16* P = (const bf16*)(F.ws + WS_PU);
    bf16* Y = (bf16*)(F.ws + WS_Y);
    u32x2* cand = (u32x2*)(F.ws + WS_CAND) + (size_t)F.bid * 32 * DSA_CAP;
    const int lane = F.lane, w = F.wave, r = lane & 31, hh = lane >> 5;
    LAS unsigned char* wscr = F.lds + w * 12288;
    LAS unsigned* Tq = (LAS unsigned*)(F.lds + 98304); LAS unsigned* nq = Tq + 32;
    LAS unsigned* hist = (LAS unsigned*)(F.lds + 98816 + w * 1024);
    LAS unsigned* qhist = (LAS unsigned*)(F.lds + 107008);
    const int q0 = G32 * 32, c = G32 >> 1, nt = c + 1, nrounds = (nt + 7) >> 3;
    __syncthreads();
    if (F.tid < 32) { Tq[F.tid] = 0u; Tq[DSA_TU + F.tid] = 0xffffffffu; Tq[DSA_TU + 32 + F.tid] = 0u; nq[F.tid] = 0u; nq[32 + F.tid] = 0u; nq[64 + F.tid] = 0u; }
#pragma unroll
    for (int k = 0; k < 4; ++k) *(LAS u32x4*)(qhist + F.tid * 4 + k * 2048) = (u32x4){0u, 0u, 0u, 0u};
    if (F.tid < 32) *(LAS u32x4*)(qhist + 8192 + F.tid * 4) = (u32x4){0u, 0u, 0u, 0u};
    bf16x8 Qf[4][2]; float wh[4];
    { const bf16* qp = P + (size_t)(q0 + r) * PW;
#pragma unroll
      for (int h = 0; h < 4; ++h) { wh[h] = bf2f(qp[C_WI + h]);
#pragma unroll
          for (int kk = 0; kk < 2; ++kk) Qf[h][kk] = *(const bf16x8*)(qp + C_QI + h * 32 + kk * 16 + 8 * hh); } }
    bf16x8 Kf[2][2];
    { const int jf = (nrounds - (nrounds < 3 ? nrounds : 3)) * 8 + w; const int j0 = jf < nt ? jf : 0;
#pragma unroll
      for (int kb = 0; kb < 2; ++kb)
#pragma unroll
          for (int kk = 0; kk < 2; ++kk) Kf[kb][kk] = *(const bf16x8*)(P + (size_t)(j0 * 64 + kb * 32 + r) * PW + C_KI + kk * 16 + 8 * hh); }
    __syncthreads();
    LAS unsigned* nlast = nq + 32;
    const int R0 = nrounds < 3 ? nrounds : 3, nvr = nrounds + R0;
    asm volatile(".p2align 8" ::: "memory");
    for (int vr = 0; vr < nvr; ++vr) {
        const int rd = vr < R0 ? nrounds - R0 + vr : vr - R0;
        const int mode = vr < R0 ? 0 : (rd >= nrounds - R0 ? 2 : 1);
        const int j = rd * 8 + w;
        int rr = r; asm volatile("" : "+v"(rr));
        u32x2* myl = cand + (size_t)rr * DSA_CAP;
        if (j < nt) {
            f32x16 acc[2];
#pragma unroll
            for (int h = 0; h < 4; ++h)
#pragma unroll
                for (int kb = 0; kb < 2; ++kb) { f32x16 sv;
#pragma unroll
                    for (int i = 0; i < 16; ++i) sv[i] = 0.f;
                    sv = __builtin_amdgcn_mfma_f32_32x32x16_bf16(Kf[kb][0], Qf[h][0], sv, 0, 0, 0); sv = __builtin_amdgcn_mfma_f32_32x32x16_bf16(Kf[kb][1], Qf[h][1], sv, 0, 0, 0);
                    const f32x2 w2 = (f32x2){wh[h], wh[h]};
#pragma unroll
                    for (int i = 0; i < 16; i += 2) { const f32x2 rl = (f32x2){relu_bits(sv[i]), relu_bits(sv[i + 1])};
                        const f32x2 a2 = (h == 0) ? __builtin_elementwise_fma(w2, rl, (f32x2){0.f, 0.f}) : __builtin_elementwise_fma(w2, rl, (f32x2){acc[kb][i], acc[kb][i + 1]});
                        acc[kb][i] = a2.x; acc[kb][i + 1] = a2.y; } }
            LAS unsigned* myv = (LAS unsigned*)wscr + lane * 36;
            unsigned pm = 0u;
            if (mode == 0) {
#pragma unroll
                for (int kb = 0; kb < 2; ++kb)
#pragma unroll
                    for (int g = 0; g < 4; ++g) { const unsigned b0 = dsa_bin_f(acc[kb][4 * g]), b1 = dsa_bin_f(acc[kb][4 * g + 1]), b2 = dsa_bin_f(acc[kb][4 * g + 2]), b3 = dsa_bin_f(acc[kb][4 * g + 3]); LAS unsigned* qh = qhist + rr * QHP;
                        (void)__hip_atomic_fetch_add(qh + (b0 >> 1), 1u << (16u * (b0 & 1u)), __ATOMIC_RELAXED, __HIP_MEMORY_SCOPE_WORKGROUP); (void)__hip_atomic_fetch_add(qh + (b1 >> 1), 1u << (16u * (b1 & 1u)), __ATOMIC_RELAXED, __HIP_MEMORY_SCOPE_WORKGROUP);
                        (void)__hip_atomic_fetch_add(qh + (b2 >> 1), 1u << (16u * (b2 & 1u)), __ATOMIC_RELAXED, __HIP_MEMORY_SCOPE_WORKGROUP); (void)__hip_atomic_fetch_add(qh + (b3 >> 1), 1u << (16u * (b3 & 1u)), __ATOMIC_RELAXED, __HIP_MEMORY_SCOPE_WORKGROUP); }
            } else {
                unsigned T1 = Tq[rr]; T1 = T1 == 0xffffffffu ? T1 : T1 + 1u; T1 = T1 < 0x007fffffu ? 0x007fffffu : T1;
                const float Tf = __builtin_bit_cast(float, (T1 & 0x80000000u) ? (T1 & 0x7fffffffu) : ~T1);
#define DSA_C2(n) "v_cmp_ge_f32 vcc, %" #n ", %9\n\tv_addc_co_u32 %0, vcc, %0, %0, vcc\n\t"
#pragma unroll
                for (int e8 = 3; e8 >= 0; --e8) { const int kb = e8 >> 1, o8 = (e8 & 1) * 8;
                    asm(DSA_C2(8) DSA_C2(7) DSA_C2(6) DSA_C2(5) DSA_C2(4) DSA_C2(3) DSA_C2(2) DSA_C2(1) : "+v"(pm)
                        : "v"(acc[kb][o8]), "v"(acc[kb][o8 + 1]), "v"(acc[kb][o8 + 2]), "v"(acc[kb][o8 + 3]), "v"(acc[kb][o8 + 4]), "v"(acc[kb][o8 + 5]), "v"(acc[kb][o8 + 6]), "v"(acc[kb][o8 + 7]), "v"(Tf) : "vcc"); }
#undef DSA_C2
#pragma unroll
                for (int kb = 0; kb < 2; ++kb)
#pragma unroll
                    for (int g = 0; g < 4; ++g) *(LAS f32x4*)(myv + kb * 16 + 4 * g) = (f32x4){acc[kb][4 * g], acc[kb][4 * g + 1], acc[kb][4 * g + 2], acc[kb][4 * g + 3]};
            }
            asm volatile("s_waitcnt lgkmcnt(0)" ::: "memory");
            if (__any(pm != 0u)) {
                unsigned pos1 = 0u;
                if (pm) pos1 = __hip_atomic_fetch_add(nq + rr, (unsigned)__popc(pm), __ATOMIC_RELAXED, __HIP_MEMORY_SCOPE_WORKGROUP);
                while (__any(pm != 0u)) {
                    if (pm) { const int e = __builtin_ctz(pm); pm &= pm - 1u; const unsigned sv1 = sortable(__builtin_bit_cast(float, myv[e]));
                        if (mode == 1) { const unsigned bn = dsa_bin(sv1); (void)__hip_atomic_fetch_add(qhist + rr * QHP + (bn >> 1), 1u << (16u * (bn & 1u)), __ATOMIC_RELAXED, __HIP_MEMORY_SCOPE_WORKGROUP); }
                        myl[pos1++] = (u32x2){sv1, (unsigned)(j * 64 + (e >> 4) * 32 + (e & 3) + 8 * ((e & 15) >> 2) + 4 * hh)}; }
                }
            }
        }
        { const int nv = vr + 1, nrd = nv < R0 ? nrounds - R0 + nv : nv - R0; int jn = nrd * 8 + w; if (jn >= nt || nv >= nvr) jn = (j < nt ? j : 0);
#pragma unroll
          for (int kb = 0; kb < 2; ++kb)
#pragma unroll
              for (int kk = 0; kk < 2; ++kk) Kf[kb][kk] = *(const bf16x8*)(P + (size_t)(jn * 64 + kb * 32 + r) * PW + C_KI + kk * 16 + 8 * hh); }
        LAS unsigned* oflag = nq + 64;
        { const int q = w * 4 + (lane >> 4); const unsigned n = nq[q]; const bool over = n > (unsigned)DSA_TRIG;
          if (__any(over)) { if (lane == 0) oflag[0] = 1u; }
          const bool want = !over && !(mode == 1 && n < nlast[q] + 1u);
          if (__any(want)) { if (want && (lane & 15) == 0) nlast[q] = n;
              dsa_hist_T4(qhist + (w * 4) * QHP, Tq + w * 4, lane, want); } }
        __syncthreads();
        if (oflag[0]) {
            asm volatile("s_waitcnt vmcnt(0)" ::: "memory");
            __syncthreads();
#pragma unroll 1
            for (int qq = 0; qq < 4; ++qq) { const int q = w * 4 + qq; const unsigned n = nq[q];
                if (n > (unsigned)DSA_TRIG) {
                    const unsigned Th = dsa_hist_T(qhist + q * QHP, lane);
                    dsa_prune(cand + (size_t)q * DSA_CAP, nq, Tq, q, (LAS u32x2*)wscr, hist, lane, false, Th > Tq[q] ? Th : Tq[q]);
                    const int n2 = (int)nq[q]; LAS unsigned* qh = qhist + q * QHP;
                    *(LAS u32x4*)(qh + 4 * lane) = (u32x4){0u, 0u, 0u, 0u};
                    asm volatile("s_waitcnt lgkmcnt(0)" ::: "memory");
#pragma unroll 1
                    for (int i = lane; i < n2; i += 64) { const unsigned bn = dsa_bin(ld_list(cand + (size_t)q * DSA_CAP + i).x); (void)__hip_atomic_fetch_add(qh + (bn >> 1), 1u << (16u * (bn & 1u)), __ATOMIC_RELAXED, __HIP_MEMORY_SCOPE_WORKGROUP); }
                    __builtin_amdgcn_fence(__ATOMIC_ACQUIRE, "agent");
                    asm volatile("s_waitcnt vmcnt(0) lgkmcnt(0)" ::: "memory");
                    if (lane == 0) nlast[q] = (unsigned)n2;
                } }
            __syncthreads();
            if (F.tid == 0) oflag[0] = 0u;
            __syncthreads();
        }
    }
    asm volatile("s_waitcnt vmcnt(0)" ::: "memory");
    __syncthreads();
    dsa_hist_T4(qhist + (w * 4) * QHP, Tq + w * 4, lane, true);
    __syncthreads();
#pragma unroll 1
    for (int qq = 0; qq < 4; ++qq) {
        const int q = w * 4 + qq, qrow = q0 + q; const int n0 = (int)nq[q];
        LAS unsigned* bmp = (LAS unsigned*)(F.lds + 107008 + w * 2048);
        *(LAS u32x4*)(bmp + 8 * lane) = (u32x4){0u, 0u, 0u, 0u}; *(LAS u32x4*)(bmp + 8 * lane + 4) = (u32x4){0u, 0u, 0u, 0u};
        asm volatile("s_waitcnt lgkmcnt(0)" ::: "memory");
        const int n = dsa_final(cand + (size_t)q * DSA_CAP, n0, n0 > 256 ? Tq[q] : 0u, n0 > 256 ? Tq[DSA_TU + q] : 0u, (LAS u32x2*)wscr, hist, bmp, lane);
        unsigned short* srow = (unsigned short*)(F.ws + WS_SEL) + (size_t)qrow * 256;
        { const u32x4 b0 = *(LAS u32x4*)(bmp + 8 * lane), b1 = *(LAS u32x4*)(bmp + 8 * lane + 4); const unsigned wd[8] = {b0.x, b0.y, b0.z, b0.w, b1.x, b1.y, b1.z, b1.w};
          unsigned cnt = 0u;
#pragma unroll
          for (int i = 0; i < 8; ++i) cnt += (unsigned)__popc(wd[i]);
          unsigned pos = wave_prefix_incl(cnt) - cnt;
#pragma unroll
          for (int i = 0; i < 8; ++i) { unsigned wv = wd[i]; while (wv) { const int bpos = __builtin_ctz(wv); srow[pos < 255u ? pos : 255u] = (unsigned short)(lane * 256 + i * 32 + bpos); ++pos; wv &= wv - 1u; } } }
        if (lane == 0) ((int*)(F.ws + WS_NSEL))[qrow] = n < 256 ? n : 256;
    }
    asm volatile("s_waitcnt vmcnt(0)" ::: "memory");
}
__device__ __forceinline__ void dsa_pack_phase(Frame& F) {
    const bf16* P = (const bf16*)(F.ws + WS_PU); unsigned char* T8 = F.ws + WS_KV8;
    for (int t = F.bid * 512 + F.tid; t < S * 32; t += F.G * 512) {
        const int row = t >> 5, ch = t & 31;
        const bf16* src = P + (size_t)row * PW + C_KA + ch * 16;
        const u32x4 a0 = *(const u32x4*)src, a1 = *(const u32x4*)(src + 8);
        u32x4 o; int v;
        v = __builtin_amdgcn_cvt_pk_fp8_f32(bflo(a0.x), bfhi(a0.x), 0, false); v = __builtin_amdgcn_cvt_pk_fp8_f32(bflo(a0.y), bfhi(a0.y), v, true); o.x = (unsigned)v;
        v = __builtin_amdgcn_cvt_pk_fp8_f32(bflo(a0.z), bfhi(a0.z), 0, false); v = __builtin_amdgcn_cvt_pk_fp8_f32(bflo(a0.w), bfhi(a0.w), v, true); o.y = (unsigned)v;
        v = __builtin_amdgcn_cvt_pk_fp8_f32(bflo(a1.x), bfhi(a1.x), 0, false); v = __builtin_amdgcn_cvt_pk_fp8_f32(bflo(a1.y), bfhi(a1.y), v, true); o.z = (unsigned)v;
        v = __builtin_amdgcn_cvt_pk_fp8_f32(bflo(a1.z), bfhi(a1.z), 0, false); v = __builtin_amdgcn_cvt_pk_fp8_f32(bflo(a1.w), bfhi(a1.w), v, true); o.w = (unsigned)v;
        *(u32x4*)(T8 + (size_t)row * 512 + ch * 16) = o;
    }
}
__device__ __forceinline__ void dsa_sparse_unit(Frame& F, int G32) {
    const bf16* P = (const bf16*)(F.ws + WS_PU); bf16* Y = (bf16*)(F.ws + WS_Y);
    const int lane = F.lane, w = F.wave, q0 = G32 * 32;
    int n_nx; unsigned long long id_nx; u32x4 a0_nx, a1_nx;
#define SP_PREF(qrow_) do { int l3 = lane; asm volatile("" : "+v"(l3)); n_nx = ((const int*)(F.ws + WS_NSEL))[qrow_]; id_nx = ((const unsigned long long*)((const unsigned short*)(F.ws + WS_SEL) + (size_t)(qrow_) * 256))[l3]; \
        a0_nx = *(const u32x4*)(P + (size_t)(qrow_) * PW + C_QA + (l3 & 15) * 16); a1_nx = *(const u32x4*)(P + (size_t)(qrow_) * PW + C_QA + (l3 & 15) * 16 + 8); } while (0)
    SP_PREF(q0 + w * 4);
#pragma unroll 1
    for (int qq = 0; qq < 4; ++qq) {
        int l2 = lane; asm volatile("" : "+v"(l2)); const int ks = l2 >> 4, dg = l2 & 15;
        const int q = w * 4 + qq, qrow = q0 + q; const int n = n_nx;
        LAS unsigned short* srt = (LAS unsigned short*)(F.lds + w * 1024 + (qq & 1) * 512);
        ((LAS unsigned long long*)srt)[lane] = id_nx;
        const u32x4 a0 = a0_nx, a1 = a1_nx;
        if (qq < 3) SP_PREF(qrow + 1);
        asm volatile("s_waitcnt lgkmcnt(0)" ::: "memory");
        f32x2 qv[8];
        { const float sc = 0.125f * 1.4426950408889634f;
          qv[0] = (f32x2){bflo(a0.x) * sc, bfhi(a0.x) * sc}; qv[1] = (f32x2){bflo(a0.y) * sc, bfhi(a0.y) * sc}; qv[2] = (f32x2){bflo(a0.z) * sc, bfhi(a0.z) * sc}; qv[3] = (f32x2){bflo(a0.w) * sc, bfhi(a0.w) * sc};
          qv[4] = (f32x2){bflo(a1.x) * sc, bfhi(a1.x) * sc}; qv[5] = (f32x2){bflo(a1.y) * sc, bfhi(a1.y) * sc}; qv[6] = (f32x2){bflo(a1.z) * sc, bfhi(a1.z) * sc}; qv[7] = (f32x2){bflo(a1.w) * sc, bfhi(a1.w) * sc}; }
        float mrun = -1e30f, lrun = 0.f; f32x2 o[8];
#pragma unroll
        for (int i = 0; i < 8; ++i) o[i] = (f32x2){0.f, 0.f};
        const int nb = (n + 31) >> 5;
        const unsigned char* T8 = F.ws + WS_KV8 + dg * 16;
        asm volatile(".p2align 8" ::: "memory");
#pragma unroll 1
        for (int bt = 0; bt < nb; ++bt) {
            u32x4 kk[8], vv[8]; bool val[8];
#pragma unroll
            for (int t = 0; t < 8; ++t) { const int jn = bt * 32 + t * 4 + ks; val[t] = jn < n; const unsigned sid = (unsigned)srt[jn & 255]; const unsigned idx = val[t] ? sid : 0u;
                const unsigned char* kp = T8 + (size_t)idx * 512; kk[t] = *(const u32x4*)kp; vv[t] = *(const u32x4*)(kp + 256); }
            float d[8];
#pragma unroll
            for (int t = 0; t < 8; ++t) { f32x2 d2 = (f32x2){0.f, 0.f};
#pragma unroll
                for (int c4 = 0; c4 < 4; ++c4) { const int wd = (int)kk[t][c4]; const f32x2 lo = __builtin_amdgcn_cvt_pk_f32_fp8(wd, false), hi = __builtin_amdgcn_cvt_pk_f32_fp8(wd, true);
                    d2 = __builtin_elementwise_fma(qv[2 * c4], lo, d2); d2 = __builtin_elementwise_fma(qv[2 * c4 + 1], hi, d2); }
                float dd = d2.x + d2.y;
                dd += __builtin_bit_cast(float, __builtin_amdgcn_update_dpp(0, __builtin_bit_cast(int, dd), 0xB1, 0xf, 0xf, false));
                dd += __builtin_bit_cast(float, __builtin_amdgcn_update_dpp(0, __builtin_bit_cast(int, dd), 0x4E, 0xf, 0xf, false));
                d[t] = val[t] ? dd : -1e30f; }
            const float dm = fmaxf(fmaxf(fmaxf(d[0], d[1]), fmaxf(d[2], d[3])), fmaxf(fmaxf(d[4], d[5]), fmaxf(d[6], d[7])));
            if (__any(dm > mrun + 8.f)) { const float mn = fmaxf(mrun, dm), al = __builtin_amdgcn_exp2f(mrun - mn); mrun = mn; lrun *= al;
#pragma unroll
                for (int i = 0; i < 8; ++i) o[i] *= al; }
            float p[8];
#pragma unroll
            for (int t = 0; t < 8; ++t) { p[t] = val[t] ? __builtin_amdgcn_exp2f(d[t] - mrun) : 0.f; lrun += p[t]; }
#pragma unroll
            for (int t = 0; t < 8; ++t) { const f32x2 p2 = (f32x2){p[t], p[t]};
#pragma unroll
                for (int c4 = 0; c4 < 4; ++c4) { const int wd = (int)vv[t][c4]; const f32x2 lo = __builtin_amdgcn_cvt_pk_f32_fp8(wd, false), hi = __builtin_amdgcn_cvt_pk_f32_fp8(wd, true);
                    o[2 * c4] = __builtin_elementwise_fma(p2, lo, o[2 * c4]); o[2 * c4 + 1] = __builtin_elementwise_fma(p2, hi, o[2 * c4 + 1]); } }
        }
        { float ma = fmaxf(mrun, __shfl_xor(mrun, 16)); ma = fmaxf(ma, __shfl_xor(ma, 32)); const float al = __builtin_amdgcn_exp2f(mrun - ma);
          lrun *= al; lrun += __shfl_xor(lrun, 16); lrun += __shfl_xor(lrun, 32); const float iv = 1.f / lrun;
#pragma unroll
          for (int i = 0; i < 8; ++i) { float t = o[i].x * al; t += __shfl_xor(t, 16); t += __shfl_xor(t, 32); o[i].x = t * iv; t = o[i].y * al; t += __shfl_xor(t, 16); t += __shfl_xor(t, 32); o[i].y = t * iv; } }
        if (ks == 0) { u32x4 y0, y1; y0.x = pk2(o[0].x, o[0].y); y0.y = pk2(o[1].x, o[1].y); y0.z = pk2(o[2].x, o[2].y); y0.w = pk2(o[3].x, o[3].y); y1.x = pk2(o[4].x, o[4].y); y1.y = pk2(o[5].x, o[5].y); y1.z = pk2(o[6].x, o[6].y); y1.w = pk2(o[7].x, o[7].y);
            *(u32x4*)(Y + (size_t)qrow * 256 + dg * 16) = y0; *(u32x4*)(Y + (size_t)qrow * 256 + dg * 16 + 8) = y1; }
    }
}
__device__ __forceinline__ void dsa_phase(Frame& F) {
#pragma unroll 1
    for (int i2 = F.bid * 2; i2 < 512; i2 += F.G * 2)
#pragma unroll 1
        for (int rep = 0; rep < 2; ++rep) dsa_unit(F, rep ? 511 - (i2 >> 1) : (i2 >> 1));
    __syncthreads();
}
__device__ __forceinline__ void dsa_sparse_phase(Frame& F) {
#pragma unroll 1
    for (int i2 = F.bid * 2; i2 < 512; i2 += F.G * 2)
#pragma unroll 1
        for (int rep = 0; rep < 2; ++rep) dsa_sparse_unit(F, rep ? 511 - (i2 >> 1) : (i2 >> 1));
}

__device__ __forceinline__ void phase_mixers_stub(Frame& F) {
    u32x4* y = (u32x4*)(F.ws + WS_Y); const size_t n = (size_t)1 * S * 256 * 2 / 16;
    for (size_t i = (size_t)F.bid * 512 + F.tid; i < n; i += (size_t)F.G * 512) y[i] = (u32x4){0u, 0u, 0u, 0u};
}

__device__ __forceinline__ Frame mkframe() {
    Frame F; int t = threadIdx.x; asm volatile("" : "+v"(t));
    extern __shared__ __attribute__((aligned(16))) unsigned char lds_raw[];
    F.lds = (LAS unsigned char*)lds_raw; F.ws = kargs()->ws; F.ctl = (unsigned*)(F.ws + WS_CTL);
    F.tid = t; F.lane = t & 63; F.wave = __builtin_amdgcn_readfirstlane(t >> 6); F.G = gridDim.x; F.bid = blockIdx.x;
    return F;
}
__device__ __forceinline__ void grid_barrier() {
    extern __shared__ __attribute__((aligned(16))) unsigned char lds_raw[];
    XcdBarrier b; b.bar = (unsigned*)(kargs()->ws + WS_CTL) + CW_BAR; b.x = xb_xcc_id(); b.st = (volatile LAS unsigned*)((LAS unsigned char*)lds_raw + MISC_OFF) + 8;
    xcd_barrier(b);
}
constexpr int NSEG = 14;
#ifndef SEGMASK
#define SEGMASK 0xffff
#endif
template <int l> __device__ __forceinline__ void layer_body() {
#if MK_MULTI
#define RUN(k) (((SEGMASK >> (k)) & 1) && (l * NSEG + (k)) >= kargs()->seg_lo && (l * NSEG + (k)) < kargs()->seg_hi)
#define SEAM(k) do { } while (0)
#else
#define RUN(k) ((SEGMASK >> (k)) & 1)
#define SEAM(k) grid_barrier()
#endif
    {
        if (RUN(0) && l == 0) {
            Frame F = mkframe();
            phase_convert(F, l, 0, CVT_A);
            if (l == 0) { const int gw = F.bid * 8 + F.wave, NGW = F.G * 8; const float* x0 = kargs()->in[0]; const float* g0 = kargs()->in[1];
#pragma unroll 2
                for (int m = gw; m < S; m += NGW) rms_row_to_bf16(x0 + (size_t)m * D, g0, (bf16*)(F.ws + WS_H) + (size_t)m * D, F.lane); }
        }
        if (l == 0) SEAM(0);
        if (RUN(1)) {
            Frame F = mkframe();
            pg8::Gemm g{(const bf16*)(F.ws + WS_H), (const bf16*)(F.ws + WS_WIN), S, PW, 1024}; pg8::StaticOrder So; So.init(S, PW, F.G, F.bid);
            pg8::EpiStore E{(bf16*)(F.ws + WS_PU), PW, 0x7fffffff, F.ws + WS_KV8};
            pg8::gemm_phase<pg8::EpiStore, pg8::StaticOrder, true, true>(F.lds, g, So, E, F.tid);
        }
        SEAM(1);
        if (RUN(2)) { Frame F = mkframe(); ml_phase1(F, l); }
        if (RUN(2)) { Frame F = mkframe(); attn_phase<0>(F, l); }
        SEAM(2);
        if (RUN(3)) { Frame F = mkframe(); ml_phase3(F, l); }
        if (RUN(3)) { Frame F = mkframe(); attnD_phase(F, l); }
        SEAM(3);
        if (RUN(4)) { Frame F = mkframe(); ml_phase4(F); }
        if (RUN(4)) { Frame F = mkframe(); dsa_phase(F); }
        if (RUN(4)) { Frame F = mkframe(); dsa_sparse_phase(F); }
        SEAM(4);
        if (RUN(5)) { Frame F = mkframe(); ml_phase5(F, l); }
        SEAM(5);
        if (RUN(6)) {
            Frame F = mkframe();
            pg8::Gemm g{(const bf16*)(F.ws + WS_Y), (const bf16*)(F.ws + WS_WBR), 4 * S, 4096, 256}; pg8::SchedUp Su{F.G, F.bid};
            pg8::EpiStore E{(bf16*)(F.ws + WS_PU), 4096, 63, nullptr};
            pg8::gemm_phase<pg8::EpiStore, pg8::SchedUp, true, true>(F.lds, g, Su, E, F.tid);
        }
        SEAM(6);
        if (RUN(7)) {
            Frame F = mkframe();
            pg8::Gemm g{(const bf16*)(F.ws + WS_H), (const bf16*)(F.ws + WS_WGATE), S, 4096, 1024}; pg8::StaticOrder So; So.init(S, 4096, F.G, F.bid);
            pg8::EpiGateMix E{(const bf16*)(F.ws + WS_PU), (bf16*)(F.ws + WS_MIXED)};
            pg8::gemm_phase<pg8::EpiGateMix, pg8::StaticOrder, true, true>(F.lds, g, So, E, F.tid);
        }
        SEAM(7);
        if (RUN(8)) {
            Frame F = mkframe();
            pg8::Gemm g{(const bf16*)(F.ws + WS_MIXED), (const bf16*)(F.ws + WS_WOUT), S, 1024, 1024}; pg8::StaticOrder So; So.init(S, 1024, F.G, F.bid);
            pg8::EpiResid<(l > 0)> E{(l == 0) ? (const void*)kargs()->in[0] : (const void*)kargs()->out, (bf16*)(F.ws + WS_XS)};
            pg8::gemm_phase<pg8::EpiResid<(l > 0)>, pg8::StaticOrder, true, true>(F.lds, g, So, E, F.tid);
        }
        SEAM(8);
        if (RUN(9)) { Frame F = mkframe(); phase_router(F, l, (const bf16*)(F.ws + WS_XS)); }
        SEAM(9);
        if (RUN(10)) { Frame F = mkframe(); phase_scatter(F, l); __syncthreads(); phase_convert(F, l, CVT_A, CVT_B); }
        SEAM(10);
        if (RUN(11)) {
            Frame F = mkframe();
            const LAS int* tab = (const LAS int*)(F.lds + LDSCTL_OFF);
            pg8::Gemm g{(const bf16*)(F.ws + WS_H), (const bf16*)(F.ws + WS_W13), S, NE * 1024, 1024, (const int*)(F.ws + WS_RT + 589824)}; pg8::SchedMoe Sm{F.G, F.bid, __builtin_amdgcn_readfirstlane(tab[224]) * 4, tab};
            pg8::EpiSwiglu E{(bf16*)(F.ws + WS_ACT)};
            pg8::gemm_phase<pg8::EpiSwiglu, pg8::SchedMoe, true, true, true>(F.lds, g, Sm, E, F.tid);
            phase_convert(F, l, CVT_B, CVT_N);
        }
        SEAM(11);
        if (RUN(12)) {
            Frame F = mkframe();
            const LAS int* tab = (const LAS int*)(F.lds + LDSCTL_OFF);
            pg8::Gemm g{(const bf16*)(F.ws + WS_ACT), (const bf16*)(F.ws + WS_W2), NRMAX, NE * 1024, FE}; pg8::SchedMoe Sm{F.G, F.bid, __builtin_amdgcn_readfirstlane(tab[224]) * 4, tab};
            pg8::EpiDown E{(bf16*)(F.ws + WS_YE), (const float*)(F.ws + WS_RT + 393216)};
            pg8::gemm_phase<pg8::EpiDown, pg8::SchedMoe, true, true>(F.lds, g, Sm, E, F.tid);
        }
        SEAM(12);
        if (RUN(13)) { Frame F = mkframe(); phase_combine(F, l, (const bf16*)(F.ws + WS_XS), (void*)kargs()->out); }
        if (RUN(13) && l + 1 < NL) { Frame F = mkframe(); phase_convert(F, l + 1, 0, CVT_A); }
        if (l + 1 < NL) SEAM(13);
    }
#undef RUN
#undef SEAM
}
__global__ void __launch_bounds__(512, 2) fwd_kernel(Args args) {
    extern __shared__ __attribute__((aligned(16))) unsigned char lds_raw[];
    {
        LAS unsigned char* lds = (LAS unsigned char*)lds_raw;
        for (int u = threadIdx.x; u < (LDS_BYTES - LDSCTL_OFF) / 4; u += 512) ((LAS unsigned*)(lds + LDSCTL_OFF))[u] = 0u;
        __syncthreads();
        if (!MK_MULTI) (void)xcd_barrier_post((unsigned*)(kargs()->ws + WS_CTL) + CW_BAR, (volatile LAS unsigned*)(lds + MISC_OFF) + 8);
    }
    layer_body<0>();
    layer_body<1>();
}

extern "C" void kernel_launch(void* const* d_in, const int* in_sizes, int n_in, void* d_out, int out_size, void* d_ws, size_t ws_size, hipStream_t stream) {
    static int grid = 0;
    if (grid == 0) {
        if (n_in != 23 || out_size != S * D || ws_size < WS_END) { fprintf(stderr, "kernel_launch: unexpected shapes (n_in %d out %d ws %zu need %zu)\n", n_in, out_size, ws_size, (size_t)WS_END); grid = -1; return; }
        int dev = 0, cus = 0, per_cu = 0;
        if (hipGetDevice(&dev) != hipSuccess || hipDeviceGetAttribute(&cus, hipDeviceAttributeMultiprocessorCount, dev) != hipSuccess) { grid = -1; return; }
        if (hipFuncSetAttribute((const void*)fwd_kernel, hipFuncAttributeMaxDynamicSharedMemorySize, LDS_BYTES) != hipSuccess) { fprintf(stderr, "kernel_launch: hipFuncSetAttribute failed\n"); grid = -1; return; }
        if (hipOccupancyMaxActiveBlocksPerMultiprocessor(&per_cu, (const void*)fwd_kernel, 512, LDS_BYTES) != hipSuccess || per_cu < 1) fprintf(stderr, "kernel_launch: occupancy query says %d\n", per_cu);
        (void)hipGetLastError();
        grid = cus;
    }
    if (grid < 0) return;
    if (hipMemsetAsync((char*)d_ws + WS_CTL, 0, CTL_ZERO_BYTES, stream) != hipSuccess) return;
    Args a{};
    for (int i = 0; i < 23; ++i) a.in[i] = (const float*)d_in[i];
    a.out = (float*)d_out; a.ws = (unsigned char*)d_ws;
#if MK_MULTI
    for (int s = 0; s < NL * NSEG; ++s) { a.seg_lo = s; a.seg_hi = s + 1; hipLaunchKernelGGL(fwd_kernel, dim3(grid), dim3(512), LDS_BYTES, stream, a); }
#else
    a.seg_lo = 0; a.seg_hi = NL * NSEG;
    hipLaunchKernelGGL(fwd_kernel, dim3(grid), dim3(512), LDS_BYTES, stream, a);
#endif
}
```
